# Optimizing an MI355X kernel written in HIP

```python
import math
import jax
import jax.numpy as jnp
from jax import lax
import numpy as np

D_MODEL = 1024
BATCH = 8
SEQ = 4096
DEPTH = 2
DEC_BATCH = 32
DEC_SEQ = 32
PAST_LEN = 2048

CHUNK = 64
N_EVEN = (DEPTH + 1) // 2
N_ODD = DEPTH // 2
RMS_EPS = 1e-6
ROPE_THETA = 500000.0
NEG_INF = -1e30

SWA_HEADS = 8
SWA_KV_HEADS = 2
SWA_GROUP = SWA_HEADS // SWA_KV_HEADS
HEAD_DIM = 64
ROT_DIM = HEAD_DIM // 4
WINDOW = 128
WINDOW_CHUNKS = WINDOW // CHUNK
BAND = (WINDOW_CHUNKS + 1) * CHUNK
SWA_Q = SWA_HEADS * HEAD_DIM
SWA_KV = SWA_KV_HEADS * HEAD_DIM
SWA_SCALE = HEAD_DIM ** -0.5

S5_WIDTH = 512
S5_GROUP = 16
S5_GROUPS = S5_WIDTH // S5_GROUP
S5_STATE = 64

POOL_WIDTH = 512
POOL_WINDOWS = (2, 4, 8, 16)
POOL_GROUP = POOL_WIDTH // len(POOL_WINDOWS)
POOL_MAX = 16
POOL_BUF = POOL_MAX - 1

MLA_HEADS = 8
Q_LORA = 512
KV_LORA = 256
NOPE_DIM = 64
ROPE_DIM = 32
V_DIM = 64
Q_BLOCK = 128
MLA_SCALE = (NOPE_DIM + ROPE_DIM) ** -0.5

EVEN_IN = SWA_Q + 2 * SWA_KV + S5_WIDTH
EVEN_MIX = SWA_Q + S5_WIDTH
ODD_IN = Q_LORA + KV_LORA + ROPE_DIM + POOL_WIDTH
ODD_MIX = POOL_WIDTH + MLA_HEADS * V_DIM

PEER_HEADS = 8
N_KEYS = 128
N_EXPERTS = N_KEYS * N_KEYS
D_KEY = 128
D_HALF = D_KEY // 2
PEER_TOPK = 16
PEER_BLOCK = 256

kernel_name = 'hybrid_streaming_encoder_step'


def rmsnorm(x, g):
    xf = x.astype(jnp.float32)
    y = xf * lax.rsqrt(jnp.mean(xf * xf, axis=-1, keepdims=True) + RMS_EPS)
    return (y * g.astype(jnp.float32)).astype(x.dtype)


def rope(x, pos):
    r = x.shape[-1]
    inv = ROPE_THETA ** (-jnp.arange(0, r, 2, dtype=jnp.float32) / r)
    ang = pos.astype(jnp.float32)[:, None] * inv[None, :]
    cos = jnp.cos(ang)[:, None, :]
    sin = jnp.sin(ang)[:, None, :]
    xf = x.astype(jnp.float32)
    x1, x2 = xf[..., : r // 2], xf[..., r // 2:]
    return jnp.concatenate([x1 * cos - x2 * sin, x2 * cos + x1 * sin], axis=-1).astype(x.dtype)


def partial_rope(x, pos):
    return jnp.concatenate([rope(x[..., :ROT_DIM], pos), x[..., ROT_DIM:]], axis=-1)


def sink_softmax(s, sink):
    sk = sink.astype(jnp.float32).reshape(SWA_KV_HEADS, SWA_GROUP)[:, :, None, None]
    m = jnp.maximum(jnp.max(s, axis=-1, keepdims=True), sk)
    p = jnp.exp(s - m)
    return p / (jnp.sum(p, axis=-1, keepdims=True) + jnp.exp(sk - m))


def swa_attend_prompt(q, k, v, sink):
    b, s = q.shape[:2]
    nc = s // CHUNK
    qc = q.reshape(b, nc, CHUNK, SWA_KV_HEADS, SWA_GROUP, HEAD_DIM)
    pad = WINDOW_CHUNKS * CHUNK

    def band(t):
        tp = jnp.pad(t, ((0, 0), (pad, 0), (0, 0), (0, 0)))
        tp = tp.reshape(b, nc + WINDOW_CHUNKS, CHUNK, SWA_KV_HEADS, HEAD_DIM)
        return jnp.concatenate([tp[:, i:i + nc] for i in range(WINDOW_CHUNKS + 1)], axis=2)

    kb, vb = band(k), band(v)
    sc = jnp.einsum('bcqhgd,bckhd->bchgqk', qc, kb, preferred_element_type=jnp.float32) * SWA_SCALE
    key_pos = (jnp.arange(nc)[:, None] - WINDOW_CHUNKS) * CHUNK + jnp.arange(BAND)[None, :]
    sc = jnp.where((key_pos >= 0)[None, :, None, None, None, :], sc, NEG_INF)
    p = sink_softmax(sc, sink).astype(v.dtype)
    o = jnp.einsum('bchgqk,bckhd->bcqhgd', p, vb)
    return o.reshape(b, s, SWA_Q)


def swa_attend_sample(q, k_all, v_all, sink):
    b, t = q.shape[:2]
    qg = q.reshape(b, t, SWA_KV_HEADS, SWA_GROUP, HEAD_DIM)
    sc = jnp.einsum('bqhgd,bkhd->bhgqk', qg, k_all, preferred_element_type=jnp.float32) * SWA_SCALE
    p = sink_softmax(sc, sink).astype(v_all.dtype)
    o = jnp.einsum('bhgqk,bkhd->bqhgd', p, v_all)
    return o.reshape(b, t, SWA_Q)


def s5_scan(u, h0_re, h0_im, lam_re, lam_im, log_dt, b_re, b_im, c_re, c_im, d_skip):
    bsz, t = u.shape[:2]
    uf = u.astype(jnp.float32).reshape(bsz, t, S5_GROUPS, S5_GROUP)
    lr = jnp.minimum(lam_re.astype(jnp.float32), -1e-4)
    li = lam_im.astype(jnp.float32)
    dt = jnp.exp(log_dt.astype(jnp.float32))[:, None]
    mag = jnp.exp(lr * dt)
    ang = li * dt
    ab_re, ab_im = mag * jnp.cos(ang), mag * jnp.sin(ang)
    den = lr * lr + li * li
    nr, ni = ab_re - 1.0, ab_im
    f_re = (nr * lr + ni * li) / den
    f_im = (ni * lr - nr * li) / den
    br, bi = b_re.astype(jnp.float32), b_im.astype(jnp.float32)
    bb_re = f_re[..., None] * br - f_im[..., None] * bi
    bb_im = f_re[..., None] * bi + f_im[..., None] * br
    bu_re = jnp.einsum('btgc,gnc->btgn', uf, bb_re)
    bu_im = jnp.einsum('btgc,gnc->btgn', uf, bb_im)
    h0r, h0i = h0_re.astype(jnp.float32), h0_im.astype(jnp.float32)
    bu_re = bu_re.at[:, 0].add(ab_re * h0r - ab_im * h0i)
    bu_im = bu_im.at[:, 0].add(ab_re * h0i + ab_im * h0r)
    a_re = jnp.broadcast_to(ab_re, (1, t, S5_GROUPS, S5_STATE))
    a_im = jnp.broadcast_to(ab_im, (1, t, S5_GROUPS, S5_STATE))

    def combine(e1, e2):
        a1r, a1i, b1r, b1i = e1
        a2r, a2i, b2r, b2i = e2
        return (a2r * a1r - a2i * a1i, a2r * a1i + a2i * a1r,
                a2r * b1r - a2i * b1i + b2r, a2r * b1i + a2i * b1r + b2i)

    _, _, hr, hi = lax.associative_scan(combine, (a_re, a_im, bu_re, bu_im), axis=1)
    y = (jnp.einsum('btgn,gcn->btgc', hr, c_re.astype(jnp.float32))
         - jnp.einsum('btgn,gcn->btgc', hi, c_im.astype(jnp.float32))
         + d_skip.astype(jnp.float32).reshape(S5_GROUPS, S5_GROUP) * uf)
    return y.reshape(bsz, t, S5_WIDTH).astype(u.dtype), hr[:, -1], hi[:, -1]


def pool_mix(u, prev, pos, pool_w, pool_scale):
    t = u.shape[1]
    ext = jnp.concatenate([prev.astype(u.dtype), u], axis=1)
    extf = ext.astype(jnp.float32)
    cs = jnp.pad(jnp.cumsum(extf, axis=1), ((0, 0), (1, 0), (0, 0)))
    uf = u.astype(jnp.float32)
    outs = []
    for gi, w in enumerate(POOL_WINDOWS):
        sl = slice(gi * POOL_GROUP, (gi + 1) * POOL_GROUP)
        tot = cs[:, POOL_MAX:POOL_MAX + t, sl] - cs[:, POOL_MAX - w:POOL_MAX - w + t, sl]
        cnt = jnp.minimum(pos + 1, w).astype(jnp.float32)[None, :, None]
        outs.append(tot / cnt - uf[..., sl])
    m = jnp.stack(outs, axis=2)
    y = jnp.einsum('btgc,gcd->btgd', m, pool_w.astype(jnp.float32)).reshape(u.shape[0], t, POOL_WIDTH)
    y = y * pool_scale.astype(jnp.float32)
    return y.astype(u.dtype), ext[:, -POOL_BUF:]


def mla_block(qa, qp, c, kp, mask=None):
    s = (jnp.einsum('bthc,bsc->bhts', qa, c, preferred_element_type=jnp.float32)
         + jnp.einsum('bthr,bsr->bhts', qp, kp, preferred_element_type=jnp.float32)) * MLA_SCALE
    if mask is not None:
        s = jnp.where(mask[None, None], s, NEG_INF)
    p = jax.nn.softmax(s, axis=-1).astype(c.dtype)
    return jnp.einsum('bhts,bsc->bthc', p, c)


def mla_prompt(qa, qp, c, kp):
    b, s = qa.shape[:2]
    nb = s // Q_BLOCK
    kchunk = jnp.arange(s) // CHUNK
    qa_b = qa.reshape(b, nb, Q_BLOCK, MLA_HEADS, KV_LORA).swapaxes(0, 1)
    qp_b = qp.reshape(b, nb, Q_BLOCK, MLA_HEADS, ROPE_DIM).swapaxes(0, 1)

    def one(args):
        qa_i, qp_i, i = args
        qchunk = (i * Q_BLOCK + jnp.arange(Q_BLOCK)) // CHUNK
        mask = kchunk[None, :] <= qchunk[:, None]
        return mla_block(qa_i, qp_i, c, kp, mask)

    o = lax.map(one, (qa_b, qp_b, jnp.arange(nb)))
    return o.swapaxes(0, 1).reshape(b, s, MLA_HEADS, KV_LORA)


def even_mixer(hn, pos, k_prev, v_prev, hre_prev, him_prev, w_in, w_out, sink, lam_re, lam_im,
               log_dt, b_re, b_im, c_re, c_im, d_skip, w_glu, b_glu):
    b, t = hn.shape[:2]
    proj = hn @ w_in
    q = proj[..., :SWA_Q].reshape(b, t, SWA_HEADS, HEAD_DIM)
    k = proj[..., SWA_Q:SWA_Q + SWA_KV].reshape(b, t, SWA_KV_HEADS, HEAD_DIM)
    v = proj[..., SWA_Q + SWA_KV:SWA_Q + 2 * SWA_KV].reshape(b, t, SWA_KV_HEADS, HEAD_DIM)
    u = proj[..., SWA_Q + 2 * SWA_KV:]
    q = partial_rope(q, pos)
    k = partial_rope(k, pos)
    if k_prev is None:
        att = swa_attend_prompt(q, k, v, sink)
        k_all, v_all = k, v
        hre_prev = jnp.zeros((b, S5_GROUPS, S5_STATE), jnp.float32)
        him_prev = jnp.zeros((b, S5_GROUPS, S5_STATE), jnp.float32)
    else:
        k_all = jnp.concatenate([k_prev.astype(k.dtype), k], axis=1)
        v_all = jnp.concatenate([v_prev.astype(v.dtype), v], axis=1)
        att = swa_attend_sample(q, k_all, v_all, sink)
    y, hre, him = s5_scan(u, hre_prev, him_prev, lam_re, lam_im, log_dt, b_re, b_im, c_re, c_im, d_skip)
    z = jax.nn.gelu(y)
    s5o = z * jax.nn.sigmoid(z @ w_glu + b_glu)
    out = jnp.concatenate([att, s5o.astype(att.dtype)], axis=-1) @ w_out
    return out, k_all[:, -WINDOW:], v_all[:, -WINDOW:], hre, him


def odd_mixer(hn, pos, pool_prev, ckv_prev, kpe_prev, w_in, w_out, pool_w, pool_scale,
              q_norm, kv_norm, w_uq, w_uk, w_uv):
    b, t = hn.shape[:2]
    proj = hn @ w_in
    o0 = Q_LORA
    o1 = o0 + KV_LORA
    o2 = o1 + ROPE_DIM
    cq, ckv, kpe, u = proj[..., :o0], proj[..., o0:o1], proj[..., o1:o2], proj[..., o2:]
    if pool_prev is None:
        pool_prev = jnp.zeros((b, POOL_BUF, POOL_WIDTH), u.dtype)
    pool_out, pool_new = pool_mix(u, pool_prev, pos, pool_w, pool_scale)
    q = (rmsnorm(cq, q_norm) @ w_uq).reshape(b, t, MLA_HEADS, NOPE_DIM + ROPE_DIM)
    q_nope = q[..., :NOPE_DIM]
    q_pe = rope(q[..., NOPE_DIM:], pos)
    c = rmsnorm(ckv, kv_norm)
    kp = rope(kpe[:, :, None, :], pos)[:, :, 0]
    qa = jnp.einsum('bthn,chn->bthc', q_nope, w_uk)
    if ckv_prev is None:
        o_lat = mla_prompt(qa, q_pe, c, kp)
    else:
        c_all = jnp.concatenate([ckv_prev.astype(c.dtype), c], axis=1)
        kp_all = jnp.concatenate([kpe_prev.astype(kp.dtype), kp], axis=1)
        o_lat = mla_block(qa, q_pe, c_all, kp_all)
    mla_out = jnp.einsum('bthc,chv->bthv', o_lat, w_uv).reshape(b, t, MLA_HEADS * V_DIM)
    out = jnp.concatenate([pool_out, mla_out.astype(pool_out.dtype)], axis=-1) @ w_out
    return out, pool_new, c, kp


def peer(x, w_q, sub_keys, u_tab, v_tab):
    shp = x.shape
    xt = x.reshape(-1, D_MODEL)
    n = xt.shape[0]
    blk = min(PEER_BLOCK, n)
    n_pad = -(-n // blk) * blk
    xt = jnp.pad(xt, ((0, n_pad - n), (0, 0)))

    def one(xb):
        q = (xb @ w_q).reshape(blk, PEER_HEADS, 2, D_HALF)
        s = jnp.einsum('nhpd,hpkd->nhpk', q, sub_keys, preferred_element_type=jnp.float32)
        sv, si = lax.top_k(s, PEER_TOPK)
        cand = (sv[:, :, 0, :, None] + sv[:, :, 1, None, :]).reshape(blk, PEER_HEADS, PEER_TOPK * PEER_TOPK)
        cv, ci = lax.top_k(cand, PEER_TOPK)
        i1 = jnp.take_along_axis(si[:, :, 0], ci // PEER_TOPK, axis=-1)
        i2 = jnp.take_along_axis(si[:, :, 1], ci % PEER_TOPK, axis=-1)
        eid = i1 * N_KEYS + i2
        g = jax.nn.softmax(cv, axis=-1)
        act = jax.nn.gelu(jnp.einsum('nd,nhkd->nhk', xb, u_tab[eid], preferred_element_type=jnp.float32),
                          approximate=False)
        return jnp.einsum('nhk,nhkd->nd', (g * act).astype(xb.dtype), v_tab[eid])

    out = lax.map(one, xt.reshape(n_pad // blk, blk, D_MODEL)).reshape(n_pad, D_MODEL)[:n]
    return out.reshape(shp).astype(x.dtype)


def setup_inputs(seed: int = 0) -> dict:
    key = jax.random.key(seed)
    ks = iter(jax.random.split(key, 64))

    def nrm(shape, scale):
        return jax.random.normal(next(ks), shape, jnp.float32) * scale

    E, O, L = N_EVEN, N_ODD, DEPTH
    return {
        'x_prompt': nrm((BATCH, SEQ, D_MODEL), 1.0),
        'x_sample': nrm((DEC_BATCH, DEC_SEQ, D_MODEL), 1.0),
        'cache_swa_k': nrm((E, DEC_BATCH, WINDOW, SWA_KV_HEADS, HEAD_DIM), 1.0),
        'cache_swa_v': nrm((E, DEC_BATCH, WINDOW, SWA_KV_HEADS, HEAD_DIM), 1.0),
        'state_ssm_re': nrm((E, DEC_BATCH, S5_GROUPS, S5_STATE), 0.3),
        'state_ssm_im': nrm((E, DEC_BATCH, S5_GROUPS, S5_STATE), 0.3),
        'state_pool': nrm((O, DEC_BATCH, POOL_BUF, POOL_WIDTH), 1.0),
        'cache_mla_ckv': nrm((O, DEC_BATCH, PAST_LEN, KV_LORA), 1.0),
        'cache_mla_kpe': nrm((O, DEC_BATCH, PAST_LEN, ROPE_DIM), 1.0),
        'norm_mix': 1.0 + nrm((L, D_MODEL), 0.02),
        'norm_ffn': 1.0 + nrm((L, D_MODEL), 0.02),
        'norm_final': 1.0 + nrm((D_MODEL,), 0.02),
        'w_in_even': nrm((E, D_MODEL, EVEN_IN), D_MODEL ** -0.5),
        'w_out_even': nrm((E, EVEN_MIX, D_MODEL), EVEN_MIX ** -0.5),
        'swa_sink': nrm((E, SWA_HEADS), 1.0),
        's5_lam_re': -0.5 + nrm((E, S5_GROUPS, S5_STATE), 0.01),
        's5_lam_im': jnp.pi * jnp.arange(S5_STATE, dtype=jnp.float32) + nrm((E, S5_GROUPS, S5_STATE), 0.01),
        's5_log_dt': jax.random.uniform(next(ks), (E, S5_GROUPS), jnp.float32, math.log(1e-3), math.log(1e-1)),
        's5_b_re': nrm((E, S5_GROUPS, S5_STATE, S5_GROUP), (2 * S5_GROUP) ** -0.5),
        's5_b_im': nrm((E, S5_GROUPS, S5_STATE, S5_GROUP), (2 * S5_GROUP) ** -0.5),
        's5_c_re': nrm((E, S5_GROUPS, S5_GROUP, S5_STATE), S5_STATE ** -0.5),
        's5_c_im': nrm((E, S5_GROUPS, S5_GROUP, S5_STATE), S5_STATE ** -0.5),
        's5_d': nrm((E, S5_WIDTH), 1.0),
        's5_w_glu': nrm((E, S5_WIDTH, S5_WIDTH), S5_WIDTH ** -0.5),
        's5_b_glu': nrm((E, S5_WIDTH), 0.02),
        'w_in_odd': nrm((O, D_MODEL, ODD_IN), D_MODEL ** -0.5),
        'w_out_odd': nrm((O, ODD_MIX, D_MODEL), ODD_MIX ** -0.5),
        'pool_w': nrm((O, len(POOL_WINDOWS), POOL_GROUP, POOL_GROUP), POOL_GROUP ** -0.5),
        'pool_scale': 1.0 + nrm((O, POOL_WIDTH), 0.1),
        'mla_q_norm': 1.0 + nrm((O, Q_LORA), 0.02),
        'mla_kv_norm': 1.0 + nrm((O, KV_LORA), 0.02),
        'mla_w_uq': nrm((O, Q_LORA, MLA_HEADS * (NOPE_DIM + ROPE_DIM)), Q_LORA ** -0.5),
        'mla_w_uk': nrm((O, KV_LORA, MLA_HEADS, NOPE_DIM), KV_LORA ** -0.5),
        'mla_w_uv': nrm((O, KV_LORA, MLA_HEADS, V_DIM), KV_LORA ** -0.5),
        'peer_w_q': nrm((L, D_MODEL, PEER_HEADS * D_KEY), D_MODEL ** -0.5),
        'peer_keys': nrm((L, PEER_HEADS, 2, N_KEYS, D_HALF), D_HALF ** -0.5),
        'peer_u': nrm((L, N_EXPERTS, D_MODEL), D_MODEL ** -0.5),
        'peer_v': nrm((L, N_EXPERTS, D_MODEL), (PEER_HEADS * PEER_TOPK) ** -0.5),
    }


def reference(x_prompt, x_sample, cache_swa_k, cache_swa_v, state_ssm_re, state_ssm_im, state_pool,
              cache_mla_ckv, cache_mla_kpe, norm_mix, norm_ffn, norm_final, w_in_even, w_out_even,
              swa_sink, s5_lam_re, s5_lam_im, s5_log_dt, s5_b_re, s5_b_im, s5_c_re, s5_c_im, s5_d,
              s5_w_glu, s5_b_glu, w_in_odd, w_out_odd, pool_w, pool_scale, mla_q_norm, mla_kv_norm,
              mla_w_uq, mla_w_uk, mla_w_uv, peer_w_q, peer_keys, peer_u, peer_v):
    pos_p = jnp.arange(x_prompt.shape[1])
    pos_s = PAST_LEN + jnp.arange(x_sample.shape[1])
    xp, xs = x_prompt, x_sample
    kp_l, vp_l, rp_l, ip_l, poolp_l, cp_l, ep_l = [], [], [], [], [], [], []
    ks_l, vs_l, rs_l, is_l, pools_l, cs_l, es_l = [], [], [], [], [], [], []
    for layer in range(DEPTH):
        i = layer // 2
        if layer % 2 == 0:
            ew = (w_in_even[i], w_out_even[i], swa_sink[i], s5_lam_re[i], s5_lam_im[i], s5_log_dt[i],
                  s5_b_re[i], s5_b_im[i], s5_c_re[i], s5_c_im[i], s5_d[i], s5_w_glu[i], s5_b_glu[i])
            mp, k1, v1, r1, i1 = even_mixer(rmsnorm(xp, norm_mix[layer]), pos_p, None, None, None, None, *ew)
            ms, k2, v2, r2, i2 = even_mixer(rmsnorm(xs, norm_mix[layer]), pos_s, cache_swa_k[i], cache_swa_v[i],
                                            state_ssm_re[i], state_ssm_im[i], *ew)
            kp_l.append(k1); vp_l.append(v1); rp_l.append(r1); ip_l.append(i1)
            ks_l.append(k2); vs_l.append(v2); rs_l.append(r2); is_l.append(i2)
        else:
            ow = (w_in_odd[i], w_out_odd[i], pool_w[i], pool_scale[i], mla_q_norm[i], mla_kv_norm[i],
                  mla_w_uq[i], mla_w_uk[i], mla_w_uv[i])
            mp, p1, c1, e1 = odd_mixer(rmsnorm(xp, norm_mix[layer]), pos_p, None, None, None, *ow)
            ms, p2, c2, e2 = odd_mixer(rmsnorm(xs, norm_mix[layer]), pos_s, state_pool[i], cache_mla_ckv[i],
                                       cache_mla_kpe[i], *ow)
            poolp_l.append(p1); cp_l.append(c1); ep_l.append(e1)
            pools_l.append(p2); cs_l.append(c2); es_l.append(e2)
        xp = xp + mp
        xs = xs + ms
        xp = xp + peer(rmsnorm(xp, norm_ffn[layer]), peer_w_q[layer], peer_keys[layer], peer_u[layer], peer_v[layer])
        xs = xs + peer(rmsnorm(xs, norm_ffn[layer]), peer_w_q[layer], peer_keys[layer], peer_u[layer], peer_v[layer])
    y_prompt = rmsnorm(xp, norm_final)
    y_sample = rmsnorm(xs, norm_final)
    return (y_prompt, y_sample,
            jnp.stack(kp_l), jnp.stack(vp_l), jnp.stack(rp_l), jnp.stack(ip_l),
            jnp.stack(poolp_l), jnp.stack(cp_l), jnp.stack(ep_l),
            jnp.stack(ks_l), jnp.stack(vs_l), jnp.stack(rs_l), jnp.stack(is_l),
            jnp.stack(pools_l), jnp.stack(cs_l), jnp.stack(es_l))
```

```cpp
#include <hip/hip_runtime.h>
#include <hip/hip_bf16.h>
#include <hip/hip_cooperative_groups.h>
#include <cstdio>
namespace cg = cooperative_groups;

typedef unsigned short bf16_t;
using bf16x8 = __attribute__((ext_vector_type(8))) short;
using f32x4 = __attribute__((ext_vector_type(4))) float;

#ifndef PH
#define PH 0xFFFFFFu
#endif
#ifndef DBL
#define DBL 0u
#endif
#define NREP(n) ((int)((PH >> (n)) & 1u) * (1 + (int)((DBL >> (n)) & 1u)))
#define NT 512
#define T_TOT 33792
#define T_P 32768
#define LOG2_THETA 18.931568569324174f

#define O_Y 0
#define O_SWAK_P 34603008
#define O_SWAV_P 34734080
#define O_SSMRE_P 34865152
#define O_SSMIM_P 34881536
#define O_POOL_P 34897920
#define O_CKV_P 34959360
#define O_KPE_P 43347968
#define O_SWAK_S 44396544
#define O_SWAV_S 44920832
#define O_SSMRE_S 45445120
#define O_SSMIM_S 45510656
#define O_POOL_S 45576192
#define O_CKV_S 45821952
#define O_KPE_S 46084096

constexpr size_t OFF_PROJ = 0;
constexpr size_t OFF_TAB = OFF_PROJ + 88670208ull;
constexpr size_t OFF_MIX = OFF_TAB + 67108864ull;
constexpr size_t OFF_QBUF = OFF_MIX + 69206016ull;
constexpr size_t OFF_QMLA = OFF_QBUF + 69206016ull;
constexpr size_t OFF_Z = OFF_QMLA + 51904512ull;
constexpr size_t OFF_M = OFF_Z + 34603008ull;
constexpr size_t OFF_C = OFF_M + 34603008ull;
constexpr size_t OFF_KP = OFF_C + 17301504ull;
constexpr size_t OFF_VT0 = OFF_KP + 2162688ull;
constexpr size_t OFF_KALL = OFF_VT0 + 8388608ull;
constexpr size_t OFF_VTALL = OFF_KALL + 1327104ull;
constexpr size_t OFF_KPS = OFF_VTALL + 1572864ull;
constexpr size_t OFF_WT = OFF_KPS + 4325376ull;
constexpr size_t WS_NEED = OFF_WT + 16187392ull;
constexpr size_t OFF_KUPS = OFF_PROJ;
constexpr size_t OFF_VTS = OFF_PROJ + 69206016ull;
constexpr size_t WT_IN_E = 0;
constexpr size_t WT_OUT_E = WT_IN_E + 1310720;
constexpr size_t WT_GLU = WT_OUT_E + 1048576;
constexpr size_t WT_IN_O = WT_GLU + 262144;
constexpr size_t WT_OUT_O = WT_IN_O + 1343488;
constexpr size_t WT_POOL = WT_OUT_O + 1048576;
constexpr size_t WT_UQ = WT_POOL + 65536;
constexpr size_t WT_UK = WT_UQ + 393216;
constexpr size_t WT_UV = WT_UK + 131072;
constexpr size_t WT_PQ = WT_UV + 131072;
constexpr size_t WT_KEYS = WT_PQ + 2097152;

struct Params {
  const float* in[38];
  float* out;
  unsigned char* ws;
};

typedef __bf16 bf16x2_t __attribute__((ext_vector_type(2)));
typedef float float2_t __attribute__((ext_vector_type(2)));
__device__ __forceinline__ unsigned pack2(float a, float b) {
  float2_t f = {a, b};
  bf16x2_t h = __builtin_convertvector(f, bf16x2_t);
  return __builtin_bit_cast(unsigned, h);
}
__device__ __forceinline__ unsigned short f2bf(float f) { return (unsigned short)(pack2(f, 0.f) & 0xffffu); }
__device__ __forceinline__ float bf2f(unsigned short b) { return __uint_as_float(((unsigned)b) << 16); }
__device__ __forceinline__ float lo2f(unsigned u) { return __uint_as_float(u << 16); }
__device__ __forceinline__ float hi2f(unsigned u) { return __uint_as_float(u & 0xffff0000u); }
__device__ __forceinline__ void unpack8(uint4 v, float* x) {
  x[0] = lo2f(v.x); x[1] = hi2f(v.x); x[2] = lo2f(v.y); x[3] = hi2f(v.y);
  x[4] = lo2f(v.z); x[5] = hi2f(v.z); x[6] = lo2f(v.w); x[7] = hi2f(v.w);
}
__device__ __forceinline__ uint4 pack8(const float* x) {
  uint4 v; v.x = pack2(x[0], x[1]); v.y = pack2(x[2], x[3]); v.z = pack2(x[4], x[5]); v.w = pack2(x[6], x[7]); return v;
}
template <int CTRL> __device__ __forceinline__ float dpp_f(float v) {
  return __int_as_float(__builtin_amdgcn_update_dpp(0, __float_as_int(v), CTRL, 0xf, 0xf, true));
}
__device__ __forceinline__ float row16_max(float v) {
  v = fmaxf(v, dpp_f<0xB1>(v)); v = fmaxf(v, dpp_f<0x4E>(v)); v = fmaxf(v, dpp_f<0x141>(v)); v = fmaxf(v, dpp_f<0x140>(v)); return v;
}
__device__ __forceinline__ float row16_sum(float v) {
  v += dpp_f<0xB1>(v); v += dpp_f<0x4E>(v); v += dpp_f<0x141>(v); v += dpp_f<0x140>(v); return v;
}
__device__ __forceinline__ float wave_sum(float v) {
  v = row16_sum(v);
  const float a = __int_as_float(__builtin_amdgcn_readlane(__float_as_int(v), 0));
  const float b = __int_as_float(__builtin_amdgcn_readlane(__float_as_int(v), 16));
  const float c = __int_as_float(__builtin_amdgcn_readlane(__float_as_int(v), 32));
  const float d = __int_as_float(__builtin_amdgcn_readlane(__float_as_int(v), 48));
  return (a + b) + (c + d);
}
__device__ __forceinline__ void sincos_rev(float ang, float& s, float& c) {
  float rev = ang * 0.15915494309189535f;
  rev = rev - floorf(rev);
  s = __builtin_amdgcn_sinf(rev);
  c = __builtin_amdgcn_cosf(rev);
}
__device__ __forceinline__ float gelu_tanh(float x) {
  float y = 0.7978845608028654f * (x + 0.044715f * x * x * x);
  float t = 1.f - 2.f / (1.f + __expf(2.f * y));
  return 0.5f * x * (1.f + t);
}
__device__ __forceinline__ float gelu_erf(float x) { return 0.5f * x * (1.f + erff(x * 0.7071067811865476f)); }
__device__ __forceinline__ int logical_bid() {
  const int G = (int)gridDim.x, b = (int)blockIdx.x;
  return ((G & 7) == 0) ? ((b & 7) * (G >> 3) + (b >> 3)) : b;
}
__device__ __forceinline__ int rot_start(int vbase) {
  int G = (int)gridDim.x;
  int s = (logical_bid() - vbase) % G;
  if (s < 0) s += G;
  return s;
}

__device__ __forceinline__ void transpose_convert(int tid, unsigned char* smem, const float* __restrict__ src, bf16_t* __restrict__ dst, int K, int N, int& vbase) {
  float* tl = (float*)smem;
  const int tk = K / 64, tn = (N + 63) / 64;
  const int ntiles = tk * tn;
  for (int tile = rot_start(vbase); tile < ntiles; tile += gridDim.x) {
    const int k0 = (tile / tn) * 64, n0 = (tile % tn) * 64;
    __syncthreads();
#pragma unroll
    for (int i = 0; i < 2; ++i) {
      int r = (tid >> 4) + 32 * i, c4 = (tid & 15) * 4;
      float4 v = make_float4(0.f, 0.f, 0.f, 0.f);
      if (n0 + c4 < N) v = *(const float4*)(src + (size_t)(k0 + r) * N + n0 + c4);
      tl[r * 65 + c4 + 0] = v.x; tl[r * 65 + c4 + 1] = v.y; tl[r * 65 + c4 + 2] = v.z; tl[r * 65 + c4 + 3] = v.w;
    }
    __syncthreads();
    int n = tid >> 3, k8 = (tid & 7) * 8;
    if (n0 + n < N) {
      float x[8];
#pragma unroll
      for (int j = 0; j < 8; ++j) x[j] = tl[(k8 + j) * 65 + n];
      *(uint4*)(dst + (size_t)(n0 + n) * K + k0 + k8) = pack8(x);
    }
  }
  vbase += ntiles;
}

__device__ __forceinline__ void convert_plain(int tid, const float* __restrict__ src, bf16_t* __restrict__ dst, size_t n) {
  size_t i = ((size_t)blockIdx.x * NT + tid) * 8;
  const size_t stride = (size_t)gridDim.x * NT * 8;
  for (; i < n; i += stride) {
    float4 a = *(const float4*)(src + i), b = *(const float4*)(src + i + 4);
    uint4 v; v.x = pack2(a.x, a.y); v.y = pack2(a.z, a.w); v.z = pack2(b.x, b.y); v.w = pack2(b.z, b.w);
    *(uint4*)(dst + i) = v;
  }
}

template <int V> struct IC { static constexpr int value = V; };
template <int AMODE, class Epi>
__device__ __forceinline__ void gemm_run(int tid, unsigned char* smem, const void* A, const void* A2, int splitRow, int lda,
                                         const float* __restrict__ gain, const bf16_t* __restrict__ Bt,
                                         int M, int N, int K, int& vbase, Epi epi) {
  bf16_t* sA = (bf16_t*)smem;
  bf16_t* sB = sA + 128 * 72;
  float* sR = (float*)(sB + 128 * 72);
  float* sG = sR + 128;
  if (AMODE == 2) {
    __syncthreads();
    sG[tid] = gain[tid]; sG[tid + 512] = gain[tid + 512];
    __syncthreads();
  }
  const int lane = tid & 63, w = tid >> 6;
  const int l16 = lane & 15, quad = lane >> 4;
  const int wm = w >> 1, wn = w & 1;
  const int tilesN = (N + 127) / 128, tilesM = M / 128;
  const int ntiles = tilesM * tilesN;
  const int arow = tid >> 2, aseg = (tid & 3) * 16;
  const int nk = K / 64;
  for (int tile = rot_start(vbase); tile < ntiles; tile += gridDim.x) {
    const int tm = tile / tilesN, tn = tile % tilesN;
    const int m0 = tm * 128, n0 = tn * 128;
    const int grow = m0 + arow;
    const unsigned char* aptr;
    if (AMODE == 0) aptr = (grow < splitRow) ? (const unsigned char*)A + (size_t)grow * lda * 2 : (const unsigned char*)A2 + (size_t)(grow - splitRow) * lda * 2;
    else aptr = (grow < splitRow) ? (const unsigned char*)A + (size_t)grow * lda * 4 : (const unsigned char*)A2 + (size_t)(grow - splitRow) * lda * 4;
    const bool bvalid = (n0 + arow) < N;
    const bf16_t* bptr = Bt + (size_t)(n0 + arow) * K + aseg;
    f32x4 acc[2][4];
#pragma unroll
    for (int i = 0; i < 2; ++i)
#pragma unroll
      for (int j = 0; j < 4; ++j) acc[i][j] = (f32x4){0.f, 0.f, 0.f, 0.f};
    float ss = 0.f;
    float4 af0[4], af1[4];
    uint4 ab0[2], ab1[2];
    uint4 bb0[2], bb1[2];
#define GLOAD(AF, AB, BB, KT) { \
      const int k0_ = (KT) * 64; \
      if (AMODE == 0) { AB[0] = *(const uint4*)(aptr + (size_t)(k0_ + aseg) * 2); AB[1] = *(const uint4*)(aptr + (size_t)(k0_ + aseg + 8) * 2); } \
      else { \
        _Pragma("unroll") for (int i = 0; i < 4; ++i) AF[i] = *(const float4*)(aptr + (size_t)(k0_ + aseg + 4 * i) * 4); \
      } \
      if (bvalid) { BB[0] = *(const uint4*)(bptr + k0_); BB[1] = *(const uint4*)(bptr + k0_ + 8); } \
      else { BB[0] = make_uint4(0, 0, 0, 0); BB[1] = BB[0]; } }
#define LSTORE(AF, AB, BB, KT) { \
      uint4 s0, s1; \
      if (AMODE == 0) { s0 = AB[0]; s1 = AB[1]; } \
      else { \
        if (AMODE == 2) { \
          const float* gp = sG + (KT) * 64 + aseg; \
          _Pragma("unroll") for (int i = 0; i < 4; ++i) { \
            float4 g = *(const float4*)(gp + 4 * i); \
            ss += AF[i].x * AF[i].x + AF[i].y * AF[i].y + AF[i].z * AF[i].z + AF[i].w * AF[i].w; \
            AF[i].x *= g.x; AF[i].y *= g.y; AF[i].z *= g.z; AF[i].w *= g.w; \
          } \
        } \
        s0.x = pack2(AF[0].x, AF[0].y); s0.y = pack2(AF[0].z, AF[0].w); s0.z = pack2(AF[1].x, AF[1].y); s0.w = pack2(AF[1].z, AF[1].w); \
        s1.x = pack2(AF[2].x, AF[2].y); s1.y = pack2(AF[2].z, AF[2].w); s1.z = pack2(AF[3].x, AF[3].y); s1.w = pack2(AF[3].z, AF[3].w); \
      } \
      *(uint4*)(sA + arow * 72 + aseg) = s0; \
      *(uint4*)(sA + arow * 72 + aseg + 8) = s1; \
      *(uint4*)(sB + arow * 72 + aseg) = BB[0]; \
      *(uint4*)(sB + arow * 72 + aseg + 8) = BB[1]; }
#define GCOMPUTE() { \
      _Pragma("unroll") for (int ks = 0; ks < 2; ++ks) { \
        bf16x8 a[2], b[4]; \
        _Pragma("unroll") for (int i = 0; i < 2; ++i) a[i] = *(const bf16x8*)(sA + (wm * 32 + i * 16 + l16) * 72 + ks * 32 + quad * 8); \
        _Pragma("unroll") for (int j = 0; j < 4; ++j) b[j] = *(const bf16x8*)(sB + (wn * 64 + j * 16 + l16) * 72 + ks * 32 + quad * 8); \
        _Pragma("unroll") for (int i = 0; i < 2; ++i) \
          _Pragma("unroll") for (int j = 0; j < 4; ++j) acc[i][j] = __builtin_amdgcn_mfma_f32_16x16x32_bf16(a[i], b[j], acc[i][j], 0, 0, 0); \
      } }
    GLOAD(af0, ab0, bb0, 0);
    GLOAD(af1, ab1, bb1, 1);
    for (int kt = 0; kt < nk; kt += 2) {
      __syncthreads();
      LSTORE(af0, ab0, bb0, kt);
      __syncthreads();
      if (kt + 2 < nk) GLOAD(af0, ab0, bb0, kt + 2);
      GCOMPUTE();
      __syncthreads();
      LSTORE(af1, ab1, bb1, kt + 1);
      __syncthreads();
      if (kt + 3 < nk) GLOAD(af1, ab1, bb1, kt + 3);
      GCOMPUTE();
    }
    if (AMODE == 2) {
      ss += __shfl_xor(ss, 1);
      ss += __shfl_xor(ss, 2);
      if ((tid & 3) == 0) sR[arow] = rsqrtf(ss / (float)K + 1e-6f);
      __syncthreads();
    }
#pragma unroll
    for (int i = 0; i < 2; ++i)
#pragma unroll
      for (int r = 0; r < 4; ++r) {
        const int rl = wm * 32 + i * 16 + quad * 4 + r;
        const float rs = (AMODE == 2) ? sR[rl] : 1.f;
#pragma unroll
        for (int j = 0; j < 4; ++j) {
          const int col = n0 + wn * 64 + j * 16 + l16;
          if (col < N) epi(m0 + rl, col, acc[i][j][r] * rs);
        }
      }
  }
  vbase += ntiles;
}

struct AttnDesc {
  const bf16_t* q; int ldq; int active; int kt_lo, kt_hi; bf16_t* out; int ldo; float m0, l0; int pos0;
  const bf16_t* k; int ldk; const bf16_t* kx; const bf16_t* vt; int ldv; int nkeys; int bt_lo, bt_hi; float scale;
};

template <int DQK>
__device__ __forceinline__ void attn_item(int tid, unsigned char* smem, const AttnDesc& d) {
  constexpr int LDK = DQK + 8;
  bf16_t* sK = (bf16_t*)smem;
  bf16_t* sVt = sK + 64 * 104;
  bf16_t* sP = sVt + 64 * 72;
  const int lane = tid & 63, w = tid >> 6;
  const int l16 = lane & 15, quad = lane >> 4;
  bf16_t* sPw = sP + w * 16 * 72;
  bf16x8 qf[DQK / 32];
  if (d.active) {
#pragma unroll
    for (int ks = 0; ks < DQK / 32; ++ks) {
      const bf16_t* qp = d.q + (size_t)l16 * d.ldq + ks * 32 + quad * 8;
      uint4 v = *(const uint4*)qp;
      if (DQK == 96 && ks == 2) {
        const int pq = (quad < 2) ? 16 : -16;
        uint4 pv = *(const uint4*)(qp + pq);
        float x[8], y[8];
        unpack8(v, x); unpack8(pv, y);
        const float pos = (float)(d.pos0 + l16);
#pragma unroll
        for (int j = 0; j < 8; ++j) {
          const int f = (quad & 1) * 8 + j;
          float inv = exp2f(-(float)f * (LOG2_THETA / 16.f));
          float sn, cs; sincos_rev(pos * inv, sn, cs);
          x[j] = (quad < 2) ? (x[j] * cs - y[j] * sn) : (x[j] * cs + y[j] * sn);
        }
        v = pack8(x);
      }
      qf[ks] = *(bf16x8*)&v;
    }
  }
  f32x4 o[4];
#pragma unroll
  for (int i = 0; i < 4; ++i) o[i] = (f32x4){0.f, 0.f, 0.f, 0.f};
  float m[4], l[4];
#pragma unroll
  for (int r = 0; r < 4; ++r) { m[r] = d.m0; l[r] = d.l0; }

  for (int kt = d.bt_lo; kt < d.bt_hi; ++kt) {
    __syncthreads();
    {
      const int key = tid >> 3, seg = tid & 7;
      uint4 kv = *(const uint4*)(d.k + (size_t)(kt * 64 + key) * d.ldk + seg * 8);
      uint4 vv = *(const uint4*)(d.vt + (size_t)key * d.ldv + kt * 64 + seg * 8);
      *(uint4*)(sK + key * LDK + seg * 8) = kv;
      *(uint4*)(sVt + key * 72 + seg * 8) = vv;
      if (DQK == 96 && tid < 256) {
        const int key2 = tid >> 2, seg2 = tid & 3;
        uint4 xv = *(const uint4*)(d.kx + (size_t)(kt * 64 + key2) * 32 + seg2 * 8);
        *(uint4*)(sK + key2 * LDK + 64 + seg2 * 8) = xv;
      }
    }
    __syncthreads();
    if (d.active && kt >= d.kt_lo && kt < d.kt_hi) {
      f32x4 s[4];
#pragma unroll
      for (int i = 0; i < 4; ++i) s[i] = (f32x4){0.f, 0.f, 0.f, 0.f};
#pragma unroll
      for (int ks = 0; ks < DQK / 32; ++ks)
#pragma unroll
        for (int nt = 0; nt < 4; ++nt) {
          bf16x8 b = *(const bf16x8*)(sK + (nt * 16 + l16) * LDK + ks * 32 + quad * 8);
          s[nt] = __builtin_amdgcn_mfma_f32_16x16x32_bf16(qf[ks], b, s[nt], 0, 0, 0);
        }
#pragma unroll
      for (int nt = 0; nt < 4; ++nt) {
        const bool valid = (kt * 64 + nt * 16 + l16) < d.nkeys;
#pragma unroll
        for (int r = 0; r < 4; ++r) s[nt][r] = valid ? s[nt][r] * d.scale : -1e30f;
      }
#pragma unroll
      for (int r = 0; r < 4; ++r) {
        float mx = fmaxf(fmaxf(s[0][r], s[1][r]), fmaxf(s[2][r], s[3][r]));
        mx = row16_max(mx);
        const float mnew = fmaxf(m[r], mx);
        const float alpha = __expf(m[r] - mnew);
        float p0 = __expf(s[0][r] - mnew), p1 = __expf(s[1][r] - mnew), p2 = __expf(s[2][r] - mnew), p3 = __expf(s[3][r] - mnew);
        float rs = p0 + p1 + p2 + p3;
        rs = row16_sum(rs);
        l[r] = l[r] * alpha + rs;
        m[r] = mnew;
#pragma unroll
        for (int dt = 0; dt < 4; ++dt) o[dt][r] *= alpha;
        bf16_t* pr = sPw + (quad * 4 + r) * 72 + l16;
        pr[0] = f2bf(p0); pr[16] = f2bf(p1); pr[32] = f2bf(p2); pr[48] = f2bf(p3);
      }
      asm volatile("s_waitcnt lgkmcnt(0)" ::: "memory");
#pragma unroll
      for (int ks = 0; ks < 2; ++ks) {
        bf16x8 a = *(const bf16x8*)(sPw + l16 * 72 + ks * 32 + quad * 8);
#pragma unroll
        for (int dt = 0; dt < 4; ++dt) {
          bf16x8 b = *(const bf16x8*)(sVt + (dt * 16 + l16) * 72 + ks * 32 + quad * 8);
          o[dt] = __builtin_amdgcn_mfma_f32_16x16x32_bf16(a, b, o[dt], 0, 0, 0);
        }
      }
      asm volatile("s_waitcnt lgkmcnt(0)" ::: "memory");
    }
  }
  if (d.active) {
#pragma unroll
    for (int r = 0; r < 4; ++r) {
      const float il = 1.f / l[r];
#pragma unroll
      for (int dt = 0; dt < 4; ++dt) d.out[(size_t)(quad * 4 + r) * d.ldo + dt * 16 + l16] = f2bf(o[dt][r] * il);
    }
  }
}

template <int MODE>
__device__ __forceinline__ void s5_item(int tid, float* sUw, const Params& p, int item) {
  const int lane = tid & 63;
  const bf16_t* proj = (const bf16_t*)(p.ws + OFF_PROJ);
  int b, chunk, g, tok0; bool isS;
  if (item < 32768) { isS = false; g = item & 31; chunk = (item >> 5) & 127; b = item >> 12; tok0 = b * 4096 + chunk * 32; }
  else { isS = true; int it = item - 32768; g = it & 31; b = it >> 5; chunk = 0; tok0 = T_P + b * 32; }
  const int n = lane;
  const int gn = g * 64 + n;
  const float lr = fminf(p.in[15][gn], -1e-4f), li = p.in[16][gn];
  const float dt = __expf(p.in[17][g]);
  const float mag = __expf(lr * dt);
  float sn, cs; sincos_rev(li * dt, sn, cs);
  const float abr = mag * cs, abi = mag * sn;
  const float den = lr * lr + li * li;
  const float nr = abr - 1.f, ni = abi;
  const float fre = (nr * lr + ni * li) / den, fim = (ni * lr - nr * li) / den;
  float bbr[16], bbi[16];
  {
    const float4* br4 = (const float4*)(p.in[18] + (size_t)gn * 16);
    const float4* bi4 = (const float4*)(p.in[19] + (size_t)gn * 16);
#pragma unroll
    for (int i = 0; i < 4; ++i) {
      float4 r4 = br4[i], i4 = bi4[i];
      bbr[4 * i + 0] = fre * r4.x - fim * i4.x; bbi[4 * i + 0] = fre * i4.x + fim * r4.x;
      bbr[4 * i + 1] = fre * r4.y - fim * i4.y; bbi[4 * i + 1] = fre * i4.y + fim * r4.y;
      bbr[4 * i + 2] = fre * r4.z - fim * i4.z; bbi[4 * i + 2] = fre * i4.z + fim * r4.z;
      bbr[4 * i + 3] = fre * r4.w - fim * i4.w; bbi[4 * i + 3] = fre * i4.w + fim * r4.w;
    }
  }
  {
    const int t = lane >> 1, c8 = (lane & 1) * 8;
    uint4 uv = *(const uint4*)(proj + (size_t)(tok0 + t) * 1280 + 768 + g * 16 + c8);
    float x[8]; unpack8(uv, x);
    *(float4*)(sUw + t * 16 + c8) = make_float4(x[0], x[1], x[2], x[3]);
    *(float4*)(sUw + t * 16 + c8 + 4) = make_float4(x[4], x[5], x[6], x[7]);
  }
  asm volatile("s_waitcnt lgkmcnt(0)" ::: "memory");
  float hr = 0.f, hi = 0.f;
  if (MODE == 0) {
#pragma unroll 4
    for (int t = 0; t < 32; ++t) {
      float uu[16];
#pragma unroll
      for (int i = 0; i < 4; ++i) { float4 v = *(const float4*)(sUw + t * 16 + 4 * i); uu[4 * i] = v.x; uu[4 * i + 1] = v.y; uu[4 * i + 2] = v.z; uu[4 * i + 3] = v.w; }
      float bur = 0.f, bui = 0.f;
#pragma unroll
      for (int c = 0; c < 16; ++c) { bur += bbr[c] * uu[c]; bui += bbi[c] * uu[c]; }
      const float nhr = abr * hr - abi * hi + bur, nhi = abr * hi + abi * hr + bui;
      hr = nhr; hi = nhi;
    }
    float* s1re = (float*)(p.ws + OFF_QMLA);
    float* s1im = s1re + 2097152;
    const size_t idx = ((size_t)(b * 128 + chunk) * 32 + g) * 64 + n;
    s1re[idx] = hr; s1im[idx] = hi;
    asm volatile("s_waitcnt lgkmcnt(0)" ::: "memory");
    return;
  } else {
    float cr[16], ci[16];
#pragma unroll
    for (int c = 0; c < 16; ++c) { cr[c] = p.in[20][(size_t)(g * 16 + c) * 64 + n]; ci[c] = p.in[21][(size_t)(g * 16 + c) * 64 + n]; }
    if (isS) { hr = p.in[4][(size_t)(b * 32 + g) * 64 + n]; hi = p.in[5][(size_t)(b * 32 + g) * 64 + n]; }
    else {
      const float* hinre = (const float*)(p.ws + OFF_QMLA) + 2 * 2097152;
      const float* hinim = hinre + 2097152;
      const size_t idx = ((size_t)(b * 128 + chunk) * 32 + g) * 64 + n;
      hr = hinre[idx]; hi = hinim[idx];
    }
    const int b0 = lane & 1, b1 = (lane >> 1) & 1, b2 = (lane >> 2) & 1, b3 = (lane >> 3) & 1;
    const int cc = b0 * 8 + b1 * 4 + b2 * 2 + b3;
    const int quad = lane >> 4;
    const float dsk = p.in[22][g * 16 + cc];
    bf16_t* zbuf = (bf16_t*)(p.ws + OFF_Z);
    float zkeep = 0.f;
#pragma unroll 2
    for (int t = 0; t < 32; ++t) {
      float uu[16];
#pragma unroll
      for (int i = 0; i < 4; ++i) { float4 v = *(const float4*)(sUw + t * 16 + 4 * i); uu[4 * i] = v.x; uu[4 * i + 1] = v.y; uu[4 * i + 2] = v.z; uu[4 * i + 3] = v.w; }
      float bur = 0.f, bui = 0.f;
#pragma unroll
      for (int c = 0; c < 16; ++c) { bur += bbr[c] * uu[c]; bui += bbi[c] * uu[c]; }
      const float nhr = abr * hr - abi * hi + bur, nhi = abr * hi + abi * hr + bui;
      hr = nhr; hi = nhi;
      float v16[16];
#pragma unroll
      for (int c = 0; c < 16; ++c) v16[c] = hr * cr[c] - hi * ci[c];
      float v8[8], v4[4], v2[2], v1;
#pragma unroll
      for (int i = 0; i < 8; ++i) { float keep = b0 ? v16[8 + i] : v16[i]; float send = b0 ? v16[i] : v16[8 + i]; v8[i] = keep + __shfl_xor(send, 1); }
#pragma unroll
      for (int i = 0; i < 4; ++i) { float keep = b1 ? v8[4 + i] : v8[i]; float send = b1 ? v8[i] : v8[4 + i]; v4[i] = keep + __shfl_xor(send, 2); }
#pragma unroll
      for (int i = 0; i < 2; ++i) { float keep = b2 ? v4[2 + i] : v4[i]; float send = b2 ? v4[i] : v4[2 + i]; v2[i] = keep + __shfl_xor(send, 4); }
      { float keep = b3 ? v2[1] : v2[0]; float send = b3 ? v2[0] : v2[1]; v1 = keep + __shfl_xor(send, 8); }
      v1 += __shfl_xor(v1, 16);
      v1 += __shfl_xor(v1, 32);
      const float y = v1 + dsk * sUw[t * 16 + cc];
      const float z = gelu_tanh(y);
      if (quad == (t & 3)) zkeep = z;
      if ((t & 3) == 3) zbuf[(size_t)(tok0 + t - 3 + quad) * 512 + g * 16 + cc] = f2bf(zkeep);
    }
    if (isS) {
      p.out[O_SSMRE_S + (size_t)(b * 32 + g) * 64 + n] = hr;
      p.out[O_SSMIM_S + (size_t)(b * 32 + g) * 64 + n] = hi;
    }
    asm volatile("s_waitcnt lgkmcnt(0)" ::: "memory");
  }
}

#define TAB_V_OFF 16777216ull
#define TAB_SU_OFF 33554432ull
#define TAB_SV_OFF (33554432ull + 65536ull)
__device__ __forceinline__ void quant_rows(const float* __restrict__ src, unsigned char* __restrict__ dst, float* __restrict__ scales, int gw, int nw, int tid) {
  const int lane = tid & 63;
  for (int row = gw; row < 16384; row += nw) {
    const float* r = src + (size_t)row * 1024 + lane * 16;
    float x[16];
#pragma unroll
    for (int i = 0; i < 4; ++i) { float4 v = *(const float4*)(r + 4 * i); x[4 * i] = v.x; x[4 * i + 1] = v.y; x[4 * i + 2] = v.z; x[4 * i + 3] = v.w; }
    float am = 0.f;
#pragma unroll
    for (int i = 0; i < 16; ++i) am = fmaxf(am, fabsf(x[i]));
#pragma unroll
    for (int o = 32; o; o >>= 1) am = fmaxf(am, __shfl_xor(am, o));
    const float inv = (am > 0.f) ? 127.f / am : 0.f;
    unsigned q[4];
#pragma unroll
    for (int i = 0; i < 4; ++i) {
      unsigned b0 = (unsigned)((int)rintf(x[4 * i] * inv)) & 255u, b1 = (unsigned)((int)rintf(x[4 * i + 1] * inv)) & 255u;
      unsigned b2 = (unsigned)((int)rintf(x[4 * i + 2] * inv)) & 255u, b3 = (unsigned)((int)rintf(x[4 * i + 3] * inv)) & 255u;
      q[i] = b0 | (b1 << 8) | (b2 << 16) | (b3 << 24);
    }
    *(uint4*)(dst + (size_t)row * 1024 + lane * 16) = make_uint4(q[0], q[1], q[2], q[3]);
    if (lane == 0) scales[row] = am * (1.f / 127.f);
  }
}

__device__ __forceinline__ float ub0(unsigned u) { return (float)(u & 0xffu); }
__device__ __forceinline__ float ub1(unsigned u) { return (float)((u >> 8) & 0xffu); }
__device__ __forceinline__ float ub2(unsigned u) { return (float)((u >> 16) & 0xffu); }
__device__ __forceinline__ float ub3(unsigned u) { return (float)(u >> 24); }
__device__ __forceinline__ float dot16(const float* xn, uint4 u) {
  float d = 0.f;
  d += xn[0] * ub0(u.x); d += xn[1] * ub1(u.x); d += xn[2] * ub2(u.x); d += xn[3] * ub3(u.x);
  d += xn[4] * ub0(u.y); d += xn[5] * ub1(u.y); d += xn[6] * ub2(u.y); d += xn[7] * ub3(u.y);
  d += xn[8] * ub0(u.z); d += xn[9] * ub1(u.z); d += xn[10] * ub2(u.z); d += xn[11] * ub3(u.z);
  d += xn[12] * ub0(u.w); d += xn[13] * ub1(u.w); d += xn[14] * ub2(u.w); d += xn[15] * ub3(u.w);
  return d;
}
__device__ __forceinline__ void axpy16(float* acc, float a, uint4 u) {
  acc[0] += a * ub0(u.x); acc[1] += a * ub1(u.x); acc[2] += a * ub2(u.x); acc[3] += a * ub3(u.x);
  acc[4] += a * ub0(u.y); acc[5] += a * ub1(u.y); acc[6] += a * ub2(u.y); acc[7] += a * ub3(u.y);
  acc[8] += a * ub0(u.z); acc[9] += a * ub1(u.z); acc[10] += a * ub2(u.z); acc[11] += a * ub3(u.z);
  acc[12] += a * ub0(u.w); acc[13] += a * ub1(u.w); acc[14] += a * ub2(u.w); acc[15] += a * ub3(u.w);
}

template <bool FINAL, bool DRY>
__device__ __forceinline__ void peer_token(int tid, const Params& p, int layer, int tok) {
  const int lane = tid & 63;
  float* xres = p.out + O_Y;
  const float* gain = p.in[10] + layer * 1024;
  const unsigned char* U = p.ws + OFF_TAB;
  const unsigned char* V = U + TAB_V_OFF;
  const int* ebuf = (const int*)(p.ws + OFF_M);
  const float* gbuf = (const float*)(p.ws + OFF_M + 17301504ull);
  const float* sus = (const float*)(p.ws + OFF_TAB + TAB_SU_OFF);
  const float* svs = (const float*)(p.ws + OFF_TAB + TAB_SV_OFF);
  float* xr = xres + (size_t)tok * 1024 + lane * 16;
  float x[16], xn[16], acc[16];
  float ss = 0.f, sx = 0.f;
#pragma unroll
  for (int i = 0; i < 4; ++i) {
    float4 v = *(const float4*)(xr + 4 * i);
    float4 g = *(const float4*)(gain + lane * 16 + 4 * i);
    x[4 * i] = v.x; x[4 * i + 1] = v.y; x[4 * i + 2] = v.z; x[4 * i + 3] = v.w;
    xn[4 * i] = v.x * g.x; xn[4 * i + 1] = v.y * g.y; xn[4 * i + 2] = v.z * g.z; xn[4 * i + 3] = v.w * g.w;
    ss += v.x * v.x + v.y * v.y + v.z * v.z + v.w * v.w;
    sx += xn[4 * i] + xn[4 * i + 1] + xn[4 * i + 2] + xn[4 * i + 3];
  }
  ss = wave_sum(ss);
  sx = wave_sum(sx);
  const float rstd = rsqrtf(ss * (1.f / 1024.f) + 1e-6f);
#pragma unroll
  for (int i = 0; i < 16; ++i) acc[i] = 0.f;
  float sumA = 0.f;
  const int b0 = lane & 1, b1 = (lane >> 1) & 1, b2 = (lane >> 2) & 1;
  const int pe = b0 * 4 + b1 * 2 + b2;
  const size_t pbase = (size_t)tok * 128 + pe;
#pragma unroll 1
  for (int kb = 0; kb < 16; ++kb) {
    const int myeid = ebuf[pbase + kb * 8];
    const float myg = gbuf[pbase + kb * 8] * svs[myeid];
    const float mysu = sus[myeid];
    uint4 uu[8], vv[8];
#pragma unroll
    for (int j = 0; j < 8; ++j) {
      const int src = ((j & 1) << 2) | (j & 2) | ((j >> 2) & 1);
      const int eid = __builtin_amdgcn_readlane(myeid, src);
      uu[j] = *(const uint4*)(U + (size_t)eid * 1024 + lane * 16);
      vv[j] = *(const uint4*)(V + (size_t)eid * 1024 + lane * 16);
    }
    float d[8];
#pragma unroll
    for (int j = 0; j < 8; ++j) d[j] = dot16(xn, uu[j]);
    float w4[4], w2[2], w1;
#pragma unroll
    for (int i = 0; i < 4; ++i) { float keep = b0 ? d[4 + i] : d[i]; float send = b0 ? d[i] : d[4 + i]; w4[i] = keep + __shfl_xor(send, 1); }
#pragma unroll
    for (int i = 0; i < 2; ++i) { float keep = b1 ? w4[2 + i] : w4[i]; float send = b1 ? w4[i] : w4[2 + i]; w2[i] = keep + __shfl_xor(send, 2); }
    { float keep = b2 ? w2[1] : w2[0]; float send = b2 ? w2[0] : w2[1]; w1 = keep + __shfl_xor(send, 4); }
    w1 += __shfl_xor(w1, 8); w1 += __shfl_xor(w1, 16); w1 += __shfl_xor(w1, 32);
    const float dot = rstd * mysu * (w1 - 128.f * sx);
    const float a = gelu_erf(dot) * myg;
#pragma unroll
    for (int j = 0; j < 8; ++j) {
      const int src = ((j & 1) << 2) | (j & 2) | ((j >> 2) & 1);
      const float A = __int_as_float(__builtin_amdgcn_readlane(__float_as_int(a), src));
      sumA += A;
      axpy16(acc, A, vv[j]);
    }
  }
  float y[16];
#pragma unroll
  for (int i = 0; i < 16; ++i) y[i] = x[i] + acc[i] - 128.f * sumA;
  if (FINAL) {
    float s2 = 0.f;
#pragma unroll
    for (int i = 0; i < 16; ++i) s2 += y[i] * y[i];
    s2 = wave_sum(s2);
    const float r2 = rsqrtf(s2 * (1.f / 1024.f) + 1e-6f);
    const float* gf = p.in[11] + lane * 16;
#pragma unroll
    for (int i = 0; i < 4; ++i) {
      float4 g = *(const float4*)(gf + 4 * i);
      y[4 * i] *= r2 * g.x; y[4 * i + 1] *= r2 * g.y; y[4 * i + 2] *= r2 * g.z; y[4 * i + 3] *= r2 * g.w;
    }
  }
  if (DRY && ss != -1.f) return;
#pragma unroll
  for (int i = 0; i < 4; ++i) *(float4*)(xr + 4 * i) = make_float4(y[4 * i], y[4 * i + 1], y[4 * i + 2], y[4 * i + 3]);
}

#define OFF_PD OFF_MIX
#define OFF_PSS OFF_KP
#define OFF_PSX (OFF_KP + 1081344ull)
template <int CTRL> __device__ __forceinline__ int dpp_i(int v) { return __builtin_amdgcn_update_dpp(0, v, CTRL, 0xf, 0xf, true); }
__device__ __forceinline__ unsigned packq4(float a, float b, float c, float d, float inv) {
  const unsigned q0 = (unsigned)((int)rintf(a * inv)) & 255u, q1 = (unsigned)((int)rintf(b * inv)) & 255u;
  const unsigned q2 = (unsigned)((int)rintf(c * inv)) & 255u, q3 = (unsigned)((int)rintf(d * inv));
  return q0 | (q1 << 8) | (q2 << 16) | (q3 << 24);
}
__device__ __forceinline__ void peer9a_token(int tid, const Params& p, int layer, int tok, int j) {
  const int lane = tid & 63, g8 = lane >> 3, sub = lane & 7;
  const float* xr = p.out + O_Y + (size_t)tok * 1024 + j * 128 + sub * 16;
  const float* gn = p.in[10] + layer * 1024 + j * 128 + sub * 16;
  const unsigned char* U = p.ws + OFF_TAB + j * 128 + sub * 16;
  const int* eb = (const int*)(p.ws + OFF_M) + (size_t)tok * 128 + g8;
  float* pd = (float*)(p.ws + OFF_PD) + ((size_t)tok * 8 + j) * 128;
  int eid[16];
#pragma unroll
  for (int k = 0; k < 16; ++k) eid[k] = eb[k * 8];
  float xs[16];
  float ss = 0.f, am = 0.f;
#pragma unroll
  for (int i = 0; i < 4; ++i) {
    float4 v = *(const float4*)(xr + 4 * i);
    float4 g = *(const float4*)(gn + 4 * i);
    xs[4 * i] = v.x * g.x; xs[4 * i + 1] = v.y * g.y; xs[4 * i + 2] = v.z * g.z; xs[4 * i + 3] = v.w * g.w;
    ss += v.x * v.x + v.y * v.y + v.z * v.z + v.w * v.w;
    am = fmaxf(fmaxf(am, fmaxf(fabsf(xs[4 * i]), fabsf(xs[4 * i + 1]))), fmaxf(fabsf(xs[4 * i + 2]), fabsf(xs[4 * i + 3])));
  }
  uint4 rows[16];
#pragma unroll
  for (int k = 0; k < 16; ++k) rows[k] = *(const uint4*)(U + (size_t)eid[k] * 1024);
  am = fmaxf(am, dpp_f<0xB1>(am)); am = fmaxf(am, dpp_f<0x4E>(am)); am = fmaxf(am, dpp_f<0x141>(am));
  const float inv = (am > 0.f) ? 127.f / am : 0.f;
  const float xscale = am * (1.f / 127.f);
  int xq[4];
#pragma unroll
  for (int d = 0; d < 4; ++d) xq[d] = (int)packq4(xs[4 * d], xs[4 * d + 1], xs[4 * d + 2], xs[4 * d + 3], inv);
  int keep0 = 0, keep1 = 0;
#pragma unroll
  for (int k = 0; k < 16; ++k) {
    int D = __builtin_amdgcn_sdot4((int)rows[k].x, xq[0], 0, false);
    D = __builtin_amdgcn_sdot4((int)rows[k].y, xq[1], D, false);
    D = __builtin_amdgcn_sdot4((int)rows[k].z, xq[2], D, false);
    D = __builtin_amdgcn_sdot4((int)rows[k].w, xq[3], D, false);
    D += dpp_i<0xB1>(D); D += dpp_i<0x4E>(D); D += dpp_i<0x141>(D);
    if (k < 8) keep0 = (sub == k) ? D : keep0; else keep1 = (sub == k - 8) ? D : keep1;
  }
  pd[sub * 8 + g8] = (float)keep0 * xscale;
  pd[64 + sub * 8 + g8] = (float)keep1 * xscale;
  ss += dpp_f<0xB1>(ss); ss += dpp_f<0x4E>(ss); ss += dpp_f<0x141>(ss);
  if (lane == 0) ((float*)(p.ws + OFF_PSS))[(size_t)tok * 8 + j] = ss;
}

__device__ __forceinline__ void peer9m_token(int tid, unsigned char* smem, const Params& p, int tok) {
  const int lane = tid & 63, w = __builtin_amdgcn_readfirstlane(tid >> 6);
  unsigned char* sAq = smem + w * 128;
  const float* pd = (const float*)(p.ws + OFF_PD) + (size_t)tok * 1024;
  float* pss = (float*)(p.ws + OFF_PSS) + (size_t)tok * 8;
  const int* ebuf = (const int*)(p.ws + OFF_M) + (size_t)tok * 128;
  float* gbuf = (float*)(p.ws + OFF_M + 17301504ull) + (size_t)tok * 128;
  const float* sus = (const float*)(p.ws + OFF_TAB + TAB_SU_OFF);
  const float* svs = (const float*)(p.ws + OFF_TAB + TAB_SV_OFF);
  float ss = 0.f, d0 = 0.f, d1 = 0.f;
#pragma unroll
  for (int j = 0; j < 8; ++j) { ss += pss[j]; d0 += pd[j * 128 + lane]; d1 += pd[j * 128 + 64 + lane]; }
  const int e0 = ebuf[lane], e1 = ebuf[64 + lane];
  const float rstd = rsqrtf(ss * (1.f / 1024.f) + 1e-6f);
  const float a0 = gelu_erf(rstd * sus[e0] * d0) * gbuf[lane] * svs[e0];
  const float a1 = gelu_erf(rstd * sus[e1] * d1) * gbuf[64 + lane] * svs[e1];
  float am = row16_max(fmaxf(fabsf(a0), fabsf(a1)));
  {
    const float m0 = __int_as_float(__builtin_amdgcn_readlane(__float_as_int(am), 0)), m1 = __int_as_float(__builtin_amdgcn_readlane(__float_as_int(am), 16));
    const float m2 = __int_as_float(__builtin_amdgcn_readlane(__float_as_int(am), 32)), m3 = __int_as_float(__builtin_amdgcn_readlane(__float_as_int(am), 48));
    am = fmaxf(fmaxf(m0, m1), fmaxf(m2, m3));
  }
  const float inv = (am > 0.f) ? 127.f / am : 0.f;
  const int addr0 = (lane & 7) * 16 + (lane >> 3);
  sAq[addr0] = (unsigned char)((int)rintf(a0 * inv) & 255);
  sAq[addr0 + 8] = (unsigned char)((int)rintf(a1 * inv) & 255);
  asm volatile("s_waitcnt lgkmcnt(0)" ::: "memory");
  unsigned pk = 0u;
  if (lane < 32) pk = ((const unsigned*)sAq)[lane];
  asm volatile("s_waitcnt vmcnt(0) lgkmcnt(0)" ::: "memory");
  if (lane < 32) ((unsigned*)gbuf)[lane] = pk;
  if (lane == 0) pss[0] = am * (1.f / 127.f);
  asm volatile("s_waitcnt lgkmcnt(0)" ::: "memory");
}

__device__ __forceinline__ void peer9b_token(int tid, const Params& p, int tok, int j) {
  const int lane = tid & 63, g8 = lane >> 3, sub = lane & 7;
  float* xr = p.out + O_Y + (size_t)tok * 1024 + j * 128 + sub * 16;
  const unsigned char* V = p.ws + OFF_TAB + TAB_V_OFF + j * 128 + sub * 16;
  const int* eb = (const int*)(p.ws + OFF_M) + (size_t)tok * 128 + g8;
  const uint4 apk = *(const uint4*)((const unsigned*)(p.ws + OFF_M + 17301504ull) + (size_t)tok * 128 + g8 * 4);
  const float scaleA = ((const float*)(p.ws + OFF_PSS))[(size_t)tok * 8];
  int eid[16];
#pragma unroll
  for (int k = 0; k < 16; ++k) eid[k] = eb[k * 8];
  uint4 rows[16];
#pragma unroll
  for (int k = 0; k < 16; ++k) rows[k] = *(const uint4*)(V + (size_t)eid[k] * 1024);
  int acci[16];
#pragma unroll
  for (int i = 0; i < 16; ++i) acci[i] = 0;
#define P9B_DW(DWF, DW, AP, KQ) { \
    const unsigned r0 = rows[(KQ) * 4 + 0].DWF, r1 = rows[(KQ) * 4 + 1].DWF, r2 = rows[(KQ) * 4 + 2].DWF, r3 = rows[(KQ) * 4 + 3].DWF; \
    const unsigned t0 = __builtin_amdgcn_perm(r1, r0, 0x05010400u), t1 = __builtin_amdgcn_perm(r1, r0, 0x07030602u); \
    const unsigned t2 = __builtin_amdgcn_perm(r3, r2, 0x05010400u), t3 = __builtin_amdgcn_perm(r3, r2, 0x07030602u); \
    acci[(DW) * 4 + 0] = __builtin_amdgcn_sdot4((int)__builtin_amdgcn_perm(t2, t0, 0x05040100u), (int)(AP), acci[(DW) * 4 + 0], false); \
    acci[(DW) * 4 + 1] = __builtin_amdgcn_sdot4((int)__builtin_amdgcn_perm(t2, t0, 0x07060302u), (int)(AP), acci[(DW) * 4 + 1], false); \
    acci[(DW) * 4 + 2] = __builtin_amdgcn_sdot4((int)__builtin_amdgcn_perm(t3, t1, 0x05040100u), (int)(AP), acci[(DW) * 4 + 2], false); \
    acci[(DW) * 4 + 3] = __builtin_amdgcn_sdot4((int)__builtin_amdgcn_perm(t3, t1, 0x07060302u), (int)(AP), acci[(DW) * 4 + 3], false); }
#define P9B_KQ(AP, KQ) { P9B_DW(x, 0, AP, KQ) P9B_DW(y, 1, AP, KQ) P9B_DW(z, 2, AP, KQ) P9B_DW(w, 3, AP, KQ) }
  P9B_KQ(apk.x, 0) P9B_KQ(apk.y, 1) P9B_KQ(apk.z, 2) P9B_KQ(apk.w, 3)
  float acc[16];
#pragma unroll
  for (int i = 0; i < 16; ++i) acc[i] = (float)acci[i] * scaleA;
  const int b3 = (lane >> 3) & 1, b4 = (lane >> 4) & 1, b5 = (lane >> 5) & 1;
  float v8[8], v4[4], v2[2];
#pragma unroll
  for (int i = 0; i < 8; ++i) { float keep = b3 ? acc[8 + i] : acc[i]; float send = b3 ? acc[i] : acc[8 + i]; v8[i] = keep + dpp_f<0x128>(send); }
#pragma unroll
  for (int i = 0; i < 4; ++i) { float keep = b4 ? v8[4 + i] : v8[i]; float send = b4 ? v8[i] : v8[4 + i]; v4[i] = keep + __shfl_xor(send, 16); }
#pragma unroll
  for (int i = 0; i < 2; ++i) { float keep = b5 ? v4[2 + i] : v4[i]; float send = b5 ? v4[i] : v4[2 + i]; v2[i] = keep + __shfl_xor(send, 32); }
  const int c = b3 * 8 + b4 * 4 + b5 * 2;
  float2 xv = *(const float2*)(xr + c);
  xv.x += v2[0];
  xv.y += v2[1];
  *(float2*)(xr + c) = xv;
}

__device__ __forceinline__ void final_norm_token(int tid, const Params& p, int tok) {
  const int lane = tid & 63;
  float* xr = p.out + O_Y + (size_t)tok * 1024 + lane * 16;
  const float* gf = p.in[11] + lane * 16;
  float y[16]; float s2 = 0.f;
#pragma unroll
  for (int i = 0; i < 4; ++i) { float4 v = *(const float4*)(xr + 4 * i); y[4 * i] = v.x; y[4 * i + 1] = v.y; y[4 * i + 2] = v.z; y[4 * i + 3] = v.w; s2 += v.x * v.x + v.y * v.y + v.z * v.z + v.w * v.w; }
  s2 = wave_sum(s2);
  const float r2 = rsqrtf(s2 * (1.f / 1024.f) + 1e-6f);
#pragma unroll
  for (int i = 0; i < 4; ++i) {
    float4 g = *(const float4*)(gf + 4 * i);
    *(float4*)(xr + 4 * i) = make_float4(y[4 * i] * r2 * g.x, y[4 * i + 1] * r2 * g.y, y[4 * i + 2] * r2 * g.z, y[4 * i + 3] * r2 * g.w);
  }
}

__device__ __forceinline__ unsigned f2ukey(float v) { unsigned u = __float_as_uint(v); return (u & 0x80000000u) ? ~u : (u | 0x80000000u); }
__device__ __forceinline__ float ukey2f(unsigned k) { unsigned u = (k & 0x80000000u) ? (k & 0x7fffffffu) : ~k; return __uint_as_float(u); }
__device__ __forceinline__ int popc64(unsigned long long m) { return __builtin_popcountll(m); }
__device__ __forceinline__ int mbcnt64(unsigned long long m) { return (int)__builtin_amdgcn_mbcnt_hi((unsigned)(m >> 32), __builtin_amdgcn_mbcnt_lo((unsigned)m, 0u)); }

struct TopkFrags { bf16x8 a[2][2]; bf16x8 b[2][2]; };
__device__ __forceinline__ void topk_load(TopkFrags& f, int tid, const Params& p, int layer, int item) {
  const int lane = tid & 63, w = __builtin_amdgcn_readfirstlane(tid >> 6);
  const int l16 = lane & 15, quad = lane >> 4;
  const int h = item & 7, tok0 = (item >> 3) * 32;
  const int pp = w >> 2;
  const bf16_t* qb = (const bf16_t*)(p.ws + OFF_QBUF);
  const bf16_t* keys = (const bf16_t*)(p.ws + OFF_WT) + WT_KEYS + (size_t)((layer * 8 + h) * 2 + pp) * 8192;
#pragma unroll
  for (int ks = 0; ks < 2; ++ks) {
#pragma unroll
    for (int mt = 0; mt < 2; ++mt) f.a[ks][mt] = *(const bf16x8*)(qb + (size_t)(tok0 + mt * 16 + l16) * 1024 + h * 128 + pp * 64 + ks * 32 + quad * 8);
#pragma unroll
    for (int j = 0; j < 2; ++j) {
      const int nt = (w & 3) * 2 + j;
      f.b[ks][j] = *(const bf16x8*)(keys + (nt * 16 + l16) * 64 + ks * 32 + quad * 8);
    }
  }
}

__device__ __forceinline__ void peer_topk_item(int tid, unsigned char* smem, const Params& p, const TopkFrags& f, int item) {
  unsigned* sS = (unsigned*)smem;
  const int lane = tid & 63, w = __builtin_amdgcn_readfirstlane(tid >> 6);
  const int l16 = lane & 15, quad = lane >> 4;
  const int h = item & 7, tile = item >> 3;
  const int tok0 = tile * 32;
  unsigned* wtop = (unsigned*)(smem + 32768) + w * 192;
  float* wexp = (float*)(wtop + 128);
  __syncthreads();
  {
    const int pp = w >> 2;
    f32x4 acc[2][2];
#pragma unroll
    for (int i = 0; i < 2; ++i)
#pragma unroll
      for (int j = 0; j < 2; ++j) acc[i][j] = (f32x4){0.f, 0.f, 0.f, 0.f};
#pragma unroll
    for (int ks = 0; ks < 2; ++ks)
#pragma unroll
      for (int mt = 0; mt < 2; ++mt)
#pragma unroll
        for (int j = 0; j < 2; ++j) acc[mt][j] = __builtin_amdgcn_mfma_f32_16x16x32_bf16(f.a[ks][mt], f.b[ks][j], acc[mt][j], 0, 0, 0);
#pragma unroll
    for (int mt = 0; mt < 2; ++mt)
#pragma unroll
      for (int j = 0; j < 2; ++j) {
        const int nt = (w & 3) * 2 + j;
#pragma unroll
        for (int r = 0; r < 4; ++r) {
          const int key = nt * 16 + l16;
          sS[((mt * 16 + quad * 4 + r) * 2 + pp) * 128 + key] = (f2ukey(acc[mt][j][r]) & ~127u) | (unsigned)(127 - key);
        }
      }
  }
  __syncthreads();
  int* ebuf = (int*)(p.ws + OFF_M);
  float* gbuf = (float*)(p.ws + OFF_M + 17301504ull);
  unsigned k0[8], k1[8], T[8];
#pragma unroll
  for (int c = 0; c < 8; ++c) {
    const unsigned* row = sS + ((w * 4 + (c >> 1)) * 2 + (c & 1)) * 128;
    k0[c] = row[lane]; k1[c] = row[64 + lane]; T[c] = 0u;
  }
#pragma unroll 1
  for (int bit = 31; bit >= 7; --bit) {
    const unsigned bm = 1u << bit;
#pragma unroll
    for (int c = 0; c < 8; ++c) {
      const unsigned cand = T[c] | bm;
      const int cnt = popc64(__builtin_amdgcn_ballot_w64(k0[c] >= cand)) + popc64(__builtin_amdgcn_ballot_w64(k1[c] >= cand));
      T[c] = (cnt >= 16) ? cand : T[c];
    }
  }
  {
    bool need = false;
#pragma unroll
    for (int c = 0; c < 8; ++c) {
      const int cnt = popc64(__builtin_amdgcn_ballot_w64(k0[c] >= T[c])) + popc64(__builtin_amdgcn_ballot_w64(k1[c] >= T[c]));
      need = need || (cnt > 16);
    }
    if (need) {
#pragma unroll 1
      for (int bit = 6; bit >= 0; --bit) {
        const unsigned bm = 1u << bit;
#pragma unroll
        for (int c = 0; c < 8; ++c) {
          const unsigned cand = T[c] | bm;
          const int cnt = popc64(__builtin_amdgcn_ballot_w64(k0[c] >= cand)) + popc64(__builtin_amdgcn_ballot_w64(k1[c] >= cand));
          T[c] = (cnt >= 16) ? cand : T[c];
        }
      }
    }
  }
#pragma unroll
  for (int c = 0; c < 8; ++c) {
    const unsigned long long m0 = __builtin_amdgcn_ballot_w64(k0[c] >= T[c]);
    const unsigned long long m1 = __builtin_amdgcn_ballot_w64(k1[c] >= T[c]);
    const int s0 = mbcnt64(m0), s1 = popc64(m0) + mbcnt64(m1);
    if (k0[c] >= T[c]) wtop[c * 16 + s0] = k0[c];
    if (k1[c] >= T[c]) wtop[c * 16 + s1] = k1[c];
  }
  asm volatile("s_waitcnt lgkmcnt(0)" ::: "memory");
  float cs[4][4];
  unsigned ck[4][4], T2[4], ka[4];
  uint4 kb4[4];
#pragma unroll
  for (int t = 0; t < 4; ++t) {
    ka[t] = wtop[(t * 2) * 16 + (lane >> 2)];
    kb4[t] = *(const uint4*)(wtop + (t * 2 + 1) * 16 + (lane & 3) * 4);
    const float a = ukey2f(ka[t]);
    cs[t][0] = a + ukey2f(kb4[t].x); cs[t][1] = a + ukey2f(kb4[t].y); cs[t][2] = a + ukey2f(kb4[t].z); cs[t][3] = a + ukey2f(kb4[t].w);
#pragma unroll
    for (int jj = 0; jj < 4; ++jj) ck[t][jj] = (f2ukey(cs[t][jj]) & ~255u) | (unsigned)(255 - (lane * 4 + jj));
    T2[t] = 0u;
  }
#pragma unroll 1
  for (int bit = 31; bit >= 8; --bit) {
    const unsigned bm = 1u << bit;
#pragma unroll
    for (int t = 0; t < 4; ++t) {
      const unsigned cand = T2[t] | bm;
      int cnt = 0;
#pragma unroll
      for (int jj = 0; jj < 4; ++jj) cnt += popc64(__builtin_amdgcn_ballot_w64(ck[t][jj] >= cand));
      T2[t] = (cnt >= 16) ? cand : T2[t];
    }
  }
  {
    bool need = false;
#pragma unroll
    for (int t = 0; t < 4; ++t) {
      int cnt = 0;
#pragma unroll
      for (int jj = 0; jj < 4; ++jj) cnt += popc64(__builtin_amdgcn_ballot_w64(ck[t][jj] >= T2[t]));
      need = need || (cnt > 16);
    }
    if (need) {
#pragma unroll 1
      for (int bit = 7; bit >= 0; --bit) {
        const unsigned bm = 1u << bit;
#pragma unroll
        for (int t = 0; t < 4; ++t) {
          const unsigned cand = T2[t] | bm;
          int cnt = 0;
#pragma unroll
          for (int jj = 0; jj < 4; ++jj) cnt += popc64(__builtin_amdgcn_ballot_w64(ck[t][jj] >= cand));
          T2[t] = (cnt >= 16) ? cand : T2[t];
        }
      }
    }
  }
  int slot[4][4];
  float ev[4][4];
#pragma unroll
  for (int t = 0; t < 4; ++t) {
    const float cT = ukey2f(T2[t]);
    int base = 0;
#pragma unroll
    for (int jj = 0; jj < 4; ++jj) {
      const bool win = ck[t][jj] >= T2[t];
      const unsigned long long m = __builtin_amdgcn_ballot_w64(win);
      slot[t][jj] = win ? (base + mbcnt64(m)) : -1;
      base += popc64(m);
      ev[t][jj] = __expf(fminf(cs[t][jj] - cT, 60.f));
      if (win) wexp[t * 16 + slot[t][jj]] = ev[t][jj];
    }
  }
  asm volatile("s_waitcnt lgkmcnt(0)" ::: "memory");
#pragma unroll
  for (int t = 0; t < 4; ++t) {
    float es = 0.f;
#pragma unroll
    for (int q = 0; q < 4; ++q) { const float4 ee = *(const float4*)(wexp + t * 16 + q * 4); es += ee.x + ee.y + ee.z + ee.w; }
    const float ies = 1.f / es;
    const int i1 = 127 - (int)(ka[t] & 127u);
    const size_t o = (size_t)(tok0 + w * 4 + t) * 128 + h * 16;
    const unsigned kbv[4] = {kb4[t].x, kb4[t].y, kb4[t].z, kb4[t].w};
#pragma unroll
    for (int jj = 0; jj < 4; ++jj) {
      if (slot[t][jj] >= 0) {
        ebuf[o + slot[t][jj]] = i1 * 128 + (127 - (int)(kbv[jj] & 127u));
        gbuf[o + slot[t][jj]] = ev[t][jj] * ies;
      }
    }
  }
  asm volatile("s_waitcnt lgkmcnt(0)" ::: "memory");
}

struct EpiStoreBf16 { bf16_t* dst; int ld; __device__ void operator()(int r, int c, float v) const { dst[(size_t)r * ld + c] = f2bf(v); } };
struct EpiGlu { const bf16_t* z; const float* bias; bf16_t* mix; __device__ void operator()(int r, int c, float v) const {
  float zz = bf2f(z[(size_t)r * 512 + c]); float s = v + bias[c]; mix[(size_t)r * 1024 + 512 + c] = f2bf(zz / (1.f + __expf(-s))); } };
struct EpiRes0 { const float* xp; const float* xs; float* xres; __device__ void operator()(int r, int c, float v) const {
  float x = (r < T_P) ? xp[(size_t)r * 1024 + c] : xs[(size_t)(r - T_P) * 1024 + c]; xres[(size_t)r * 1024 + c] = x + v; } };
struct EpiRes1 { float* xres; __device__ void operator()(int r, int c, float v) const { xres[(size_t)r * 1024 + c] += v; } };
struct EpiPool { bf16_t* mix; const float* scale; int g; __device__ void operator()(int r, int c, float v) const {
  mix[(size_t)r * 1024 + g * 128 + c] = f2bf(v * scale[g * 128 + c]); } };
struct EpiKup { bf16_t* dst; int rowsPerB; int keyOff; int bStride; __device__ void operator()(int r, int c, float v) const {
  int b = r / rowsPerB, key = r % rowsPerB + keyOff; dst[((size_t)b * bStride + key) * 512 + c] = f2bf(v); } };
struct EpiVt { bf16_t* dst; int rowsPerB; int keyOff; int ldv; __device__ void operator()(int r, int c, float v) const {
  int b = r / rowsPerB, key = r % rowsPerB + keyOff; dst[((size_t)(b * 8 + (c >> 6)) * 64 + (c & 63)) * ldv + key] = f2bf(v); } };


typedef const Params __attribute__((address_space(4))) KParams;

constexpr size_t OFF_BAR = WS_NEED;
__device__ __forceinline__ void grid_barrier(unsigned* ctr, unsigned target) {
  asm volatile("s_waitcnt vmcnt(0)" ::: "memory");
  __syncthreads();
  if (threadIdx.x == 0) {
    __builtin_amdgcn_fence(__ATOMIC_RELEASE, "agent");
    asm volatile("s_waitcnt vmcnt(0)" ::: "memory");
    __hip_atomic_fetch_add(ctr, 1u, __ATOMIC_RELAXED, __HIP_MEMORY_SCOPE_AGENT);
    unsigned spins = 0;
    while (__hip_atomic_load(ctr, __ATOMIC_RELAXED, __HIP_MEMORY_SCOPE_AGENT) < target) {
      __builtin_amdgcn_s_sleep(1);
      if (++spins > (1u << 27)) break;
    }
    __builtin_amdgcn_fence(__ATOMIC_ACQUIRE, "agent");
    asm volatile("s_waitcnt vmcnt(0)" ::: "memory");
  }
  __syncthreads();
}
#define GRID_BAR() { unsigned* ctr_ = (unsigned*)(((KParams*)__builtin_amdgcn_kernarg_segment_ptr())->ws + OFF_BAR); bar_k += 1; grid_barrier(ctr_, (unsigned)bar_k * gridDim.x); }
#define PHASE_BEGIN \
  Params p; \
  { KParams* kp_ = (KParams*)__builtin_amdgcn_kernarg_segment_ptr(); asm volatile("" : "+s"(kp_)); \
    _Pragma("unroll") for (int i_ = 0; i_ < 38; ++i_) p.in[i_] = kp_->in[i_]; \
    p.out = kp_->out; p.ws = kp_->ws; } \
  int tid = threadIdx.x; asm volatile("" : "+v"(tid)); \
  const int lane = tid & 63, w = __builtin_amdgcn_readfirstlane(tid >> 6); \
  const int gw = blockIdx.x * 8 + w, nw = gridDim.x * 8; \
  const size_t gtid = (size_t)blockIdx.x * NT + tid, gthreads = (size_t)gridDim.x * NT; \
  bf16_t* wt = (bf16_t*)(p.ws + OFF_WT); \
  bf16_t* proj = (bf16_t*)(p.ws + OFF_PROJ); \
  bf16_t* mix = (bf16_t*)(p.ws + OFF_MIX); \
  bf16_t* qbuf = (bf16_t*)(p.ws + OFF_QBUF); \
  bf16_t* zbuf = (bf16_t*)(p.ws + OFF_Z); \
  float* xres = p.out + O_Y; \
  (void)lane; (void)gw; (void)nw; (void)gtid; (void)gthreads; (void)wt; (void)proj; (void)mix; (void)qbuf; (void)zbuf; (void)xres;

template <int LAYER>
__device__ __forceinline__ void peer_phases(int& bar_k, unsigned char* smem) {
  const int layer = LAYER;
    for (int rep_ = 0; rep_ < NREP(7); ++rep_)
    {
    PHASE_BEGIN
      int vb = 0;
      gemm_run<2>(tid, smem, xres, xres, T_TOT, 1024, p.in[10] + layer * 1024, wt + WT_PQ + (size_t)layer * 1048576, T_TOT, 1024, 1024, vb, EpiStoreBf16{qbuf, 1024});
    }
    GRID_BAR();
    for (int rep_ = 0; rep_ < NREP(8); ++rep_) {
    PHASE_BEGIN
    {
      TopkFrags fr;
      int item = blockIdx.x;
      if (item < 1056 * 8) topk_load(fr, tid, p, layer, item);
      for (; item < 1056 * 8; item += gridDim.x) {
        TopkFrags cur = fr;
        const int nxt = item + gridDim.x;
        if (nxt < 1056 * 8) topk_load(fr, tid, p, layer, nxt);
        peer_topk_item(tid, smem, p, cur, item);
      }
    }
    }
    GRID_BAR();
    for (int rep_ = 0; rep_ < NREP(9); ++rep_) {
    PHASE_BEGIN
      int j = blockIdx.x & 7, lb = blockIdx.x >> 3, nb = ((int)gridDim.x - j + 7) >> 3;
      {
        unsigned* cnt_ = (unsigned*)(p.ws + OFF_BAR) + 16;
        bool ok_ = true;
#pragma unroll
        for (int x_ = 0; x_ < 16; ++x_) {
          const unsigned c_ = __hip_atomic_load(&cnt_[x_], __ATOMIC_RELAXED, __HIP_MEMORY_SCOPE_AGENT);
          ok_ = ok_ && ((x_ < 8) ? (c_ > 0u) : (c_ == 0u));
        }
        if (ok_) {
          j = ((const int*)(smem + 45040))[0]; lb = ((const int*)(smem + 45040))[1];
          nb = (int)__hip_atomic_load(&cnt_[j], __ATOMIC_RELAXED, __HIP_MEMORY_SCOPE_AGENT);
        }
      }
      for (int tok = lb * 8 + w; tok < T_TOT; tok += nb * 8) peer9a_token(tid, p, layer, tok, j);
    }
    GRID_BAR();
    for (int rep_ = 0; rep_ < NREP(9); ++rep_) {
    PHASE_BEGIN
      for (int tok = gw; tok < T_TOT; tok += nw) peer9m_token(tid, smem, p, tok);
    }
    GRID_BAR();
    for (int rep_ = 0; rep_ < NREP(9); ++rep_) {
    PHASE_BEGIN
      int j = blockIdx.x & 7, lb = blockIdx.x >> 3, nb = ((int)gridDim.x - j + 7) >> 3;
      {
        unsigned* cnt_ = (unsigned*)(p.ws + OFF_BAR) + 16;
        bool ok_ = true;
#pragma unroll
        for (int x_ = 0; x_ < 16; ++x_) {
          const unsigned c_ = __hip_atomic_load(&cnt_[x_], __ATOMIC_RELAXED, __HIP_MEMORY_SCOPE_AGENT);
          ok_ = ok_ && ((x_ < 8) ? (c_ > 0u) : (c_ == 0u));
        }
        if (ok_) {
          j = ((const int*)(smem + 45040))[0]; lb = ((const int*)(smem + 45040))[1];
          nb = (int)__hip_atomic_load(&cnt_[j], __ATOMIC_RELAXED, __HIP_MEMORY_SCOPE_AGENT);
        }
      }
      for (int tok = lb * 8 + w; tok < T_TOT; tok += nb * 8) peer9b_token(tid, p, tok, j);
    }
    if (layer == 1) {
      GRID_BAR();
      for (int rep_ = 0; rep_ < NREP(9); ++rep_) {
      PHASE_BEGIN
        for (int tok = gw; tok < T_TOT; tok += nw) final_norm_token(tid, p, tok);
      }
    }
}

__global__ void __launch_bounds__(NT) mega(Params kparams_) {
  cg::grid_group grid = cg::this_grid();
  int bar_k = 0;
  __shared__ __attribute__((aligned(16))) unsigned char smem[45056];
  if (threadIdx.x == 0) {
    unsigned* cnt_ = (unsigned*)(((KParams*)__builtin_amdgcn_kernarg_segment_ptr())->ws + OFF_BAR) + 16;
    const unsigned xcc_ = (unsigned)__builtin_amdgcn_s_getreg((3 << 11) | 20) & 0xFu;
    const unsigned rank_ = __hip_atomic_fetch_add(&cnt_[xcc_], 1u, __ATOMIC_RELAXED, __HIP_MEMORY_SCOPE_AGENT);
    ((int*)(smem + 45040))[0] = (int)xcc_;
    ((int*)(smem + 45040))[1] = (int)rank_;
  }

  for (int rep_ = 0; rep_ < NREP(0); ++rep_)
  {
    PHASE_BEGIN
    int vb = 0;
    transpose_convert(tid, smem, p.in[12], wt + WT_IN_E, 1024, 1280, vb);
    transpose_convert(tid, smem, p.in[13], wt + WT_OUT_E, 1024, 1024, vb);
    transpose_convert(tid, smem, p.in[23], wt + WT_GLU, 512, 512, vb);
    transpose_convert(tid, smem, p.in[25], wt + WT_IN_O, 1024, 1312, vb);
    transpose_convert(tid, smem, p.in[26], wt + WT_OUT_O, 1024, 1024, vb);
    for (int g = 0; g < 4; ++g) transpose_convert(tid, smem, p.in[27] + g * 16384, wt + WT_POOL + g * 16384, 128, 128, vb);
    transpose_convert(tid, smem, p.in[31], wt + WT_UQ, 512, 768, vb);
    transpose_convert(tid, smem, p.in[32], wt + WT_UK, 256, 512, vb);
    transpose_convert(tid, smem, p.in[33], wt + WT_UV, 256, 512, vb);
    transpose_convert(tid, smem, p.in[34], wt + WT_PQ, 1024, 1024, vb);
    transpose_convert(tid, smem, p.in[34] + 1048576, wt + WT_PQ + 1048576, 1024, 1024, vb);
    convert_plain(tid, p.in[35], wt + WT_KEYS, 262144);
    quant_rows(p.in[36], p.ws + OFF_TAB, (float*)(p.ws + OFF_TAB + TAB_SU_OFF), gw, nw, tid);
    quant_rows(p.in[37], p.ws + OFF_TAB + TAB_V_OFF, (float*)(p.ws + OFF_TAB + TAB_SV_OFF), gw, nw, tid);
  }
  grid.sync();

  for (int rep_ = 0; rep_ < NREP(1); ++rep_)
  {
    PHASE_BEGIN
    int vb = 0;
    gemm_run<2>(tid, smem, p.in[0], p.in[1], T_P, 1024, p.in[9], wt + WT_IN_E, T_TOT, 1280, 1024, vb, EpiStoreBf16{proj, 1280});
  }
  GRID_BAR();

  for (int rep_ = 0; rep_ < NREP(2); ++rep_)
  {
    PHASE_BEGIN
    bf16_t* vt0 = (bf16_t*)(p.ws + OFF_VT0);
    bf16_t* kall = (bf16_t*)(p.ws + OFF_KALL);
    bf16_t* vtall = (bf16_t*)(p.ws + OFF_VTALL);
    for (int tok = gw; tok < T_TOT; tok += nw) {
      const bool isS = tok >= T_P;
      int b, t, pos;
      if (!isS) { b = tok >> 12; t = tok & 4095; pos = t; } else { int s = tok - T_P; b = s >> 5; t = s & 31; pos = 2048 + t; }
      bf16_t* row = proj + (size_t)tok * 1280;
      const int lm = lane & 7;
      float sn[8], cs[8];
#pragma unroll
      for (int j = 0; j < 8; ++j) { float inv = exp2f(-(float)j * (LOG2_THETA / 8.f)); sincos_rev((float)pos * inv, sn[j], cs[j]); }
      {
        uint4 qv = *(const uint4*)(row + lane * 8);
        float x[8]; unpack8(qv, x);
#pragma unroll
        for (int j = 0; j < 8; ++j) {
          float other = __shfl_xor(x[j], 1);
          if (lm == 0) x[j] = x[j] * cs[j] - other * sn[j];
          else if (lm == 1) x[j] = x[j] * cs[j] + other * sn[j];
        }
        *(uint4*)(row + lane * 8) = pack8(x);
      }
      {
        uint4 kv = make_uint4(0, 0, 0, 0);
        if (lane < 32) kv = *(const uint4*)(row + 512 + lane * 8);
        float x[8]; unpack8(kv, x);
#pragma unroll
        for (int j = 0; j < 8; ++j) {
          float other = __shfl_xor(x[j], 1);
          if (lane < 16) {
            if (lm == 0) x[j] = x[j] * cs[j] - other * sn[j];
            else if (lm == 1) x[j] = x[j] * cs[j] + other * sn[j];
          }
        }
        if (lane < 32) {
          const uint4 pk = pack8(x);
          const int e0 = (lane & 15) * 8;
          if (!isS) {
            if (lane < 16) *(uint4*)(row + 512 + lane * 8) = pk;
            else {
              const int kvh = e0 >> 6, d0 = e0 & 63;
#pragma unroll
              for (int j = 0; j < 8; ++j) vt0[((size_t)(b * 2 + kvh) * 64 + d0 + j) * 4096 + t] = f2bf(x[j]);
            }
            if (t >= 3968) {
              float* dst = p.out + ((lane < 16) ? O_SWAK_P : O_SWAV_P) + ((size_t)(b * 128 + (t - 3968)) * 128 + e0);
              *(float4*)dst = make_float4(x[0], x[1], x[2], x[3]);
              *(float4*)(dst + 4) = make_float4(x[4], x[5], x[6], x[7]);
            }
          } else {
            float* dst = p.out + ((lane < 16) ? O_SWAK_S : O_SWAV_S) + ((size_t)(b * 128 + 96 + t) * 128 + e0);
            *(float4*)dst = make_float4(x[0], x[1], x[2], x[3]);
            *(float4*)(dst + 4) = make_float4(x[4], x[5], x[6], x[7]);
            if (lane < 16) *(uint4*)(kall + (size_t)(b * 160 + 128 + t) * 128 + e0) = pk;
            else {
              const int kvh = e0 >> 6, d0 = e0 & 63;
#pragma unroll
              for (int j = 0; j < 8; ++j) vtall[((size_t)(b * 2 + kvh) * 64 + d0 + j) * 192 + 128 + t] = f2bf(x[j]);
            }
          }
        }
      }
    }
    for (size_t idx = gtid; idx < (size_t)32 * 96 * 128; idx += gthreads) {
      const int e = (int)(idx & 127); const int wd = (int)((idx >> 7) % 96); const int b = (int)(idx / (96 * 128));
      const size_t src = ((size_t)(b * 128 + 32 + wd)) * 128 + e, dst = ((size_t)(b * 128 + wd)) * 128 + e;
      p.out[O_SWAK_S + dst] = p.in[2][src];
      p.out[O_SWAV_S + dst] = p.in[3][src];
    }
    for (size_t idx = gtid; idx < (size_t)32 * 128 * 128; idx += gthreads) {
      const int e = (int)(idx & 127); const int key = (int)((idx >> 7) & 127); const int b = (int)(idx >> 14);
      kall[(size_t)(b * 160 + key) * 128 + e] = f2bf(p.in[2][idx]);
      vtall[((size_t)(b * 2 + (e >> 6)) * 64 + (e & 63)) * 192 + key] = f2bf(p.in[3][idx]);
    }
    for (size_t idx = gtid; idx < (size_t)32 * 2 * 64 * 32; idx += gthreads) {
      const int kk = (int)(idx & 31); const size_t rr = idx >> 5;
      vtall[rr * 192 + 160 + kk] = 0;
    }
    float* sUw = (float*)smem + w * 512;
    for (int item = gw; item < 32768; item += nw) s5_item<0>(tid, sUw, p, item);
  }
  GRID_BAR();

  for (int rep_ = 0; rep_ < NREP(3); ++rep_)
  {
    PHASE_BEGIN
    if (gtid < 16384) {
      const int n = (int)(gtid & 63), g = (int)((gtid >> 6) & 31), b = (int)(gtid >> 11);
      const int gn = g * 64 + n;
      const float lr = fminf(p.in[15][gn], -1e-4f), li = p.in[16][gn];
      const float dt = __expf(p.in[17][g]);
      const float mag = __expf(lr * dt);
      float sn, cs; sincos_rev(li * dt, sn, cs);
      float ar = mag * cs, ai = mag * sn;
#pragma unroll
      for (int i = 0; i < 5; ++i) { float nr = ar * ar - ai * ai, ni = 2.f * ar * ai; ar = nr; ai = ni; }
      const float* s1re = (const float*)(p.ws + OFF_QMLA);
      const float* s1im = s1re + 2097152;
      float* hinre = (float*)(p.ws + OFF_QMLA) + 2 * 2097152;
      float* hinim = hinre + 2097152;
      float hr = 0.f, hi = 0.f;
#pragma unroll 8
      for (int c = 0; c < 128; ++c) {
        const size_t idx = ((size_t)(b * 128 + c) * 32 + g) * 64 + n;
        hinre[idx] = hr; hinim[idx] = hi;
        const float sr = s1re[idx], si = s1im[idx];
        const float nhr = ar * hr - ai * hi + sr, nhi = ar * hi + ai * hr + si;
        hr = nhr; hi = nhi;
      }
      p.out[O_SSMRE_P + (size_t)(b * 32 + g) * 64 + n] = hr;
      p.out[O_SSMIM_P + (size_t)(b * 32 + g) * 64 + n] = hi;
    }
    const bf16_t* vt0 = (const bf16_t*)(p.ws + OFF_VT0);
    const bf16_t* kall = (const bf16_t*)(p.ws + OFF_KALL);
    const bf16_t* vtall = (const bf16_t*)(p.ws + OFF_VTALL);
    const float* sink = p.in[14];
    for (int item = blockIdx.x; item < 2048 + 256; item += gridDim.x) {
      AttnDesc d;
      d.scale = 0.125f; d.kx = nullptr; d.pos0 = 0;
      if (item < 2048) {
        const int h = item & 7, pr = (item >> 3) & 31, b = item >> 8;
        const int kvh = h >> 2;
        const int chunk = pr * 2 + (w >> 2);
        const int tok = b * 4096 + chunk * 64 + (w & 3) * 16;
        d.q = proj + (size_t)tok * 1280 + h * 64; d.ldq = 1280; d.active = 1;
        d.kt_lo = max(0, chunk - 2); d.kt_hi = chunk + 1;
        d.out = mix + (size_t)tok * 1024 + h * 64; d.ldo = 1024;
        d.m0 = sink[h]; d.l0 = 1.f;
        d.k = proj + (size_t)(b * 4096) * 1280 + 512 + kvh * 64; d.ldk = 1280;
        d.vt = vt0 + (size_t)(b * 2 + kvh) * 64 * 4096; d.ldv = 4096; d.nkeys = 4096;
        d.bt_lo = max(0, pr * 2 - 2); d.bt_hi = pr * 2 + 2;
      } else {
        const int it = item - 2048;
        const int h = it & 7, b = it >> 3;
        const int kvh = h >> 2;
        const int tok = T_P + b * 32 + (w & 1) * 16;
        d.q = proj + (size_t)tok * 1280 + h * 64; d.ldq = 1280; d.active = (w < 2);
        d.kt_lo = 0; d.kt_hi = 3;
        d.out = mix + (size_t)tok * 1024 + h * 64; d.ldo = 1024;
        d.m0 = sink[h]; d.l0 = 1.f;
        d.k = kall + (size_t)(b * 160) * 128 + kvh * 64; d.ldk = 128;
        d.vt = vtall + (size_t)(b * 2 + kvh) * 64 * 192; d.ldv = 192; d.nkeys = 160;
        d.bt_lo = 0; d.bt_hi = 3;
      }
      attn_item<64>(tid, smem, d);
    }
  }
  GRID_BAR();

  for (int rep_ = 0; rep_ < NREP(4); ++rep_)
  {
    PHASE_BEGIN
    float* sUw = (float*)smem + w * 512;
    for (int item = gw; item < 33792; item += nw) s5_item<1>(tid, sUw, p, item);
  }
  GRID_BAR();

  for (int rep_ = 0; rep_ < NREP(5); ++rep_)
  {
    PHASE_BEGIN
    int vb = 0;
    gemm_run<0>(tid, smem, zbuf, zbuf, T_TOT, 512, nullptr, wt + WT_GLU, T_TOT, 512, 512, vb, EpiGlu{zbuf, p.in[24], mix});
  }
  GRID_BAR();

  for (int rep_ = 0; rep_ < NREP(6); ++rep_)
  {
    PHASE_BEGIN
    int vb = 0;
    gemm_run<0>(tid, smem, mix, mix, T_TOT, 1024, nullptr, wt + WT_OUT_E, T_TOT, 1024, 1024, vb, EpiRes0{p.in[0], p.in[1], xres});
  }
  GRID_BAR();

  peer_phases<0>(bar_k, smem);
  GRID_BAR();
      for (int rep_ = 0; rep_ < NREP(10); ++rep_)
      {
    PHASE_BEGIN
        int vb = 0;
        gemm_run<2>(tid, smem, xres, xres, T_TOT, 1024, p.in[9] + 1024, wt + WT_IN_O, T_TOT, 1312, 1024, vb, EpiStoreBf16{proj, 1312});
      }
      GRID_BAR();
      for (int rep_ = 0; rep_ < NREP(11); ++rep_)
      {
    PHASE_BEGIN
        bf16_t* cqn = zbuf;
        bf16_t* mbuf = (bf16_t*)(p.ws + OFF_M);
        bf16_t* cbuf = (bf16_t*)(p.ws + OFF_C);
        bf16_t* kpbuf = (bf16_t*)(p.ws + OFF_KP);
        bf16_t* kps = (bf16_t*)(p.ws + OFF_KPS);
        for (int tok = gw; tok < T_TOT; tok += nw) {
          const bool isS = tok >= T_P;
          int b, t, pos;
          if (!isS) { b = tok >> 12; t = tok & 4095; pos = t; } else { int s = tok - T_P; b = s >> 5; t = s & 31; pos = 2048 + t; }
          const bf16_t* row = proj + (size_t)tok * 1312;
          {
            uint4 v = *(const uint4*)(row + lane * 8);
            float x[8]; unpack8(v, x);
            float ss = 0.f;
#pragma unroll
            for (int j = 0; j < 8; ++j) ss += x[j] * x[j];
            ss = wave_sum(ss);
            const float rs = rsqrtf(ss * (1.f / 512.f) + 1e-6f);
            const float4 g0 = *(const float4*)(p.in[29] + lane * 8), g1 = *(const float4*)(p.in[29] + lane * 8 + 4);
            x[0] *= rs * g0.x; x[1] *= rs * g0.y; x[2] *= rs * g0.z; x[3] *= rs * g0.w;
            x[4] *= rs * g1.x; x[5] *= rs * g1.y; x[6] *= rs * g1.z; x[7] *= rs * g1.w;
            *(uint4*)(cqn + (size_t)tok * 512 + lane * 8) = pack8(x);
          }
          {
            uint2 v = *(const uint2*)(row + 512 + lane * 4);
            float x0 = lo2f(v.x), x1 = hi2f(v.x), x2 = lo2f(v.y), x3 = hi2f(v.y);
            float ss = wave_sum(x0 * x0 + x1 * x1 + x2 * x2 + x3 * x3);
            const float rs = rsqrtf(ss * (1.f / 256.f) + 1e-6f);
            const float4 g = *(const float4*)(p.in[30] + lane * 4);
            x0 *= rs * g.x; x1 *= rs * g.y; x2 *= rs * g.z; x3 *= rs * g.w;
            uint2 o; o.x = pack2(x0, x1); o.y = pack2(x2, x3);
            *(uint2*)(cbuf + (size_t)tok * 256 + lane * 4) = o;
            float* dst = isS ? (p.out + O_CKV_S + (size_t)(tok - T_P) * 256 + lane * 4) : (p.out + O_CKV_P + (size_t)tok * 256 + lane * 4);
            *(float4*)dst = make_float4(x0, x1, x2, x3);
          }
          {
            float xv = 0.f;
            if (lane < 32) xv = bf2f(row[768 + lane]);
            const float other = __shfl_xor(xv, 16);
            const int f = lane & 15;
            const float inv = exp2f(-(float)f * (LOG2_THETA / 16.f));
            float sn, cs; sincos_rev((float)pos * inv, sn, cs);
            const float r = (lane < 16) ? (xv * cs - other * sn) : (xv * cs + other * sn);
            if (lane < 32) {
              kpbuf[(size_t)tok * 32 + lane] = f2bf(r);
              if (isS) { p.out[O_KPE_S + (size_t)(tok - T_P) * 32 + lane] = r; kps[((size_t)b * 2112 + 2048 + t) * 32 + lane] = f2bf(r); }
              else p.out[O_KPE_P + (size_t)tok * 32 + lane] = r;
            }
          }
          {
            const int gi = lane >> 4; const int wlen = 2 << gi;
            float tot[8], cur[8];
#pragma unroll
            for (int j = 0; j < 8; ++j) tot[j] = 0.f;
            uint4 v = *(const uint4*)(row + 800 + lane * 8);
            unpack8(v, cur);
#pragma unroll
            for (int j = 0; j < 8; ++j) tot[j] = cur[j];
            for (int jb = 1; jb < 16; ++jb) {
              if (jb < wlen) {
                const int tt = t - jb;
                if (tt >= 0) {
                  uint4 pv = *(const uint4*)(row - (size_t)jb * 1312 + 800 + lane * 8);
                  float y[8]; unpack8(pv, y);
#pragma unroll
                  for (int j = 0; j < 8; ++j) tot[j] += y[j];
                } else if (isS) {
                  const float* sp = p.in[6] + ((size_t)b * 15 + (15 + tt)) * 512 + lane * 8;
                  float4 a = *(const float4*)sp, bq = *(const float4*)(sp + 4);
                  tot[0] += a.x; tot[1] += a.y; tot[2] += a.z; tot[3] += a.w; tot[4] += bq.x; tot[5] += bq.y; tot[6] += bq.z; tot[7] += bq.w;
                }
              }
            }
            const float cnt = (float)min(pos + 1, wlen);
            float mm[8];
#pragma unroll
            for (int j = 0; j < 8; ++j) mm[j] = tot[j] / cnt - cur[j];
            *(uint4*)(mbuf + (size_t)tok * 512 + lane * 8) = pack8(mm);
            const int tlen = isS ? 32 : 4096;
            if (t >= tlen - 15) {
              const int i = t - (tlen - 15);
              float* dst = isS ? (p.out + O_POOL_S + ((size_t)b * 15 + i) * 512 + lane * 8) : (p.out + O_POOL_P + ((size_t)b * 15 + i) * 512 + lane * 8);
              *(float4*)dst = make_float4(cur[0], cur[1], cur[2], cur[3]);
              *(float4*)(dst + 4) = make_float4(cur[4], cur[5], cur[6], cur[7]);
            }
          }
        }
        for (size_t idx = gtid; idx < (size_t)32 * 2048 * 32; idx += gthreads) {
          const int e = (int)(idx & 31); const int key = (int)((idx >> 5) & 2047); const int b = (int)(idx >> 16);
          kps[((size_t)b * 2112 + key) * 32 + e] = f2bf(p.in[8][idx]);
        }
      }
      GRID_BAR();
      for (int rep_ = 0; rep_ < NREP(12); ++rep_)
      {
    PHASE_BEGIN
        bf16_t* cqn = zbuf;
        bf16_t* mbuf = (bf16_t*)(p.ws + OFF_M);
        bf16_t* cbuf = (bf16_t*)(p.ws + OFF_C);
        bf16_t* qmla = (bf16_t*)(p.ws + OFF_QMLA);
        bf16_t* kupp = qbuf;
        bf16_t* vtp = qbuf + 16777216;
        bf16_t* kups = (bf16_t*)(p.ws + OFF_KUPS);
        bf16_t* vts = (bf16_t*)(p.ws + OFF_VTS);
        for (size_t idx = gtid; idx < (size_t)32 * 8 * 64 * 32; idx += gthreads) {
          const int kk = (int)(idx & 31); const size_t rr = idx >> 5;
          vts[rr * 2112 + 2080 + kk] = 0;
        }
        int vb = 0;
        gemm_run<1>(tid, smem, p.in[7], p.in[7], 65536, 256, nullptr, wt + WT_UK, 65536, 512, 256, vb, EpiKup{kups, 2048, 0, 2112});
        gemm_run<1>(tid, smem, p.in[7], p.in[7], 65536, 256, nullptr, wt + WT_UV, 65536, 512, 256, vb, EpiVt{vts, 2048, 0, 2112});
        gemm_run<0>(tid, smem, cqn, cqn, T_TOT, 512, nullptr, wt + WT_UQ, T_TOT, 768, 512, vb, EpiStoreBf16{qmla, 768});
        gemm_run<0>(tid, smem, cbuf, cbuf, T_P, 256, nullptr, wt + WT_UK, T_P, 512, 256, vb, EpiKup{kupp, 4096, 0, 4096});
        gemm_run<0>(tid, smem, cbuf, cbuf, T_P, 256, nullptr, wt + WT_UV, T_P, 512, 256, vb, EpiVt{vtp, 4096, 0, 4096});
        gemm_run<0>(tid, smem, cbuf + (size_t)T_P * 256, cbuf, 1024, 256, nullptr, wt + WT_UK, 1024, 512, 256, vb, EpiKup{kups, 32, 2048, 2112});
        gemm_run<0>(tid, smem, cbuf + (size_t)T_P * 256, cbuf, 1024, 256, nullptr, wt + WT_UV, 1024, 512, 256, vb, EpiVt{vts, 32, 2048, 2112});
        for (int g = 0; g < 4; ++g)
          gemm_run<0>(tid, smem, mbuf + g * 128, mbuf, T_TOT, 512, nullptr, wt + WT_POOL + g * 16384, T_TOT, 128, 128, vb, EpiPool{mix, p.in[28], g});
      }
      GRID_BAR();
      for (int rep_ = 0; rep_ < NREP(13); ++rep_)
      {
    PHASE_BEGIN
        const bf16_t* qmla = (const bf16_t*)(p.ws + OFF_QMLA);
        const bf16_t* kupp = qbuf;
        const bf16_t* vtp = qbuf + 16777216;
        const bf16_t* kups = (const bf16_t*)(p.ws + OFF_KUPS);
        const bf16_t* vts = (const bf16_t*)(p.ws + OFF_VTS);
        const bf16_t* kpbuf = (const bf16_t*)(p.ws + OFF_KP);
        const bf16_t* kps = (const bf16_t*)(p.ws + OFF_KPS);
        const int G = gridDim.x;
        const bool xsched = (G == 256);
        const int nitems = 2048 + 256;
        const int xcd = blockIdx.x & 7, loc = blockIdx.x >> 3;
        for (int k = 0;; ++k) {
          int pit, sit = -1;
          if (xsched) {
            if (k >= 9) break;
            if (k == 0) { pit = -1; sit = blockIdx.x; }
            else {
              const int r = k - 1;
              const int grp = xcd + 8 * r;
              const int pr = (r & 1) ? (31 - loc) : loc;
              pit = ((31 - pr) << 6) | grp;
            }
          } else {
            const int posn = (k & 1) ? (G - 1 - (int)blockIdx.x) : (int)blockIdx.x;
            const int v = k * G + posn;
            if (k * G >= nitems) break;
            if (v >= nitems) continue;
            if (v < 1024) pit = v; else if (v < 1280) { pit = -1; sit = v - 1024; } else pit = v - 256;
          }
          AttnDesc d;
          d.scale = 0.10206207261596575f; d.m0 = -1e30f; d.l0 = 0.f;
          if (pit >= 0) {
            const int pr = 31 - (pit >> 6); const int h = pit & 7, b = (pit >> 3) & 7;
            const int chunk = pr * 2 + (w >> 2);
            const int tok = b * 4096 + chunk * 64 + (w & 3) * 16;
            d.q = qmla + (size_t)tok * 768 + h * 96; d.ldq = 768; d.active = 1; d.pos0 = chunk * 64 + (w & 3) * 16;
            d.kt_lo = 0; d.kt_hi = chunk + 1;
            d.out = mix + (size_t)tok * 1024 + 512 + h * 64; d.ldo = 1024;
            d.k = kupp + (size_t)(b * 4096) * 512 + h * 64; d.ldk = 512;
            d.kx = kpbuf + (size_t)(b * 4096) * 32;
            d.vt = vtp + (size_t)(b * 8 + h) * 64 * 4096; d.ldv = 4096; d.nkeys = 4096;
            d.bt_lo = 0; d.bt_hi = pr * 2 + 2;
          } else {
            const int h = sit & 7, b = sit >> 3;
            const int tok = T_P + b * 32 + (w & 1) * 16;
            d.q = qmla + (size_t)tok * 768 + h * 96; d.ldq = 768; d.active = (w < 2); d.pos0 = 2048 + (w & 1) * 16;
            d.kt_lo = 0; d.kt_hi = 33;
            d.out = mix + (size_t)tok * 1024 + 512 + h * 64; d.ldo = 1024;
            d.k = kups + (size_t)(b * 2112) * 512 + h * 64; d.ldk = 512;
            d.kx = kps + (size_t)(b * 2112) * 32;
            d.vt = vts + (size_t)(b * 8 + h) * 64 * 2112; d.ldv = 2112; d.nkeys = 2080;
            d.bt_lo = 0; d.bt_hi = 33;
          }
          attn_item<96>(tid, smem, d);
        }
      }
      GRID_BAR();
      for (int rep_ = 0; rep_ < NREP(14); ++rep_)
      {
    PHASE_BEGIN
        quant_rows(p.in[36] + 16777216, p.ws + OFF_TAB, (float*)(p.ws + OFF_TAB + TAB_SU_OFF), gw, nw, tid);
        quant_rows(p.in[37] + 16777216, p.ws + OFF_TAB + TAB_V_OFF, (float*)(p.ws + OFF_TAB + TAB_SV_OFF), gw, nw, tid);
        int vb = 0;
        gemm_run<0>(tid, smem, mix, mix, T_TOT, 1024, nullptr, wt + WT_OUT_O, T_TOT, 1024, 1024, vb, EpiRes1{xres});
      }
      GRID_BAR();
  peer_phases<1>(bar_k, smem);
}

extern "C" void kernel_launch(void* const* d_in, const int* in_sizes, int n_in, void* d_out, int out_size, void* d_ws, size_t ws_size, hipStream_t stream) {
  static int grid_blocks = 0;
  if (grid_blocks == 0) {
    int dev = 0, cus = 0, per_cu = 0;
    hipGetDevice(&dev);
    hipDeviceGetAttribute(&cus, hipDeviceAttributeMultiprocessorCount, dev);
    hipOccupancyMaxActiveBlocksPerMultiprocessor(&per_cu, (const void*)mega, NT, 0);
    if (per_cu < 1) per_cu = 1;
    if (per_cu > 1) per_cu = 1;
    grid_blocks = cus * per_cu;
    if (ws_size < WS_NEED + 256) fprintf(stderr, "kernel_launch: workspace too small: %zu < %zu\n", ws_size, (size_t)WS_NEED);
  }
  hipMemsetAsync((unsigned char*)d_ws + OFF_BAR, 0, 256, stream);
  Params p{};
  for (int i = 0; i < 38; ++i) p.in[i] = (const float*)d_in[i];
  p.out = (float*)d_out;
  p.ws = (unsigned char*)d_ws;
  void* args[] = {&p};
  hipError_t e = hipLaunchCooperativeKernel((const void*)mega, dim3(grid_blocks), dim3(NT), args, 0, stream);
  if (e != hipSuccess) fprintf(stderr, "cooperative launch failed: %s (grid %d)\n", hipGetErrorString(e), grid_blocks);
}
```

```cpp
#include <hip/hip_runtime.h>
#include <hip/hip_bf16.h>
#include <hip/hip_cooperative_groups.h>
#include <cstdio>
namespace cg = cooperative_groups;

typedef unsigned short bf16_t;
using bf16x8 = __attribute__((ext_vector_type(8))) short;
using f32x4 = __attribute__((ext_vector_type(4))) float;

#ifndef PH
#define PH 0xFFFFFFu
#endif
#ifndef DBL
#define DBL 0u
#endif
#define NREP(n) ((int)((PH >> (n)) & 1u) * (1 + (int)((DBL >> (n)) & 1u)))
#define NT 512
#define T_TOT 33792
#define T_P 32768
#define LOG2_THETA 18.931568569324174f

#define O_Y 0
#define O_SWAK_P 34603008
#define O_SWAV_P 34734080
#define O_SSMRE_P 34865152
#define O_SSMIM_P 34881536
#define O_POOL_P 34897920
#define O_CKV_P 34959360
#define O_KPE_P 43347968
#define O_SWAK_S 44396544
#define O_SWAV_S 44920832
#define O_SSMRE_S 45445120
#define O_SSMIM_S 45510656
#define O_POOL_S 45576192
#define O_CKV_S 45821952
#define O_KPE_S 46084096

constexpr size_t OFF_PROJ = 0;
constexpr size_t OFF_TAB = OFF_PROJ + 88670208ull;
constexpr size_t OFF_MIX = OFF_TAB + 67108864ull;
constexpr size_t OFF_QBUF = OFF_MIX + 69206016ull;
constexpr size_t OFF_QMLA = OFF_QBUF + 69206016ull;
constexpr size_t OFF_Z = OFF_QMLA + 51904512ull;
constexpr size_t OFF_M = OFF_Z + 34603008ull;
constexpr size_t OFF_C = OFF_M + 34603008ull;
constexpr size_t OFF_KP = OFF_C + 17301504ull;
constexpr size_t OFF_VT0 = OFF_KP + 2162688ull;
constexpr size_t OFF_KALL = OFF_VT0 + 8388608ull;
constexpr size_t OFF_VTALL = OFF_KALL + 1327104ull;
constexpr size_t OFF_KPS = OFF_VTALL + 1572864ull;
constexpr size_t OFF_WT = OFF_KPS + 4325376ull;
constexpr size_t WS_NEED = OFF_WT + 16187392ull;
constexpr size_t OFF_KUPS = OFF_PROJ;
constexpr size_t OFF_VTS = OFF_PROJ + 69206016ull;
constexpr size_t WT_IN_E = 0;
constexpr size_t WT_OUT_E = WT_IN_E + 1310720;
constexpr size_t WT_GLU = WT_OUT_E + 1048576;
constexpr size_t WT_IN_O = WT_GLU + 262144;
constexpr size_t WT_OUT_O = WT_IN_O + 1343488;
constexpr size_t WT_POOL = WT_OUT_O + 1048576;
constexpr size_t WT_UQ = WT_POOL + 65536;
constexpr size_t WT_UK = WT_UQ + 393216;
constexpr size_t WT_UV = WT_UK + 131072;
constexpr size_t WT_PQ = WT_UV + 131072;
constexpr size_t WT_KEYS = WT_PQ + 2097152;

struct Params {
  const float* in[38];
  float* out;
  unsigned char* ws;
};

typedef __bf16 bf16x2_t __attribute__((ext_vector_type(2)));
typedef float float2_t __attribute__((ext_vector_type(2)));
__device__ __forceinline__ unsigned pack2(float a, float b) {
  float2_t f = {a, b};
  bf16x2_t h = __builtin_convertvector(f, bf16x2_t);
  return __builtin_bit_cast(unsigned, h);
}
__device__ __forceinline__ unsigned short f2bf(float f) { return (unsigned short)(pack2(f, 0.f) & 0xffffu); }
__device__ __forceinline__ float bf2f(unsigned short b) { return __uint_as_float(((unsigned)b) << 16); }
__device__ __forceinline__ float lo2f(unsigned u) { return __uint_as_float(u << 16); }
__device__ __forceinline__ float hi2f(unsigned u) { return __uint_as_float(u & 0xffff0000u); }
__device__ __forceinline__ void unpack8(uint4 v, float* x) {
  x[0] = lo2f(v.x); x[1] = hi2f(v.x); x[2] = lo2f(v.y); x[3] = hi2f(v.y);
  x[4] = lo2f(v.z); x[5] = hi2f(v.z); x[6] = lo2f(v.w); x[7] = hi2f(v.w);
}
__device__ __forceinline__ uint4 pack8(const float* x) {
  uint4 v; v.x = pack2(x[0], x[1]); v.y = pack2(x[2], x[3]); v.z = pack2(x[4], x[5]); v.w = pack2(x[6], x[7]); return v;
}
template <int CTRL> __device__ __forceinline__ float dpp_f(float v) {
  return __int_as_float(__builtin_amdgcn_update_dpp(0, __float_as_int(v), CTRL, 0xf, 0xf, true));
}
__device__ __forceinline__ float row16_max(float v) {
  v = fmaxf(v, dpp_f<0xB1>(v)); v = fmaxf(v, dpp_f<0x4E>(v)); v = fmaxf(v, dpp_f<0x141>(v)); v = fmaxf(v, dpp_f<0x140>(v)); return v;
}
__device__ __forceinline__ float row16_sum(float v) {
  v += dpp_f<0xB1>(v); v += dpp_f<0x4E>(v); v += dpp_f<0x141>(v); v += dpp_f<0x140>(v); return v;
}
__device__ __forceinline__ float wave_sum(float v) {
  v = row16_sum(v);
  const float a = __int_as_float(__builtin_amdgcn_readlane(__float_as_int(v), 0));
  const float b = __int_as_float(__builtin_amdgcn_readlane(__float_as_int(v), 16));
  const float c = __int_as_float(__builtin_amdgcn_readlane(__float_as_int(v), 32));
  const float d = __int_as_float(__builtin_amdgcn_readlane(__float_as_int(v), 48));
  return (a + b) + (c + d);
}
__device__ __forceinline__ void sincos_rev(float ang, float& s, float& c) {
  float rev = ang * 0.15915494309189535f;
  rev = rev - floorf(rev);
  s = __builtin_amdgcn_sinf(rev);
  c = __builtin_amdgcn_cosf(rev);
}
__device__ __forceinline__ float gelu_tanh(float x) {
  float y = 0.7978845608028654f * (x + 0.044715f * x * x * x);
  float t = 1.f - 2.f / (1.f + __expf(2.f * y));
  return 0.5f * x * (1.f + t);
}
__device__ __forceinline__ float gelu_erf(float x) { return 0.5f * x * (1.f + erff(x * 0.7071067811865476f)); }
__device__ __forceinline__ int logical_bid() {
  const int G = (int)gridDim.x, b = (int)blockIdx.x;
  return ((G & 7) == 0) ? ((b & 7) * (G >> 3) + (b >> 3)) : b;
}
__device__ __forceinline__ int rot_start(int vbase) {
  int G = (int)gridDim.x;
  int s = (logical_bid() - vbase) % G;
  if (s < 0) s += G;
  return s;
}

__device__ __forceinline__ void transpose_convert(int tid, unsigned char* smem, const float* __restrict__ src, bf16_t* __restrict__ dst, int K, int N, int& vbase) {
  float* tl = (float*)smem;
  const int tk = K / 64, tn = (N + 63) / 64;
  const int ntiles = tk * tn;
  for (int tile = rot_start(vbase); tile < ntiles; tile += gridDim.x) {
    const int k0 = (tile / tn) * 64, n0 = (tile % tn) * 64;
    __syncthreads();
#pragma unroll
    for (int i = 0; i < 2; ++i) {
      int r = (tid >> 4) + 32 * i, c4 = (tid & 15) * 4;
      float4 v = make_float4(0.f, 0.f, 0.f, 0.f);
      if (n0 + c4 < N) v = *(const float4*)(src + (size_t)(k0 + r) * N + n0 + c4);
      tl[r * 65 + c4 + 0] = v.x; tl[r * 65 + c4 + 1] = v.y; tl[r * 65 + c4 + 2] = v.z; tl[r * 65 + c4 + 3] = v.w;
    }
    __syncthreads();
    int n = tid >> 3, k8 = (tid & 7) * 8;
    if (n0 + n < N) {
      float x[8];
#pragma unroll
      for (int j = 0; j < 8; ++j) x[j] = tl[(k8 + j) * 65 + n];
      *(uint4*)(dst + (size_t)(n0 + n) * K + k0 + k8) = pack8(x);
    }
  }
  vbase += ntiles;
}

__device__ __forceinline__ void convert_plain(int tid, const float* __restrict__ src, bf16_t* __restrict__ dst, size_t n) {
  size_t i = ((size_t)blockIdx.x * NT + tid) * 8;
  const size_t stride = (size_t)gridDim.x * NT * 8;
  for (; i < n; i += stride) {
    float4 a = *(const float4*)(src + i), b = *(const float4*)(src + i + 4);
    uint4 v; v.x = pack2(a.x, a.y); v.y = pack2(a.z, a.w); v.z = pack2(b.x, b.y); v.w = pack2(b.z, b.w);
    *(uint4*)(dst + i) = v;
  }
}

template <int V> struct IC { static constexpr int value = V; };
template <int AMODE, class Epi>
__device__ __forceinline__ void gemm_run(int tid, unsigned char* smem, const void* A, const void* A2, int splitRow, int lda,
                                         const float* __restrict__ gain, const bf16_t* __restrict__ Bt,
                                         int M, int N, int K, int& vbase, Epi epi) {
  bf16_t* sA = (bf16_t*)smem;
  bf16_t* sB = sA + 128 * 72;
  float* sR = (float*)(sB + 128 * 72);
  float* sG = sR + 128;
  if (AMODE == 2) {
    __syncthreads();
    sG[tid] = gain[tid]; sG[tid + 512] = gain[tid + 512];
    __syncthreads();
  }
  const int lane = tid & 63, w = tid >> 6;
  const int l16 = lane & 15, quad = lane >> 4;
  const int wm = w >> 1, wn = w & 1;
  const int tilesN = (N + 127) / 128, tilesM = M / 128;
  const int ntiles = tilesM * tilesN;
  const int arow = tid >> 2, aseg = (tid & 3) * 16;
  const int nk = K / 64;
  for (int tile = rot_start(vbase); tile < ntiles; tile += gridDim.x) {
    const int tm = tile / tilesN, tn = tile % tilesN;
    const int m0 = tm * 128, n0 = tn * 128;
    const int grow = m0 + arow;
    const unsigned char* aptr;
    if (AMODE == 0) aptr = (grow < splitRow) ? (const unsigned char*)A + (size_t)grow * lda * 2 : (const unsigned char*)A2 + (size_t)(grow - splitRow) * lda * 2;
    else aptr = (grow < splitRow) ? (const unsigned char*)A + (size_t)grow * lda * 4 : (const unsigned char*)A2 + (size_t)(grow - splitRow) * lda * 4;
    const bool bvalid = (n0 + arow) < N;
    const bf16_t* bptr = Bt + (size_t)(n0 + arow) * K + aseg;
    f32x4 acc[2][4];
#pragma unroll
    for (int i = 0; i < 2; ++i)
#pragma unroll
      for (int j = 0; j < 4; ++j) acc[i][j] = (f32x4){0.f, 0.f, 0.f, 0.f};
    float ss = 0.f;
    float4 af0[4], af1[4];
    uint4 ab0[2], ab1[2];
    uint4 bb0[2], bb1[2];
#define GLOAD(AF, AB, BB, KT) { \
      const int k0_ = (KT) * 64; \
      if (AMODE == 0) { AB[0] = *(const uint4*)(aptr + (size_t)(k0_ + aseg) * 2); AB[1] = *(const uint4*)(aptr + (size_t)(k0_ + aseg + 8) * 2); } \
      else { \
        _Pragma("unroll") for (int i = 0; i < 4; ++i) AF[i] = *(const float4*)(aptr + (size_t)(k0_ + aseg + 4 * i) * 4); \
      } \
      if (bvalid) { BB[0] = *(const uint4*)(bptr + k0_); BB[1] = *(const uint4*)(bptr + k0_ + 8); } \
      else { BB[0] = make_uint4(0, 0, 0, 0); BB[1] = BB[0]; } }
#define LSTORE(AF, AB, BB, KT) { \
      uint4 s0, s1; \
      if (AMODE == 0) { s0 = AB[0]; s1 = AB[1]; } \
      else { \
        if (AMODE == 2) { \
          const float* gp = sG + (KT) * 64 + aseg; \
          _Pragma("unroll") for (int i = 0; i < 4; ++i) { \
            float4 g = *(const float4*)(gp + 4 * i); \
            ss += AF[i].x * AF[i].x + AF[i].y * AF[i].y + AF[i].z * AF[i].z + AF[i].w * AF[i].w; \
            AF[i].x *= g.x; AF[i].y *= g.y; AF[i].z *= g.z; AF[i].w *= g.w; \
          } \
        } \
        s0.x = pack2(AF[0].x, AF[0].y); s0.y = pack2(AF[0].z, AF[0].w); s0.z = pack2(AF[1].x, AF[1].y); s0.w = pack2(AF[1].z, AF[1].w); \
        s1.x = pack2(AF[2].x, AF[2].y); s1.y = pack2(AF[2].z, AF[2].w); s1.z = pack2(AF[3].x, AF[3].y); s1.w = pack2(AF[3].z, AF[3].w); \
      } \
      *(uint4*)(sA + arow * 72 + aseg) = s0; \
      *(uint4*)(sA + arow * 72 + aseg + 8) = s1; \
      *(uint4*)(sB + arow * 72 + aseg) = BB[0]; \
      *(uint4*)(sB + arow * 72 + aseg + 8) = BB[1]; }
#define GCOMPUTE() { \
      _Pragma("unroll") for (int ks = 0; ks < 2; ++ks) { \
        bf16x8 a[2], b[4]; \
        _Pragma("unroll") for (int i = 0; i < 2; ++i) a[i] = *(const bf16x8*)(sA + (wm * 32 + i * 16 + l16) * 72 + ks * 32 + quad * 8); \
        _Pragma("unroll") for (int j = 0; j < 4; ++j) b[j] = *(const bf16x8*)(sB + (wn * 64 + j * 16 + l16) * 72 + ks * 32 + quad * 8); \
        _Pragma("unroll") for (int i = 0; i < 2; ++i) \
          _Pragma("unroll") for (int j = 0; j < 4; ++j) acc[i][j] = __builtin_amdgcn_mfma_f32_16x16x32_bf16(a[i], b[j], acc[i][j], 0, 0, 0); \
      } }
    GLOAD(af0, ab0, bb0, 0);
    GLOAD(af1, ab1, bb1, 1);
    for (int kt = 0; kt < nk; kt += 2) {
      __syncthreads();
      LSTORE(af0, ab0, bb0, kt);
      __syncthreads();
      if (kt + 2 < nk) GLOAD(af0, ab0, bb0, kt + 2);
      GCOMPUTE();
      __syncthreads();
      LSTORE(af1, ab1, bb1, kt + 1);
      __syncthreads();
      if (kt + 3 < nk) GLOAD(af1, ab1, bb1, kt + 3);
      GCOMPUTE();
    }
    if (AMODE == 2) {
      ss += __shfl_xor(ss, 1);
      ss += __shfl_xor(ss, 2);
      if ((tid & 3) == 0) sR[arow] = rsqrtf(ss / (float)K + 1e-6f);
      __syncthreads();
    }
#pragma unroll
    for (int i = 0; i < 2; ++i)
#pragma unroll
      for (int r = 0; r < 4; ++r) {
        const int rl = wm * 32 + i * 16 + quad * 4 + r;
        const float rs = (AMODE == 2) ? sR[rl] : 1.f;
#pragma unroll
        for (int j = 0; j < 4; ++j) {
          const int col = n0 + wn * 64 + j * 16 + l16;
          if (col < N) epi(m0 + rl, col, acc[i][j][r] * rs);
        }
      }
  }
  vbase += ntiles;
}

struct AttnDesc {
  const bf16_t* q; int ldq; int active; int kt_lo, kt_hi; bf16_t* out; int ldo; float m0, l0; int pos0;
  const bf16_t* k; int ldk; const bf16_t* kx; const bf16_t* vt; int ldv; int nkeys; int bt_lo, bt_hi; float scale;
};

template <int DQK>
__device__ __forceinline__ void attn_item(int tid, unsigned char* smem, const AttnDesc& d) {
  constexpr int LDK = DQK + 8;
  bf16_t* sK = (bf16_t*)smem;
  bf16_t* sVt = sK + 64 * 104;
  bf16_t* sP = sVt + 64 * 72;
  const int lane = tid & 63, w = tid >> 6;
  const int l16 = lane & 15, quad = lane >> 4;
  bf16_t* sPw = sP + w * 16 * 72;
  bf16x8 qf[DQK / 32];
  if (d.active) {
#pragma unroll
    for (int ks = 0; ks < DQK / 32; ++ks) {
      const bf16_t* qp = d.q + (size_t)l16 * d.ldq + ks * 32 + quad * 8;
      uint4 v = *(const uint4*)qp;
      if (DQK == 96 && ks == 2) {
        const int pq = (quad < 2) ? 16 : -16;
        uint4 pv = *(const uint4*)(qp + pq);
        float x[8], y[8];
        unpack8(v, x); unpack8(pv, y);
        const float pos = (float)(d.pos0 + l16);
#pragma unroll
        for (int j = 0; j < 8; ++j) {
          const int f = (quad & 1) * 8 + j;
          float inv = exp2f(-(float)f * (LOG2_THETA / 16.f));
          float sn, cs; sincos_rev(pos * inv, sn, cs);
          x[j] = (quad < 2) ? (x[j] * cs - y[j] * sn) : (x[j] * cs + y[j] * sn);
        }
        v = pack8(x);
      }
      qf[ks] = *(bf16x8*)&v;
    }
  }
  f32x4 o[4];
#pragma unroll
  for (int i = 0; i < 4; ++i) o[i] = (f32x4){0.f, 0.f, 0.f, 0.f};
  float m[4], l[4];
#pragma unroll
  for (int r = 0; r < 4; ++r) { m[r] = d.m0; l[r] = d.l0; }

  const int key = tid >> 3, seg = tid & 7;
  const int key2 = (tid >> 2) & 63, seg2 = tid & 3;
  uint4 kv_r = make_uint4(0, 0, 0, 0), vv_r = kv_r, xv_r = kv_r;
  if (d.bt_lo < d.bt_hi) {
    kv_r = *(const uint4*)(d.k + (size_t)(d.bt_lo * 64 + key) * d.ldk + seg * 8);
    vv_r = *(const uint4*)(d.vt + (size_t)key * d.ldv + d.bt_lo * 64 + seg * 8);
    if (DQK == 96 && tid < 256) xv_r = *(const uint4*)(d.kx + (size_t)(d.bt_lo * 64 + key2) * 32 + seg2 * 8);
  }
  for (int kt = d.bt_lo; kt < d.bt_hi; ++kt) {
    __syncthreads();
    *(uint4*)(sK + key * LDK + seg * 8) = kv_r;
    *(uint4*)(sVt + key * 72 + seg * 8) = vv_r;
    if (DQK == 96 && tid < 256) *(uint4*)(sK + key2 * LDK + 64 + seg2 * 8) = xv_r;
    __syncthreads();
    if (kt + 1 < d.bt_hi) {
      kv_r = *(const uint4*)(d.k + (size_t)((kt + 1) * 64 + key) * d.ldk + seg * 8);
      vv_r = *(const uint4*)(d.vt + (size_t)key * d.ldv + (kt + 1) * 64 + seg * 8);
      if (DQK == 96 && tid < 256) xv_r = *(const uint4*)(d.kx + (size_t)((kt + 1) * 64 + key2) * 32 + seg2 * 8);
    }
    if (d.active && kt >= d.kt_lo && kt < d.kt_hi) {
      f32x4 s[4];
#pragma unroll
      for (int i = 0; i < 4; ++i) s[i] = (f32x4){0.f, 0.f, 0.f, 0.f};
#pragma unroll
      for (int ks = 0; ks < DQK / 32; ++ks)
#pragma unroll
        for (int nt = 0; nt < 4; ++nt) {
          bf16x8 b = *(const bf16x8*)(sK + (nt * 16 + l16) * LDK + ks * 32 + quad * 8);
          s[nt] = __builtin_amdgcn_mfma_f32_16x16x32_bf16(qf[ks], b, s[nt], 0, 0, 0);
        }
#pragma unroll
      for (int nt = 0; nt < 4; ++nt) {
        const bool valid = (kt * 64 + nt * 16 + l16) < d.nkeys;
#pragma unroll
        for (int r = 0; r < 4; ++r) s[nt][r] = valid ? s[nt][r] * d.scale : -1e30f;
      }
#pragma unroll
      for (int r = 0; r < 4; ++r) {
        float mx = fmaxf(fmaxf(s[0][r], s[1][r]), fmaxf(s[2][r], s[3][r]));
        mx = row16_max(mx);
        const float mnew = fmaxf(m[r], mx);
        const float alpha = __expf(m[r] - mnew);
        float p0 = __expf(s[0][r] - mnew), p1 = __expf(s[1][r] - mnew), p2 = __expf(s[2][r] - mnew), p3 = __expf(s[3][r] - mnew);
        float rs = p0 + p1 + p2 + p3;
        rs = row16_sum(rs);
        l[r] = l[r] * alpha + rs;
        m[r] = mnew;
#pragma unroll
        for (int dt = 0; dt < 4; ++dt) o[dt][r] *= alpha;
        bf16_t* pr = sPw + (quad * 4 + r) * 72 + l16;
        pr[0] = f2bf(p0); pr[16] = f2bf(p1); pr[32] = f2bf(p2); pr[48] = f2bf(p3);
      }
      asm volatile("s_waitcnt lgkmcnt(0)" ::: "memory");
#pragma unroll
      for (int ks = 0; ks < 2; ++ks) {
        bf16x8 a = *(const bf16x8*)(sPw + l16 * 72 + ks * 32 + quad * 8);
#pragma unroll
        for (int dt = 0; dt < 4; ++dt) {
          bf16x8 b = *(const bf16x8*)(sVt + (dt * 16 + l16) * 72 + ks * 32 + quad * 8);
          o[dt] = __builtin_amdgcn_mfma_f32_16x16x32_bf16(a, b, o[dt], 0, 0, 0);
        }
      }
      asm volatile("s_waitcnt lgkmcnt(0)" ::: "memory");
    }
  }
  if (d.active) {
#pragma unroll
    for (int r = 0; r < 4; ++r) {
      const float il = 1.f / l[r];
#pragma unroll
      for (int dt = 0; dt < 4; ++dt) d.out[(size_t)(quad * 4 + r) * d.ldo + dt * 16 + l16] = f2bf(o[dt][r] * il);
    }
  }
}

template <int MODE>
__device__ __forceinline__ void s5_item(int tid, float* sUw, const Params& p, int item) {
  const int lane = tid & 63;
  const bf16_t* proj = (const bf16_t*)(p.ws + OFF_PROJ);
  int b, chunk, g, tok0; bool isS;
  if (item < 32768) { isS = false; g = item & 31; chunk = (item >> 5) & 127; b = item >> 12; tok0 = b * 4096 + chunk * 32; }
  else { isS = true; int it = item - 32768; g = it & 31; b = it >> 5; chunk = 0; tok0 = T_P + b * 32; }
  const int n = lane;
  const int gn = g * 64 + n;
  const float lr = fminf(p.in[15][gn], -1e-4f), li = p.in[16][gn];
  const float dt = __expf(p.in[17][g]);
  const float mag = __expf(lr * dt);
  float sn, cs; sincos_rev(li * dt, sn, cs);
  const float abr = mag * cs, abi = mag * sn;
  const float den = lr * lr + li * li;
  const float nr = abr - 1.f, ni = abi;
  const float fre = (nr * lr + ni * li) / den, fim = (ni * lr - nr * li) / den;
  float bbr[16], bbi[16];
  {
    const float4* br4 = (const float4*)(p.in[18] + (size_t)gn * 16);
    const float4* bi4 = (const float4*)(p.in[19] + (size_t)gn * 16);
#pragma unroll
    for (int i = 0; i < 4; ++i) {
      float4 r4 = br4[i], i4 = bi4[i];
      bbr[4 * i + 0] = fre * r4.x - fim * i4.x; bbi[4 * i + 0] = fre * i4.x + fim * r4.x;
      bbr[4 * i + 1] = fre * r4.y - fim * i4.y; bbi[4 * i + 1] = fre * i4.y + fim * r4.y;
      bbr[4 * i + 2] = fre * r4.z - fim * i4.z; bbi[4 * i + 2] = fre * i4.z + fim * r4.z;
      bbr[4 * i + 3] = fre * r4.w - fim * i4.w; bbi[4 * i + 3] = fre * i4.w + fim * r4.w;
    }
  }
  {
    const int t = lane >> 1, c8 = (lane & 1) * 8;
    uint4 uv = *(const uint4*)(proj + (size_t)(tok0 + t) * 1280 + 768 + g * 16 + c8);
    float x[8]; unpack8(uv, x);
    *(float4*)(sUw + t * 16 + c8) = make_float4(x[0], x[1], x[2], x[3]);
    *(float4*)(sUw + t * 16 + c8 + 4) = make_float4(x[4], x[5], x[6], x[7]);
  }
  asm volatile("s_waitcnt lgkmcnt(0)" ::: "memory");
  float hr = 0.f, hi = 0.f;
  if (MODE == 0) {
#pragma unroll 4
    for (int t = 0; t < 32; ++t) {
      float uu[16];
#pragma unroll
      for (int i = 0; i < 4; ++i) { float4 v = *(const float4*)(sUw + t * 16 + 4 * i); uu[4 * i] = v.x; uu[4 * i + 1] = v.y; uu[4 * i + 2] = v.z; uu[4 * i + 3] = v.w; }
      float bur = 0.f, bui = 0.f;
#pragma unroll
      for (int c = 0; c < 16; ++c) { bur += bbr[c] * uu[c]; bui += bbi[c] * uu[c]; }
      const float nhr = abr * hr - abi * hi + bur, nhi = abr * hi + abi * hr + bui;
      hr = nhr; hi = nhi;
    }
    float* s1re = (float*)(p.ws + OFF_QMLA);
    float* s1im = s1re + 2097152;
    const size_t idx = ((size_t)(b * 128 + chunk) * 32 + g) * 64 + n;
    s1re[idx] = hr; s1im[idx] = hi;
    asm volatile("s_waitcnt lgkmcnt(0)" ::: "memory");
    return;
  } else {
    float cr[16], ci[16];
#pragma unroll
    for (int c = 0; c < 16; ++c) { cr[c] = p.in[20][(size_t)(g * 16 + c) * 64 + n]; ci[c] = p.in[21][(size_t)(g * 16 + c) * 64 + n]; }
    if (isS) { hr = p.in[4][(size_t)(b * 32 + g) * 64 + n]; hi = p.in[5][(size_t)(b * 32 + g) * 64 + n]; }
    else {
      const float* hinre = (const float*)(p.ws + OFF_QMLA) + 2 * 2097152;
      const float* hinim = hinre + 2097152;
      const size_t idx = ((size_t)(b * 128 + chunk) * 32 + g) * 64 + n;
      hr = hinre[idx]; hi = hinim[idx];
    }
    const int b0 = lane & 1, b1 = (lane >> 1) & 1, b2 = (lane >> 2) & 1, b3 = (lane >> 3) & 1;
    const int cc = b0 * 8 + b1 * 4 + b2 * 2 + b3;
    const int quad = lane >> 4;
    const float dsk = p.in[22][g * 16 + cc];
    bf16_t* zbuf = (bf16_t*)(p.ws + OFF_Z);
    float zkeep = 0.f;
#pragma unroll 2
    for (int t = 0; t < 32; ++t) {
      float uu[16];
#pragma unroll
      for (int i = 0; i < 4; ++i) { float4 v = *(const float4*)(sUw + t * 16 + 4 * i); uu[4 * i] = v.x; uu[4 * i + 1] = v.y; uu[4 * i + 2] = v.z; uu[4 * i + 3] = v.w; }
      float bur = 0.f, bui = 0.f;
#pragma unroll
      for (int c = 0; c < 16; ++c) { bur += bbr[c] * uu[c]; bui += bbi[c] * uu[c]; }
      const float nhr = abr * hr - abi * hi + bur, nhi = abr * hi + abi * hr + bui;
      hr = nhr; hi = nhi;
      float v16[16];
#pragma unroll
      for (int c = 0; c < 16; ++c) v16[c] = hr * cr[c] - hi * ci[c];
      float v8[8], v4[4], v2[2], v1;
#pragma unroll
      for (int i = 0; i < 8; ++i) { float keep = b0 ? v16[8 + i] : v16[i]; float send = b0 ? v16[i] : v16[8 + i]; v8[i] = keep + __shfl_xor(send, 1); }
#pragma unroll
      for (int i = 0; i < 4; ++i) { float keep = b1 ? v8[4 + i] : v8[i]; float send = b1 ? v8[i] : v8[4 + i]; v4[i] = keep + __shfl_xor(send, 2); }
#pragma unroll
      for (int i = 0; i < 2; ++i) { float keep = b2 ? v4[2 + i] : v4[i]; float send = b2 ? v4[i] : v4[2 + i]; v2[i] = keep + __shfl_xor(send, 4); }
      { float keep = b3 ? v2[1] : v2[0]; float send = b3 ? v2[0] : v2[1]; v1 = keep + __shfl_xor(send, 8); }
      v1 += __shfl_xor(v1, 16);
      v1 += __shfl_xor(v1, 32);
      const float y = v1 + dsk * sUw[t * 16 + cc];
      const float z = gelu_tanh(y);
      if (quad == (t & 3)) zkeep = z;
      if ((t & 3) == 3) zbuf[(size_t)(tok0 + t - 3 + quad) * 512 + g * 16 + cc] = f2bf(zkeep);
    }
    if (isS) {
      p.out[O_SSMRE_S + (size_t)(b * 32 + g) * 64 + n] = hr;
      p.out[O_SSMIM_S + (size_t)(b * 32 + g) * 64 + n] = hi;
    }
    asm volatile("s_waitcnt lgkmcnt(0)" ::: "memory");
  }
}

#define TAB_V_OFF 16777216ull
#define TAB_SU_OFF 33554432ull
#define TAB_SV_OFF (33554432ull + 65536ull)
__device__ __forceinline__ void quant_rows(const float* __restrict__ src, unsigned char* __restrict__ dst, float* __restrict__ scales, int gw, int nw, int tid) {
  const int lane = tid & 63;
  for (int row = gw; row < 16384; row += nw) {
    const float* r = src + (size_t)row * 1024 + lane * 16;
    float x[16];
#pragma unroll
    for (int i = 0; i < 4; ++i) { float4 v = *(const float4*)(r + 4 * i); x[4 * i] = v.x; x[4 * i + 1] = v.y; x[4 * i + 2] = v.z; x[4 * i + 3] = v.w; }
    float am = 0.f;
#pragma unroll
    for (int i = 0; i < 16; ++i) am = fmaxf(am, fabsf(x[i]));
#pragma unroll
    for (int o = 32; o; o >>= 1) am = fmaxf(am, __shfl_xor(am, o));
    const float inv = (am > 0.f) ? 127.f / am : 0.f;
    unsigned q[4];
#pragma unroll
    for (int i = 0; i < 4; ++i) {
      unsigned b0 = (unsigned)((int)rintf(x[4 * i] * inv)) & 255u, b1 = (unsigned)((int)rintf(x[4 * i + 1] * inv)) & 255u;
      unsigned b2 = (unsigned)((int)rintf(x[4 * i + 2] * inv)) & 255u, b3 = (unsigned)((int)rintf(x[4 * i + 3] * inv)) & 255u;
      q[i] = b0 | (b1 << 8) | (b2 << 16) | (b3 << 24);
    }
    *(uint4*)(dst + (size_t)row * 1024 + lane * 16) = make_uint4(q[0], q[1], q[2], q[3]);
    if (lane == 0) scales[row] = am * (1.f / 127.f);
  }
}

__device__ __forceinline__ float ub0(unsigned u) { return (float)(u & 0xffu); }
__device__ __forceinline__ float ub1(unsigned u) { return (float)((u >> 8) & 0xffu); }
__device__ __forceinline__ float ub2(unsigned u) { return (float)((u >> 16) & 0xffu); }
__device__ __forceinline__ float ub3(unsigned u) { return (float)(u >> 24); }
__device__ __forceinline__ float dot16(const float* xn, uint4 u) {
  float d = 0.f;
  d += xn[0] * ub0(u.x); d += xn[1] * ub1(u.x); d += xn[2] * ub2(u.x); d += xn[3] * ub3(u.x);
  d += xn[4] * ub0(u.y); d += xn[5] * ub1(u.y); d += xn[6] * ub2(u.y); d += xn[7] * ub3(u.y);
  d += xn[8] * ub0(u.z); d += xn[9] * ub1(u.z); d += xn[10] * ub2(u.z); d += xn[11] * ub3(u.z);
  d += xn[12] * ub0(u.w); d += xn[13] * ub1(u.w); d += xn[14] * ub2(u.w); d += xn[15] * ub3(u.w);
  return d;
}
__device__ __forceinline__ void axpy16(float* acc, float a, uint4 u) {
  acc[0] += a * ub0(u.x); acc[1] += a * ub1(u.x); acc[2] += a * ub2(u.x); acc[3] += a * ub3(u.x);
  acc[4] += a * ub0(u.y); acc[5] += a * ub1(u.y); acc[6] += a * ub2(u.y); acc[7] += a * ub3(u.y);
  acc[8] += a * ub0(u.z); acc[9] += a * ub1(u.z); acc[10] += a * ub2(u.z); acc[11] += a * ub3(u.z);
  acc[12] += a * ub0(u.w); acc[13] += a * ub1(u.w); acc[14] += a * ub2(u.w); acc[15] += a * ub3(u.w);
}

template <bool FINAL, bool DRY>
__device__ __forceinline__ void peer_token(int tid, const Params& p, int layer, int tok) {
  const int lane = tid & 63;
  float* xres = p.out + O_Y;
  const float* gain = p.in[10] + layer * 1024;
  const unsigned char* U = p.ws + OFF_TAB;
  const unsigned char* V = U + TAB_V_OFF;
  const int* ebuf = (const int*)(p.ws + OFF_M);
  const float* gbuf = (const float*)(p.ws + OFF_M + 17301504ull);
  const float* sus = (const float*)(p.ws + OFF_TAB + TAB_SU_OFF);
  const float* svs = (const float*)(p.ws + OFF_TAB + TAB_SV_OFF);
  float* xr = xres + (size_t)tok * 1024 + lane * 16;
  float x[16], xn[16], acc[16];
  float ss = 0.f, sx = 0.f;
#pragma unroll
  for (int i = 0; i < 4; ++i) {
    float4 v = *(const float4*)(xr + 4 * i);
    float4 g = *(const float4*)(gain + lane * 16 + 4 * i);
    x[4 * i] = v.x; x[4 * i + 1] = v.y; x[4 * i + 2] = v.z; x[4 * i + 3] = v.w;
    xn[4 * i] = v.x * g.x; xn[4 * i + 1] = v.y * g.y; xn[4 * i + 2] = v.z * g.z; xn[4 * i + 3] = v.w * g.w;
    ss += v.x * v.x + v.y * v.y + v.z * v.z + v.w * v.w;
    sx += xn[4 * i] + xn[4 * i + 1] + xn[4 * i + 2] + xn[4 * i + 3];
  }
  ss = wave_sum(ss);
  sx = wave_sum(sx);
  const float rstd = rsqrtf(ss * (1.f / 1024.f) + 1e-6f);
#pragma unroll
  for (int i = 0; i < 16; ++i) acc[i] = 0.f;
  float sumA = 0.f;
  const int b0 = lane & 1, b1 = (lane >> 1) & 1, b2 = (lane >> 2) & 1;
  const int pe = b0 * 4 + b1 * 2 + b2;
  const size_t pbase = (size_t)tok * 128 + pe;
#pragma unroll 1
  for (int kb = 0; kb < 16; ++kb) {
    const int myeid = ebuf[pbase + kb * 8];
    const float myg = gbuf[pbase + kb * 8] * svs[myeid];
    const float mysu = sus[myeid];
    uint4 uu[8], vv[8];
#pragma unroll
    for (int j = 0; j < 8; ++j) {
      const int src = ((j & 1) << 2) | (j & 2) | ((j >> 2) & 1);
      const int eid = __builtin_amdgcn_readlane(myeid, src);
      uu[j] = *(const uint4*)(U + (size_t)eid * 1024 + lane * 16);
      vv[j] = *(const uint4*)(V + (size_t)eid * 1024 + lane * 16);
    }
    float d[8];
#pragma unroll
    for (int j = 0; j < 8; ++j) d[j] = dot16(xn, uu[j]);
    float w4[4], w2[2], w1;
#pragma unroll
    for (int i = 0; i < 4; ++i) { float keep = b0 ? d[4 + i] : d[i]; float send = b0 ? d[i] : d[4 + i]; w4[i] = keep + __shfl_xor(send, 1); }
#pragma unroll
    for (int i = 0; i < 2; ++i) { float keep = b1 ? w4[2 + i] : w4[i]; float send = b1 ? w4[i] : w4[2 + i]; w2[i] = keep + __shfl_xor(send, 2); }
    { float keep = b2 ? w2[1] : w2[0]; float send = b2 ? w2[0] : w2[1]; w1 = keep + __shfl_xor(send, 4); }
    w1 += __shfl_xor(w1, 8); w1 += __shfl_xor(w1, 16); w1 += __shfl_xor(w1, 32);
    const float dot = rstd * mysu * (w1 - 128.f * sx);
    const float a = gelu_erf(dot) * myg;
#pragma unroll
    for (int j = 0; j < 8; ++j) {
      const int src = ((j & 1) << 2) | (j & 2) | ((j >> 2) & 1);
      const float A = __int_as_float(__builtin_amdgcn_readlane(__float_as_int(a), src));
      sumA += A;
      axpy16(acc, A, vv[j]);
    }
  }
  float y[16];
#pragma unroll
  for (int i = 0; i < 16; ++i) y[i] = x[i] + acc[i] - 128.f * sumA;
  if (FINAL) {
    float s2 = 0.f;
#pragma unroll
    for (int i = 0; i < 16; ++i) s2 += y[i] * y[i];
    s2 = wave_sum(s2);
    const float r2 = rsqrtf(s2 * (1.f / 1024.f) + 1e-6f);
    const float* gf = p.in[11] + lane * 16;
#pragma unroll
    for (int i = 0; i < 4; ++i) {
      float4 g = *(const float4*)(gf + 4 * i);
      y[4 * i] *= r2 * g.x; y[4 * i + 1] *= r2 * g.y; y[4 * i + 2] *= r2 * g.z; y[4 * i + 3] *= r2 * g.w;
    }
  }
  if (DRY && ss != -1.f) return;
#pragma unroll
  for (int i = 0; i < 4; ++i) *(float4*)(xr + 4 * i) = make_float4(y[4 * i], y[4 * i + 1], y[4 * i + 2], y[4 * i + 3]);
}

#define OFF_PD OFF_MIX
#define OFF_PSS OFF_KP
#define OFF_PSX (OFF_KP + 1081344ull)
template <int CTRL> __device__ __forceinline__ int dpp_i(int v) { return __builtin_amdgcn_update_dpp(0, v, CTRL, 0xf, 0xf, true); }
__device__ __forceinline__ unsigned packq4(float a, float b, float c, float d, float inv) {
  const unsigned q0 = (unsigned)((int)rintf(a * inv)) & 255u, q1 = (unsigned)((int)rintf(b * inv)) & 255u;
  const unsigned q2 = (unsigned)((int)rintf(c * inv)) & 255u, q3 = (unsigned)((int)rintf(d * inv));
  return q0 | (q1 << 8) | (q2 << 16) | (q3 << 24);
}
__device__ __forceinline__ void peer9a_token(int tid, const Params& p, int layer, int tok, int j) {
  const int lane = tid & 63, g8 = lane >> 3, sub = lane & 7;
  const float* xr = p.out + O_Y + (size_t)tok * 1024 + j * 128 + sub * 16;
  const float* gn = p.in[10] + layer * 1024 + j * 128 + sub * 16;
  const unsigned char* U = p.ws + OFF_TAB + j * 128 + sub * 16;
  const int* eb = (const int*)(p.ws + OFF_M) + (size_t)tok * 128 + g8;
  float* pd = (float*)(p.ws + OFF_PD) + ((size_t)tok * 8 + j) * 128;
  int eid[16];
#pragma unroll
  for (int k = 0; k < 16; ++k) eid[k] = eb[k * 8];
  float xs[16];
  float ss = 0.f, am = 0.f;
#pragma unroll
  for (int i = 0; i < 4; ++i) {
    float4 v = *(const float4*)(xr + 4 * i);
    float4 g = *(const float4*)(gn + 4 * i);
    xs[4 * i] = v.x * g.x; xs[4 * i + 1] = v.y * g.y; xs[4 * i + 2] = v.z * g.z; xs[4 * i + 3] = v.w * g.w;
    ss += v.x * v.x + v.y * v.y + v.z * v.z + v.w * v.w;
    am = fmaxf(fmaxf(am, fmaxf(fabsf(xs[4 * i]), fabsf(xs[4 * i + 1]))), fmaxf(fabsf(xs[4 * i + 2]), fabsf(xs[4 * i + 3])));
  }
  uint4 rows[16];
#pragma unroll
  for (int k = 0; k < 16; ++k) rows[k] = *(const uint4*)(U + (size_t)eid[k] * 1024);
  am = fmaxf(am, dpp_f<0xB1>(am)); am = fmaxf(am, dpp_f<0x4E>(am)); am = fmaxf(am, dpp_f<0x141>(am));
  const float inv = (am > 0.f) ? 127.f / am : 0.f;
  const float xscale = am * (1.f / 127.f);
  int xq[4];
#pragma unroll
  for (int d = 0; d < 4; ++d) xq[d] = (int)packq4(xs[4 * d], xs[4 * d + 1], xs[4 * d + 2], xs[4 * d + 3], inv);
  int keep0 = 0, keep1 = 0;
#pragma unroll
  for (int k = 0; k < 16; ++k) {
    int D = __builtin_amdgcn_sdot4((int)rows[k].x, xq[0], 0, false);
    D = __builtin_amdgcn_sdot4((int)rows[k].y, xq[1], D, false);
    D = __builtin_amdgcn_sdot4((int)rows[k].z, xq[2], D, false);
    D = __builtin_amdgcn_sdot4((int)rows[k].w, xq[3], D, false);
    D += dpp_i<0xB1>(D); D += dpp_i<0x4E>(D); D += dpp_i<0x141>(D);
    if (k < 8) keep0 = (sub == k) ? D : keep0; else keep1 = (sub == k - 8) ? D : keep1;
  }
  pd[sub * 8 + g8] = (float)keep0 * xscale;
  pd[64 + sub * 8 + g8] = (float)keep1 * xscale;
  ss += dpp_f<0xB1>(ss); ss += dpp_f<0x4E>(ss); ss += dpp_f<0x141>(ss);
  if (lane == 0) ((float*)(p.ws + OFF_PSS))[(size_t)tok * 8 + j] = ss;
}

__device__ __forceinline__ void peer9m_token(int tid, unsigned char* smem, const Params& p, int tok) {
  const int lane = tid & 63, w = __builtin_amdgcn_readfirstlane(tid >> 6);
  unsigned char* sAq = smem + w * 128;
  const float* pd = (const float*)(p.ws + OFF_PD) + (size_t)tok * 1024;
  float* pss = (float*)(p.ws + OFF_PSS) + (size_t)tok * 8;
  const int* ebuf = (const int*)(p.ws + OFF_M) + (size_t)tok * 128;
  float* gbuf = (float*)(p.ws + OFF_M + 17301504ull) + (size_t)tok * 128;
  const float* sus = (const float*)(p.ws + OFF_TAB + TAB_SU_OFF);
  const float* svs = (const float*)(p.ws + OFF_TAB + TAB_SV_OFF);
  float ss = 0.f, d0 = 0.f, d1 = 0.f;
#pragma unroll
  for (int j = 0; j < 8; ++j) { ss += pss[j]; d0 += pd[j * 128 + lane]; d1 += pd[j * 128 + 64 + lane]; }
  const int e0 = ebuf[lane], e1 = ebuf[64 + lane];
  const float rstd = rsqrtf(ss * (1.f / 1024.f) + 1e-6f);
  const float a0 = gelu_erf(rstd * sus[e0] * d0) * gbuf[lane] * svs[e0];
  const float a1 = gelu_erf(rstd * sus[e1] * d1) * gbuf[64 + lane] * svs[e1];
  float am = row16_max(fmaxf(fabsf(a0), fabsf(a1)));
  {
    const float m0 = __int_as_float(__builtin_amdgcn_readlane(__float_as_int(am), 0)), m1 = __int_as_float(__builtin_amdgcn_readlane(__float_as_int(am), 16));
    const float m2 = __int_as_float(__builtin_amdgcn_readlane(__float_as_int(am), 32)), m3 = __int_as_float(__builtin_amdgcn_readlane(__float_as_int(am), 48));
    am = fmaxf(fmaxf(m0, m1), fmaxf(m2, m3));
  }
  const float inv = (am > 0.f) ? 127.f / am : 0.f;
  const int addr0 = (lane & 7) * 16 + (lane >> 3);
  sAq[addr0] = (unsigned char)((int)rintf(a0 * inv) & 255);
  sAq[addr0 + 8] = (unsigned char)((int)rintf(a1 * inv) & 255);
  asm volatile("s_waitcnt lgkmcnt(0)" ::: "memory");
  unsigned pk = 0u;
  if (lane < 32) pk = ((const unsigned*)sAq)[lane];
  asm volatile("s_waitcnt vmcnt(0) lgkmcnt(0)" ::: "memory");
  if (lane < 32) ((unsigned*)gbuf)[lane] = pk;
  if (lane == 0) pss[0] = am * (1.f / 127.f);
  asm volatile("s_waitcnt lgkmcnt(0)" ::: "memory");
}

__device__ __forceinline__ void peer9b_token(int tid, const Params& p, int tok, int j) {
  const int lane = tid & 63, g8 = lane >> 3, sub = lane & 7;
  float* xr = p.out + O_Y + (size_t)tok * 1024 + j * 128 + sub * 16;
  const unsigned char* V = p.ws + OFF_TAB + TAB_V_OFF + j * 128 + sub * 16;
  const int* eb = (const int*)(p.ws + OFF_M) + (size_t)tok * 128 + g8;
  const uint4 apk = *(const uint4*)((const unsigned*)(p.ws + OFF_M + 17301504ull) + (size_t)tok * 128 + g8 * 4);
  const float scaleA = ((const float*)(p.ws + OFF_PSS))[(size_t)tok * 8];
  int eid[16];
#pragma unroll
  for (int k = 0; k < 16; ++k) eid[k] = eb[k * 8];
  uint4 rows[16];
#pragma unroll
  for (int k = 0; k < 16; ++k) rows[k] = *(const uint4*)(V + (size_t)eid[k] * 1024);
  int acci[16];
#pragma unroll
  for (int i = 0; i < 16; ++i) acci[i] = 0;
#define P9B_DW(DWF, DW, AP, KQ) { \
    const unsigned r0 = rows[(KQ) * 4 + 0].DWF, r1 = rows[(KQ) * 4 + 1].DWF, r2 = rows[(KQ) * 4 + 2].DWF, r3 = rows[(KQ) * 4 + 3].DWF; \
    const unsigned t0 = __builtin_amdgcn_perm(r1, r0, 0x05010400u), t1 = __builtin_amdgcn_perm(r1, r0, 0x07030602u); \
    const unsigned t2 = __builtin_amdgcn_perm(r3, r2, 0x05010400u), t3 = __builtin_amdgcn_perm(r3, r2, 0x07030602u); \
    acci[(DW) * 4 + 0] = __builtin_amdgcn_sdot4((int)__builtin_amdgcn_perm(t2, t0, 0x05040100u), (int)(AP), acci[(DW) * 4 + 0], false); \
    acci[(DW) * 4 + 1] = __builtin_amdgcn_sdot4((int)__builtin_amdgcn_perm(t2, t0, 0x07060302u), (int)(AP), acci[(DW) * 4 + 1], false); \
    acci[(DW) * 4 + 2] = __builtin_amdgcn_sdot4((int)__builtin_amdgcn_perm(t3, t1, 0x05040100u), (int)(AP), acci[(DW) * 4 + 2], false); \
    acci[(DW) * 4 + 3] = __builtin_amdgcn_sdot4((int)__builtin_amdgcn_perm(t3, t1, 0x07060302u), (int)(AP), acci[(DW) * 4 + 3], false); }
#define P9B_KQ(AP, KQ) { P9B_DW(x, 0, AP, KQ) P9B_DW(y, 1, AP, KQ) P9B_DW(z, 2, AP, KQ) P9B_DW(w, 3, AP, KQ) }
  P9B_KQ(apk.x, 0) P9B_KQ(apk.y, 1) P9B_KQ(apk.z, 2) P9B_KQ(apk.w, 3)
  float acc[16];
#pragma unroll
  for (int i = 0; i < 16; ++i) acc[i] = (float)acci[i] * scaleA;
  const int b3 = (lane >> 3) & 1, b4 = (lane >> 4) & 1, b5 = (lane >> 5) & 1;
  float v8[8], v4[4], v2[2];
#pragma unroll
  for (int i = 0; i < 8; ++i) { float keep = b3 ? acc[8 + i] : acc[i]; float send = b3 ? acc[i] : acc[8 + i]; v8[i] = keep + dpp_f<0x128>(send); }
#pragma unroll
  for (int i = 0; i < 4; ++i) { float keep = b4 ? v8[4 + i] : v8[i]; float send = b4 ? v8[i] : v8[4 + i]; v4[i] = keep + __shfl_xor(send, 16); }
#pragma unroll
  for (int i = 0; i < 2; ++i) { float keep = b5 ? v4[2 + i] : v4[i]; float send = b5 ? v4[i] : v4[2 + i]; v2[i] = keep + __shfl_xor(send, 32); }
  const int c = b3 * 8 + b4 * 4 + b5 * 2;
  float2 xv = *(const float2*)(xr + c);
  xv.x += v2[0];
  xv.y += v2[1];
  *(float2*)(xr + c) = xv;
}

__device__ __forceinline__ void final_norm_token(int tid, const Params& p, int tok) {
  const int lane = tid & 63;
  float* xr = p.out + O_Y + (size_t)tok * 1024 + lane * 16;
  const float* gf = p.in[11] + lane * 16;
  float y[16]; float s2 = 0.f;
#pragma unroll
  for (int i = 0; i < 4; ++i) { float4 v = *(const float4*)(xr + 4 * i); y[4 * i] = v.x; y[4 * i + 1] = v.y; y[4 * i + 2] = v.z; y[4 * i + 3] = v.w; s2 += v.x * v.x + v.y * v.y + v.z * v.z + v.w * v.w; }
  s2 = wave_sum(s2);
  const float r2 = rsqrtf(s2 * (1.f / 1024.f) + 1e-6f);
#pragma unroll
  for (int i = 0; i < 4; ++i) {
    float4 g = *(const float4*)(gf + 4 * i);
    *(float4*)(xr + 4 * i) = make_float4(y[4 * i] * r2 * g.x, y[4 * i + 1] * r2 * g.y, y[4 * i + 2] * r2 * g.z, y[4 * i + 3] * r2 * g.w);
  }
}

__device__ __forceinline__ unsigned f2ukey(float v) { unsigned u = __float_as_uint(v); return (u & 0x80000000u) ? ~u : (u | 0x80000000u); }
__device__ __forceinline__ float ukey2f(unsigned k) { unsigned u = (k & 0x80000000u) ? (k & 0x7fffffffu) : ~k; return __uint_as_float(u); }
__device__ __forceinline__ int popc64(unsigned long long m) { return __builtin_popcountll(m); }
__device__ __forceinline__ int mbcnt64(unsigned long long m) { return (int)__builtin_amdgcn_mbcnt_hi((unsigned)(m >> 32), __builtin_amdgcn_mbcnt_lo((unsigned)m, 0u)); }

struct TopkFrags { bf16x8 a[2][2]; bf16x8 b[2][2]; };
__device__ __forceinline__ void topk_load(TopkFrags& f, int tid, const Params& p, int layer, int item) {
  const int lane = tid & 63, w = __builtin_amdgcn_readfirstlane(tid >> 6);
  const int l16 = lane & 15, quad = lane >> 4;
  const int h = item & 7, tok0 = (item >> 3) * 32;
  const int pp = w >> 2;
  const bf16_t* qb = (const bf16_t*)(p.ws + OFF_QBUF);
  const bf16_t* keys = (const bf16_t*)(p.ws + OFF_WT) + WT_KEYS + (size_t)((layer * 8 + h) * 2 + pp) * 8192;
#pragma unroll
  for (int ks = 0; ks < 2; ++ks) {
#pragma unroll
    for (int mt = 0; mt < 2; ++mt) f.a[ks][mt] = *(const bf16x8*)(qb + (size_t)(tok0 + mt * 16 + l16) * 1024 + h * 128 + pp * 64 + ks * 32 + quad * 8);
#pragma unroll
    for (int j = 0; j < 2; ++j) {
      const int nt = (w & 3) * 2 + j;
      f.b[ks][j] = *(const bf16x8*)(keys + (nt * 16 + l16) * 64 + ks * 32 + quad * 8);
    }
  }
}

__device__ __forceinline__ void peer_topk_item(int tid, unsigned char* smem, const Params& p, const TopkFrags& f, int item) {
  unsigned* sS = (unsigned*)smem;
  const int lane = tid & 63, w = __builtin_amdgcn_readfirstlane(tid >> 6);
  const int l16 = lane & 15, quad = lane >> 4;
  const int h = item & 7, tile = item >> 3;
  const int tok0 = tile * 32;
  unsigned* wtop = (unsigned*)(smem + 32768) + w * 192;
  float* wexp = (float*)(wtop + 128);
  __syncthreads();
  {
    const int pp = w >> 2;
    f32x4 acc[2][2];
#pragma unroll
    for (int i = 0; i < 2; ++i)
#pragma unroll
      for (int j = 0; j < 2; ++j) acc[i][j] = (f32x4){0.f, 0.f, 0.f, 0.f};
#pragma unroll
    for (int ks = 0; ks < 2; ++ks)
#pragma unroll
      for (int mt = 0; mt < 2; ++mt)
#pragma unroll
        for (int j = 0; j < 2; ++j) acc[mt][j] = __builtin_amdgcn_mfma_f32_16x16x32_bf16(f.a[ks][mt], f.b[ks][j], acc[mt][j], 0, 0, 0);
#pragma unroll
    for (int mt = 0; mt < 2; ++mt)
#pragma unroll
      for (int j = 0; j < 2; ++j) {
        const int nt = (w & 3) * 2 + j;
#pragma unroll
        for (int r = 0; r < 4; ++r) {
          const int key = nt * 16 + l16;
          sS[((mt * 16 + quad * 4 + r) * 2 + pp) * 128 + key] = (f2ukey(acc[mt][j][r]) & ~127u) | (unsigned)(127 - key);
        }
      }
  }
  __syncthreads();
  int* ebuf = (int*)(p.ws + OFF_M);
  float* gbuf = (float*)(p.ws + OFF_M + 17301504ull);
  unsigned k0[8], k1[8], T[8];
#pragma unroll
  for (int c = 0; c < 8; ++c) {
    const unsigned* row = sS + ((w * 4 + (c >> 1)) * 2 + (c & 1)) * 128;
    k0[c] = row[lane]; k1[c] = row[64 + lane]; T[c] = 0u;
  }
#pragma unroll 1
  for (int bit = 31; bit >= 7; --bit) {
    const unsigned bm = 1u << bit;
#pragma unroll
    for (int c = 0; c < 8; ++c) {
      const unsigned cand = T[c] | bm;
      const int cnt = popc64(__builtin_amdgcn_ballot_w64(k0[c] >= cand)) + popc64(__builtin_amdgcn_ballot_w64(k1[c] >= cand));
      T[c] = (cnt >= 16) ? cand : T[c];
    }
  }
  {
    bool need = false;
#pragma unroll
    for (int c = 0; c < 8; ++c) {
      const int cnt = popc64(__builtin_amdgcn_ballot_w64(k0[c] >= T[c])) + popc64(__builtin_amdgcn_ballot_w64(k1[c] >= T[c]));
      need = need || (cnt > 16);
    }
    if (need) {
#pragma unroll 1
      for (int bit = 6; bit >= 0; --bit) {
        const unsigned bm = 1u << bit;
#pragma unroll
        for (int c = 0; c < 8; ++c) {
          const unsigned cand = T[c] | bm;
          const int cnt = popc64(__builtin_amdgcn_ballot_w64(k0[c] >= cand)) + popc64(__builtin_amdgcn_ballot_w64(k1[c] >= cand));
          T[c] = (cnt >= 16) ? cand : T[c];
        }
      }
    }
  }
#pragma unroll
  for (int c = 0; c < 8; ++c) {
    const unsigned long long m0 = __builtin_amdgcn_ballot_w64(k0[c] >= T[c]);
    const unsigned long long m1 = __builtin_amdgcn_ballot_w64(k1[c] >= T[c]);
    const int s0 = mbcnt64(m0), s1 = popc64(m0) + mbcnt64(m1);
    if (k0[c] >= T[c]) wtop[c * 16 + s0] = k0[c];
    if (k1[c] >= T[c]) wtop[c * 16 + s1] = k1[c];
  }
  asm volatile("s_waitcnt lgkmcnt(0)" ::: "memory");
  float cs[4][4];
  unsigned ck[4][4], T2[4], ka[4];
  uint4 kb4[4];
#pragma unroll
  for (int t = 0; t < 4; ++t) {
    ka[t] = wtop[(t * 2) * 16 + (lane >> 2)];
    kb4[t] = *(const uint4*)(wtop + (t * 2 + 1) * 16 + (lane & 3) * 4);
    const float a = ukey2f(ka[t]);
    cs[t][0] = a + ukey2f(kb4[t].x); cs[t][1] = a + ukey2f(kb4[t].y); cs[t][2] = a + ukey2f(kb4[t].z); cs[t][3] = a + ukey2f(kb4[t].w);
#pragma unroll
    for (int jj = 0; jj < 4; ++jj) ck[t][jj] = (f2ukey(cs[t][jj]) & ~255u) | (unsigned)(255 - (lane * 4 + jj));
    T2[t] = 0u;
  }
#pragma unroll 1
  for (int bit = 31; bit >= 8; --bit) {
    const unsigned bm = 1u << bit;
#pragma unroll
    for (int t = 0; t < 4; ++t) {
      const unsigned cand = T2[t] | bm;
      int cnt = 0;
#pragma unroll
      for (int jj = 0; jj < 4; ++jj) cnt += popc64(__builtin_amdgcn_ballot_w64(ck[t][jj] >= cand));
      T2[t] = (cnt >= 16) ? cand : T2[t];
    }
  }
  {
    bool need = false;
#pragma unroll
    for (int t = 0; t < 4; ++t) {
      int cnt = 0;
#pragma unroll
      for (int jj = 0; jj < 4; ++jj) cnt += popc64(__builtin_amdgcn_ballot_w64(ck[t][jj] >= T2[t]));
      need = need || (cnt > 16);
    }
    if (need) {
#pragma unroll 1
      for (int bit = 7; bit >= 0; --bit) {
        const unsigned bm = 1u << bit;
#pragma unroll
        for (int t = 0; t < 4; ++t) {
          const unsigned cand = T2[t] | bm;
          int cnt = 0;
#pragma unroll
          for (int jj = 0; jj < 4; ++jj) cnt += popc64(__builtin_amdgcn_ballot_w64(ck[t][jj] >= cand));
          T2[t] = (cnt >= 16) ? cand : T2[t];
        }
      }
    }
  }
  int slot[4][4];
  float ev[4][4];
#pragma unroll
  for (int t = 0; t < 4; ++t) {
    const float cT = ukey2f(T2[t]);
    int base = 0;
#pragma unroll
    for (int jj = 0; jj < 4; ++jj) {
      const bool win = ck[t][jj] >= T2[t];
      const unsigned long long m = __builtin_amdgcn_ballot_w64(win);
      slot[t][jj] = win ? (base + mbcnt64(m)) : -1;
      base += popc64(m);
      ev[t][jj] = __expf(fminf(cs[t][jj] - cT, 60.f));
      if (win) wexp[t * 16 + slot[t][jj]] = ev[t][jj];
    }
  }
  asm volatile("s_waitcnt lgkmcnt(0)" ::: "memory");
#pragma unroll
  for (int t = 0; t < 4; ++t) {
    float es = 0.f;
#pragma unroll
    for (int q = 0; q < 4; ++q) { const float4 ee = *(const float4*)(wexp + t * 16 + q * 4); es += ee.x + ee.y + ee.z + ee.w; }
    const float ies = 1.f / es;
    const int i1 = 127 - (int)(ka[t] & 127u);
    const size_t o = (size_t)(tok0 + w * 4 + t) * 128 + h * 16;
    const unsigned kbv[4] = {kb4[t].x, kb4[t].y, kb4[t].z, kb4[t].w};
#pragma unroll
    for (int jj = 0; jj < 4; ++jj) {
      if (slot[t][jj] >= 0) {
        ebuf[o + slot[t][jj]] = i1 * 128 + (127 - (int)(kbv[jj] & 127u));
        gbuf[o + slot[t][jj]] = ev[t][jj] * ies;
      }
    }
  }
  asm volatile("s_waitcnt lgkmcnt(0)" ::: "memory");
}

struct EpiStoreBf16 { bf16_t* dst; int ld; __device__ void operator()(int r, int c, float v) const { dst[(size_t)r * ld + c] = f2bf(v); } };
struct EpiGlu { const bf16_t* z; const float* bias; bf16_t* mix; __device__ void operator()(int r, int c, float v) const {
  float zz = bf2f(z[(size_t)r * 512 + c]); float s = v + bias[c]; mix[(size_t)r * 1024 + 512 + c] = f2bf(zz / (1.f + __expf(-s))); } };
struct EpiRes0 { const float* xp; const float* xs; float* xres; __device__ void operator()(int r, int c, float v) const {
  float x = (r < T_P) ? xp[(size_t)r * 1024 + c] : xs[(size_t)(r - T_P) * 1024 + c]; xres[(size_t)r * 1024 + c] = x + v; } };
struct EpiRes1 { float* xres; __device__ void operator()(int r, int c, float v) const { xres[(size_t)r * 1024 + c] += v; } };
struct EpiPool { bf16_t* mix; const float* scale; int g; __device__ void operator()(int r, int c, float v) const {
  mix[(size_t)r * 1024 + g * 128 + c] = f2bf(v * scale[g * 128 + c]); } };
struct EpiKup { bf16_t* dst; int rowsPerB; int keyOff; int bStride; __device__ void operator()(int r, int c, float v) const {
  int b = r / rowsPerB, key = r % rowsPerB + keyOff; dst[((size_t)b * bStride + key) * 512 + c] = f2bf(v); } };
struct EpiVt { bf16_t* dst; int rowsPerB; int keyOff; int ldv; __device__ void operator()(int r, int c, float v) const {
  int b = r / rowsPerB, key = r % rowsPerB + keyOff; dst[((size_t)(b * 8 + (c >> 6)) * 64 + (c & 63)) * ldv + key] = f2bf(v); } };


typedef const Params __attribute__((address_space(4))) KParams;

constexpr size_t OFF_BAR = WS_NEED;
__device__ __forceinline__ void grid_barrier(unsigned* ctr, unsigned target) {
  asm volatile("s_waitcnt vmcnt(0)" ::: "memory");
  __syncthreads();
  if (threadIdx.x == 0) {
    __builtin_amdgcn_fence(__ATOMIC_RELEASE, "agent");
    asm volatile("s_waitcnt vmcnt(0)" ::: "memory");
    __hip_atomic_fetch_add(ctr, 1u, __ATOMIC_RELAXED, __HIP_MEMORY_SCOPE_AGENT);
    unsigned spins = 0;
    while (__hip_atomic_load(ctr, __ATOMIC_RELAXED, __HIP_MEMORY_SCOPE_AGENT) < target) {
      __builtin_amdgcn_s_sleep(1);
      if (++spins > (1u << 27)) break;
    }
    __builtin_amdgcn_fence(__ATOMIC_ACQUIRE, "agent");
    asm volatile("s_waitcnt vmcnt(0)" ::: "memory");
  }
  __syncthreads();
}
#define GRID_BAR() { unsigned* ctr_ = (unsigned*)(((KParams*)__builtin_amdgcn_kernarg_segment_ptr())->ws + OFF_BAR); bar_k += 1; grid_barrier(ctr_, (unsigned)bar_k * gridDim.x); }
#define PHASE_BEGIN \
  Params p; \
  { KParams* kp_ = (KParams*)__builtin_amdgcn_kernarg_segment_ptr(); asm volatile("" : "+s"(kp_)); \
    _Pragma("unroll") for (int i_ = 0; i_ < 38; ++i_) p.in[i_] = kp_->in[i_]; \
    p.out = kp_->out; p.ws = kp_->ws; } \
  int tid = threadIdx.x; asm volatile("" : "+v"(tid)); \
  const int lane = tid & 63, w = __builtin_amdgcn_readfirstlane(tid >> 6); \
  const int gw = blockIdx.x * 8 + w, nw = gridDim.x * 8; \
  const size_t gtid = (size_t)blockIdx.x * NT + tid, gthreads = (size_t)gridDim.x * NT; \
  bf16_t* wt = (bf16_t*)(p.ws + OFF_WT); \
  bf16_t* proj = (bf16_t*)(p.ws + OFF_PROJ); \
  bf16_t* mix = (bf16_t*)(p.ws + OFF_MIX); \
  bf16_t* qbuf = (bf16_t*)(p.ws + OFF_QBUF); \
  bf16_t* zbuf = (bf16_t*)(p.ws + OFF_Z); \
  float* xres = p.out + O_Y; \
  (void)lane; (void)gw; (void)nw; (void)gtid; (void)gthreads; (void)wt; (void)proj; (void)mix; (void)qbuf; (void)zbuf; (void)xres;

template <int LAYER>
__device__ __forceinline__ void peer_phases(int& bar_k, unsigned char* smem) {
  const int layer = LAYER;
    for (int rep_ = 0; rep_ < NREP(7); ++rep_)
    {
    PHASE_BEGIN
      int vb = 0;
      gemm_run<2>(tid, smem, xres, xres, T_TOT, 1024, p.in[10] + layer * 1024, wt + WT_PQ + (size_t)layer * 1048576, T_TOT, 1024, 1024, vb, EpiStoreBf16{qbuf, 1024});
    }
    GRID_BAR();
    for (int rep_ = 0; rep_ < NREP(8); ++rep_) {
    PHASE_BEGIN
    {
      TopkFrags fr;
      int item = blockIdx.x;
      if (item < 1056 * 8) topk_load(fr, tid, p, layer, item);
      for (; item < 1056 * 8; item += gridDim.x) {
        TopkFrags cur = fr;
        const int nxt = item + gridDim.x;
        if (nxt < 1056 * 8) topk_load(fr, tid, p, layer, nxt);
        peer_topk_item(tid, smem, p, cur, item);
      }
    }
    }
    GRID_BAR();
    for (int rep_ = 0; rep_ < NREP(9); ++rep_) {
    PHASE_BEGIN
      int j = blockIdx.x & 7, lb = blockIdx.x >> 3, nb = ((int)gridDim.x - j + 7) >> 3;
      {
        unsigned* cnt_ = (unsigned*)(p.ws + OFF_BAR) + 16;
        bool ok_ = true;
#pragma unroll
        for (int x_ = 0; x_ < 16; ++x_) {
          const unsigned c_ = __hip_atomic_load(&cnt_[x_], __ATOMIC_RELAXED, __HIP_MEMORY_SCOPE_AGENT);
          ok_ = ok_ && ((x_ < 8) ? (c_ > 0u) : (c_ == 0u));
        }
        if (ok_) {
          j = ((const int*)(smem + 45040))[0]; lb = ((const int*)(smem + 45040))[1];
          nb = (int)__hip_atomic_load(&cnt_[j], __ATOMIC_RELAXED, __HIP_MEMORY_SCOPE_AGENT);
        }
      }
      for (int tok = lb * 8 + w; tok < T_TOT; tok += nb * 8) peer9a_token(tid, p, layer, tok, j);
    }
    GRID_BAR();
    for (int rep_ = 0; rep_ < NREP(9); ++rep_) {
    PHASE_BEGIN
      for (int tok = gw; tok < T_TOT; tok += nw) peer9m_token(tid, smem, p, tok);
    }
    GRID_BAR();
    for (int rep_ = 0; rep_ < NREP(9); ++rep_) {
    PHASE_BEGIN
      int j = blockIdx.x & 7, lb = blockIdx.x >> 3, nb = ((int)gridDim.x - j + 7) >> 3;
      {
        unsigned* cnt_ = (unsigned*)(p.ws + OFF_BAR) + 16;
        bool ok_ = true;
#pragma unroll
        for (int x_ = 0; x_ < 16; ++x_) {
          const unsigned c_ = __hip_atomic_load(&cnt_[x_], __ATOMIC_RELAXED, __HIP_MEMORY_SCOPE_AGENT);
          ok_ = ok_ && ((x_ < 8) ? (c_ > 0u) : (c_ == 0u));
        }
        if (ok_) {
          j = ((const int*)(smem + 45040))[0]; lb = ((const int*)(smem + 45040))[1];
          nb = (int)__hip_atomic_load(&cnt_[j], __ATOMIC_RELAXED, __HIP_MEMORY_SCOPE_AGENT);
        }
      }
      for (int tok = lb * 8 + w; tok < T_TOT; tok += nb * 8) peer9b_token(tid, p, tok, j);
    }
    if (layer == 1) {
      GRID_BAR();
      for (int rep_ = 0; rep_ < NREP(9); ++rep_) {
      PHASE_BEGIN
        for (int tok = gw; tok < T_TOT; tok += nw) final_norm_token(tid, p, tok);
      }
    }
}

__global__ void __launch_bounds__(NT) mega(Params kparams_) {
  cg::grid_group grid = cg::this_grid();
  int bar_k = 0;
  __shared__ __attribute__((aligned(16))) unsigned char smem[45056];
  if (threadIdx.x == 0) {
    unsigned* cnt_ = (unsigned*)(((KParams*)__builtin_amdgcn_kernarg_segment_ptr())->ws + OFF_BAR) + 16;
    const unsigned xcc_ = (unsigned)__builtin_amdgcn_s_getreg((3 << 11) | 20) & 0xFu;
    const unsigned rank_ = __hip_atomic_fetch_add(&cnt_[xcc_], 1u, __ATOMIC_RELAXED, __HIP_MEMORY_SCOPE_AGENT);
    ((int*)(smem + 45040))[0] = (int)xcc_;
    ((int*)(smem + 45040))[1] = (int)rank_;
  }

  for (int rep_ = 0; rep_ < NREP(0); ++rep_)
  {
    PHASE_BEGIN
    int vb = 0;
    transpose_convert(tid, smem, p.in[12], wt + WT_IN_E, 1024, 1280, vb);
    transpose_convert(tid, smem, p.in[13], wt + WT_OUT_E, 1024, 1024, vb);
    transpose_convert(tid, smem, p.in[23], wt + WT_GLU, 512, 512, vb);
    transpose_convert(tid, smem, p.in[25], wt + WT_IN_O, 1024, 1312, vb);
    transpose_convert(tid, smem, p.in[26], wt + WT_OUT_O, 1024, 1024, vb);
    for (int g = 0; g < 4; ++g) transpose_convert(tid, smem, p.in[27] + g * 16384, wt + WT_POOL + g * 16384, 128, 128, vb);
    transpose_convert(tid, smem, p.in[31], wt + WT_UQ, 512, 768, vb);
    transpose_convert(tid, smem, p.in[32], wt + WT_UK, 256, 512, vb);
    transpose_convert(tid, smem, p.in[33], wt + WT_UV, 256, 512, vb);
    transpose_convert(tid, smem, p.in[34], wt + WT_PQ, 1024, 1024, vb);
    transpose_convert(tid, smem, p.in[34] + 1048576, wt + WT_PQ + 1048576, 1024, 1024, vb);
    convert_plain(tid, p.in[35], wt + WT_KEYS, 262144);
    quant_rows(p.in[36], p.ws + OFF_TAB, (float*)(p.ws + OFF_TAB + TAB_SU_OFF), gw, nw, tid);
    quant_rows(p.in[37], p.ws + OFF_TAB + TAB_V_OFF, (float*)(p.ws + OFF_TAB + TAB_SV_OFF), gw, nw, tid);
  }
  grid.sync();

  for (int rep_ = 0; rep_ < NREP(1); ++rep_)
  {
    PHASE_BEGIN
    int vb = 0;
    gemm_run<2>(tid, smem, p.in[0], p.in[1], T_P, 1024, p.in[9], wt + WT_IN_E, T_TOT, 1280, 1024, vb, EpiStoreBf16{proj, 1280});
  }
  GRID_BAR();

  for (int rep_ = 0; rep_ < NREP(2); ++rep_)
  {
    PHASE_BEGIN
    bf16_t* vt0 = (bf16_t*)(p.ws + OFF_VT0);
    bf16_t* kall = (bf16_t*)(p.ws + OFF_KALL);
    bf16_t* vtall = (bf16_t*)(p.ws + OFF_VTALL);
    for (int tok = gw; tok < T_TOT; tok += nw) {
      const bool isS = tok >= T_P;
      int b, t, pos;
      if (!isS) { b = tok >> 12; t = tok & 4095; pos = t; } else { int s = tok - T_P; b = s >> 5; t = s & 31; pos = 2048 + t; }
      bf16_t* row = proj + (size_t)tok * 1280;
      const int lm = lane & 7;
      float sn[8], cs[8];
#pragma unroll
      for (int j = 0; j < 8; ++j) { float inv = exp2f(-(float)j * (LOG2_THETA / 8.f)); sincos_rev((float)pos * inv, sn[j], cs[j]); }
      {
        uint4 qv = *(const uint4*)(row + lane * 8);
        float x[8]; unpack8(qv, x);
#pragma unroll
        for (int j = 0; j < 8; ++j) {
          float other = __shfl_xor(x[j], 1);
          if (lm == 0) x[j] = x[j] * cs[j] - other * sn[j];
          else if (lm == 1) x[j] = x[j] * cs[j] + other * sn[j];
        }
        *(uint4*)(row + lane * 8) = pack8(x);
      }
      {
        uint4 kv = make_uint4(0, 0, 0, 0);
        if (lane < 32) kv = *(const uint4*)(row + 512 + lane * 8);
        float x[8]; unpack8(kv, x);
#pragma unroll
        for (int j = 0; j < 8; ++j) {
          float other = __shfl_xor(x[j], 1);
          if (lane < 16) {
            if (lm == 0) x[j] = x[j] * cs[j] - other * sn[j];
            else if (lm == 1) x[j] = x[j] * cs[j] + other * sn[j];
          }
        }
        if (lane < 32) {
          const uint4 pk = pack8(x);
          const int e0 = (lane & 15) * 8;
          if (!isS) {
            if (lane < 16) *(uint4*)(row + 512 + lane * 8) = pk;
            else {
              const int kvh = e0 >> 6, d0 = e0 & 63;
#pragma unroll
              for (int j = 0; j < 8; ++j) vt0[((size_t)(b * 2 + kvh) * 64 + d0 + j) * 4096 + t] = f2bf(x[j]);
            }
            if (t >= 3968) {
              float* dst = p.out + ((lane < 16) ? O_SWAK_P : O_SWAV_P) + ((size_t)(b * 128 + (t - 3968)) * 128 + e0);
              *(float4*)dst = make_float4(x[0], x[1], x[2], x[3]);
              *(float4*)(dst + 4) = make_float4(x[4], x[5], x[6], x[7]);
            }
          } else {
            float* dst = p.out + ((lane < 16) ? O_SWAK_S : O_SWAV_S) + ((size_t)(b * 128 + 96 + t) * 128 + e0);
            *(float4*)dst = make_float4(x[0], x[1], x[2], x[3]);
            *(float4*)(dst + 4) = make_float4(x[4], x[5], x[6], x[7]);
            if (lane < 16) *(uint4*)(kall + (size_t)(b * 160 + 128 + t) * 128 + e0) = pk;
            else {
              const int kvh = e0 >> 6, d0 = e0 & 63;
#pragma unroll
              for (int j = 0; j < 8; ++j) vtall[((size_t)(b * 2 + kvh) * 64 + d0 + j) * 192 + 128 + t] = f2bf(x[j]);
            }
          }
        }
      }
    }
    for (size_t idx = gtid; idx < (size_t)32 * 96 * 128; idx += gthreads) {
      const int e = (int)(idx & 127); const int wd = (int)((idx >> 7) % 96); const int b = (int)(idx / (96 * 128));
      const size_t src = ((size_t)(b * 128 + 32 + wd)) * 128 + e, dst = ((size_t)(b * 128 + wd)) * 128 + e;
      p.out[O_SWAK_S + dst] = p.in[2][src];
      p.out[O_SWAV_S + dst] = p.in[3][src];
    }
    for (size_t idx = gtid; idx < (size_t)32 * 128 * 128; idx += gthreads) {
      const int e = (int)(idx & 127); const int key = (int)((idx >> 7) & 127); const int b = (int)(idx >> 14);
      kall[(size_t)(b * 160 + key) * 128 + e] = f2bf(p.in[2][idx]);
      vtall[((size_t)(b * 2 + (e >> 6)) * 64 + (e & 63)) * 192 + key] = f2bf(p.in[3][idx]);
    }
    for (size_t idx = gtid; idx < (size_t)32 * 2 * 64 * 32; idx += gthreads) {
      const int kk = (int)(idx & 31); const size_t rr = idx >> 5;
      vtall[rr * 192 + 160 + kk] = 0;
    }
    float* sUw = (float*)smem + w * 512;
    for (int item = gw; item < 32768; item += nw) s5_item<0>(tid, sUw, p, item);
  }
  GRID_BAR();

  for (int rep_ = 0; rep_ < NREP(3); ++rep_)
  {
    PHASE_BEGIN
    if (gtid < 16384) {
      const int n = (int)(gtid & 63), g = (int)((gtid >> 6) & 31), b = (int)(gtid >> 11);
      const int gn = g * 64 + n;
      const float lr = fminf(p.in[15][gn], -1e-4f), li = p.in[16][gn];
      const float dt = __expf(p.in[17][g]);
      const float mag = __expf(lr * dt);
      float sn, cs; sincos_rev(li * dt, sn, cs);
      float ar = mag * cs, ai = mag * sn;
#pragma unroll
      for (int i = 0; i < 5; ++i) { float nr = ar * ar - ai * ai, ni = 2.f * ar * ai; ar = nr; ai = ni; }
      const float* s1re = (const float*)(p.ws + OFF_QMLA);
      const float* s1im = s1re + 2097152;
      float* hinre = (float*)(p.ws + OFF_QMLA) + 2 * 2097152;
      float* hinim = hinre + 2097152;
      float hr = 0.f, hi = 0.f;
#pragma unroll 8
      for (int c = 0; c < 128; ++c) {
        const size_t idx = ((size_t)(b * 128 + c) * 32 + g) * 64 + n;
        hinre[idx] = hr; hinim[idx] = hi;
        const float sr = s1re[idx], si = s1im[idx];
        const float nhr = ar * hr - ai * hi + sr, nhi = ar * hi + ai * hr + si;
        hr = nhr; hi = nhi;
      }
      p.out[O_SSMRE_P + (size_t)(b * 32 + g) * 64 + n] = hr;
      p.out[O_SSMIM_P + (size_t)(b * 32 + g) * 64 + n] = hi;
    }
    const bf16_t* vt0 = (const bf16_t*)(p.ws + OFF_VT0);
    const bf16_t* kall = (const bf16_t*)(p.ws + OFF_KALL);
    const bf16_t* vtall = (const bf16_t*)(p.ws + OFF_VTALL);
    const float* sink = p.in[14];
    for (int item = blockIdx.x; item < 2048 + 256; item += gridDim.x) {
      AttnDesc d;
      d.scale = 0.125f; d.kx = nullptr; d.pos0 = 0;
      if (item < 2048) {
        const int h = item & 7, pr = (item >> 3) & 31, b = item >> 8;
        const int kvh = h >> 2;
        const int chunk = pr * 2 + (w >> 2);
        const int tok = b * 4096 + chunk * 64 + (w & 3) * 16;
        d.q = proj + (size_t)tok * 1280 + h * 64; d.ldq = 1280; d.active = 1;
        d.kt_lo = max(0, chunk - 2); d.kt_hi = chunk + 1;
        d.out = mix + (size_t)tok * 1024 + h * 64; d.ldo = 1024;
        d.m0 = sink[h]; d.l0 = 1.f;
        d.k = proj + (size_t)(b * 4096) * 1280 + 512 + kvh * 64; d.ldk = 1280;
        d.vt = vt0 + (size_t)(b * 2 + kvh) * 64 * 4096; d.ldv = 4096; d.nkeys = 4096;
        d.bt_lo = max(0, pr * 2 - 2); d.bt_hi = pr * 2 + 2;
      } else {
        const int it = item - 2048;
        const int h = it & 7, b = it >> 3;
        const int kvh = h >> 2;
        const int tok = T_P + b * 32 + (w & 1) * 16;
        d.q = proj + (size_t)tok * 1280 + h * 64; d.ldq = 1280; d.active = (w < 2);
        d.kt_lo = 0; d.kt_hi = 3;
        d.out = mix + (size_t)tok * 1024 + h * 64; d.ldo = 1024;
        d.m0 = sink[h]; d.l0 = 1.f;
        d.k = kall + (size_t)(b * 160) * 128 + kvh * 64; d.ldk = 128;
        d.vt = vtall + (size_t)(b * 2 + kvh) * 64 * 192; d.ldv = 192; d.nkeys = 160;
        d.bt_lo = 0; d.bt_hi = 3;
      }
      attn_item<64>(tid, smem, d);
    }
  }
  GRID_BAR();

  for (int rep_ = 0; rep_ < NREP(4); ++rep_)
  {
    PHASE_BEGIN
    float* sUw = (float*)smem + w * 512;
    for (int item = gw; item < 33792; item += nw) s5_item<1>(tid, sUw, p, item);
  }
  GRID_BAR();

  for (int rep_ = 0; rep_ < NREP(5); ++rep_)
  {
    PHASE_BEGIN
    int vb = 0;
    gemm_run<0>(tid, smem, zbuf, zbuf, T_TOT, 512, nullptr, wt + WT_GLU, T_TOT, 512, 512, vb, EpiGlu{zbuf, p.in[24], mix});
  }
  GRID_BAR();

  for (int rep_ = 0; rep_ < NREP(6); ++rep_)
  {
    PHASE_BEGIN
    int vb = 0;
    gemm_run<0>(tid, smem, mix, mix, T_TOT, 1024, nullptr, wt + WT_OUT_E, T_TOT, 1024, 1024, vb, EpiRes0{p.in[0], p.in[1], xres});
  }
  GRID_BAR();

  peer_phases<0>(bar_k, smem);
  GRID_BAR();
      for (int rep_ = 0; rep_ < NREP(10); ++rep_)
      {
    PHASE_BEGIN
        int vb = 0;
        gemm_run<2>(tid, smem, xres, xres, T_TOT, 1024, p.in[9] + 1024, wt + WT_IN_O, T_TOT, 1312, 1024, vb, EpiStoreBf16{proj, 1312});
      }
      GRID_BAR();
      for (int rep_ = 0; rep_ < NREP(11); ++rep_)
      {
    PHASE_BEGIN
        bf16_t* cqn = zbuf;
        bf16_t* mbuf = (bf16_t*)(p.ws + OFF_M);
        bf16_t* cbuf = (bf16_t*)(p.ws + OFF_C);
        bf16_t* kpbuf = (bf16_t*)(p.ws + OFF_KP);
        bf16_t* kps = (bf16_t*)(p.ws + OFF_KPS);
        for (int tok = gw; tok < T_TOT; tok += nw) {
          const bool isS = tok >= T_P;
          int b, t, pos;
          if (!isS) { b = tok >> 12; t = tok & 4095; pos = t; } else { int s = tok - T_P; b = s >> 5; t = s & 31; pos = 2048 + t; }
          const bf16_t* row = proj + (size_t)tok * 1312;
          {
            uint4 v = *(const uint4*)(row + lane * 8);
            float x[8]; unpack8(v, x);
            float ss = 0.f;
#pragma unroll
            for (int j = 0; j < 8; ++j) ss += x[j] * x[j];
            ss = wave_sum(ss);
            const float rs = rsqrtf(ss * (1.f / 512.f) + 1e-6f);
            const float4 g0 = *(const float4*)(p.in[29] + lane * 8), g1 = *(const float4*)(p.in[29] + lane * 8 + 4);
            x[0] *= rs * g0.x; x[1] *= rs * g0.y; x[2] *= rs * g0.z; x[3] *= rs * g0.w;
            x[4] *= rs * g1.x; x[5] *= rs * g1.y; x[6] *= rs * g1.z; x[7] *= rs * g1.w;
            *(uint4*)(cqn + (size_t)tok * 512 + lane * 8) = pack8(x);
          }
          {
            uint2 v = *(const uint2*)(row + 512 + lane * 4);
            float x0 = lo2f(v.x), x1 = hi2f(v.x), x2 = lo2f(v.y), x3 = hi2f(v.y);
            float ss = wave_sum(x0 * x0 + x1 * x1 + x2 * x2 + x3 * x3);
            const float rs = rsqrtf(ss * (1.f / 256.f) + 1e-6f);
            const float4 g = *(const float4*)(p.in[30] + lane * 4);
            x0 *= rs * g.x; x1 *= rs * g.y; x2 *= rs * g.z; x3 *= rs * g.w;
            uint2 o; o.x = pack2(x0, x1); o.y = pack2(x2, x3);
            *(uint2*)(cbuf + (size_t)tok * 256 + lane * 4) = o;
            float* dst = isS ? (p.out + O_CKV_S + (size_t)(tok - T_P) * 256 + lane * 4) : (p.out + O_CKV_P + (size_t)tok * 256 + lane * 4);
            *(float4*)dst = make_float4(x0, x1, x2, x3);
          }
          {
            float xv = 0.f;
            if (lane < 32) xv = bf2f(row[768 + lane]);
            const float other = __shfl_xor(xv, 16);
            const int f = lane & 15;
            const float inv = exp2f(-(float)f * (LOG2_THETA / 16.f));
            float sn, cs; sincos_rev((float)pos * inv, sn, cs);
            const float r = (lane < 16) ? (xv * cs - other * sn) : (xv * cs + other * sn);
            if (lane < 32) {
              kpbuf[(size_t)tok * 32 + lane] = f2bf(r);
              if (isS) { p.out[O_KPE_S + (size_t)(tok - T_P) * 32 + lane] = r; kps[((size_t)b * 2112 + 2048 + t) * 32 + lane] = f2bf(r); }
              else p.out[O_KPE_P + (size_t)tok * 32 + lane] = r;
            }
          }
          {
            const int gi = lane >> 4; const int wlen = 2 << gi;
            float tot[8], cur[8];
#pragma unroll
            for (int j = 0; j < 8; ++j) tot[j] = 0.f;
            uint4 v = *(const uint4*)(row + 800 + lane * 8);
            unpack8(v, cur);
#pragma unroll
            for (int j = 0; j < 8; ++j) tot[j] = cur[j];
            for (int jb = 1; jb < 16; ++jb) {
              if (jb < wlen) {
                const int tt = t - jb;
                if (tt >= 0) {
                  uint4 pv = *(const uint4*)(row - (size_t)jb * 1312 + 800 + lane * 8);
                  float y[8]; unpack8(pv, y);
#pragma unroll
                  for (int j = 0; j < 8; ++j) tot[j] += y[j];
                } else if (isS) {
                  const float* sp = p.in[6] + ((size_t)b * 15 + (15 + tt)) * 512 + lane * 8;
                  float4 a = *(const float4*)sp, bq = *(const float4*)(sp + 4);
                  tot[0] += a.x; tot[1] += a.y; tot[2] += a.z; tot[3] += a.w; tot[4] += bq.x; tot[5] += bq.y; tot[6] += bq.z; tot[7] += bq.w;
                }
              }
            }
            const float cnt = (float)min(pos + 1, wlen);
            float mm[8];
#pragma unroll
            for (int j = 0; j < 8; ++j) mm[j] = tot[j] / cnt - cur[j];
            *(uint4*)(mbuf + (size_t)tok * 512 + lane * 8) = pack8(mm);
            const int tlen = isS ? 32 : 4096;
            if (t >= tlen - 15) {
              const int i = t - (tlen - 15);
              float* dst = isS ? (p.out + O_POOL_S + ((size_t)b * 15 + i) * 512 + lane * 8) : (p.out + O_POOL_P + ((size_t)b * 15 + i) * 512 + lane * 8);
              *(float4*)dst = make_float4(cur[0], cur[1], cur[2], cur[3]);
              *(float4*)(dst + 4) = make_float4(cur[4], cur[5], cur[6], cur[7]);
            }
          }
        }
        for (size_t idx = gtid; idx < (size_t)32 * 2048 * 32; idx += gthreads) {
          const int e = (int)(idx & 31); const int key = (int)((idx >> 5) & 2047); const int b = (int)(idx >> 16);
          kps[((size_t)b * 2112 + key) * 32 + e] = f2bf(p.in[8][idx]);
        }
      }
      GRID_BAR();
      for (int rep_ = 0; rep_ < NREP(12); ++rep_)
      {
    PHASE_BEGIN
        bf16_t* cqn = zbuf;
        bf16_t* mbuf = (bf16_t*)(p.ws + OFF_M);
        bf16_t* cbuf = (bf16_t*)(p.ws + OFF_C);
        bf16_t* qmla = (bf16_t*)(p.ws + OFF_QMLA);
        bf16_t* kupp = qbuf;
        bf16_t* vtp = qbuf + 16777216;
        bf16_t* kups = (bf16_t*)(p.ws + OFF_KUPS);
        bf16_t* vts = (bf16_t*)(p.ws + OFF_VTS);
        for (size_t idx = gtid; idx < (size_t)32 * 8 * 64 * 32; idx += gthreads) {
          const int kk = (int)(idx & 31); const size_t rr = idx >> 5;
          vts[rr * 2112 + 2080 + kk] = 0;
        }
        int vb = 0;
        gemm_run<1>(tid, smem, p.in[7], p.in[7], 65536, 256, nullptr, wt + WT_UK, 65536, 512, 256, vb, EpiKup{kups, 2048, 0, 2112});
        gemm_run<1>(tid, smem, p.in[7], p.in[7], 65536, 256, nullptr, wt + WT_UV, 65536, 512, 256, vb, EpiVt{vts, 2048, 0, 2112});
        gemm_run<0>(tid, smem, cqn, cqn, T_TOT, 512, nullptr, wt + WT_UQ, T_TOT, 768, 512, vb, EpiStoreBf16{qmla, 768});
        gemm_run<0>(tid, smem, cbuf, cbuf, T_P, 256, nullptr, wt + WT_UK, T_P, 512, 256, vb, EpiKup{kupp, 4096, 0, 4096});
        gemm_run<0>(tid, smem, cbuf, cbuf, T_P, 256, nullptr, wt + WT_UV, T_P, 512, 256, vb, EpiVt{vtp, 4096, 0, 4096});
        gemm_run<0>(tid, smem, cbuf + (size_t)T_P * 256, cbuf, 1024, 256, nullptr, wt + WT_UK, 1024, 512, 256, vb, EpiKup{kups, 32, 2048, 2112});
        gemm_run<0>(tid, smem, cbuf + (size_t)T_P * 256, cbuf, 1024, 256, nullptr, wt + WT_UV, 1024, 512, 256, vb, EpiVt{vts, 32, 2048, 2112});
        for (int g = 0; g < 4; ++g)
          gemm_run<0>(tid, smem, mbuf + g * 128, mbuf, T_TOT, 512, nullptr, wt + WT_POOL + g * 16384, T_TOT, 128, 128, vb, EpiPool{mix, p.in[28], g});
      }
      GRID_BAR();
      for (int rep_ = 0; rep_ < NREP(13); ++rep_)
      {
    PHASE_BEGIN
        const bf16_t* qmla = (const bf16_t*)(p.ws + OFF_QMLA);
        const bf16_t* kupp = qbuf;
        const bf16_t* vtp = qbuf + 16777216;
        const bf16_t* kups = (const bf16_t*)(p.ws + OFF_KUPS);
        const bf16_t* vts = (const bf16_t*)(p.ws + OFF_VTS);
        const bf16_t* kpbuf = (const bf16_t*)(p.ws + OFF_KP);
        const bf16_t* kps = (const bf16_t*)(p.ws + OFF_KPS);
        const int G = gridDim.x;
        const bool xsched = (G == 256);
        const int nitems = 2048 + 256;
        const int xcd = blockIdx.x & 7, loc = blockIdx.x >> 3;
        for (int k = 0;; ++k) {
          int pit, sit = -1;
          if (xsched) {
            if (k >= 9) break;
            if (k == 0) { pit = -1; sit = blockIdx.x; }
            else {
              const int r = k - 1;
              const int grp = xcd + 8 * r;
              const int pr = (r & 1) ? (31 - loc) : loc;
              pit = ((31 - pr) << 6) | grp;
            }
          } else {
            const int posn = (k & 1) ? (G - 1 - (int)blockIdx.x) : (int)blockIdx.x;
            const int v = k * G + posn;
            if (k * G >= nitems) break;
            if (v >= nitems) continue;
            if (v < 1024) pit = v; else if (v < 1280) { pit = -1; sit = v - 1024; } else pit = v - 256;
          }
          AttnDesc d;
          d.scale = 0.10206207261596575f; d.m0 = -1e30f; d.l0 = 0.f;
          if (pit >= 0) {
            const int pr = 31 - (pit >> 6); const int h = pit & 7, b = (pit >> 3) & 7;
            const int chunk = pr * 2 + (w >> 2);
            const int tok = b * 4096 + chunk * 64 + (w & 3) * 16;
            d.q = qmla + (size_t)tok * 768 + h * 96; d.ldq = 768; d.active = 1; d.pos0 = chunk * 64 + (w & 3) * 16;
            d.kt_lo = 0; d.kt_hi = chunk + 1;
            d.out = mix + (size_t)tok * 1024 + 512 + h * 64; d.ldo = 1024;
            d.k = kupp + (size_t)(b * 4096) * 512 + h * 64; d.ldk = 512;
            d.kx = kpbuf + (size_t)(b * 4096) * 32;
            d.vt = vtp + (size_t)(b * 8 + h) * 64 * 4096; d.ldv = 4096; d.nkeys = 4096;
            d.bt_lo = 0; d.bt_hi = pr * 2 + 2;
          } else {
            const int h = sit & 7, b = sit >> 3;
            const int tok = T_P + b * 32 + (w & 1) * 16;
            d.q = qmla + (size_t)tok * 768 + h * 96; d.ldq = 768; d.active = (w < 2); d.pos0 = 2048 + (w & 1) * 16;
            d.kt_lo = 0; d.kt_hi = 33;
            d.out = mix + (size_t)tok * 1024 + 512 + h * 64; d.ldo = 1024;
            d.k = kups + (size_t)(b * 2112) * 512 + h * 64; d.ldk = 512;
            d.kx = kps + (size_t)(b * 2112) * 32;
            d.vt = vts + (size_t)(b * 8 + h) * 64 * 2112; d.ldv = 2112; d.nkeys = 2080;
            d.bt_lo = 0; d.bt_hi = 33;
          }
          attn_item<96>(tid, smem, d);
        }
      }
      GRID_BAR();
      for (int rep_ = 0; rep_ < NREP(14); ++rep_)
      {
    PHASE_BEGIN
        quant_rows(p.in[36] + 16777216, p.ws + OFF_TAB, (float*)(p.ws + OFF_TAB + TAB_SU_OFF), gw, nw, tid);
        quant_rows(p.in[37] + 16777216, p.ws + OFF_TAB + TAB_V_OFF, (float*)(p.ws + OFF_TAB + TAB_SV_OFF), gw, nw, tid);
        int vb = 0;
        gemm_run<0>(tid, smem, mix, mix, T_TOT, 1024, nullptr, wt + WT_OUT_O, T_TOT, 1024, 1024, vb, EpiRes1{xres});
      }
      GRID_BAR();
  peer_phases<1>(bar_k, smem);
}

extern "C" void kernel_launch(void* const* d_in, const int* in_sizes, int n_in, void* d_out, int out_size, void* d_ws, size_t ws_size, hipStream_t stream) {
  static int grid_blocks = 0;
  if (grid_blocks == 0) {
    int dev = 0, cus = 0, per_cu = 0;
    hipGetDevice(&dev);
    hipDeviceGetAttribute(&cus, hipDeviceAttributeMultiprocessorCount, dev);
    hipOccupancyMaxActiveBlocksPerMultiprocessor(&per_cu, (const void*)mega, NT, 0);
    if (per_cu < 1) per_cu = 1;
    if (per_cu > 1) per_cu = 1;
    grid_blocks = cus * per_cu;
    if (ws_size < WS_NEED + 256) fprintf(stderr, "kernel_launch: workspace too small: %zu < %zu\n", ws_size, (size_t)WS_NEED);
  }
  hipMemsetAsync((unsigned char*)d_ws + OFF_BAR, 0, 256, stream);
  Params p{};
  for (int i = 0; i < 38; ++i) p.in[i] = (const float*)d_in[i];
  p.out = (float*)d_out;
  p.ws = (unsigned char*)d_ws;
  void* args[] = {&p};
  hipError_t e = hipLaunchCooperativeKernel((const void*)mega, dim3(grid_blocks), dim3(NT), args, 0, stream);
  if (e != hipSuccess) fprintf(stderr, "cooperative launch failed: %s (grid %d)\n", hipGetErrorString(e), grid_blocks);
}
```

```cpp
#include <hip/hip_runtime.h>
#include <hip/hip_bf16.h>
#include <hip/hip_cooperative_groups.h>
#include <cstdio>
namespace cg = cooperative_groups;

typedef unsigned short bf16_t;
using bf16x8 = __attribute__((ext_vector_type(8))) short;
using f32x4 = __attribute__((ext_vector_type(4))) float;

#ifndef PH
#define PH 0xFFFFFFu
#endif
#ifndef DBL
#define DBL 0u
#endif
#define NREP(n) ((int)((PH >> (n)) & 1u) * (1 + (int)((DBL >> (n)) & 1u)))
#define NT 512
#define T_TOT 33792
#define T_P 32768
#define LOG2_THETA 18.931568569324174f

#define O_Y 0
#define O_SWAK_P 34603008
#define O_SWAV_P 34734080
#define O_SSMRE_P 34865152
#define O_SSMIM_P 34881536
#define O_POOL_P 34897920
#define O_CKV_P 34959360
#define O_KPE_P 43347968
#define O_SWAK_S 44396544
#define O_SWAV_S 44920832
#define O_SSMRE_S 45445120
#define O_SSMIM_S 45510656
#define O_POOL_S 45576192
#define O_CKV_S 45821952
#define O_KPE_S 46084096

constexpr size_t OFF_PROJ = 0;
constexpr size_t OFF_TAB = OFF_PROJ + 88670208ull;
constexpr size_t OFF_MIX = OFF_TAB + 67108864ull;
constexpr size_t OFF_QBUF = OFF_MIX + 69206016ull;
constexpr size_t OFF_QMLA = OFF_QBUF + 69206016ull;
constexpr size_t OFF_Z = OFF_QMLA + 51904512ull;
constexpr size_t OFF_M = OFF_Z + 34603008ull;
constexpr size_t OFF_C = OFF_M + 34603008ull;
constexpr size_t OFF_KP = OFF_C + 17301504ull;
constexpr size_t OFF_VT0 = OFF_KP + 2162688ull;
constexpr size_t OFF_KALL = OFF_VT0 + 8388608ull;
constexpr size_t OFF_VTALL = OFF_KALL + 1327104ull;
constexpr size_t OFF_KPS = OFF_VTALL + 1572864ull;
constexpr size_t OFF_WT = OFF_KPS + 4325376ull;
constexpr size_t WS_NEED = OFF_WT + 16187392ull;
constexpr size_t OFF_KUPS = OFF_PROJ;
constexpr size_t OFF_VTS = OFF_PROJ + 69206016ull;
constexpr size_t WT_IN_E = 0;
constexpr size_t WT_OUT_E = WT_IN_E + 1310720;
constexpr size_t WT_GLU = WT_OUT_E + 1048576;
constexpr size_t WT_IN_O = WT_GLU + 262144;
constexpr size_t WT_OUT_O = WT_IN_O + 1343488;
constexpr size_t WT_POOL = WT_OUT_O + 1048576;
constexpr size_t WT_UQ = WT_POOL + 65536;
constexpr size_t WT_UK = WT_UQ + 393216;
constexpr size_t WT_UV = WT_UK + 131072;
constexpr size_t WT_PQ = WT_UV + 131072;
constexpr size_t WT_KEYS = WT_PQ + 2097152;

struct Params {
  const float* in[38];
  float* out;
  unsigned char* ws;
};

typedef __bf16 bf16x2_t __attribute__((ext_vector_type(2)));
typedef float float2_t __attribute__((ext_vector_type(2)));
__device__ __forceinline__ unsigned pack2(float a, float b) {
  float2_t f = {a, b};
  bf16x2_t h = __builtin_convertvector(f, bf16x2_t);
  return __builtin_bit_cast(unsigned, h);
}
__device__ __forceinline__ unsigned short f2bf(float f) { return (unsigned short)(pack2(f, 0.f) & 0xffffu); }
__device__ __forceinline__ float bf2f(unsigned short b) { return __uint_as_float(((unsigned)b) << 16); }
__device__ __forceinline__ float lo2f(unsigned u) { return __uint_as_float(u << 16); }
__device__ __forceinline__ float hi2f(unsigned u) { return __uint_as_float(u & 0xffff0000u); }
__device__ __forceinline__ void unpack8(uint4 v, float* x) {
  x[0] = lo2f(v.x); x[1] = hi2f(v.x); x[2] = lo2f(v.y); x[3] = hi2f(v.y);
  x[4] = lo2f(v.z); x[5] = hi2f(v.z); x[6] = lo2f(v.w); x[7] = hi2f(v.w);
}
__device__ __forceinline__ uint4 pack8(const float* x) {
  uint4 v; v.x = pack2(x[0], x[1]); v.y = pack2(x[2], x[3]); v.z = pack2(x[4], x[5]); v.w = pack2(x[6], x[7]); return v;
}
template <int CTRL> __device__ __forceinline__ float dpp_f(float v) {
  return __int_as_float(__builtin_amdgcn_update_dpp(0, __float_as_int(v), CTRL, 0xf, 0xf, true));
}
__device__ __forceinline__ float row16_max(float v) {
  v = fmaxf(v, dpp_f<0xB1>(v)); v = fmaxf(v, dpp_f<0x4E>(v)); v = fmaxf(v, dpp_f<0x141>(v)); v = fmaxf(v, dpp_f<0x140>(v)); return v;
}
__device__ __forceinline__ float row16_sum(float v) {
  v += dpp_f<0xB1>(v); v += dpp_f<0x4E>(v); v += dpp_f<0x141>(v); v += dpp_f<0x140>(v); return v;
}
__device__ __forceinline__ float wave_sum(float v) {
  v = row16_sum(v);
  const float a = __int_as_float(__builtin_amdgcn_readlane(__float_as_int(v), 0));
  const float b = __int_as_float(__builtin_amdgcn_readlane(__float_as_int(v), 16));
  const float c = __int_as_float(__builtin_amdgcn_readlane(__float_as_int(v), 32));
  const float d = __int_as_float(__builtin_amdgcn_readlane(__float_as_int(v), 48));
  return (a + b) + (c + d);
}
__device__ __forceinline__ void sincos_rev(float ang, float& s, float& c) {
  float rev = ang * 0.15915494309189535f;
  rev = rev - floorf(rev);
  s = __builtin_amdgcn_sinf(rev);
  c = __builtin_amdgcn_cosf(rev);
}
__device__ __forceinline__ float gelu_tanh(float x) {
  float y = 0.7978845608028654f * (x + 0.044715f * x * x * x);
  float t = 1.f - 2.f / (1.f + __expf(2.f * y));
  return 0.5f * x * (1.f + t);
}
__device__ __forceinline__ float gelu_erf(float x) { return 0.5f * x * (1.f + erff(x * 0.7071067811865476f)); }
__device__ __forceinline__ int logical_bid() {
  const int G = (int)gridDim.x, b = (int)blockIdx.x;
  return ((G & 7) == 0) ? ((b & 7) * (G >> 3) + (b >> 3)) : b;
}
__device__ __forceinline__ int rot_start(int vbase) {
  int G = (int)gridDim.x;
  int s = (logical_bid() - vbase) % G;
  if (s < 0) s += G;
  return s;
}

__device__ __forceinline__ void transpose_convert(int tid, unsigned char* smem, const float* __restrict__ src, bf16_t* __restrict__ dst, int K, int N, int& vbase) {
  float* tl = (float*)smem;
  const int tk = K / 64, tn = (N + 63) / 64;
  const int ntiles = tk * tn;
  for (int tile = rot_start(vbase); tile < ntiles; tile += gridDim.x) {
    const int k0 = (tile / tn) * 64, n0 = (tile % tn) * 64;
    __syncthreads();
#pragma unroll
    for (int i = 0; i < 2; ++i) {
      int r = (tid >> 4) + 32 * i, c4 = (tid & 15) * 4;
      float4 v = make_float4(0.f, 0.f, 0.f, 0.f);
      if (n0 + c4 < N) v = *(const float4*)(src + (size_t)(k0 + r) * N + n0 + c4);
      tl[r * 65 + c4 + 0] = v.x; tl[r * 65 + c4 + 1] = v.y; tl[r * 65 + c4 + 2] = v.z; tl[r * 65 + c4 + 3] = v.w;
    }
    __syncthreads();
    int n = tid >> 3, k8 = (tid & 7) * 8;
    if (n0 + n < N) {
      float x[8];
#pragma unroll
      for (int j = 0; j < 8; ++j) x[j] = tl[(k8 + j) * 65 + n];
      *(uint4*)(dst + (size_t)(n0 + n) * K + k0 + k8) = pack8(x);
    }
  }
  vbase += ntiles;
}

__device__ __forceinline__ void convert_plain(int tid, const float* __restrict__ src, bf16_t* __restrict__ dst, size_t n) {
  size_t i = ((size_t)blockIdx.x * NT + tid) * 8;
  const size_t stride = (size_t)gridDim.x * NT * 8;
  for (; i < n; i += stride) {
    float4 a = *(const float4*)(src + i), b = *(const float4*)(src + i + 4);
    uint4 v; v.x = pack2(a.x, a.y); v.y = pack2(a.z, a.w); v.z = pack2(b.x, b.y); v.w = pack2(b.z, b.w);
    *(uint4*)(dst + i) = v;
  }
}

template <int V> struct IC { static constexpr int value = V; };
template <int AMODE, class Epi>
__device__ __forceinline__ void gemm_run(int tid, unsigned char* smem, const void* A, const void* A2, int splitRow, int lda,
                                         const float* __restrict__ gain, const bf16_t* __restrict__ Bt,
                                         int M, int N, int K, int& vbase, Epi epi) {
  bf16_t* sA = (bf16_t*)smem;
  bf16_t* sB = sA + 128 * 72;
  float* sR = (float*)(sB + 128 * 72);
  float* sG = sR + 128;
  if (AMODE == 2) {
    __syncthreads();
    sG[tid] = gain[tid]; sG[tid + 512] = gain[tid + 512];
    __syncthreads();
  }
  const int lane = tid & 63, w = tid >> 6;
  const int l16 = lane & 15, quad = lane >> 4;
  const int wm = w >> 1, wn = w & 1;
  const int tilesN = (N + 127) / 128, tilesM = M / 128;
  const int ntiles = tilesM * tilesN;
  const int arow = tid >> 2, aseg = (tid & 3) * 16;
  const int nk = K / 64;
  for (int tile = rot_start(vbase); tile < ntiles; tile += gridDim.x) {
    const int tm = tile / tilesN, tn = tile % tilesN;
    const int m0 = tm * 128, n0 = tn * 128;
    const int grow = m0 + arow;
    const unsigned char* aptr;
    if (AMODE == 0) aptr = (grow < splitRow) ? (const unsigned char*)A + (size_t)grow * lda * 2 : (const unsigned char*)A2 + (size_t)(grow - splitRow) * lda * 2;
    else aptr = (grow < splitRow) ? (const unsigned char*)A + (size_t)grow * lda * 4 : (const unsigned char*)A2 + (size_t)(grow - splitRow) * lda * 4;
    const bool bvalid = (n0 + arow) < N;
    const bf16_t* bptr = Bt + (size_t)(n0 + arow) * K + aseg;
    f32x4 acc[2][4];
#pragma unroll
    for (int i = 0; i < 2; ++i)
#pragma unroll
      for (int j = 0; j < 4; ++j) acc[i][j] = (f32x4){0.f, 0.f, 0.f, 0.f};
    float ss = 0.f;
    float4 af0[4], af1[4];
    uint4 ab0[2], ab1[2];
    uint4 bb0[2], bb1[2];
#define GLOAD(AF, AB, BB, KT) { \
      const int k0_ = (KT) * 64; \
      if (AMODE == 0) { AB[0] = *(const uint4*)(aptr + (size_t)(k0_ + aseg) * 2); AB[1] = *(const uint4*)(aptr + (size_t)(k0_ + aseg + 8) * 2); } \
      else { \
        _Pragma("unroll") for (int i = 0; i < 4; ++i) AF[i] = *(const float4*)(aptr + (size_t)(k0_ + aseg + 4 * i) * 4); \
      } \
      if (bvalid) { BB[0] = *(const uint4*)(bptr + k0_); BB[1] = *(const uint4*)(bptr + k0_ + 8); } \
      else { BB[0] = make_uint4(0, 0, 0, 0); BB[1] = BB[0]; } }
#define LSTORE(AF, AB, BB, KT) { \
      uint4 s0, s1; \
      if (AMODE == 0) { s0 = AB[0]; s1 = AB[1]; } \
      else { \
        if (AMODE == 2) { \
          const float* gp = sG + (KT) * 64 + aseg; \
          _Pragma("unroll") for (int i = 0; i < 4; ++i) { \
            float4 g = *(const float4*)(gp + 4 * i); \
            ss += AF[i].x * AF[i].x + AF[i].y * AF[i].y + AF[i].z * AF[i].z + AF[i].w * AF[i].w; \
            AF[i].x *= g.x; AF[i].y *= g.y; AF[i].z *= g.z; AF[i].w *= g.w; \
          } \
        } \
        s0.x = pack2(AF[0].x, AF[0].y); s0.y = pack2(AF[0].z, AF[0].w); s0.z = pack2(AF[1].x, AF[1].y); s0.w = pack2(AF[1].z, AF[1].w); \
        s1.x = pack2(AF[2].x, AF[2].y); s1.y = pack2(AF[2].z, AF[2].w); s1.z = pack2(AF[3].x, AF[3].y); s1.w = pack2(AF[3].z, AF[3].w); \
      } \
      *(uint4*)(sA + arow * 72 + aseg) = s0; \
      *(uint4*)(sA + arow * 72 + aseg + 8) = s1; \
      *(uint4*)(sB + arow * 72 + aseg) = BB[0]; \
      *(uint4*)(sB + arow * 72 + aseg + 8) = BB[1]; }
#define GCOMPUTE() { \
      _Pragma("unroll") for (int ks = 0; ks < 2; ++ks) { \
        bf16x8 a[2], b[4]; \
        _Pragma("unroll") for (int i = 0; i < 2; ++i) a[i] = *(const bf16x8*)(sA + (wm * 32 + i * 16 + l16) * 72 + ks * 32 + quad * 8); \
        _Pragma("unroll") for (int j = 0; j < 4; ++j) b[j] = *(const bf16x8*)(sB + (wn * 64 + j * 16 + l16) * 72 + ks * 32 + quad * 8); \
        _Pragma("unroll") for (int i = 0; i < 2; ++i) \
          _Pragma("unroll") for (int j = 0; j < 4; ++j) acc[i][j] = __builtin_amdgcn_mfma_f32_16x16x32_bf16(a[i], b[j], acc[i][j], 0, 0, 0); \
      } }
    GLOAD(af0, ab0, bb0, 0);
    GLOAD(af1, ab1, bb1, 1);
    for (int kt = 0; kt < nk; kt += 2) {
      __syncthreads();
      LSTORE(af0, ab0, bb0, kt);
      __syncthreads();
      if (kt + 2 < nk) GLOAD(af0, ab0, bb0, kt + 2);
      GCOMPUTE();
      __syncthreads();
      LSTORE(af1, ab1, bb1, kt + 1);
      __syncthreads();
      if (kt + 3 < nk) GLOAD(af1, ab1, bb1, kt + 3);
      GCOMPUTE();
    }
    if (AMODE == 2) {
      ss += __shfl_xor(ss, 1);
      ss += __shfl_xor(ss, 2);
      if ((tid & 3) == 0) sR[arow] = rsqrtf(ss / (float)K + 1e-6f);
      __syncthreads();
    }
#pragma unroll
    for (int i = 0; i < 2; ++i)
#pragma unroll
      for (int r = 0; r < 4; ++r) {
        const int rl = wm * 32 + i * 16 + quad * 4 + r;
        const float rs = (AMODE == 2) ? sR[rl] : 1.f;
#pragma unroll
        for (int j = 0; j < 4; ++j) {
          const int col = n0 + wn * 64 + j * 16 + l16;
          if (col < N) epi(m0 + rl, col, acc[i][j][r] * rs);
        }
      }
  }
  vbase += ntiles;
}

struct AttnDesc {
  const bf16_t* q; int ldq; int active; int kt_lo, kt_hi; bf16_t* out; int ldo; float m0, l0; int pos0;
  const bf16_t* k; int ldk; const bf16_t* kx; const bf16_t* vt; int ldv; int nkeys; int bt_lo, bt_hi; float scale;
};

template <int DQK>
__device__ __forceinline__ void attn_item(int tid, unsigned char* smem, const AttnDesc& d) {
  constexpr int LDK = DQK + 8;
  bf16_t* sK = (bf16_t*)smem;
  bf16_t* sVt = sK + 64 * 104;
  bf16_t* sP = sVt + 64 * 72;
  const int lane = tid & 63, w = tid >> 6;
  const int l16 = lane & 15, quad = lane >> 4;
  bf16_t* sPw = sP + w * 16 * 72;
  bf16x8 qf[DQK / 32];
  if (d.active) {
#pragma unroll
    for (int ks = 0; ks < DQK / 32; ++ks) {
      const bf16_t* qp = d.q + (size_t)l16 * d.ldq + ks * 32 + quad * 8;
      uint4 v = *(const uint4*)qp;
      if (DQK == 96 && ks == 2) {
        const int pq = (quad < 2) ? 16 : -16;
        uint4 pv = *(const uint4*)(qp + pq);
        float x[8], y[8];
        unpack8(v, x); unpack8(pv, y);
        const float pos = (float)(d.pos0 + l16);
#pragma unroll
        for (int j = 0; j < 8; ++j) {
          const int f = (quad & 1) * 8 + j;
          float inv = exp2f(-(float)f * (LOG2_THETA / 16.f));
          float sn, cs; sincos_rev(pos * inv, sn, cs);
          x[j] = (quad < 2) ? (x[j] * cs - y[j] * sn) : (x[j] * cs + y[j] * sn);
        }
        v = pack8(x);
      }
      qf[ks] = *(bf16x8*)&v;
    }
  }
  f32x4 o[4];
#pragma unroll
  for (int i = 0; i < 4; ++i) o[i] = (f32x4){0.f, 0.f, 0.f, 0.f};
  float m[4], l[4];
#pragma unroll
  for (int r = 0; r < 4; ++r) { m[r] = d.m0; l[r] = d.l0; }

  const int key = tid >> 3, seg = tid & 7;
  const int key2 = (tid >> 2) & 63, seg2 = tid & 3;
  uint4 kv_r = make_uint4(0, 0, 0, 0), vv_r = kv_r, xv_r = kv_r;
  if (d.bt_lo < d.bt_hi) {
    kv_r = *(const uint4*)(d.k + (size_t)(d.bt_lo * 64 + key) * d.ldk + seg * 8);
    vv_r = *(const uint4*)(d.vt + (size_t)key * d.ldv + d.bt_lo * 64 + seg * 8);
    if (DQK == 96 && tid < 256) xv_r = *(const uint4*)(d.kx + (size_t)(d.bt_lo * 64 + key2) * 32 + seg2 * 8);
  }
  for (int kt = d.bt_lo; kt < d.bt_hi; ++kt) {
    __syncthreads();
    *(uint4*)(sK + key * LDK + seg * 8) = kv_r;
    *(uint4*)(sVt + key * 72 + seg * 8) = vv_r;
    if (DQK == 96 && tid < 256) *(uint4*)(sK + key2 * LDK + 64 + seg2 * 8) = xv_r;
    __syncthreads();
    if (kt + 1 < d.bt_hi) {
      kv_r = *(const uint4*)(d.k + (size_t)((kt + 1) * 64 + key) * d.ldk + seg * 8);
      vv_r = *(const uint4*)(d.vt + (size_t)key * d.ldv + (kt + 1) * 64 + seg * 8);
      if (DQK == 96 && tid < 256) xv_r = *(const uint4*)(d.kx + (size_t)((kt + 1) * 64 + key2) * 32 + seg2 * 8);
    }
    if (d.active && kt >= d.kt_lo && kt < d.kt_hi) {
      f32x4 s[4];
#pragma unroll
      for (int i = 0; i < 4; ++i) s[i] = (f32x4){0.f, 0.f, 0.f, 0.f};
#pragma unroll
      for (int ks = 0; ks < DQK / 32; ++ks)
#pragma unroll
        for (int nt = 0; nt < 4; ++nt) {
          bf16x8 b = *(const bf16x8*)(sK + (nt * 16 + l16) * LDK + ks * 32 + quad * 8);
          s[nt] = __builtin_amdgcn_mfma_f32_16x16x32_bf16(qf[ks], b, s[nt], 0, 0, 0);
        }
#pragma unroll
      for (int nt = 0; nt < 4; ++nt) {
        const bool valid = (kt * 64 + nt * 16 + l16) < d.nkeys;
#pragma unroll
        for (int r = 0; r < 4; ++r) s[nt][r] = valid ? s[nt][r] * d.scale : -1e30f;
      }
#pragma unroll
      for (int r = 0; r < 4; ++r) {
        float mx = fmaxf(fmaxf(s[0][r], s[1][r]), fmaxf(s[2][r], s[3][r]));
        mx = row16_max(mx);
        const float mnew = fmaxf(m[r], mx);
        const float alpha = __expf(m[r] - mnew);
        float p0 = __expf(s[0][r] - mnew), p1 = __expf(s[1][r] - mnew), p2 = __expf(s[2][r] - mnew), p3 = __expf(s[3][r] - mnew);
        float rs = p0 + p1 + p2 + p3;
        rs = row16_sum(rs);
        l[r] = l[r] * alpha + rs;
        m[r] = mnew;
#pragma unroll
        for (int dt = 0; dt < 4; ++dt) o[dt][r] *= alpha;
        bf16_t* pr = sPw + (quad * 4 + r) * 72 + l16;
        pr[0] = f2bf(p0); pr[16] = f2bf(p1); pr[32] = f2bf(p2); pr[48] = f2bf(p3);
      }
      asm volatile("s_waitcnt lgkmcnt(0)" ::: "memory");
#pragma unroll
      for (int ks = 0; ks < 2; ++ks) {
        bf16x8 a = *(const bf16x8*)(sPw + l16 * 72 + ks * 32 + quad * 8);
#pragma unroll
        for (int dt = 0; dt < 4; ++dt) {
          bf16x8 b = *(const bf16x8*)(sVt + (dt * 16 + l16) * 72 + ks * 32 + quad * 8);
          o[dt] = __builtin_amdgcn_mfma_f32_16x16x32_bf16(a, b, o[dt], 0, 0, 0);
        }
      }
      asm volatile("s_waitcnt lgkmcnt(0)" ::: "memory");
    }
  }
  if (d.active) {
#pragma unroll
    for (int r = 0; r < 4; ++r) {
      const float il = 1.f / l[r];
#pragma unroll
      for (int dt = 0; dt < 4; ++dt) d.out[(size_t)(quad * 4 + r) * d.ldo + dt * 16 + l16] = f2bf(o[dt][r] * il);
    }
  }
}

template <int MODE>
__device__ __forceinline__ void s5_item(int tid, float* sUw, const Params& p, int item) {
  const int lane = tid & 63;
  const bf16_t* proj = (const bf16_t*)(p.ws + OFF_PROJ);
  int b, chunk, g, tok0; bool isS;
  if (item < 32768) { isS = false; g = item & 31; chunk = (item >> 5) & 127; b = item >> 12; tok0 = b * 4096 + chunk * 32; }
  else { isS = true; int it = item - 32768; g = it & 31; b = it >> 5; chunk = 0; tok0 = T_P + b * 32; }
  const int n = lane;
  const int gn = g * 64 + n;
  const float lr = fminf(p.in[15][gn], -1e-4f), li = p.in[16][gn];
  const float dt = __expf(p.in[17][g]);
  const float mag = __expf(lr * dt);
  float sn, cs; sincos_rev(li * dt, sn, cs);
  const float abr = mag * cs, abi = mag * sn;
  const float den = lr * lr + li * li;
  const float nr = abr - 1.f, ni = abi;
  const float fre = (nr * lr + ni * li) / den, fim = (ni * lr - nr * li) / den;
  float bbr[16], bbi[16];
  {
    const float4* br4 = (const float4*)(p.in[18] + (size_t)gn * 16);
    const float4* bi4 = (const float4*)(p.in[19] + (size_t)gn * 16);
#pragma unroll
    for (int i = 0; i < 4; ++i) {
      float4 r4 = br4[i], i4 = bi4[i];
      bbr[4 * i + 0] = fre * r4.x - fim * i4.x; bbi[4 * i + 0] = fre * i4.x + fim * r4.x;
      bbr[4 * i + 1] = fre * r4.y - fim * i4.y; bbi[4 * i + 1] = fre * i4.y + fim * r4.y;
      bbr[4 * i + 2] = fre * r4.z - fim * i4.z; bbi[4 * i + 2] = fre * i4.z + fim * r4.z;
      bbr[4 * i + 3] = fre * r4.w - fim * i4.w; bbi[4 * i + 3] = fre * i4.w + fim * r4.w;
    }
  }
  {
    const int t = lane >> 1, c8 = (lane & 1) * 8;
    uint4 uv = *(const uint4*)(proj + (size_t)(tok0 + t) * 1280 + 768 + g * 16 + c8);
    float x[8]; unpack8(uv, x);
    *(float4*)(sUw + t * 16 + c8) = make_float4(x[0], x[1], x[2], x[3]);
    *(float4*)(sUw + t * 16 + c8 + 4) = make_float4(x[4], x[5], x[6], x[7]);
  }
  asm volatile("s_waitcnt lgkmcnt(0)" ::: "memory");
  float hr = 0.f, hi = 0.f;
  if (MODE == 0) {
#pragma unroll 4
    for (int t = 0; t < 32; ++t) {
      float uu[16];
#pragma unroll
      for (int i = 0; i < 4; ++i) { float4 v = *(const float4*)(sUw + t * 16 + 4 * i); uu[4 * i] = v.x; uu[4 * i + 1] = v.y; uu[4 * i + 2] = v.z; uu[4 * i + 3] = v.w; }
      float bur = 0.f, bui = 0.f;
#pragma unroll
      for (int c = 0; c < 16; ++c) { bur += bbr[c] * uu[c]; bui += bbi[c] * uu[c]; }
      const float nhr = abr * hr - abi * hi + bur, nhi = abr * hi + abi * hr + bui;
      hr = nhr; hi = nhi;
    }
    float* s1re = (float*)(p.ws + OFF_QMLA);
    float* s1im = s1re + 2097152;
    const size_t idx = ((size_t)(b * 128 + chunk) * 32 + g) * 64 + n;
    s1re[idx] = hr; s1im[idx] = hi;
    asm volatile("s_waitcnt lgkmcnt(0)" ::: "memory");
    return;
  } else {
    float cr[16], ci[16];
#pragma unroll
    for (int c = 0; c < 16; ++c) { cr[c] = p.in[20][(size_t)(g * 16 + c) * 64 + n]; ci[c] = p.in[21][(size_t)(g * 16 + c) * 64 + n]; }
    if (isS) { hr = p.in[4][(size_t)(b * 32 + g) * 64 + n]; hi = p.in[5][(size_t)(b * 32 + g) * 64 + n]; }
    else {
      const float* hinre = (const float*)(p.ws + OFF_QMLA) + 2 * 2097152;
      const float* hinim = hinre + 2097152;
      const size_t idx = ((size_t)(b * 128 + chunk) * 32 + g) * 64 + n;
      hr = hinre[idx]; hi = hinim[idx];
    }
    const int b0 = lane & 1, b1 = (lane >> 1) & 1, b2 = (lane >> 2) & 1, b3 = (lane >> 3) & 1;
    const int cc = b0 * 8 + b1 * 4 + b2 * 2 + b3;
    const int quad = lane >> 4;
    const float dsk = p.in[22][g * 16 + cc];
    bf16_t* zbuf = (bf16_t*)(p.ws + OFF_Z);
    float zkeep = 0.f;
#pragma unroll 2
    for (int t = 0; t < 32; ++t) {
      float uu[16];
#pragma unroll
      for (int i = 0; i < 4; ++i) { float4 v = *(const float4*)(sUw + t * 16 + 4 * i); uu[4 * i] = v.x; uu[4 * i + 1] = v.y; uu[4 * i + 2] = v.z; uu[4 * i + 3] = v.w; }
      float bur = 0.f, bui = 0.f;
#pragma unroll
      for (int c = 0; c < 16; ++c) { bur += bbr[c] * uu[c]; bui += bbi[c] * uu[c]; }
      const float nhr = abr * hr - abi * hi + bur, nhi = abr * hi + abi * hr + bui;
      hr = nhr; hi = nhi;
      float v16[16];
#pragma unroll
      for (int c = 0; c < 16; ++c) v16[c] = hr * cr[c] - hi * ci[c];
      float v8[8], v4[4], v2[2], v1;
#pragma unroll
      for (int i = 0; i < 8; ++i) { float keep = b0 ? v16[8 + i] : v16[i]; float send = b0 ? v16[i] : v16[8 + i]; v8[i] = keep + __shfl_xor(send, 1); }
#pragma unroll
      for (int i = 0; i < 4; ++i) { float keep = b1 ? v8[4 + i] : v8[i]; float send = b1 ? v8[i] : v8[4 + i]; v4[i] = keep + __shfl_xor(send, 2); }
#pragma unroll
      for (int i = 0; i < 2; ++i) { float keep = b2 ? v4[2 + i] : v4[i]; float send = b2 ? v4[i] : v4[2 + i]; v2[i] = keep + __shfl_xor(send, 4); }
      { float keep = b3 ? v2[1] : v2[0]; float send = b3 ? v2[0] : v2[1]; v1 = keep + __shfl_xor(send, 8); }
      v1 += __shfl_xor(v1, 16);
      v1 += __shfl_xor(v1, 32);
      const float y = v1 + dsk * sUw[t * 16 + cc];
      const float z = gelu_tanh(y);
      if (quad == (t & 3)) zkeep = z;
      if ((t & 3) == 3) zbuf[(size_t)(tok0 + t - 3 + quad) * 512 + g * 16 + cc] = f2bf(zkeep);
    }
    if (isS) {
      p.out[O_SSMRE_S + (size_t)(b * 32 + g) * 64 + n] = hr;
      p.out[O_SSMIM_S + (size_t)(b * 32 + g) * 64 + n] = hi;
    }
    asm volatile("s_waitcnt lgkmcnt(0)" ::: "memory");
  }
}

#define TAB_V_OFF 16777216ull
#define TAB_SU_OFF 33554432ull
#define TAB_SV_OFF (33554432ull + 65536ull)
__device__ __forceinline__ void quant_rows(const float* __restrict__ src, unsigned char* __restrict__ dst, float* __restrict__ scales, int gw, int nw, int tid) {
  const int lane = tid & 63;
  for (int row = gw; row < 16384; row += nw) {
    const float* r = src + (size_t)row * 1024 + lane * 16;
    float x[16];
#pragma unroll
    for (int i = 0; i < 4; ++i) { float4 v = *(const float4*)(r + 4 * i); x[4 * i] = v.x; x[4 * i + 1] = v.y; x[4 * i + 2] = v.z; x[4 * i + 3] = v.w; }
    float am = 0.f;
#pragma unroll
    for (int i = 0; i < 16; ++i) am = fmaxf(am, fabsf(x[i]));
#pragma unroll
    for (int o = 32; o; o >>= 1) am = fmaxf(am, __shfl_xor(am, o));
    const float inv = (am > 0.f) ? 127.f / am : 0.f;
    unsigned q[4];
#pragma unroll
    for (int i = 0; i < 4; ++i) {
      unsigned b0 = (unsigned)((int)rintf(x[4 * i] * inv)) & 255u, b1 = (unsigned)((int)rintf(x[4 * i + 1] * inv)) & 255u;
      unsigned b2 = (unsigned)((int)rintf(x[4 * i + 2] * inv)) & 255u, b3 = (unsigned)((int)rintf(x[4 * i + 3] * inv)) & 255u;
      q[i] = b0 | (b1 << 8) | (b2 << 16) | (b3 << 24);
    }
    *(uint4*)(dst + (size_t)row * 1024 + lane * 16) = make_uint4(q[0], q[1], q[2], q[3]);
    if (lane == 0) scales[row] = am * (1.f / 127.f);
  }
}

__device__ __forceinline__ float ub0(unsigned u) { return (float)(u & 0xffu); }
__device__ __forceinline__ float ub1(unsigned u) { return (float)((u >> 8) & 0xffu); }
__device__ __forceinline__ float ub2(unsigned u) { return (float)((u >> 16) & 0xffu); }
__device__ __forceinline__ float ub3(unsigned u) { return (float)(u >> 24); }
__device__ __forceinline__ float dot16(const float* xn, uint4 u) {
  float d = 0.f;
  d += xn[0] * ub0(u.x); d += xn[1] * ub1(u.x); d += xn[2] * ub2(u.x); d += xn[3] * ub3(u.x);
  d += xn[4] * ub0(u.y); d += xn[5] * ub1(u.y); d += xn[6] * ub2(u.y); d += xn[7] * ub3(u.y);
  d += xn[8] * ub0(u.z); d += xn[9] * ub1(u.z); d += xn[10] * ub2(u.z); d += xn[11] * ub3(u.z);
  d += xn[12] * ub0(u.w); d += xn[13] * ub1(u.w); d += xn[14] * ub2(u.w); d += xn[15] * ub3(u.w);
  return d;
}
__device__ __forceinline__ void axpy16(float* acc, float a, uint4 u) {
  acc[0] += a * ub0(u.x); acc[1] += a * ub1(u.x); acc[2] += a * ub2(u.x); acc[3] += a * ub3(u.x);
  acc[4] += a * ub0(u.y); acc[5] += a * ub1(u.y); acc[6] += a * ub2(u.y); acc[7] += a * ub3(u.y);
  acc[8] += a * ub0(u.z); acc[9] += a * ub1(u.z); acc[10] += a * ub2(u.z); acc[11] += a * ub3(u.z);
  acc[12] += a * ub0(u.w); acc[13] += a * ub1(u.w); acc[14] += a * ub2(u.w); acc[15] += a * ub3(u.w);
}

template <bool FINAL, bool DRY>
__device__ __forceinline__ void peer_token(int tid, const Params& p, int layer, int tok) {
  const int lane = tid & 63;
  float* xres = p.out + O_Y;
  const float* gain = p.in[10] + layer * 1024;
  const unsigned char* U = p.ws + OFF_TAB;
  const unsigned char* V = U + TAB_V_OFF;
  const int* ebuf = (const int*)(p.ws + OFF_M);
  const float* gbuf = (const float*)(p.ws + OFF_M + 17301504ull);
  const float* sus = (const float*)(p.ws + OFF_TAB + TAB_SU_OFF);
  const float* svs = (const float*)(p.ws + OFF_TAB + TAB_SV_OFF);
  float* xr = xres + (size_t)tok * 1024 + lane * 16;
  float x[16], xn[16], acc[16];
  float ss = 0.f, sx = 0.f;
#pragma unroll
  for (int i = 0; i < 4; ++i) {
    float4 v = *(const float4*)(xr + 4 * i);
    float4 g = *(const float4*)(gain + lane * 16 + 4 * i);
    x[4 * i] = v.x; x[4 * i + 1] = v.y; x[4 * i + 2] = v.z; x[4 * i + 3] = v.w;
    xn[4 * i] = v.x * g.x; xn[4 * i + 1] = v.y * g.y; xn[4 * i + 2] = v.z * g.z; xn[4 * i + 3] = v.w * g.w;
    ss += v.x * v.x + v.y * v.y + v.z * v.z + v.w * v.w;
    sx += xn[4 * i] + xn[4 * i + 1] + xn[4 * i + 2] + xn[4 * i + 3];
  }
  ss = wave_sum(ss);
  sx = wave_sum(sx);
  const float rstd = rsqrtf(ss * (1.f / 1024.f) + 1e-6f);
#pragma unroll
  for (int i = 0; i < 16; ++i) acc[i] = 0.f;
  float sumA = 0.f;
  const int b0 = lane & 1, b1 = (lane >> 1) & 1, b2 = (lane >> 2) & 1;
  const int pe = b0 * 4 + b1 * 2 + b2;
  const size_t pbase = (size_t)tok * 128 + pe;
#pragma unroll 1
  for (int kb = 0; kb < 16; ++kb) {
    const int myeid = ebuf[pbase + kb * 8];
    const float myg = gbuf[pbase + kb * 8] * svs[myeid];
    const float mysu = sus[myeid];
    uint4 uu[8], vv[8];
#pragma unroll
    for (int j = 0; j < 8; ++j) {
      const int src = ((j & 1) << 2) | (j & 2) | ((j >> 2) & 1);
      const int eid = __builtin_amdgcn_readlane(myeid, src);
      uu[j] = *(const uint4*)(U + (size_t)eid * 1024 + lane * 16);
      vv[j] = *(const uint4*)(V + (size_t)eid * 1024 + lane * 16);
    }
    float d[8];
#pragma unroll
    for (int j = 0; j < 8; ++j) d[j] = dot16(xn, uu[j]);
    float w4[4], w2[2], w1;
#pragma unroll
    for (int i = 0; i < 4; ++i) { float keep = b0 ? d[4 + i] : d[i]; float send = b0 ? d[i] : d[4 + i]; w4[i] = keep + __shfl_xor(send, 1); }
#pragma unroll
    for (int i = 0; i < 2; ++i) { float keep = b1 ? w4[2 + i] : w4[i]; float send = b1 ? w4[i] : w4[2 + i]; w2[i] = keep + __shfl_xor(send, 2); }
    { float keep = b2 ? w2[1] : w2[0]; float send = b2 ? w2[0] : w2[1]; w1 = keep + __shfl_xor(send, 4); }
    w1 += __shfl_xor(w1, 8); w1 += __shfl_xor(w1, 16); w1 += __shfl_xor(w1, 32);
    const float dot = rstd * mysu * (w1 - 128.f * sx);
    const float a = gelu_erf(dot) * myg;
#pragma unroll
    for (int j = 0; j < 8; ++j) {
      const int src = ((j & 1) << 2) | (j & 2) | ((j >> 2) & 1);
      const float A = __int_as_float(__builtin_amdgcn_readlane(__float_as_int(a), src));
      sumA += A;
      axpy16(acc, A, vv[j]);
    }
  }
  float y[16];
#pragma unroll
  for (int i = 0; i < 16; ++i) y[i] = x[i] + acc[i] - 128.f * sumA;
  if (FINAL) {
    float s2 = 0.f;
#pragma unroll
    for (int i = 0; i < 16; ++i) s2 += y[i] * y[i];
    s2 = wave_sum(s2);
    const float r2 = rsqrtf(s2 * (1.f / 1024.f) + 1e-6f);
    const float* gf = p.in[11] + lane * 16;
#pragma unroll
    for (int i = 0; i < 4; ++i) {
      float4 g = *(const float4*)(gf + 4 * i);
      y[4 * i] *= r2 * g.x; y[4 * i + 1] *= r2 * g.y; y[4 * i + 2] *= r2 * g.z; y[4 * i + 3] *= r2 * g.w;
    }
  }
  if (DRY && ss != -1.f) return;
#pragma unroll
  for (int i = 0; i < 4; ++i) *(float4*)(xr + 4 * i) = make_float4(y[4 * i], y[4 * i + 1], y[4 * i + 2], y[4 * i + 3]);
}

#define OFF_PD OFF_MIX
#define OFF_PSS OFF_KP
#define OFF_PSX (OFF_KP + 1081344ull)
template <int CTRL> __device__ __forceinline__ int dpp_i(int v) { return __builtin_amdgcn_update_dpp(0, v, CTRL, 0xf, 0xf, true); }
__device__ __forceinline__ unsigned packq4(float a, float b, float c, float d, float inv) {
  const unsigned q0 = (unsigned)((int)rintf(a * inv)) & 255u, q1 = (unsigned)((int)rintf(b * inv)) & 255u;
  const unsigned q2 = (unsigned)((int)rintf(c * inv)) & 255u, q3 = (unsigned)((int)rintf(d * inv));
  return q0 | (q1 << 8) | (q2 << 16) | (q3 << 24);
}
__device__ __forceinline__ void peer9a_token(int tid, const Params& p, int layer, int tok, int j) {
  const int lane = tid & 63, g8 = lane >> 3, sub = lane & 7;
  const float* xr = p.out + O_Y + (size_t)tok * 1024 + j * 128 + sub * 16;
  const float* gn = p.in[10] + layer * 1024 + j * 128 + sub * 16;
  const unsigned char* U = p.ws + OFF_TAB + j * 128 + sub * 16;
  const int* eb = (const int*)(p.ws + OFF_M) + (size_t)tok * 128 + g8;
  float* pd = (float*)(p.ws + OFF_PD) + ((size_t)tok * 8 + j) * 128;
  int eid[16];
#pragma unroll
  for (int k = 0; k < 16; ++k) eid[k] = eb[k * 8];
  float xs[16];
  float ss = 0.f, am = 0.f;
#pragma unroll
  for (int i = 0; i < 4; ++i) {
    float4 v = *(const float4*)(xr + 4 * i);
    float4 g = *(const float4*)(gn + 4 * i);
    xs[4 * i] = v.x * g.x; xs[4 * i + 1] = v.y * g.y; xs[4 * i + 2] = v.z * g.z; xs[4 * i + 3] = v.w * g.w;
    ss += v.x * v.x + v.y * v.y + v.z * v.z + v.w * v.w;
    am = fmaxf(fmaxf(am, fmaxf(fabsf(xs[4 * i]), fabsf(xs[4 * i + 1]))), fmaxf(fabsf(xs[4 * i + 2]), fabsf(xs[4 * i + 3])));
  }
  uint4 rows[16];
#pragma unroll
  for (int k = 0; k < 16; ++k) rows[k] = *(const uint4*)(U + (size_t)eid[k] * 1024);
  am = fmaxf(am, dpp_f<0xB1>(am)); am = fmaxf(am, dpp_f<0x4E>(am)); am = fmaxf(am, dpp_f<0x141>(am));
  const float inv = (am > 0.f) ? 127.f / am : 0.f;
  const float xscale = am * (1.f / 127.f);
  int xq[4];
#pragma unroll
  for (int d = 0; d < 4; ++d) xq[d] = (int)packq4(xs[4 * d], xs[4 * d + 1], xs[4 * d + 2], xs[4 * d + 3], inv);
  int keep0 = 0, keep1 = 0;
#pragma unroll
  for (int k = 0; k < 16; ++k) {
    int D = __builtin_amdgcn_sdot4((int)rows[k].x, xq[0], 0, false);
    D = __builtin_amdgcn_sdot4((int)rows[k].y, xq[1], D, false);
    D = __builtin_amdgcn_sdot4((int)rows[k].z, xq[2], D, false);
    D = __builtin_amdgcn_sdot4((int)rows[k].w, xq[3], D, false);
    D += dpp_i<0xB1>(D); D += dpp_i<0x4E>(D); D += dpp_i<0x141>(D);
    if (k < 8) keep0 = (sub == k) ? D : keep0; else keep1 = (sub == k - 8) ? D : keep1;
  }
  pd[sub * 8 + g8] = (float)keep0 * xscale;
  pd[64 + sub * 8 + g8] = (float)keep1 * xscale;
  ss += dpp_f<0xB1>(ss); ss += dpp_f<0x4E>(ss); ss += dpp_f<0x141>(ss);
  if (lane == 0) ((float*)(p.ws + OFF_PSS))[(size_t)tok * 8 + j] = ss;
}

__device__ __forceinline__ void peer9m_token(int tid, unsigned char* smem, const Params& p, int tok) {
  const int lane = tid & 63, w = __builtin_amdgcn_readfirstlane(tid >> 6);
  unsigned char* sAq = smem + w * 128;
  const float* pd = (const float*)(p.ws + OFF_PD) + (size_t)tok * 1024;
  float* pss = (float*)(p.ws + OFF_PSS) + (size_t)tok * 8;
  const int* ebuf = (const int*)(p.ws + OFF_M) + (size_t)tok * 128;
  float* gbuf = (float*)(p.ws + OFF_M + 17301504ull) + (size_t)tok * 128;
  const float* sus = (const float*)(p.ws + OFF_TAB + TAB_SU_OFF);
  const float* svs = (const float*)(p.ws + OFF_TAB + TAB_SV_OFF);
  float ss = 0.f, d0 = 0.f, d1 = 0.f;
#pragma unroll
  for (int j = 0; j < 8; ++j) { ss += pss[j]; d0 += pd[j * 128 + lane]; d1 += pd[j * 128 + 64 + lane]; }
  const int e0 = ebuf[lane], e1 = ebuf[64 + lane];
  const float rstd = rsqrtf(ss * (1.f / 1024.f) + 1e-6f);
  const float a0 = gelu_erf(rstd * sus[e0] * d0) * gbuf[lane] * svs[e0];
  const float a1 = gelu_erf(rstd * sus[e1] * d1) * gbuf[64 + lane] * svs[e1];
  float am = row16_max(fmaxf(fabsf(a0), fabsf(a1)));
  {
    const float m0 = __int_as_float(__builtin_amdgcn_readlane(__float_as_int(am), 0)), m1 = __int_as_float(__builtin_amdgcn_readlane(__float_as_int(am), 16));
    const float m2 = __int_as_float(__builtin_amdgcn_readlane(__float_as_int(am), 32)), m3 = __int_as_float(__builtin_amdgcn_readlane(__float_as_int(am), 48));
    am = fmaxf(fmaxf(m0, m1), fmaxf(m2, m3));
  }
  const float inv = (am > 0.f) ? 127.f / am : 0.f;
  const int addr0 = (lane & 7) * 16 + (lane >> 3);
  sAq[addr0] = (unsigned char)((int)rintf(a0 * inv) & 255);
  sAq[addr0 + 8] = (unsigned char)((int)rintf(a1 * inv) & 255);
  asm volatile("s_waitcnt lgkmcnt(0)" ::: "memory");
  unsigned pk = 0u;
  if (lane < 32) pk = ((const unsigned*)sAq)[lane];
  asm volatile("s_waitcnt vmcnt(0) lgkmcnt(0)" ::: "memory");
  if (lane < 32) ((unsigned*)gbuf)[lane] = pk;
  if (lane == 0) pss[0] = am * (1.f / 127.f);
  asm volatile("s_waitcnt lgkmcnt(0)" ::: "memory");
}

__device__ __forceinline__ void peer9b_token(int tid, const Params& p, int tok, int j) {
  const int lane = tid & 63, g8 = lane >> 3, sub = lane & 7;
  float* xr = p.out + O_Y + (size_t)tok * 1024 + j * 128 + sub * 16;
  const unsigned char* V = p.ws + OFF_TAB + TAB_V_OFF + j * 128 + sub * 16;
  const int* eb = (const int*)(p.ws + OFF_M) + (size_t)tok * 128 + g8;
  const uint4 apk = *(const uint4*)((const unsigned*)(p.ws + OFF_M + 17301504ull) + (size_t)tok * 128 + g8 * 4);
  const float scaleA = ((const float*)(p.ws + OFF_PSS))[(size_t)tok * 8];
  int eid[16];
#pragma unroll
  for (int k = 0; k < 16; ++k) eid[k] = eb[k * 8];
  uint4 rows[16];
#pragma unroll
  for (int k = 0; k < 16; ++k) rows[k] = *(const uint4*)(V + (size_t)eid[k] * 1024);
  int acci[16];
#pragma unroll
  for (int i = 0; i < 16; ++i) acci[i] = 0;
#define P9B_DW(DWF, DW, AP, KQ) { \
    const unsigned r0 = rows[(KQ) * 4 + 0].DWF, r1 = rows[(KQ) * 4 + 1].DWF, r2 = rows[(KQ) * 4 + 2].DWF, r3 = rows[(KQ) * 4 + 3].DWF; \
    const unsigned t0 = __builtin_amdgcn_perm(r1, r0, 0x05010400u), t1 = __builtin_amdgcn_perm(r1, r0, 0x07030602u); \
    const unsigned t2 = __builtin_amdgcn_perm(r3, r2, 0x05010400u), t3 = __builtin_amdgcn_perm(r3, r2, 0x07030602u); \
    acci[(DW) * 4 + 0] = __builtin_amdgcn_sdot4((int)__builtin_amdgcn_perm(t2, t0, 0x05040100u), (int)(AP), acci[(DW) * 4 + 0], false); \
    acci[(DW) * 4 + 1] = __builtin_amdgcn_sdot4((int)__builtin_amdgcn_perm(t2, t0, 0x07060302u), (int)(AP), acci[(DW) * 4 + 1], false); \
    acci[(DW) * 4 + 2] = __builtin_amdgcn_sdot4((int)__builtin_amdgcn_perm(t3, t1, 0x05040100u), (int)(AP), acci[(DW) * 4 + 2], false); \
    acci[(DW) * 4 + 3] = __builtin_amdgcn_sdot4((int)__builtin_amdgcn_perm(t3, t1, 0x07060302u), (int)(AP), acci[(DW) * 4 + 3], false); }
#define P9B_KQ(AP, KQ) { P9B_DW(x, 0, AP, KQ) P9B_DW(y, 1, AP, KQ) P9B_DW(z, 2, AP, KQ) P9B_DW(w, 3, AP, KQ) }
  P9B_KQ(apk.x, 0) P9B_KQ(apk.y, 1) P9B_KQ(apk.z, 2) P9B_KQ(apk.w, 3)
  float acc[16];
#pragma unroll
  for (int i = 0; i < 16; ++i) acc[i] = (float)acci[i] * scaleA;
  const int b3 = (lane >> 3) & 1, b4 = (lane >> 4) & 1, b5 = (lane >> 5) & 1;
  float v8[8], v4[4], v2[2];
#pragma unroll
  for (int i = 0; i < 8; ++i) { float keep = b3 ? acc[8 + i] : acc[i]; float send = b3 ? acc[i] : acc[8 + i]; v8[i] = keep + dpp_f<0x128>(send); }
#pragma unroll
  for (int i = 0; i < 4; ++i) { float keep = b4 ? v8[4 + i] : v8[i]; float send = b4 ? v8[i] : v8[4 + i]; v4[i] = keep + __shfl_xor(send, 16); }
#pragma unroll
  for (int i = 0; i < 2; ++i) { float keep = b5 ? v4[2 + i] : v4[i]; float send = b5 ? v4[i] : v4[2 + i]; v2[i] = keep + __shfl_xor(send, 32); }
  const int c = b3 * 8 + b4 * 4 + b5 * 2;
  float2 xv = *(const float2*)(xr + c);
  xv.x += v2[0];
  xv.y += v2[1];
  *(float2*)(xr + c) = xv;
}

__device__ __forceinline__ void final_norm_token(int tid, const Params& p, int tok) {
  const int lane = tid & 63;
  float* xr = p.out + O_Y + (size_t)tok * 1024 + lane * 16;
  const float* gf = p.in[11] + lane * 16;
  float y[16]; float s2 = 0.f;
#pragma unroll
  for (int i = 0; i < 4; ++i) { float4 v = *(const float4*)(xr + 4 * i); y[4 * i] = v.x; y[4 * i + 1] = v.y; y[4 * i + 2] = v.z; y[4 * i + 3] = v.w; s2 += v.x * v.x + v.y * v.y + v.z * v.z + v.w * v.w; }
  s2 = wave_sum(s2);
  const float r2 = rsqrtf(s2 * (1.f / 1024.f) + 1e-6f);
#pragma unroll
  for (int i = 0; i < 4; ++i) {
    float4 g = *(const float4*)(gf + 4 * i);
    *(float4*)(xr + 4 * i) = make_float4(y[4 * i] * r2 * g.x, y[4 * i + 1] * r2 * g.y, y[4 * i + 2] * r2 * g.z, y[4 * i + 3] * r2 * g.w);
  }
}

__device__ __forceinline__ unsigned f2ukey(float v) { unsigned u = __float_as_uint(v); return (u & 0x80000000u) ? ~u : (u | 0x80000000u); }
__device__ __forceinline__ float ukey2f(unsigned k) { unsigned u = (k & 0x80000000u) ? (k & 0x7fffffffu) : ~k; return __uint_as_float(u); }
__device__ __forceinline__ int popc64(unsigned long long m) { return __builtin_popcountll(m); }
__device__ __forceinline__ int mbcnt64(unsigned long long m) { return (int)__builtin_amdgcn_mbcnt_hi((unsigned)(m >> 32), __builtin_amdgcn_mbcnt_lo((unsigned)m, 0u)); }

struct TopkFrags { bf16x8 a[2][2]; bf16x8 b[2][2]; };
__device__ __forceinline__ void topk_load(TopkFrags& f, int tid, const Params& p, int layer, int item) {
  const int lane = tid & 63, w = __builtin_amdgcn_readfirstlane(tid >> 6);
  const int l16 = lane & 15, quad = lane >> 4;
  const int h = item & 7, tok0 = (item >> 3) * 32;
  const int pp = w >> 2;
  const bf16_t* qb = (const bf16_t*)(p.ws + OFF_QBUF);
  const bf16_t* keys = (const bf16_t*)(p.ws + OFF_WT) + WT_KEYS + (size_t)((layer * 8 + h) * 2 + pp) * 8192;
#pragma unroll
  for (int ks = 0; ks < 2; ++ks) {
#pragma unroll
    for (int mt = 0; mt < 2; ++mt) f.a[ks][mt] = *(const bf16x8*)(qb + (size_t)(tok0 + mt * 16 + l16) * 1024 + h * 128 + pp * 64 + ks * 32 + quad * 8);
#pragma unroll
    for (int j = 0; j < 2; ++j) {
      const int nt = (w & 3) * 2 + j;
      f.b[ks][j] = *(const bf16x8*)(keys + (nt * 16 + l16) * 64 + ks * 32 + quad * 8);
    }
  }
}

__device__ __forceinline__ void peer_topk_item(int tid, unsigned char* smem, const Params& p, const TopkFrags& f, int item) {
  unsigned* sS = (unsigned*)smem;
  const int lane = tid & 63, w = __builtin_amdgcn_readfirstlane(tid >> 6);
  const int l16 = lane & 15, quad = lane >> 4;
  const int h = item & 7, tile = item >> 3;
  const int tok0 = tile * 32;
  unsigned* wtop = (unsigned*)(smem + 32768) + w * 256;
  float* wexp = (float*)(wtop + 128);
  __syncthreads();
  {
    const int pp = w >> 2;
    f32x4 acc[2][2];
#pragma unroll
    for (int i = 0; i < 2; ++i)
#pragma unroll
      for (int j = 0; j < 2; ++j) acc[i][j] = (f32x4){0.f, 0.f, 0.f, 0.f};
#pragma unroll
    for (int ks = 0; ks < 2; ++ks)
#pragma unroll
      for (int mt = 0; mt < 2; ++mt)
#pragma unroll
        for (int j = 0; j < 2; ++j) acc[mt][j] = __builtin_amdgcn_mfma_f32_16x16x32_bf16(f.a[ks][mt], f.b[ks][j], acc[mt][j], 0, 0, 0);
#pragma unroll
    for (int mt = 0; mt < 2; ++mt)
#pragma unroll
      for (int j = 0; j < 2; ++j) {
        const int nt = (w & 3) * 2 + j;
#pragma unroll
        for (int r = 0; r < 4; ++r) {
          const int key = nt * 16 + l16;
          sS[((mt * 16 + quad * 4 + r) * 2 + pp) * 128 + key] = (f2ukey(acc[mt][j][r]) & ~127u) | (unsigned)(127 - key);
        }
      }
  }
  __syncthreads();
  int* ebuf = (int*)(p.ws + OFF_M);
  float* gbuf = (float*)(p.ws + OFF_M + 17301504ull);
  unsigned k0[8], k1[8], T[8];
#pragma unroll
  for (int c = 0; c < 8; ++c) {
    const unsigned* row = sS + ((w * 4 + (c >> 1)) * 2 + (c & 1)) * 128;
    k0[c] = row[lane]; k1[c] = row[64 + lane]; T[c] = 0u;
  }
#pragma unroll 1
  for (int bit = 31; bit >= 7; --bit) {
    const unsigned bm = 1u << bit;
#pragma unroll
    for (int c = 0; c < 8; ++c) {
      const unsigned cand = T[c] | bm;
      const int cnt = popc64(__builtin_amdgcn_ballot_w64(k0[c] >= cand)) + popc64(__builtin_amdgcn_ballot_w64(k1[c] >= cand));
      T[c] = (cnt >= 16) ? cand : T[c];
    }
  }
  {
    bool need = false;
#pragma unroll
    for (int c = 0; c < 8; ++c) {
      const int cnt = popc64(__builtin_amdgcn_ballot_w64(k0[c] >= T[c])) + popc64(__builtin_amdgcn_ballot_w64(k1[c] >= T[c]));
      need = need || (cnt > 16);
    }
    if (need) {
#pragma unroll 1
      for (int bit = 6; bit >= 0; --bit) {
        const unsigned bm = 1u << bit;
#pragma unroll
        for (int c = 0; c < 8; ++c) {
          const unsigned cand = T[c] | bm;
          const int cnt = popc64(__builtin_amdgcn_ballot_w64(k0[c] >= cand)) + popc64(__builtin_amdgcn_ballot_w64(k1[c] >= cand));
          T[c] = (cnt >= 16) ? cand : T[c];
        }
      }
    }
  }
#pragma unroll
  for (int c = 0; c < 8; ++c) {
    const unsigned long long m0 = __builtin_amdgcn_ballot_w64(k0[c] >= T[c]);
    const unsigned long long m1 = __builtin_amdgcn_ballot_w64(k1[c] >= T[c]);
    const int s0 = mbcnt64(m0), s1 = popc64(m0) + mbcnt64(m1);
    if (k0[c] >= T[c]) wtop[c * 16 + s0] = k0[c];
    if (k1[c] >= T[c]) wtop[c * 16 + s1] = k1[c];
  }
  asm volatile("s_waitcnt lgkmcnt(0)" ::: "memory");
  float cs[4][4];
  unsigned ck[4][4], T2[4], ka[4];
  uint4 kb4[4];
#pragma unroll
  for (int t = 0; t < 4; ++t) {
    ka[t] = wtop[(t * 2) * 16 + (lane >> 2)];
    kb4[t] = *(const uint4*)(wtop + (t * 2 + 1) * 16 + (lane & 3) * 4);
    const float a = ukey2f(ka[t]);
    cs[t][0] = a + ukey2f(kb4[t].x); cs[t][1] = a + ukey2f(kb4[t].y); cs[t][2] = a + ukey2f(kb4[t].z); cs[t][3] = a + ukey2f(kb4[t].w);
#pragma unroll
    for (int jj = 0; jj < 4; ++jj) ck[t][jj] = (f2ukey(cs[t][jj]) & ~255u) | (unsigned)(255 - (lane * 4 + jj));
    T2[t] = 0u;
  }
#pragma unroll 1
  for (int bit = 31; bit >= 8; --bit) {
    const unsigned bm = 1u << bit;
#pragma unroll
    for (int t = 0; t < 4; ++t) {
      const unsigned cand = T2[t] | bm;
      int cnt = 0;
#pragma unroll
      for (int jj = 0; jj < 4; ++jj) cnt += popc64(__builtin_amdgcn_ballot_w64(ck[t][jj] >= cand));
      T2[t] = (cnt >= 16) ? cand : T2[t];
    }
  }
  {
    bool need = false;
#pragma unroll
    for (int t = 0; t < 4; ++t) {
      int cnt = 0;
#pragma unroll
      for (int jj = 0; jj < 4; ++jj) cnt += popc64(__builtin_amdgcn_ballot_w64(ck[t][jj] >= T2[t]));
      need = need || (cnt > 16);
    }
    if (need) {
#pragma unroll 1
      for (int bit = 7; bit >= 0; --bit) {
        const unsigned bm = 1u << bit;
#pragma unroll
        for (int t = 0; t < 4; ++t) {
          const unsigned cand = T2[t] | bm;
          int cnt = 0;
#pragma unroll
          for (int jj = 0; jj < 4; ++jj) cnt += popc64(__builtin_amdgcn_ballot_w64(ck[t][jj] >= cand));
          T2[t] = (cnt >= 16) ? cand : T2[t];
        }
      }
    }
  }
  int* weid = (int*)(wexp + 64);
#pragma unroll
  for (int t = 0; t < 4; ++t) {
    const float cT = ukey2f(T2[t]);
    const int i1 = 127 - (int)(ka[t] & 127u);
    const unsigned kbv[4] = {kb4[t].x, kb4[t].y, kb4[t].z, kb4[t].w};
    int base = 0;
#pragma unroll
    for (int jj = 0; jj < 4; ++jj) {
      const bool win = ck[t][jj] >= T2[t];
      const unsigned long long m = __builtin_amdgcn_ballot_w64(win);
      const int sl = base + mbcnt64(m);
      base += popc64(m);
      if (win) {
        wexp[t * 16 + sl] = __expf(fminf(cs[t][jj] - cT, 60.f));
        weid[t * 16 + sl] = i1 * 128 + (127 - (int)(kbv[jj] & 127u));
      }
    }
  }
  asm volatile("s_waitcnt lgkmcnt(0)" ::: "memory");
  {
    const int t = lane >> 4, sl = lane & 15;
    float es = 0.f;
#pragma unroll
    for (int q = 0; q < 4; ++q) { const float4 ee = *(const float4*)(wexp + t * 16 + q * 4); es += ee.x + ee.y + ee.z + ee.w; }
    const float e = wexp[t * 16 + sl];
    const int id = weid[t * 16 + sl];
    const size_t o = (size_t)(tok0 + w * 4 + t) * 128 + h * 16 + sl;
    ebuf[o] = id;
    gbuf[o] = e / es;
  }
  asm volatile("s_waitcnt lgkmcnt(0)" ::: "memory");
}

struct EpiStoreBf16 { bf16_t* dst; int ld; __device__ void operator()(int r, int c, float v) const { dst[(size_t)r * ld + c] = f2bf(v); } };
struct EpiGlu { const bf16_t* z; const float* bias; bf16_t* mix; __device__ void operator()(int r, int c, float v) const {
  float zz = bf2f(z[(size_t)r * 512 + c]); float s = v + bias[c]; mix[(size_t)r * 1024 + 512 + c] = f2bf(zz / (1.f + __expf(-s))); } };
struct EpiRes0 { const float* xp; const float* xs; float* xres; __device__ void operator()(int r, int c, float v) const {
  float x = (r < T_P) ? xp[(size_t)r * 1024 + c] : xs[(size_t)(r - T_P) * 1024 + c]; xres[(size_t)r * 1024 + c] = x + v; } };
struct EpiRes1 { float* xres; __device__ void operator()(int r, int c, float v) const { xres[(size_t)r * 1024 + c] += v; } };
struct EpiPool { bf16_t* mix; const float* scale; int g; __device__ void operator()(int r, int c, float v) const {
  mix[(size_t)r * 1024 + g * 128 + c] = f2bf(v * scale[g * 128 + c]); } };
struct EpiKup { bf16_t* dst; int rowsPerB; int keyOff; int bStride; __device__ void operator()(int r, int c, float v) const {
  int b = r / rowsPerB, key = r % rowsPerB + keyOff; dst[((size_t)b * bStride + key) * 512 + c] = f2bf(v); } };
struct EpiVt { bf16_t* dst; int rowsPerB; int keyOff; int ldv; __device__ void operator()(int r, int c, float v) const {
  int b = r / rowsPerB, key = r % rowsPerB + keyOff; dst[((size_t)(b * 8 + (c >> 6)) * 64 + (c & 63)) * ldv + key] = f2bf(v); } };


typedef const Params __attribute__((address_space(4))) KParams;

constexpr size_t OFF_BAR = WS_NEED;
__device__ __forceinline__ void grid_barrier(unsigned* ctr, unsigned target) {
  asm volatile("s_waitcnt vmcnt(0)" ::: "memory");
  __syncthreads();
  if (threadIdx.x == 0) {
    __builtin_amdgcn_fence(__ATOMIC_RELEASE, "agent");
    asm volatile("s_waitcnt vmcnt(0)" ::: "memory");
    __hip_atomic_fetch_add(ctr, 1u, __ATOMIC_RELAXED, __HIP_MEMORY_SCOPE_AGENT);
    unsigned spins = 0;
    while (__hip_atomic_load(ctr, __ATOMIC_RELAXED, __HIP_MEMORY_SCOPE_AGENT) < target) {
      __builtin_amdgcn_s_sleep(1);
      if (++spins > (1u << 27)) break;
    }
    __builtin_amdgcn_fence(__ATOMIC_ACQUIRE, "agent");
    asm volatile("s_waitcnt vmcnt(0)" ::: "memory");
  }
  __syncthreads();
}
#define GRID_BAR() { unsigned* ctr_ = (unsigned*)(((KParams*)__builtin_amdgcn_kernarg_segment_ptr())->ws + OFF_BAR); bar_k += 1; grid_barrier(ctr_, (unsigned)bar_k * gridDim.x); }
#define PHASE_BEGIN \
  Params p; \
  { KParams* kp_ = (KParams*)__builtin_amdgcn_kernarg_segment_ptr(); asm volatile("" : "+s"(kp_)); \
    _Pragma("unroll") for (int i_ = 0; i_ < 38; ++i_) p.in[i_] = kp_->in[i_]; \
    p.out = kp_->out; p.ws = kp_->ws; } \
  int tid = threadIdx.x; asm volatile("" : "+v"(tid)); \
  const int lane = tid & 63, w = __builtin_amdgcn_readfirstlane(tid >> 6); \
  const int gw = blockIdx.x * 8 + w, nw = gridDim.x * 8; \
  const size_t gtid = (size_t)blockIdx.x * NT + tid, gthreads = (size_t)gridDim.x * NT; \
  bf16_t* wt = (bf16_t*)(p.ws + OFF_WT); \
  bf16_t* proj = (bf16_t*)(p.ws + OFF_PROJ); \
  bf16_t* mix = (bf16_t*)(p.ws + OFF_MIX); \
  bf16_t* qbuf = (bf16_t*)(p.ws + OFF_QBUF); \
  bf16_t* zbuf = (bf16_t*)(p.ws + OFF_Z); \
  float* xres = p.out + O_Y; \
  (void)lane; (void)gw; (void)nw; (void)gtid; (void)gthreads; (void)wt; (void)proj; (void)mix; (void)qbuf; (void)zbuf; (void)xres;

template <int LAYER>
__device__ __forceinline__ void peer_phases(int& bar_k, unsigned char* smem) {
  const int layer = LAYER;
    for (int rep_ = 0; rep_ < NREP(7); ++rep_)
    {
    PHASE_BEGIN
      int vb = 0;
      gemm_run<2>(tid, smem, xres, xres, T_TOT, 1024, p.in[10] + layer * 1024, wt + WT_PQ + (size_t)layer * 1048576, T_TOT, 1024, 1024, vb, EpiStoreBf16{qbuf, 1024});
    }
    GRID_BAR();
    for (int rep_ = 0; rep_ < NREP(8); ++rep_) {
    PHASE_BEGIN
    {
      TopkFrags fr;
      int item = blockIdx.x;
      if (item < 1056 * 8) topk_load(fr, tid, p, layer, item);
      for (; item < 1056 * 8; item += gridDim.x) {
        TopkFrags cur = fr;
        const int nxt = item + gridDim.x;
        if (nxt < 1056 * 8) topk_load(fr, tid, p, layer, nxt);
        peer_topk_item(tid, smem, p, cur, item);
      }
    }
    }
    GRID_BAR();
    for (int rep_ = 0; rep_ < NREP(9); ++rep_) {
    PHASE_BEGIN
      int j = blockIdx.x & 7, lb = blockIdx.x >> 3, nb = ((int)gridDim.x - j + 7) >> 3;
      {
        unsigned* cnt_ = (unsigned*)(p.ws + OFF_BAR) + 16;
        bool ok_ = true;
#pragma unroll
        for (int x_ = 0; x_ < 16; ++x_) {
          const unsigned c_ = __hip_atomic_load(&cnt_[x_], __ATOMIC_RELAXED, __HIP_MEMORY_SCOPE_AGENT);
          ok_ = ok_ && ((x_ < 8) ? (c_ > 0u) : (c_ == 0u));
        }
        if (ok_) {
          j = ((const int*)(smem + 45040))[0]; lb = ((const int*)(smem + 45040))[1];
          nb = (int)__hip_atomic_load(&cnt_[j], __ATOMIC_RELAXED, __HIP_MEMORY_SCOPE_AGENT);
        }
      }
      for (int tok = lb * 8 + w; tok < T_TOT; tok += nb * 8) peer9a_token(tid, p, layer, tok, j);
    }
    GRID_BAR();
    for (int rep_ = 0; rep_ < NREP(9); ++rep_) {
    PHASE_BEGIN
      for (int tok = gw; tok < T_TOT; tok += nw) peer9m_token(tid, smem, p, tok);
    }
    GRID_BAR();
    for (int rep_ = 0; rep_ < NREP(9); ++rep_) {
    PHASE_BEGIN
      int j = blockIdx.x & 7, lb = blockIdx.x >> 3, nb = ((int)gridDim.x - j + 7) >> 3;
      {
        unsigned* cnt_ = (unsigned*)(p.ws + OFF_BAR) + 16;
        bool ok_ = true;
#pragma unroll
        for (int x_ = 0; x_ < 16; ++x_) {
          const unsigned c_ = __hip_atomic_load(&cnt_[x_], __ATOMIC_RELAXED, __HIP_MEMORY_SCOPE_AGENT);
          ok_ = ok_ && ((x_ < 8) ? (c_ > 0u) : (c_ == 0u));
        }
        if (ok_) {
          j = ((const int*)(smem + 45040))[0]; lb = ((const int*)(smem + 45040))[1];
          nb = (int)__hip_atomic_load(&cnt_[j], __ATOMIC_RELAXED, __HIP_MEMORY_SCOPE_AGENT);
        }
      }
      for (int tok = lb * 8 + w; tok < T_TOT; tok += nb * 8) peer9b_token(tid, p, tok, j);
    }
    if (layer == 1) {
      GRID_BAR();
      for (int rep_ = 0; rep_ < NREP(9); ++rep_) {
      PHASE_BEGIN
        for (int tok = gw; tok < T_TOT; tok += nw) final_norm_token(tid, p, tok);
      }
    }
}

__global__ void __launch_bounds__(NT) mega(Params kparams_) {
  cg::grid_group grid = cg::this_grid();
  int bar_k = 0;
  __shared__ __attribute__((aligned(16))) unsigned char smem[45056];
  if (threadIdx.x == 0) {
    unsigned* cnt_ = (unsigned*)(((KParams*)__builtin_amdgcn_kernarg_segment_ptr())->ws + OFF_BAR) + 16;
    const unsigned xcc_ = (unsigned)__builtin_amdgcn_s_getreg((3 << 11) | 20) & 0xFu;
    const unsigned rank_ = __hip_atomic_fetch_add(&cnt_[xcc_], 1u, __ATOMIC_RELAXED, __HIP_MEMORY_SCOPE_AGENT);
    ((int*)(smem + 45040))[0] = (int)xcc_;
    ((int*)(smem + 45040))[1] = (int)rank_;
  }

  for (int rep_ = 0; rep_ < NREP(0); ++rep_)
  {
    PHASE_BEGIN
    int vb = 0;
    transpose_convert(tid, smem, p.in[12], wt + WT_IN_E, 1024, 1280, vb);
    transpose_convert(tid, smem, p.in[13], wt + WT_OUT_E, 1024, 1024, vb);
    transpose_convert(tid, smem, p.in[23], wt + WT_GLU, 512, 512, vb);
    transpose_convert(tid, smem, p.in[25], wt + WT_IN_O, 1024, 1312, vb);
    transpose_convert(tid, smem, p.in[26], wt + WT_OUT_O, 1024, 1024, vb);
    for (int g = 0; g < 4; ++g) transpose_convert(tid, smem, p.in[27] + g * 16384, wt + WT_POOL + g * 16384, 128, 128, vb);
    transpose_convert(tid, smem, p.in[31], wt + WT_UQ, 512, 768, vb);
    transpose_convert(tid, smem, p.in[32], wt + WT_UK, 256, 512, vb);
    transpose_convert(tid, smem, p.in[33], wt + WT_UV, 256, 512, vb);
    transpose_convert(tid, smem, p.in[34], wt + WT_PQ, 1024, 1024, vb);
    transpose_convert(tid, smem, p.in[34] + 1048576, wt + WT_PQ + 1048576, 1024, 1024, vb);
    convert_plain(tid, p.in[35], wt + WT_KEYS, 262144);
    quant_rows(p.in[36], p.ws + OFF_TAB, (float*)(p.ws + OFF_TAB + TAB_SU_OFF), gw, nw, tid);
    quant_rows(p.in[37], p.ws + OFF_TAB + TAB_V_OFF, (float*)(p.ws + OFF_TAB + TAB_SV_OFF), gw, nw, tid);
  }
  grid.sync();

  for (int rep_ = 0; rep_ < NREP(1); ++rep_)
  {
    PHASE_BEGIN
    int vb = 0;
    gemm_run<2>(tid, smem, p.in[0], p.in[1], T_P, 1024, p.in[9], wt + WT_IN_E, T_TOT, 1280, 1024, vb, EpiStoreBf16{proj, 1280});
  }
  GRID_BAR();

  for (int rep_ = 0; rep_ < NREP(2); ++rep_)
  {
    PHASE_BEGIN
    bf16_t* vt0 = (bf16_t*)(p.ws + OFF_VT0);
    bf16_t* kall = (bf16_t*)(p.ws + OFF_KALL);
    bf16_t* vtall = (bf16_t*)(p.ws + OFF_VTALL);
    for (int tok = gw; tok < T_TOT; tok += nw) {
      const bool isS = tok >= T_P;
      int b, t, pos;
      if (!isS) { b = tok >> 12; t = tok & 4095; pos = t; } else { int s = tok - T_P; b = s >> 5; t = s & 31; pos = 2048 + t; }
      bf16_t* row = proj + (size_t)tok * 1280;
      const int lm = lane & 7;
      float sn[8], cs[8];
#pragma unroll
      for (int j = 0; j < 8; ++j) { float inv = exp2f(-(float)j * (LOG2_THETA / 8.f)); sincos_rev((float)pos * inv, sn[j], cs[j]); }
      {
        uint4 qv = *(const uint4*)(row + lane * 8);
        float x[8]; unpack8(qv, x);
#pragma unroll
        for (int j = 0; j < 8; ++j) {
          float other = __shfl_xor(x[j], 1);
          if (lm == 0) x[j] = x[j] * cs[j] - other * sn[j];
          else if (lm == 1) x[j] = x[j] * cs[j] + other * sn[j];
        }
        *(uint4*)(row + lane * 8) = pack8(x);
      }
      {
        uint4 kv = make_uint4(0, 0, 0, 0);
        if (lane < 32) kv = *(const uint4*)(row + 512 + lane * 8);
        float x[8]; unpack8(kv, x);
#pragma unroll
        for (int j = 0; j < 8; ++j) {
          float other = __shfl_xor(x[j], 1);
          if (lane < 16) {
            if (lm == 0) x[j] = x[j] * cs[j] - other * sn[j];
            else if (lm == 1) x[j] = x[j] * cs[j] + other * sn[j];
          }
        }
        if (lane < 32) {
          const uint4 pk = pack8(x);
          const int e0 = (lane & 15) * 8;
          if (!isS) {
            if (lane < 16) *(uint4*)(row + 512 + lane * 8) = pk;
            else {
              const int kvh = e0 >> 6, d0 = e0 & 63;
#pragma unroll
              for (int j = 0; j < 8; ++j) vt0[((size_t)(b * 2 + kvh) * 64 + d0 + j) * 4096 + t] = f2bf(x[j]);
            }
            if (t >= 3968) {
              float* dst = p.out + ((lane < 16) ? O_SWAK_P : O_SWAV_P) + ((size_t)(b * 128 + (t - 3968)) * 128 + e0);
              *(float4*)dst = make_float4(x[0], x[1], x[2], x[3]);
              *(float4*)(dst + 4) = make_float4(x[4], x[5], x[6], x[7]);
            }
          } else {
            float* dst = p.out + ((lane < 16) ? O_SWAK_S : O_SWAV_S) + ((size_t)(b * 128 + 96 + t) * 128 + e0);
            *(float4*)dst = make_float4(x[0], x[1], x[2], x[3]);
            *(float4*)(dst + 4) = make_float4(x[4], x[5], x[6], x[7]);
            if (lane < 16) *(uint4*)(kall + (size_t)(b * 160 + 128 + t) * 128 + e0) = pk;
            else {
              const int kvh = e0 >> 6, d0 = e0 & 63;
#pragma unroll
              for (int j = 0; j < 8; ++j) vtall[((size_t)(b * 2 + kvh) * 64 + d0 + j) * 192 + 128 + t] = f2bf(x[j]);
            }
          }
        }
      }
    }
    for (size_t idx = gtid; idx < (size_t)32 * 96 * 128; idx += gthreads) {
      const int e = (int)(idx & 127); const int wd = (int)((idx >> 7) % 96); const int b = (int)(idx / (96 * 128));
      const size_t src = ((size_t)(b * 128 + 32 + wd)) * 128 + e, dst = ((size_t)(b * 128 + wd)) * 128 + e;
      p.out[O_SWAK_S + dst] = p.in[2][src];
      p.out[O_SWAV_S + dst] = p.in[3][src];
    }
    for (size_t idx = gtid; idx < (size_t)32 * 128 * 128; idx += gthreads) {
      const int e = (int)(idx & 127); const int key = (int)((idx >> 7) & 127); const int b = (int)(idx >> 14);
      kall[(size_t)(b * 160 + key) * 128 + e] = f2bf(p.in[2][idx]);
      vtall[((size_t)(b * 2 + (e >> 6)) * 64 + (e & 63)) * 192 + key] = f2bf(p.in[3][idx]);
    }
    for (size_t idx = gtid; idx < (size_t)32 * 2 * 64 * 32; idx += gthreads) {
      const int kk = (int)(idx & 31); const size_t rr = idx >> 5;
      vtall[rr * 192 + 160 + kk] = 0;
    }
    float* sUw = (float*)smem + w * 512;
    for (int item = gw; item < 32768; item += nw) s5_item<0>(tid, sUw, p, item);
  }
  GRID_BAR();

  for (int rep_ = 0; rep_ < NREP(3); ++rep_)
  {
    PHASE_BEGIN
    if (gtid < 16384) {
      const int n = (int)(gtid & 63), g = (int)((gtid >> 6) & 31), b = (int)(gtid >> 11);
      const int gn = g * 64 + n;
      const float lr = fminf(p.in[15][gn], -1e-4f), li = p.in[16][gn];
      const float dt = __expf(p.in[17][g]);
      const float mag = __expf(lr * dt);
      float sn, cs; sincos_rev(li * dt, sn, cs);
      float ar = mag * cs, ai = mag * sn;
#pragma unroll
      for (int i = 0; i < 5; ++i) { float nr = ar * ar - ai * ai, ni = 2.f * ar * ai; ar = nr; ai = ni; }
      const float* s1re = (const float*)(p.ws + OFF_QMLA);
      const float* s1im = s1re + 2097152;
      float* hinre = (float*)(p.ws + OFF_QMLA) + 2 * 2097152;
      float* hinim = hinre + 2097152;
      float hr = 0.f, hi = 0.f;
#pragma unroll 8
      for (int c = 0; c < 128; ++c) {
        const size_t idx = ((size_t)(b * 128 + c) * 32 + g) * 64 + n;
        hinre[idx] = hr; hinim[idx] = hi;
        const float sr = s1re[idx], si = s1im[idx];
        const float nhr = ar * hr - ai * hi + sr, nhi = ar * hi + ai * hr + si;
        hr = nhr; hi = nhi;
      }
      p.out[O_SSMRE_P + (size_t)(b * 32 + g) * 64 + n] = hr;
      p.out[O_SSMIM_P + (size_t)(b * 32 + g) * 64 + n] = hi;
    }
    const bf16_t* vt0 = (const bf16_t*)(p.ws + OFF_VT0);
    const bf16_t* kall = (const bf16_t*)(p.ws + OFF_KALL);
    const bf16_t* vtall = (const bf16_t*)(p.ws + OFF_VTALL);
    const float* sink = p.in[14];
    for (int item = blockIdx.x; item < 2048 + 256; item += gridDim.x) {
      AttnDesc d;
      d.scale = 0.125f; d.kx = nullptr; d.pos0 = 0;
      if (item < 2048) {
        const int h = item & 7, pr = (item >> 3) & 31, b = item >> 8;
        const int kvh = h >> 2;
        const int chunk = pr * 2 + (w >> 2);
        const int tok = b * 4096 + chunk * 64 + (w & 3) * 16;
        d.q = proj + (size_t)tok * 1280 + h * 64; d.ldq = 1280; d.active = 1;
        d.kt_lo = max(0, chunk - 2); d.kt_hi = chunk + 1;
        d.out = mix + (size_t)tok * 1024 + h * 64; d.ldo = 1024;
        d.m0 = sink[h]; d.l0 = 1.f;
        d.k = proj + (size_t)(b * 4096) * 1280 + 512 + kvh * 64; d.ldk = 1280;
        d.vt = vt0 + (size_t)(b * 2 + kvh) * 64 * 4096; d.ldv = 4096; d.nkeys = 4096;
        d.bt_lo = max(0, pr * 2 - 2); d.bt_hi = pr * 2 + 2;
      } else {
        const int it = item - 2048;
        const int h = it & 7, b = it >> 3;
        const int kvh = h >> 2;
        const int tok = T_P + b * 32 + (w & 1) * 16;
        d.q = proj + (size_t)tok * 1280 + h * 64; d.ldq = 1280; d.active = (w < 2);
        d.kt_lo = 0; d.kt_hi = 3;
        d.out = mix + (size_t)tok * 1024 + h * 64; d.ldo = 1024;
        d.m0 = sink[h]; d.l0 = 1.f;
        d.k = kall + (size_t)(b * 160) * 128 + kvh * 64; d.ldk = 128;
        d.vt = vtall + (size_t)(b * 2 + kvh) * 64 * 192; d.ldv = 192; d.nkeys = 160;
        d.bt_lo = 0; d.bt_hi = 3;
      }
      attn_item<64>(tid, smem, d);
    }
  }
  GRID_BAR();

  for (int rep_ = 0; rep_ < NREP(4); ++rep_)
  {
    PHASE_BEGIN
    float* sUw = (float*)smem + w * 512;
    for (int item = gw; item < 33792; item += nw) s5_item<1>(tid, sUw, p, item);
  }
  GRID_BAR();

  for (int rep_ = 0; rep_ < NREP(5); ++rep_)
  {
    PHASE_BEGIN
    int vb = 0;
    gemm_run<0>(tid, smem, zbuf, zbuf, T_TOT, 512, nullptr, wt + WT_GLU, T_TOT, 512, 512, vb, EpiGlu{zbuf, p.in[24], mix});
  }
  GRID_BAR();

  for (int rep_ = 0; rep_ < NREP(6); ++rep_)
  {
    PHASE_BEGIN
    int vb = 0;
    gemm_run<0>(tid, smem, mix, mix, T_TOT, 1024, nullptr, wt + WT_OUT_E, T_TOT, 1024, 1024, vb, EpiRes0{p.in[0], p.in[1], xres});
  }
  GRID_BAR();

  peer_phases<0>(bar_k, smem);
  GRID_BAR();
      for (int rep_ = 0; rep_ < NREP(10); ++rep_)
      {
    PHASE_BEGIN
        int vb = 0;
        gemm_run<2>(tid, smem, xres, xres, T_TOT, 1024, p.in[9] + 1024, wt + WT_IN_O, T_TOT, 1312, 1024, vb, EpiStoreBf16{proj, 1312});
      }
      GRID_BAR();
      for (int rep_ = 0; rep_ < NREP(11); ++rep_)
      {
    PHASE_BEGIN
        bf16_t* cqn = zbuf;
        bf16_t* mbuf = (bf16_t*)(p.ws + OFF_M);
        bf16_t* cbuf = (bf16_t*)(p.ws + OFF_C);
        bf16_t* kpbuf = (bf16_t*)(p.ws + OFF_KP);
        bf16_t* kps = (bf16_t*)(p.ws + OFF_KPS);
        for (int tok = gw; tok < T_TOT; tok += nw) {
          const bool isS = tok >= T_P;
          int b, t, pos;
          if (!isS) { b = tok >> 12; t = tok & 4095; pos = t; } else { int s = tok - T_P; b = s >> 5; t = s & 31; pos = 2048 + t; }
          const bf16_t* row = proj + (size_t)tok * 1312;
          {
            uint4 v = *(const uint4*)(row + lane * 8);
            float x[8]; unpack8(v, x);
            float ss = 0.f;
#pragma unroll
            for (int j = 0; j < 8; ++j) ss += x[j] * x[j];
            ss = wave_sum(ss);
            const float rs = rsqrtf(ss * (1.f / 512.f) + 1e-6f);
            const float4 g0 = *(const float4*)(p.in[29] + lane * 8), g1 = *(const float4*)(p.in[29] + lane * 8 + 4);
            x[0] *= rs * g0.x; x[1] *= rs * g0.y; x[2] *= rs * g0.z; x[3] *= rs * g0.w;
            x[4] *= rs * g1.x; x[5] *= rs * g1.y; x[6] *= rs * g1.z; x[7] *= rs * g1.w;
            *(uint4*)(cqn + (size_t)tok * 512 + lane * 8) = pack8(x);
          }
          {
            uint2 v = *(const uint2*)(row + 512 + lane * 4);
            float x0 = lo2f(v.x), x1 = hi2f(v.x), x2 = lo2f(v.y), x3 = hi2f(v.y);
            float ss = wave_sum(x0 * x0 + x1 * x1 + x2 * x2 + x3 * x3);
            const float rs = rsqrtf(ss * (1.f / 256.f) + 1e-6f);
            const float4 g = *(const float4*)(p.in[30] + lane * 4);
            x0 *= rs * g.x; x1 *= rs * g.y; x2 *= rs * g.z; x3 *= rs * g.w;
            uint2 o; o.x = pack2(x0, x1); o.y = pack2(x2, x3);
            *(uint2*)(cbuf + (size_t)tok * 256 + lane * 4) = o;
            float* dst = isS ? (p.out + O_CKV_S + (size_t)(tok - T_P) * 256 + lane * 4) : (p.out + O_CKV_P + (size_t)tok * 256 + lane * 4);
            *(float4*)dst = make_float4(x0, x1, x2, x3);
          }
          {
            float xv = 0.f;
            if (lane < 32) xv = bf2f(row[768 + lane]);
            const float other = __shfl_xor(xv, 16);
            const int f = lane & 15;
            const float inv = exp2f(-(float)f * (LOG2_THETA / 16.f));
            float sn, cs; sincos_rev((float)pos * inv, sn, cs);
            const float r = (lane < 16) ? (xv * cs - other * sn) : (xv * cs + other * sn);
            if (lane < 32) {
              kpbuf[(size_t)tok * 32 + lane] = f2bf(r);
              if (isS) { p.out[O_KPE_S + (size_t)(tok - T_P) * 32 + lane] = r; kps[((size_t)b * 2112 + 2048 + t) * 32 + lane] = f2bf(r); }
              else p.out[O_KPE_P + (size_t)tok * 32 + lane] = r;
            }
          }
          {
            const int gi = lane >> 4; const int wlen = 2 << gi;
            float tot[8], cur[8];
#pragma unroll
            for (int j = 0; j < 8; ++j) tot[j] = 0.f;
            uint4 v = *(const uint4*)(row + 800 + lane * 8);
            unpack8(v, cur);
#pragma unroll
            for (int j = 0; j < 8; ++j) tot[j] = cur[j];
            for (int jb = 1; jb < 16; ++jb) {
              if (jb < wlen) {
                const int tt = t - jb;
                if (tt >= 0) {
                  uint4 pv = *(const uint4*)(row - (size_t)jb * 1312 + 800 + lane * 8);
                  float y[8]; unpack8(pv, y);
#pragma unroll
                  for (int j = 0; j < 8; ++j) tot[j] += y[j];
                } else if (isS) {
                  const float* sp = p.in[6] + ((size_t)b * 15 + (15 + tt)) * 512 + lane * 8;
                  float4 a = *(const float4*)sp, bq = *(const float4*)(sp + 4);
                  tot[0] += a.x; tot[1] += a.y; tot[2] += a.z; tot[3] += a.w; tot[4] += bq.x; tot[5] += bq.y; tot[6] += bq.z; tot[7] += bq.w;
                }
              }
            }
            const float cnt = (float)min(pos + 1, wlen);
            float mm[8];
#pragma unroll
            for (int j = 0; j < 8; ++j) mm[j] = tot[j] / cnt - cur[j];
            *(uint4*)(mbuf + (size_t)tok * 512 + lane * 8) = pack8(mm);
            const int tlen = isS ? 32 : 4096;
            if (t >= tlen - 15) {
              const int i = t - (tlen - 15);
              float* dst = isS ? (p.out + O_POOL_S + ((size_t)b * 15 + i) * 512 + lane * 8) : (p.out + O_POOL_P + ((size_t)b * 15 + i) * 512 + lane * 8);
              *(float4*)dst = make_float4(cur[0], cur[1], cur[2], cur[3]);
              *(float4*)(dst + 4) = make_float4(cur[4], cur[5], cur[6], cur[7]);
            }
          }
        }
        for (size_t idx = gtid; idx < (size_t)32 * 2048 * 32; idx += gthreads) {
          const int e = (int)(idx & 31); const int key = (int)((idx >> 5) & 2047); const int b = (int)(idx >> 16);
          kps[((size_t)b * 2112 + key) * 32 + e] = f2bf(p.in[8][idx]);
        }
      }
      GRID_BAR();
      for (int rep_ = 0; rep_ < NREP(12); ++rep_)
      {
    PHASE_BEGIN
        bf16_t* cqn = zbuf;
        bf16_t* mbuf = (bf16_t*)(p.ws + OFF_M);
        bf16_t* cbuf = (bf16_t*)(p.ws + OFF_C);
        bf16_t* qmla = (bf16_t*)(p.ws + OFF_QMLA);
        bf16_t* kupp = qbuf;
        bf16_t* vtp = qbuf + 16777216;
        bf16_t* kups = (bf16_t*)(p.ws + OFF_KUPS);
        bf16_t* vts = (bf16_t*)(p.ws + OFF_VTS);
        for (size_t idx = gtid; idx < (size_t)32 * 8 * 64 * 32; idx += gthreads) {
          const int kk = (int)(idx & 31); const size_t rr = idx >> 5;
          vts[rr * 2112 + 2080 + kk] = 0;
        }
        int vb = 0;
        gemm_run<1>(tid, smem, p.in[7], p.in[7], 65536, 256, nullptr, wt + WT_UK, 65536, 512, 256, vb, EpiKup{kups, 2048, 0, 2112});
        gemm_run<1>(tid, smem, p.in[7], p.in[7], 65536, 256, nullptr, wt + WT_UV, 65536, 512, 256, vb, EpiVt{vts, 2048, 0, 2112});
        gemm_run<0>(tid, smem, cqn, cqn, T_TOT, 512, nullptr, wt + WT_UQ, T_TOT, 768, 512, vb, EpiStoreBf16{qmla, 768});
        gemm_run<0>(tid, smem, cbuf, cbuf, T_P, 256, nullptr, wt + WT_UK, T_P, 512, 256, vb, EpiKup{kupp, 4096, 0, 4096});
        gemm_run<0>(tid, smem, cbuf, cbuf, T_P, 256, nullptr, wt + WT_UV, T_P, 512, 256, vb, EpiVt{vtp, 4096, 0, 4096});
        gemm_run<0>(tid, smem, cbuf + (size_t)T_P * 256, cbuf, 1024, 256, nullptr, wt + WT_UK, 1024, 512, 256, vb, EpiKup{kups, 32, 2048, 2112});
        gemm_run<0>(tid, smem, cbuf + (size_t)T_P * 256, cbuf, 1024, 256, nullptr, wt + WT_UV, 1024, 512, 256, vb, EpiVt{vts, 32, 2048, 2112});
        for (int g = 0; g < 4; ++g)
          gemm_run<0>(tid, smem, mbuf + g * 128, mbuf, T_TOT, 512, nullptr, wt + WT_POOL + g * 16384, T_TOT, 128, 128, vb, EpiPool{mix, p.in[28], g});
      }
      GRID_BAR();
      for (int rep_ = 0; rep_ < NREP(13); ++rep_)
      {
    PHASE_BEGIN
        const bf16_t* qmla = (const bf16_t*)(p.ws + OFF_QMLA);
        const bf16_t* kupp = qbuf;
        const bf16_t* vtp = qbuf + 16777216;
        const bf16_t* kups = (const bf16_t*)(p.ws + OFF_KUPS);
        const bf16_t* vts = (const bf16_t*)(p.ws + OFF_VTS);
        const bf16_t* kpbuf = (const bf16_t*)(p.ws + OFF_KP);
        const bf16_t* kps = (const bf16_t*)(p.ws + OFF_KPS);
        const int G = gridDim.x;
        const bool xsched = (G == 256);
        const int nitems = 2048 + 256;
        const int xcd = blockIdx.x & 7, loc = blockIdx.x >> 3;
        for (int k = 0;; ++k) {
          int pit, sit = -1;
          if (xsched) {
            if (k >= 9) break;
            if (k == 0) { pit = -1; sit = blockIdx.x; }
            else {
              const int r = k - 1;
              const int grp = xcd + 8 * r;
              const int pr = (r & 1) ? (31 - loc) : loc;
              pit = ((31 - pr) << 6) | grp;
            }
          } else {
            const int posn = (k & 1) ? (G - 1 - (int)blockIdx.x) : (int)blockIdx.x;
            const int v = k * G + posn;
            if (k * G >= nitems) break;
            if (v >= nitems) continue;
            if (v < 1024) pit = v; else if (v < 1280) { pit = -1; sit = v - 1024; } else pit = v - 256;
          }
          AttnDesc d;
          d.scale = 0.10206207261596575f; d.m0 = -1e30f; d.l0 = 0.f;
          if (pit >= 0) {
            const int pr = 31 - (pit >> 6); const int h = pit & 7, b = (pit >> 3) & 7;
            const int chunk = pr * 2 + (w >> 2);
            const int tok = b * 4096 + chunk * 64 + (w & 3) * 16;
            d.q = qmla + (size_t)tok * 768 + h * 96; d.ldq = 768; d.active = 1; d.pos0 = chunk * 64 + (w & 3) * 16;
            d.kt_lo = 0; d.kt_hi = chunk + 1;
            d.out = mix + (size_t)tok * 1024 + 512 + h * 64; d.ldo = 1024;
            d.k = kupp + (size_t)(b * 4096) * 512 + h * 64; d.ldk = 512;
            d.kx = kpbuf + (size_t)(b * 4096) * 32;
            d.vt = vtp + (size_t)(b * 8 + h) * 64 * 4096; d.ldv = 4096; d.nkeys = 4096;
            d.bt_lo = 0; d.bt_hi = pr * 2 + 2;
          } else {
            const int h = sit & 7, b = sit >> 3;
            const int tok = T_P + b * 32 + (w & 1) * 16;
            d.q = qmla + (size_t)tok * 768 + h * 96; d.ldq = 768; d.active = (w < 2); d.pos0 = 2048 + (w & 1) * 16;
            d.kt_lo = 0; d.kt_hi = 33;
            d.out = mix + (size_t)tok * 1024 + 512 + h * 64; d.ldo = 1024;
            d.k = kups + (size_t)(b * 2112) * 512 + h * 64; d.ldk = 512;
            d.kx = kps + (size_t)(b * 2112) * 32;
            d.vt = vts + (size_t)(b * 8 + h) * 64 * 2112; d.ldv = 2112; d.nkeys = 2080;
            d.bt_lo = 0; d.bt_hi = 33;
          }
          attn_item<96>(tid, smem, d);
        }
      }
      GRID_BAR();
      for (int rep_ = 0; rep_ < NREP(14); ++rep_)
      {
    PHASE_BEGIN
        quant_rows(p.in[36] + 16777216, p.ws + OFF_TAB, (float*)(p.ws + OFF_TAB + TAB_SU_OFF), gw, nw, tid);
        quant_rows(p.in[37] + 16777216, p.ws + OFF_TAB + TAB_V_OFF, (float*)(p.ws + OFF_TAB + TAB_SV_OFF), gw, nw, tid);
        int vb = 0;
        gemm_run<0>(tid, smem, mix, mix, T_TOT, 1024, nullptr, wt + WT_OUT_O, T_TOT, 1024, 1024, vb, EpiRes1{xres});
      }
      GRID_BAR();
  peer_phases<1>(bar_k, smem);
}

extern "C" void kernel_launch(void* const* d_in, const int* in_sizes, int n_in, void* d_out, int out_size, void* d_ws, size_t ws_size, hipStream_t stream) {
  static int grid_blocks = 0;
  if (grid_blocks == 0) {
    int dev = 0, cus = 0, per_cu = 0;
    hipGetDevice(&dev);
    hipDeviceGetAttribute(&cus, hipDeviceAttributeMultiprocessorCount, dev);
    hipOccupancyMaxActiveBlocksPerMultiprocessor(&per_cu, (const void*)mega, NT, 0);
    if (per_cu < 1) per_cu = 1;
    if (per_cu > 1) per_cu = 1;
    grid_blocks = cus * per_cu;
    if (ws_size < WS_NEED + 256) fprintf(stderr, "kernel_launch: workspace too small: %zu < %zu\n", ws_size, (size_t)WS_NEED);
  }
  hipMemsetAsync((unsigned char*)d_ws + OFF_BAR, 0, 256, stream);
  Params p{};
  for (int i = 0; i < 38; ++i) p.in[i] = (const float*)d_in[i];
  p.out = (float*)d_out;
  p.ws = (unsigned char*)d_ws;
  void* args[] = {&p};
  hipError_t e = hipLaunchCooperativeKernel((const void*)mega, dim3(grid_blocks), dim3(NT), args, 0, stream);
  if (e != hipSuccess) fprintf(stderr, "cooperative launch failed: %s (grid %d)\n", hipGetErrorString(e), grid_blocks);
}
```

```cpp
#include <hip/hip_runtime.h>
#include <hip/hip_bf16.h>
#include <hip/hip_cooperative_groups.h>
#include <cstdio>
namespace cg = cooperative_groups;

typedef unsigned short bf16_t;
using bf16x8 = __attribute__((ext_vector_type(8))) short;
using f32x4 = __attribute__((ext_vector_type(4))) float;

#ifndef PH
#define PH 0xFFFFFFu
#endif
#ifndef DBL
#define DBL 0u
#endif
#define NREP(n) ((int)((PH >> (n)) & 1u) * (1 + (int)((DBL >> (n)) & 1u)))
#define NT 512
#define T_TOT 33792
#define T_P 32768
#define LOG2_THETA 18.931568569324174f

#define O_Y 0
#define O_SWAK_P 34603008
#define O_SWAV_P 34734080
#define O_SSMRE_P 34865152
#define O_SSMIM_P 34881536
#define O_POOL_P 34897920
#define O_CKV_P 34959360
#define O_KPE_P 43347968
#define O_SWAK_S 44396544
#define O_SWAV_S 44920832
#define O_SSMRE_S 45445120
#define O_SSMIM_S 45510656
#define O_POOL_S 45576192
#define O_CKV_S 45821952
#define O_KPE_S 46084096

constexpr size_t OFF_PROJ = 0;
constexpr size_t OFF_TAB = OFF_PROJ + 88670208ull;
constexpr size_t OFF_MIX = OFF_TAB + 67108864ull;
constexpr size_t OFF_QBUF = OFF_MIX + 69206016ull;
constexpr size_t OFF_QMLA = OFF_QBUF + 69206016ull;
constexpr size_t OFF_Z = OFF_QMLA + 51904512ull;
constexpr size_t OFF_M = OFF_Z + 34603008ull;
constexpr size_t OFF_C = OFF_M + 34603008ull;
constexpr size_t OFF_KP = OFF_C + 17301504ull;
constexpr size_t OFF_VT0 = OFF_KP + 2162688ull;
constexpr size_t OFF_KALL = OFF_VT0 + 8388608ull;
constexpr size_t OFF_VTALL = OFF_KALL + 1327104ull;
constexpr size_t OFF_KPS = OFF_VTALL + 1572864ull;
constexpr size_t OFF_WT = OFF_KPS + 4325376ull;
constexpr size_t WS_NEED = OFF_WT + 16187392ull;
constexpr size_t OFF_KUPS = OFF_PROJ;
constexpr size_t OFF_VTS = OFF_PROJ + 69206016ull;
constexpr size_t WT_IN_E = 0;
constexpr size_t WT_OUT_E = WT_IN_E + 1310720;
constexpr size_t WT_GLU = WT_OUT_E + 1048576;
constexpr size_t WT_IN_O = WT_GLU + 262144;
constexpr size_t WT_OUT_O = WT_IN_O + 1343488;
constexpr size_t WT_POOL = WT_OUT_O + 1048576;
constexpr size_t WT_UQ = WT_POOL + 65536;
constexpr size_t WT_UK = WT_UQ + 393216;
constexpr size_t WT_UV = WT_UK + 131072;
constexpr size_t WT_PQ = WT_UV + 131072;
constexpr size_t WT_KEYS = WT_PQ + 2097152;

struct Params {
  const float* in[38];
  float* out;
  unsigned char* ws;
};

typedef __bf16 bf16x2_t __attribute__((ext_vector_type(2)));
typedef float float2_t __attribute__((ext_vector_type(2)));
__device__ __forceinline__ unsigned pack2(float a, float b) {
  float2_t f = {a, b};
  bf16x2_t h = __builtin_convertvector(f, bf16x2_t);
  return __builtin_bit_cast(unsigned, h);
}
__device__ __forceinline__ unsigned short f2bf(float f) { return (unsigned short)(pack2(f, 0.f) & 0xffffu); }
__device__ __forceinline__ float bf2f(unsigned short b) { return __uint_as_float(((unsigned)b) << 16); }
__device__ __forceinline__ float lo2f(unsigned u) { return __uint_as_float(u << 16); }
__device__ __forceinline__ float hi2f(unsigned u) { return __uint_as_float(u & 0xffff0000u); }
__device__ __forceinline__ void unpack8(uint4 v, float* x) {
  x[0] = lo2f(v.x); x[1] = hi2f(v.x); x[2] = lo2f(v.y); x[3] = hi2f(v.y);
  x[4] = lo2f(v.z); x[5] = hi2f(v.z); x[6] = lo2f(v.w); x[7] = hi2f(v.w);
}
__device__ __forceinline__ uint4 pack8(const float* x) {
  uint4 v; v.x = pack2(x[0], x[1]); v.y = pack2(x[2], x[3]); v.z = pack2(x[4], x[5]); v.w = pack2(x[6], x[7]); return v;
}
template <int CTRL> __device__ __forceinline__ float dpp_f(float v) {
  return __int_as_float(__builtin_amdgcn_update_dpp(0, __float_as_int(v), CTRL, 0xf, 0xf, true));
}
__device__ __forceinline__ float row16_max(float v) {
  v = fmaxf(v, dpp_f<0xB1>(v)); v = fmaxf(v, dpp_f<0x4E>(v)); v = fmaxf(v, dpp_f<0x141>(v)); v = fmaxf(v, dpp_f<0x140>(v)); return v;
}
__device__ __forceinline__ float row16_sum(float v) {
  v += dpp_f<0xB1>(v); v += dpp_f<0x4E>(v); v += dpp_f<0x141>(v); v += dpp_f<0x140>(v); return v;
}
__device__ __forceinline__ float wave_sum(float v) {
  v = row16_sum(v);
  const float a = __int_as_float(__builtin_amdgcn_readlane(__float_as_int(v), 0));
  const float b = __int_as_float(__builtin_amdgcn_readlane(__float_as_int(v), 16));
  const float c = __int_as_float(__builtin_amdgcn_readlane(__float_as_int(v), 32));
  const float d = __int_as_float(__builtin_amdgcn_readlane(__float_as_int(v), 48));
  return (a + b) + (c + d);
}
__device__ __forceinline__ void sincos_rev(float ang, float& s, float& c) {
  float rev = ang * 0.15915494309189535f;
  rev = rev - floorf(rev);
  s = __builtin_amdgcn_sinf(rev);
  c = __builtin_amdgcn_cosf(rev);
}
__device__ __forceinline__ float gelu_tanh(float x) {
  float y = 0.7978845608028654f * (x + 0.044715f * x * x * x);
  float t = 1.f - 2.f / (1.f + __expf(2.f * y));
  return 0.5f * x * (1.f + t);
}
__device__ __forceinline__ float gelu_erf(float x) { return 0.5f * x * (1.f + erff(x * 0.7071067811865476f)); }
__device__ __forceinline__ int logical_bid() {
  const int G = (int)gridDim.x, b = (int)blockIdx.x;
  return ((G & 7) == 0) ? ((b & 7) * (G >> 3) + (b >> 3)) : b;
}
__device__ __forceinline__ int rot_start(int vbase) {
  int G = (int)gridDim.x;
  int s = (logical_bid() - vbase) % G;
  if (s < 0) s += G;
  return s;
}

__device__ __forceinline__ void transpose_convert(int tid, unsigned char* smem, const float* __restrict__ src, bf16_t* __restrict__ dst, int K, int N, int& vbase) {
  float* tl = (float*)smem;
  const int tk = K / 64, tn = (N + 63) / 64;
  const int ntiles = tk * tn;
  for (int tile = rot_start(vbase); tile < ntiles; tile += gridDim.x) {
    const int k0 = (tile / tn) * 64, n0 = (tile % tn) * 64;
    __syncthreads();
#pragma unroll
    for (int i = 0; i < 2; ++i) {
      int r = (tid >> 4) + 32 * i, c4 = (tid & 15) * 4;
      float4 v = make_float4(0.f, 0.f, 0.f, 0.f);
      if (n0 + c4 < N) v = *(const float4*)(src + (size_t)(k0 + r) * N + n0 + c4);
      tl[r * 65 + c4 + 0] = v.x; tl[r * 65 + c4 + 1] = v.y; tl[r * 65 + c4 + 2] = v.z; tl[r * 65 + c4 + 3] = v.w;
    }
    __syncthreads();
    int n = tid >> 3, k8 = (tid & 7) * 8;
    if (n0 + n < N) {
      float x[8];
#pragma unroll
      for (int j = 0; j < 8; ++j) x[j] = tl[(k8 + j) * 65 + n];
      *(uint4*)(dst + (size_t)(n0 + n) * K + k0 + k8) = pack8(x);
    }
  }
  vbase += ntiles;
}

__device__ __forceinline__ void convert_plain(int tid, const float* __restrict__ src, bf16_t* __restrict__ dst, size_t n) {
  size_t i = ((size_t)blockIdx.x * NT + tid) * 8;
  const size_t stride = (size_t)gridDim.x * NT * 8;
  for (; i < n; i += stride) {
    float4 a = *(const float4*)(src + i), b = *(const float4*)(src + i + 4);
    uint4 v; v.x = pack2(a.x, a.y); v.y = pack2(a.z, a.w); v.z = pack2(b.x, b.y); v.w = pack2(b.z, b.w);
    *(uint4*)(dst + i) = v;
  }
}

template <int V> struct IC { static constexpr int value = V; };
template <int AMODE, class Epi>
__device__ __forceinline__ void gemm_run(int tid, unsigned char* smem, const void* A, const void* A2, int splitRow, int lda,
                                         const float* __restrict__ gain, const bf16_t* __restrict__ Bt,
                                         int M, int N, int K, int& vbase, Epi epi) {
  bf16_t* sA = (bf16_t*)smem;
  bf16_t* sB = sA + 128 * 72;
  float* sR = (float*)(sB + 128 * 72);
  float* sG = sR + 128;
  if (AMODE == 2) {
    __syncthreads();
    sG[tid] = gain[tid]; sG[tid + 512] = gain[tid + 512];
    __syncthreads();
  }
  const int lane = tid & 63, w = tid >> 6;
  const int l16 = lane & 15, quad = lane >> 4;
  const int wm = w >> 1, wn = w & 1;
  const int tilesN = (N + 127) / 128, tilesM = M / 128;
  const int ntiles = tilesM * tilesN;
  const int arow = tid >> 2, aseg = (tid & 3) * 16;
  const int nk = K / 64;
  for (int tile = rot_start(vbase); tile < ntiles; tile += gridDim.x) {
    const int tm = tile / tilesN, tn = tile % tilesN;
    const int m0 = tm * 128, n0 = tn * 128;
    const int grow = m0 + arow;
    const unsigned char* aptr;
    if (AMODE == 0) aptr = (grow < splitRow) ? (const unsigned char*)A + (size_t)grow * lda * 2 : (const unsigned char*)A2 + (size_t)(grow - splitRow) * lda * 2;
    else aptr = (grow < splitRow) ? (const unsigned char*)A + (size_t)grow * lda * 4 : (const unsigned char*)A2 + (size_t)(grow - splitRow) * lda * 4;
    const bool bvalid = (n0 + arow) < N;
    const bf16_t* bptr = Bt + (size_t)(n0 + arow) * K + aseg;
    f32x4 acc[2][4];
#pragma unroll
    for (int i = 0; i < 2; ++i)
#pragma unroll
      for (int j = 0; j < 4; ++j) acc[i][j] = (f32x4){0.f, 0.f, 0.f, 0.f};
    float ss = 0.f;
    float4 af0[4], af1[4];
    uint4 ab0[2], ab1[2];
    uint4 bb0[2], bb1[2];
#define GLOAD(AF, AB, BB, KT) { \
      const int k0_ = (KT) * 64; \
      if (AMODE == 0) { AB[0] = *(const uint4*)(aptr + (size_t)(k0_ + aseg) * 2); AB[1] = *(const uint4*)(aptr + (size_t)(k0_ + aseg + 8) * 2); } \
      else { \
        _Pragma("unroll") for (int i = 0; i < 4; ++i) AF[i] = *(const float4*)(aptr + (size_t)(k0_ + aseg + 4 * i) * 4); \
      } \
      if (bvalid) { BB[0] = *(const uint4*)(bptr + k0_); BB[1] = *(const uint4*)(bptr + k0_ + 8); } \
      else { BB[0] = make_uint4(0, 0, 0, 0); BB[1] = BB[0]; } }
#define LSTORE(AF, AB, BB, KT) { \
      uint4 s0, s1; \
      if (AMODE == 0) { s0 = AB[0]; s1 = AB[1]; } \
      else { \
        if (AMODE == 2) { \
          const float* gp = sG + (KT) * 64 + aseg; \
          _Pragma("unroll") for (int i = 0; i < 4; ++i) { \
            float4 g = *(const float4*)(gp + 4 * i); \
            ss += AF[i].x * AF[i].x + AF[i].y * AF[i].y + AF[i].z * AF[i].z + AF[i].w * AF[i].w; \
            AF[i].x *= g.x; AF[i].y *= g.y; AF[i].z *= g.z; AF[i].w *= g.w; \
          } \
        } \
        s0.x = pack2(AF[0].x, AF[0].y); s0.y = pack2(AF[0].z, AF[0].w); s0.z = pack2(AF[1].x, AF[1].y); s0.w = pack2(AF[1].z, AF[1].w); \
        s1.x = pack2(AF[2].x, AF[2].y); s1.y = pack2(AF[2].z, AF[2].w); s1.z = pack2(AF[3].x, AF[3].y); s1.w = pack2(AF[3].z, AF[3].w); \
      } \
      *(uint4*)(sA + arow * 72 + aseg) = s0; \
      *(uint4*)(sA + arow * 72 + aseg + 8) = s1; \
      *(uint4*)(sB + arow * 72 + aseg) = BB[0]; \
      *(uint4*)(sB + arow * 72 + aseg + 8) = BB[1]; }
#define GCOMPUTE() { \
      _Pragma("unroll") for (int ks = 0; ks < 2; ++ks) { \
        bf16x8 a[2], b[4]; \
        _Pragma("unroll") for (int i = 0; i < 2; ++i) a[i] = *(const bf16x8*)(sA + (wm * 32 + i * 16 + l16) * 72 + ks * 32 + quad * 8); \
        _Pragma("unroll") for (int j = 0; j < 4; ++j) b[j] = *(const bf16x8*)(sB + (wn * 64 + j * 16 + l16) * 72 + ks * 32 + quad * 8); \
        _Pragma("unroll") for (int i = 0; i < 2; ++i) \
          _Pragma("unroll") for (int j = 0; j < 4; ++j) acc[i][j] = __builtin_amdgcn_mfma_f32_16x16x32_bf16(a[i], b[j], acc[i][j], 0, 0, 0); \
      } }
    GLOAD(af0, ab0, bb0, 0);
    GLOAD(af1, ab1, bb1, 1);
    for (int kt = 0; kt < nk; kt += 2) {
      __syncthreads();
      LSTORE(af0, ab0, bb0, kt);
      __syncthreads();
      if (kt + 2 < nk) GLOAD(af0, ab0, bb0, kt + 2);
      GCOMPUTE();
      __syncthreads();
      LSTORE(af1, ab1, bb1, kt + 1);
      __syncthreads();
      if (kt + 3 < nk) GLOAD(af1, ab1, bb1, kt + 3);
      GCOMPUTE();
    }
    if (AMODE == 2) {
      ss += __shfl_xor(ss, 1);
      ss += __shfl_xor(ss, 2);
      if ((tid & 3) == 0) sR[arow] = rsqrtf(ss / (float)K + 1e-6f);
      __syncthreads();
    }
#pragma unroll
    for (int i = 0; i < 2; ++i)
#pragma unroll
      for (int r = 0; r < 4; ++r) {
        const int rl = wm * 32 + i * 16 + quad * 4 + r;
        const float rs = (AMODE == 2) ? sR[rl] : 1.f;
#pragma unroll
        for (int j = 0; j < 4; ++j) {
          const int col = n0 + wn * 64 + j * 16 + l16;
          if (col < N) epi(m0 + rl, col, acc[i][j][r] * rs);
        }
      }
  }
  vbase += ntiles;
}

struct AttnDesc {
  const bf16_t* q; int ldq; int active; int kt_lo, kt_hi; bf16_t* out; int ldo; float m0, l0; int pos0;
  const bf16_t* k; int ldk; const bf16_t* kx; const bf16_t* vt; int ldv; int nkeys; int bt_lo, bt_hi; float scale;
};

template <int DQK>
__device__ __forceinline__ void attn_item(int tid, unsigned char* smem, const AttnDesc& d) {
  constexpr int LDK = DQK + 8;
  bf16_t* sK = (bf16_t*)smem;
  bf16_t* sVt = sK + 64 * 104;
  bf16_t* sP = sVt + 64 * 72;
  const int lane = tid & 63, w = tid >> 6;
  const int l16 = lane & 15, quad = lane >> 4;
  bf16_t* sPw = sP + w * 16 * 72;
  bf16x8 qf[DQK / 32];
  if (d.active) {
#pragma unroll
    for (int ks = 0; ks < DQK / 32; ++ks) {
      const bf16_t* qp = d.q + (size_t)l16 * d.ldq + ks * 32 + quad * 8;
      uint4 v = *(const uint4*)qp;
      if (DQK == 96 && ks == 2) {
        const int pq = (quad < 2) ? 16 : -16;
        uint4 pv = *(const uint4*)(qp + pq);
        float x[8], y[8];
        unpack8(v, x); unpack8(pv, y);
        const float pos = (float)(d.pos0 + l16);
#pragma unroll
        for (int j = 0; j < 8; ++j) {
          const int f = (quad & 1) * 8 + j;
          float inv = exp2f(-(float)f * (LOG2_THETA / 16.f));
          float sn, cs; sincos_rev(pos * inv, sn, cs);
          x[j] = (quad < 2) ? (x[j] * cs - y[j] * sn) : (x[j] * cs + y[j] * sn);
        }
        v = pack8(x);
      }
      qf[ks] = *(bf16x8*)&v;
    }
  }
  f32x4 o[4];
#pragma unroll
  for (int i = 0; i < 4; ++i) o[i] = (f32x4){0.f, 0.f, 0.f, 0.f};
  float m[4], l[4];
#pragma unroll
  for (int r = 0; r < 4; ++r) { m[r] = d.m0; l[r] = d.l0; }

  const int key = tid >> 3, seg = tid & 7;
  const int key2 = (tid >> 2) & 63, seg2 = tid & 3;
  uint4 kv_r = make_uint4(0, 0, 0, 0), vv_r = kv_r, xv_r = kv_r;
  if (d.bt_lo < d.bt_hi) {
    kv_r = *(const uint4*)(d.k + (size_t)(d.bt_lo * 64 + key) * d.ldk + seg * 8);
    vv_r = *(const uint4*)(d.vt + (size_t)key * d.ldv + d.bt_lo * 64 + seg * 8);
    if (DQK == 96 && tid < 256) xv_r = *(const uint4*)(d.kx + (size_t)(d.bt_lo * 64 + key2) * 32 + seg2 * 8);
  }
  for (int kt = d.bt_lo; kt < d.bt_hi; ++kt) {
    __syncthreads();
    *(uint4*)(sK + key * LDK + seg * 8) = kv_r;
    *(uint4*)(sVt + key * 72 + seg * 8) = vv_r;
    if (DQK == 96 && tid < 256) *(uint4*)(sK + key2 * LDK + 64 + seg2 * 8) = xv_r;
    __syncthreads();
    if (kt + 1 < d.bt_hi) {
      kv_r = *(const uint4*)(d.k + (size_t)((kt + 1) * 64 + key) * d.ldk + seg * 8);
      vv_r = *(const uint4*)(d.vt + (size_t)key * d.ldv + (kt + 1) * 64 + seg * 8);
      if (DQK == 96 && tid < 256) xv_r = *(const uint4*)(d.kx + (size_t)((kt + 1) * 64 + key2) * 32 + seg2 * 8);
    }
    if (d.active && kt >= d.kt_lo && kt < d.kt_hi) {
      f32x4 s[4];
#pragma unroll
      for (int i = 0; i < 4; ++i) s[i] = (f32x4){0.f, 0.f, 0.f, 0.f};
#pragma unroll
      for (int ks = 0; ks < DQK / 32; ++ks)
#pragma unroll
        for (int nt = 0; nt < 4; ++nt) {
          bf16x8 b = *(const bf16x8*)(sK + (nt * 16 + l16) * LDK + ks * 32 + quad * 8);
          s[nt] = __builtin_amdgcn_mfma_f32_16x16x32_bf16(qf[ks], b, s[nt], 0, 0, 0);
        }
#pragma unroll
      for (int nt = 0; nt < 4; ++nt) {
        const bool valid = (kt * 64 + nt * 16 + l16) < d.nkeys;
#pragma unroll
        for (int r = 0; r < 4; ++r) s[nt][r] = valid ? s[nt][r] * d.scale : -1e30f;
      }
#pragma unroll
      for (int r = 0; r < 4; ++r) {
        float mx = fmaxf(fmaxf(s[0][r], s[1][r]), fmaxf(s[2][r], s[3][r]));
        mx = row16_max(mx);
        const float mnew = fmaxf(m[r], mx);
        const float alpha = __expf(m[r] - mnew);
        float p0 = __expf(s[0][r] - mnew), p1 = __expf(s[1][r] - mnew), p2 = __expf(s[2][r] - mnew), p3 = __expf(s[3][r] - mnew);
        float rs = p0 + p1 + p2 + p3;
        rs = row16_sum(rs);
        l[r] = l[r] * alpha + rs;
        m[r] = mnew;
#pragma unroll
        for (int dt = 0; dt < 4; ++dt) o[dt][r] *= alpha;
        bf16_t* pr = sPw + (quad * 4 + r) * 72 + l16;
        pr[0] = f2bf(p0); pr[16] = f2bf(p1); pr[32] = f2bf(p2); pr[48] = f2bf(p3);
      }
      asm volatile("s_waitcnt lgkmcnt(0)" ::: "memory");
#pragma unroll
      for (int ks = 0; ks < 2; ++ks) {
        bf16x8 a = *(const bf16x8*)(sPw + l16 * 72 + ks * 32 + quad * 8);
#pragma unroll
        for (int dt = 0; dt < 4; ++dt) {
          bf16x8 b = *(const bf16x8*)(sVt + (dt * 16 + l16) * 72 + ks * 32 + quad * 8);
          o[dt] = __builtin_amdgcn_mfma_f32_16x16x32_bf16(a, b, o[dt], 0, 0, 0);
        }
      }
      asm volatile("s_waitcnt lgkmcnt(0)" ::: "memory");
    }
  }
  if (d.active) {
#pragma unroll
    for (int r = 0; r < 4; ++r) {
      const float il = 1.f / l[r];
#pragma unroll
      for (int dt = 0; dt < 4; ++dt) d.out[(size_t)(quad * 4 + r) * d.ldo + dt * 16 + l16] = f2bf(o[dt][r] * il);
    }
  }
}

template <int MODE>
__device__ __forceinline__ void s5_item(int tid, float* sUw, const Params& p, int item) {
  const int lane = tid & 63;
  const bf16_t* proj = (const bf16_t*)(p.ws + OFF_PROJ);
  int b, chunk, g, tok0; bool isS;
  if (item < 32768) { isS = false; g = item & 31; chunk = (item >> 5) & 127; b = item >> 12; tok0 = b * 4096 + chunk * 32; }
  else { isS = true; int it = item - 32768; g = it & 31; b = it >> 5; chunk = 0; tok0 = T_P + b * 32; }
  const int n = lane;
  const int gn = g * 64 + n;
  const float lr = fminf(p.in[15][gn], -1e-4f), li = p.in[16][gn];
  const float dt = __expf(p.in[17][g]);
  const float mag = __expf(lr * dt);
  float sn, cs; sincos_rev(li * dt, sn, cs);
  const float abr = mag * cs, abi = mag * sn;
  const float den = lr * lr + li * li;
  const float nr = abr - 1.f, ni = abi;
  const float fre = (nr * lr + ni * li) / den, fim = (ni * lr - nr * li) / den;
  float bbr[16], bbi[16];
  {
    const float4* br4 = (const float4*)(p.in[18] + (size_t)gn * 16);
    const float4* bi4 = (const float4*)(p.in[19] + (size_t)gn * 16);
#pragma unroll
    for (int i = 0; i < 4; ++i) {
      float4 r4 = br4[i], i4 = bi4[i];
      bbr[4 * i + 0] = fre * r4.x - fim * i4.x; bbi[4 * i + 0] = fre * i4.x + fim * r4.x;
      bbr[4 * i + 1] = fre * r4.y - fim * i4.y; bbi[4 * i + 1] = fre * i4.y + fim * r4.y;
      bbr[4 * i + 2] = fre * r4.z - fim * i4.z; bbi[4 * i + 2] = fre * i4.z + fim * r4.z;
      bbr[4 * i + 3] = fre * r4.w - fim * i4.w; bbi[4 * i + 3] = fre * i4.w + fim * r4.w;
    }
  }
  {
    const int t = lane >> 1, c8 = (lane & 1) * 8;
    uint4 uv = *(const uint4*)(proj + (size_t)(tok0 + t) * 1280 + 768 + g * 16 + c8);
    float x[8]; unpack8(uv, x);
    *(float4*)(sUw + t * 16 + c8) = make_float4(x[0], x[1], x[2], x[3]);
    *(float4*)(sUw + t * 16 + c8 + 4) = make_float4(x[4], x[5], x[6], x[7]);
  }
  asm volatile("s_waitcnt lgkmcnt(0)" ::: "memory");
  float hr = 0.f, hi = 0.f;
  if (MODE == 0) {
#pragma unroll 4
    for (int t = 0; t < 32; ++t) {
      float uu[16];
#pragma unroll
      for (int i = 0; i < 4; ++i) { float4 v = *(const float4*)(sUw + t * 16 + 4 * i); uu[4 * i] = v.x; uu[4 * i + 1] = v.y; uu[4 * i + 2] = v.z; uu[4 * i + 3] = v.w; }
      float bur = 0.f, bui = 0.f;
#pragma unroll
      for (int c = 0; c < 16; ++c) { bur += bbr[c] * uu[c]; bui += bbi[c] * uu[c]; }
      const float nhr = abr * hr - abi * hi + bur, nhi = abr * hi + abi * hr + bui;
      hr = nhr; hi = nhi;
    }
    float* s1re = (float*)(p.ws + OFF_QMLA);
    float* s1im = s1re + 2097152;
    const size_t idx = ((size_t)(b * 128 + chunk) * 32 + g) * 64 + n;
    s1re[idx] = hr; s1im[idx] = hi;
    asm volatile("s_waitcnt lgkmcnt(0)" ::: "memory");
    return;
  } else {
    float cr[16], ci[16];
#pragma unroll
    for (int c = 0; c < 16; ++c) { cr[c] = p.in[20][(size_t)(g * 16 + c) * 64 + n]; ci[c] = p.in[21][(size_t)(g * 16 + c) * 64 + n]; }
    if (isS) { hr = p.in[4][(size_t)(b * 32 + g) * 64 + n]; hi = p.in[5][(size_t)(b * 32 + g) * 64 + n]; }
    else {
      const float* hinre = (const float*)(p.ws + OFF_QMLA) + 2 * 2097152;
      const float* hinim = hinre + 2097152;
      const size_t idx = ((size_t)(b * 128 + chunk) * 32 + g) * 64 + n;
      hr = hinre[idx]; hi = hinim[idx];
    }
    const int b0 = lane & 1, b1 = (lane >> 1) & 1, b2 = (lane >> 2) & 1, b3 = (lane >> 3) & 1;
    const int cc = b0 * 8 + b1 * 4 + b2 * 2 + b3;
    const int quad = lane >> 4;
    const float dsk = p.in[22][g * 16 + cc];
    bf16_t* zbuf = (bf16_t*)(p.ws + OFF_Z);
    float zkeep = 0.f;
#pragma unroll 2
    for (int t = 0; t < 32; ++t) {
      float uu[16];
#pragma unroll
      for (int i = 0; i < 4; ++i) { float4 v = *(const float4*)(sUw + t * 16 + 4 * i); uu[4 * i] = v.x; uu[4 * i + 1] = v.y; uu[4 * i + 2] = v.z; uu[4 * i + 3] = v.w; }
      float bur = 0.f, bui = 0.f;
#pragma unroll
      for (int c = 0; c < 16; ++c) { bur += bbr[c] * uu[c]; bui += bbi[c] * uu[c]; }
      const float nhr = abr * hr - abi * hi + bur, nhi = abr * hi + abi * hr + bui;
      hr = nhr; hi = nhi;
      float v16[16];
#pragma unroll
      for (int c = 0; c < 16; ++c) v16[c] = hr * cr[c] - hi * ci[c];
      float v8[8], v4[4], v2[2], v1;
#pragma unroll
      for (int i = 0; i < 8; ++i) { float keep = b0 ? v16[8 + i] : v16[i]; float send = b0 ? v16[i] : v16[8 + i]; v8[i] = keep + __shfl_xor(send, 1); }
#pragma unroll
      for (int i = 0; i < 4; ++i) { float keep = b1 ? v8[4 + i] : v8[i]; float send = b1 ? v8[i] : v8[4 + i]; v4[i] = keep + __shfl_xor(send, 2); }
#pragma unroll
      for (int i = 0; i < 2; ++i) { float keep = b2 ? v4[2 + i] : v4[i]; float send = b2 ? v4[i] : v4[2 + i]; v2[i] = keep + __shfl_xor(send, 4); }
      { float keep = b3 ? v2[1] : v2[0]; float send = b3 ? v2[0] : v2[1]; v1 = keep + __shfl_xor(send, 8); }
      v1 += __shfl_xor(v1, 16);
      v1 += __shfl_xor(v1, 32);
      const float y = v1 + dsk * sUw[t * 16 + cc];
      const float z = gelu_tanh(y);
      if (quad == (t & 3)) zkeep = z;
      if ((t & 3) == 3) zbuf[(size_t)(tok0 + t - 3 + quad) * 512 + g * 16 + cc] = f2bf(zkeep);
    }
    if (isS) {
      p.out[O_SSMRE_S + (size_t)(b * 32 + g) * 64 + n] = hr;
      p.out[O_SSMIM_S + (size_t)(b * 32 + g) * 64 + n] = hi;
    }
    asm volatile("s_waitcnt lgkmcnt(0)" ::: "memory");
  }
}

#define TAB_V_OFF 16777216ull
#define TAB_SU_OFF 33554432ull
#define TAB_SV_OFF (33554432ull + 65536ull)
__device__ __forceinline__ void quant_rows(const float* __restrict__ src, unsigned char* __restrict__ dst, float* __restrict__ scales, int gw, int nw, int tid) {
  const int lane = tid & 63;
  for (int row = gw; row < 16384; row += nw) {
    const float* r = src + (size_t)row * 1024 + lane * 16;
    float x[16];
#pragma unroll
    for (int i = 0; i < 4; ++i) { float4 v = *(const float4*)(r + 4 * i); x[4 * i] = v.x; x[4 * i + 1] = v.y; x[4 * i + 2] = v.z; x[4 * i + 3] = v.w; }
    float am = 0.f;
#pragma unroll
    for (int i = 0; i < 16; ++i) am = fmaxf(am, fabsf(x[i]));
#pragma unroll
    for (int o = 32; o; o >>= 1) am = fmaxf(am, __shfl_xor(am, o));
    const float inv = (am > 0.f) ? 127.f / am : 0.f;
    unsigned q[4];
#pragma unroll
    for (int i = 0; i < 4; ++i) {
      unsigned b0 = (unsigned)((int)rintf(x[4 * i] * inv)) & 255u, b1 = (unsigned)((int)rintf(x[4 * i + 1] * inv)) & 255u;
      unsigned b2 = (unsigned)((int)rintf(x[4 * i + 2] * inv)) & 255u, b3 = (unsigned)((int)rintf(x[4 * i + 3] * inv)) & 255u;
      q[i] = b0 | (b1 << 8) | (b2 << 16) | (b3 << 24);
    }
    *(uint4*)(dst + (size_t)row * 1024 + lane * 16) = make_uint4(q[0], q[1], q[2], q[3]);
    if (lane == 0) scales[row] = am * (1.f / 127.f);
  }
}

__device__ __forceinline__ float ub0(unsigned u) { return (float)(u & 0xffu); }
__device__ __forceinline__ float ub1(unsigned u) { return (float)((u >> 8) & 0xffu); }
__device__ __forceinline__ float ub2(unsigned u) { return (float)((u >> 16) & 0xffu); }
__device__ __forceinline__ float ub3(unsigned u) { return (float)(u >> 24); }
__device__ __forceinline__ float dot16(const float* xn, uint4 u) {
  float d = 0.f;
  d += xn[0] * ub0(u.x); d += xn[1] * ub1(u.x); d += xn[2] * ub2(u.x); d += xn[3] * ub3(u.x);
  d += xn[4] * ub0(u.y); d += xn[5] * ub1(u.y); d += xn[6] * ub2(u.y); d += xn[7] * ub3(u.y);
  d += xn[8] * ub0(u.z); d += xn[9] * ub1(u.z); d += xn[10] * ub2(u.z); d += xn[11] * ub3(u.z);
  d += xn[12] * ub0(u.w); d += xn[13] * ub1(u.w); d += xn[14] * ub2(u.w); d += xn[15] * ub3(u.w);
  return d;
}
__device__ __forceinline__ void axpy16(float* acc, float a, uint4 u) {
  acc[0] += a * ub0(u.x); acc[1] += a * ub1(u.x); acc[2] += a * ub2(u.x); acc[3] += a * ub3(u.x);
  acc[4] += a * ub0(u.y); acc[5] += a * ub1(u.y); acc[6] += a * ub2(u.y); acc[7] += a * ub3(u.y);
  acc[8] += a * ub0(u.z); acc[9] += a * ub1(u.z); acc[10] += a * ub2(u.z); acc[11] += a * ub3(u.z);
  acc[12] += a * ub0(u.w); acc[13] += a * ub1(u.w); acc[14] += a * ub2(u.w); acc[15] += a * ub3(u.w);
}

template <bool FINAL, bool DRY>
__device__ __forceinline__ void peer_token(int tid, const Params& p, int layer, int tok) {
  const int lane = tid & 63;
  float* xres = p.out + O_Y;
  const float* gain = p.in[10] + layer * 1024;
  const unsigned char* U = p.ws + OFF_TAB;
  const unsigned char* V = U + TAB_V_OFF;
  const int* ebuf = (const int*)(p.ws + OFF_M);
  const float* gbuf = (const float*)(p.ws + OFF_M + 17301504ull);
  const float* sus = (const float*)(p.ws + OFF_TAB + TAB_SU_OFF);
  const float* svs = (const float*)(p.ws + OFF_TAB + TAB_SV_OFF);
  float* xr = xres + (size_t)tok * 1024 + lane * 16;
  float x[16], xn[16], acc[16];
  float ss = 0.f, sx = 0.f;
#pragma unroll
  for (int i = 0; i < 4; ++i) {
    float4 v = *(const float4*)(xr + 4 * i);
    float4 g = *(const float4*)(gain + lane * 16 + 4 * i);
    x[4 * i] = v.x; x[4 * i + 1] = v.y; x[4 * i + 2] = v.z; x[4 * i + 3] = v.w;
    xn[4 * i] = v.x * g.x; xn[4 * i + 1] = v.y * g.y; xn[4 * i + 2] = v.z * g.z; xn[4 * i + 3] = v.w * g.w;
    ss += v.x * v.x + v.y * v.y + v.z * v.z + v.w * v.w;
    sx += xn[4 * i] + xn[4 * i + 1] + xn[4 * i + 2] + xn[4 * i + 3];
  }
  ss = wave_sum(ss);
  sx = wave_sum(sx);
  const float rstd = rsqrtf(ss * (1.f / 1024.f) + 1e-6f);
#pragma unroll
  for (int i = 0; i < 16; ++i) acc[i] = 0.f;
  float sumA = 0.f;
  const int b0 = lane & 1, b1 = (lane >> 1) & 1, b2 = (lane >> 2) & 1;
  const int pe = b0 * 4 + b1 * 2 + b2;
  const size_t pbase = (size_t)tok * 128 + pe;
#pragma unroll 1
  for (int kb = 0; kb < 16; ++kb) {
    const int myeid = ebuf[pbase + kb * 8];
    const float myg = gbuf[pbase + kb * 8] * svs[myeid];
    const float mysu = sus[myeid];
    uint4 uu[8], vv[8];
#pragma unroll
    for (int j = 0; j < 8; ++j) {
      const int src = ((j & 1) << 2) | (j & 2) | ((j >> 2) & 1);
      const int eid = __builtin_amdgcn_readlane(myeid, src);
      uu[j] = *(const uint4*)(U + (size_t)eid * 1024 + lane * 16);
      vv[j] = *(const uint4*)(V + (size_t)eid * 1024 + lane * 16);
    }
    float d[8];
#pragma unroll
    for (int j = 0; j < 8; ++j) d[j] = dot16(xn, uu[j]);
    float w4[4], w2[2], w1;
#pragma unroll
    for (int i = 0; i < 4; ++i) { float keep = b0 ? d[4 + i] : d[i]; float send = b0 ? d[i] : d[4 + i]; w4[i] = keep + __shfl_xor(send, 1); }
#pragma unroll
    for (int i = 0; i < 2; ++i) { float keep = b1 ? w4[2 + i] : w4[i]; float send = b1 ? w4[i] : w4[2 + i]; w2[i] = keep + __shfl_xor(send, 2); }
    { float keep = b2 ? w2[1] : w2[0]; float send = b2 ? w2[0] : w2[1]; w1 = keep + __shfl_xor(send, 4); }
    w1 += __shfl_xor(w1, 8); w1 += __shfl_xor(w1, 16); w1 += __shfl_xor(w1, 32);
    const float dot = rstd * mysu * (w1 - 128.f * sx);
    const float a = gelu_erf(dot) * myg;
#pragma unroll
    for (int j = 0; j < 8; ++j) {
      const int src = ((j & 1) << 2) | (j & 2) | ((j >> 2) & 1);
      const float A = __int_as_float(__builtin_amdgcn_readlane(__float_as_int(a), src));
      sumA += A;
      axpy16(acc, A, vv[j]);
    }
  }
  float y[16];
#pragma unroll
  for (int i = 0; i < 16; ++i) y[i] = x[i] + acc[i] - 128.f * sumA;
  if (FINAL) {
    float s2 = 0.f;
#pragma unroll
    for (int i = 0; i < 16; ++i) s2 += y[i] * y[i];
    s2 = wave_sum(s2);
    const float r2 = rsqrtf(s2 * (1.f / 1024.f) + 1e-6f);
    const float* gf = p.in[11] + lane * 16;
#pragma unroll
    for (int i = 0; i < 4; ++i) {
      float4 g = *(const float4*)(gf + 4 * i);
      y[4 * i] *= r2 * g.x; y[4 * i + 1] *= r2 * g.y; y[4 * i + 2] *= r2 * g.z; y[4 * i + 3] *= r2 * g.w;
    }
  }
  if (DRY && ss != -1.f) return;
#pragma unroll
  for (int i = 0; i < 4; ++i) *(float4*)(xr + 4 * i) = make_float4(y[4 * i], y[4 * i + 1], y[4 * i + 2], y[4 * i + 3]);
}

#define OFF_PD OFF_MIX
#define OFF_PSS OFF_KP
#define OFF_PSX (OFF_KP + 1081344ull)
template <int CTRL> __device__ __forceinline__ int dpp_i(int v) { return __builtin_amdgcn_update_dpp(0, v, CTRL, 0xf, 0xf, true); }
__device__ __forceinline__ unsigned packq4(float a, float b, float c, float d, float inv) {
  const unsigned q0 = (unsigned)((int)rintf(a * inv)) & 255u, q1 = (unsigned)((int)rintf(b * inv)) & 255u;
  const unsigned q2 = (unsigned)((int)rintf(c * inv)) & 255u, q3 = (unsigned)((int)rintf(d * inv));
  return q0 | (q1 << 8) | (q2 << 16) | (q3 << 24);
}
__device__ __forceinline__ void peer9a_token(int tid, const Params& p, int layer, int tok, int j) {
  const int lane = tid & 63, g8 = lane >> 3, sub = lane & 7;
  const float* xr = p.out + O_Y + (size_t)tok * 1024 + j * 128 + sub * 16;
  const float* gn = p.in[10] + layer * 1024 + j * 128 + sub * 16;
  const unsigned char* U = p.ws + OFF_TAB + j * 128 + sub * 16;
  const int* eb = (const int*)(p.ws + OFF_M) + (size_t)tok * 128 + g8;
  float* pd = (float*)(p.ws + OFF_PD) + ((size_t)tok * 8 + j) * 128;
  int eid[16];
#pragma unroll
  for (int k = 0; k < 16; ++k) eid[k] = eb[k * 8];
  float xs[16];
  float ss = 0.f, am = 0.f;
#pragma unroll
  for (int i = 0; i < 4; ++i) {
    float4 v = *(const float4*)(xr + 4 * i);
    float4 g = *(const float4*)(gn + 4 * i);
    xs[4 * i] = v.x * g.x; xs[4 * i + 1] = v.y * g.y; xs[4 * i + 2] = v.z * g.z; xs[4 * i + 3] = v.w * g.w;
    ss += v.x * v.x + v.y * v.y + v.z * v.z + v.w * v.w;
    am = fmaxf(fmaxf(am, fmaxf(fabsf(xs[4 * i]), fabsf(xs[4 * i + 1]))), fmaxf(fabsf(xs[4 * i + 2]), fabsf(xs[4 * i + 3])));
  }
  uint4 rows[16];
#pragma unroll
  for (int k = 0; k < 16; ++k) rows[k] = *(const uint4*)(U + (size_t)eid[k] * 1024);
  am = fmaxf(am, dpp_f<0xB1>(am)); am = fmaxf(am, dpp_f<0x4E>(am)); am = fmaxf(am, dpp_f<0x141>(am));
  const float inv = (am > 0.f) ? 127.f / am : 0.f;
  const float xscale = am * (1.f / 127.f);
  int xq[4];
#pragma unroll
  for (int d = 0; d < 4; ++d) xq[d] = (int)packq4(xs[4 * d], xs[4 * d + 1], xs[4 * d + 2], xs[4 * d + 3], inv);
  int keep0 = 0, keep1 = 0;
#pragma unroll
  for (int k = 0; k < 16; ++k) {
    int D = __builtin_amdgcn_sdot4((int)rows[k].x, xq[0], 0, false);
    D = __builtin_amdgcn_sdot4((int)rows[k].y, xq[1], D, false);
    D = __builtin_amdgcn_sdot4((int)rows[k].z, xq[2], D, false);
    D = __builtin_amdgcn_sdot4((int)rows[k].w, xq[3], D, false);
    D += dpp_i<0xB1>(D); D += dpp_i<0x4E>(D); D += dpp_i<0x141>(D);
    if (k < 8) keep0 = (sub == k) ? D : keep0; else keep1 = (sub == k - 8) ? D : keep1;
  }
  pd[sub * 8 + g8] = (float)keep0 * xscale;
  pd[64 + sub * 8 + g8] = (float)keep1 * xscale;
  ss += dpp_f<0xB1>(ss); ss += dpp_f<0x4E>(ss); ss += dpp_f<0x141>(ss);
  if (lane == 0) ((float*)(p.ws + OFF_PSS))[(size_t)tok * 8 + j] = ss;
}

__device__ __forceinline__ void peer9m_token(int tid, unsigned char* smem, const Params& p, int tok) {
  const int lane = tid & 63, w = __builtin_amdgcn_readfirstlane(tid >> 6);
  unsigned char* sAq = smem + w * 128;
  const float* pd = (const float*)(p.ws + OFF_PD) + (size_t)tok * 1024;
  float* pss = (float*)(p.ws + OFF_PSS) + (size_t)tok * 8;
  const int* ebuf = (const int*)(p.ws + OFF_M) + (size_t)tok * 128;
  float* gbuf = (float*)(p.ws + OFF_M + 17301504ull) + (size_t)tok * 128;
  const float* sus = (const float*)(p.ws + OFF_TAB + TAB_SU_OFF);
  const float* svs = (const float*)(p.ws + OFF_TAB + TAB_SV_OFF);
  float ss = 0.f, d0 = 0.f, d1 = 0.f;
#pragma unroll
  for (int j = 0; j < 8; ++j) { ss += pss[j]; d0 += pd[j * 128 + lane]; d1 += pd[j * 128 + 64 + lane]; }
  const int e0 = ebuf[lane], e1 = ebuf[64 + lane];
  const float rstd = rsqrtf(ss * (1.f / 1024.f) + 1e-6f);
  const float a0 = gelu_erf(rstd * sus[e0] * d0) * gbuf[lane] * svs[e0];
  const float a1 = gelu_erf(rstd * sus[e1] * d1) * gbuf[64 + lane] * svs[e1];
  float am = row16_max(fmaxf(fabsf(a0), fabsf(a1)));
  {
    const float m0 = __int_as_float(__builtin_amdgcn_readlane(__float_as_int(am), 0)), m1 = __int_as_float(__builtin_amdgcn_readlane(__float_as_int(am), 16));
    const float m2 = __int_as_float(__builtin_amdgcn_readlane(__float_as_int(am), 32)), m3 = __int_as_float(__builtin_amdgcn_readlane(__float_as_int(am), 48));
    am = fmaxf(fmaxf(m0, m1), fmaxf(m2, m3));
  }
  const float inv = (am > 0.f) ? 127.f / am : 0.f;
  const int addr0 = (lane & 7) * 16 + (lane >> 3);
  sAq[addr0] = (unsigned char)((int)rintf(a0 * inv) & 255);
  sAq[addr0 + 8] = (unsigned char)((int)rintf(a1 * inv) & 255);
  asm volatile("s_waitcnt lgkmcnt(0)" ::: "memory");
  unsigned pk = 0u;
  if (lane < 32) pk = ((const unsigned*)sAq)[lane];
  asm volatile("s_waitcnt vmcnt(0) lgkmcnt(0)" ::: "memory");
  if (lane < 32) ((unsigned*)gbuf)[lane] = pk;
  if (lane == 0) pss[0] = am * (1.f / 127.f);
  asm volatile("s_waitcnt lgkmcnt(0)" ::: "memory");
}

__device__ __forceinline__ void peer9b_token(int tid, const Params& p, int tok, int j) {
  const int lane = tid & 63, g8 = lane >> 3, sub = lane & 7;
  float* xr = p.out + O_Y + (size_t)tok * 1024 + j * 128 + sub * 16;
  const unsigned char* V = p.ws + OFF_TAB + TAB_V_OFF + j * 128 + sub * 16;
  const int* eb = (const int*)(p.ws + OFF_M) + (size_t)tok * 128 + g8;
  const uint4 apk = *(const uint4*)((const unsigned*)(p.ws + OFF_M + 17301504ull) + (size_t)tok * 128 + g8 * 4);
  const float scaleA = ((const float*)(p.ws + OFF_PSS))[(size_t)tok * 8];
  int eid[16];
#pragma unroll
  for (int k = 0; k < 16; ++k) eid[k] = eb[k * 8];
  uint4 rows[16];
#pragma unroll
  for (int k = 0; k < 16; ++k) rows[k] = *(const uint4*)(V + (size_t)eid[k] * 1024);
  int acci[16];
#pragma unroll
  for (int i = 0; i < 16; ++i) acci[i] = 0;
#define P9B_DW(DWF, DW, AP, KQ) { \
    const unsigned r0 = rows[(KQ) * 4 + 0].DWF, r1 = rows[(KQ) * 4 + 1].DWF, r2 = rows[(KQ) * 4 + 2].DWF, r3 = rows[(KQ) * 4 + 3].DWF; \
    const unsigned t0 = __builtin_amdgcn_perm(r1, r0, 0x05010400u), t1 = __builtin_amdgcn_perm(r1, r0, 0x07030602u); \
    const unsigned t2 = __builtin_amdgcn_perm(r3, r2, 0x05010400u), t3 = __builtin_amdgcn_perm(r3, r2, 0x07030602u); \
    acci[(DW) * 4 + 0] = __builtin_amdgcn_sdot4((int)__builtin_amdgcn_perm(t2, t0, 0x05040100u), (int)(AP), acci[(DW) * 4 + 0], false); \
    acci[(DW) * 4 + 1] = __builtin_amdgcn_sdot4((int)__builtin_amdgcn_perm(t2, t0, 0x07060302u), (int)(AP), acci[(DW) * 4 + 1], false); \
    acci[(DW) * 4 + 2] = __builtin_amdgcn_sdot4((int)__builtin_amdgcn_perm(t3, t1, 0x05040100u), (int)(AP), acci[(DW) * 4 + 2], false); \
    acci[(DW) * 4 + 3] = __builtin_amdgcn_sdot4((int)__builtin_amdgcn_perm(t3, t1, 0x07060302u), (int)(AP), acci[(DW) * 4 + 3], false); }
#define P9B_KQ(AP, KQ) { P9B_DW(x, 0, AP, KQ) P9B_DW(y, 1, AP, KQ) P9B_DW(z, 2, AP, KQ) P9B_DW(w, 3, AP, KQ) }
  P9B_KQ(apk.x, 0) P9B_KQ(apk.y, 1) P9B_KQ(apk.z, 2) P9B_KQ(apk.w, 3)
  float acc[16];
#pragma unroll
  for (int i = 0; i < 16; ++i) acc[i] = (float)acci[i] * scaleA;
  const int b3 = (lane >> 3) & 1, b4 = (lane >> 4) & 1, b5 = (lane >> 5) & 1;
  float v8[8], v4[4], v2[2];
#pragma unroll
  for (int i = 0; i < 8; ++i) { float keep = b3 ? acc[8 + i] : acc[i]; float send = b3 ? acc[i] : acc[8 + i]; v8[i] = keep + dpp_f<0x128>(send); }
#pragma unroll
  for (int i = 0; i < 4; ++i) { float keep = b4 ? v8[4 + i] : v8[i]; float send = b4 ? v8[i] : v8[4 + i]; v4[i] = keep + __shfl_xor(send, 16); }
#pragma unroll
  for (int i = 0; i < 2; ++i) { float keep = b5 ? v4[2 + i] : v4[i]; float send = b5 ? v4[i] : v4[2 + i]; v2[i] = keep + __shfl_xor(send, 32); }
  const int c = b3 * 8 + b4 * 4 + b5 * 2;
  float2 xv = *(const float2*)(xr + c);
  xv.x += v2[0];
  xv.y += v2[1];
  *(float2*)(xr + c) = xv;
}

__device__ __forceinline__ void final_norm_token(int tid, const Params& p, int tok) {
  const int lane = tid & 63;
  float* xr = p.out + O_Y + (size_t)tok * 1024 + lane * 16;
  const float* gf = p.in[11] + lane * 16;
  float y[16]; float s2 = 0.f;
#pragma unroll
  for (int i = 0; i < 4; ++i) { float4 v = *(const float4*)(xr + 4 * i); y[4 * i] = v.x; y[4 * i + 1] = v.y; y[4 * i + 2] = v.z; y[4 * i + 3] = v.w; s2 += v.x * v.x + v.y * v.y + v.z * v.z + v.w * v.w; }
  s2 = wave_sum(s2);
  const float r2 = rsqrtf(s2 * (1.f / 1024.f) + 1e-6f);
#pragma unroll
  for (int i = 0; i < 4; ++i) {
    float4 g = *(const float4*)(gf + 4 * i);
    *(float4*)(xr + 4 * i) = make_float4(y[4 * i] * r2 * g.x, y[4 * i + 1] * r2 * g.y, y[4 * i + 2] * r2 * g.z, y[4 * i + 3] * r2 * g.w);
  }
}

__device__ __forceinline__ unsigned f2ukey(float v) { unsigned u = __float_as_uint(v); return (u & 0x80000000u) ? ~u : (u | 0x80000000u); }
__device__ __forceinline__ float ukey2f(unsigned k) { unsigned u = (k & 0x80000000u) ? (k & 0x7fffffffu) : ~k; return __uint_as_float(u); }
__device__ __forceinline__ int popc64(unsigned long long m) { return __builtin_popcountll(m); }
__device__ __forceinline__ int mbcnt64(unsigned long long m) { return (int)__builtin_amdgcn_mbcnt_hi((unsigned)(m >> 32), __builtin_amdgcn_mbcnt_lo((unsigned)m, 0u)); }

struct TopkFrags { bf16x8 a[2][2]; bf16x8 b[2][2]; };
__device__ __forceinline__ void topk_load(TopkFrags& f, int tid, const Params& p, int layer, int item) {
  const int lane = tid & 63, w = __builtin_amdgcn_readfirstlane(tid >> 6);
  const int l16 = lane & 15, quad = lane >> 4;
  const int h = item & 7, tok0 = (item >> 3) * 32;
  const int pp = w >> 2;
  const bf16_t* qb = (const bf16_t*)(p.ws + OFF_QBUF);
  const bf16_t* keys = (const bf16_t*)(p.ws + OFF_WT) + WT_KEYS + (size_t)((layer * 8 + h) * 2 + pp) * 8192;
#pragma unroll
  for (int ks = 0; ks < 2; ++ks) {
#pragma unroll
    for (int mt = 0; mt < 2; ++mt) f.a[ks][mt] = *(const bf16x8*)(qb + (size_t)(tok0 + mt * 16 + l16) * 1024 + h * 128 + pp * 64 + ks * 32 + quad * 8);
#pragma unroll
    for (int j = 0; j < 2; ++j) {
      const int nt = (w & 3) * 2 + j;
      f.b[ks][j] = *(const bf16x8*)(keys + (nt * 16 + l16) * 64 + ks * 32 + quad * 8);
    }
  }
}

__device__ __forceinline__ void peer_topk_item(int tid, unsigned char* smem, const Params& p, const TopkFrags& f, int item) {
  unsigned* sS = (unsigned*)smem;
  const int lane = tid & 63, w = __builtin_amdgcn_readfirstlane(tid >> 6);
  const int l16 = lane & 15, quad = lane >> 4;
  const int h = item & 7, tile = item >> 3;
  const int tok0 = tile * 32;
  unsigned* wtop = (unsigned*)(smem + 32768) + w * 256;
  float* wexp = (float*)(wtop + 128);
  __syncthreads();
  {
    const int pp = w >> 2;
    f32x4 acc[2][2];
#pragma unroll
    for (int i = 0; i < 2; ++i)
#pragma unroll
      for (int j = 0; j < 2; ++j) acc[i][j] = (f32x4){0.f, 0.f, 0.f, 0.f};
#pragma unroll
    for (int ks = 0; ks < 2; ++ks)
#pragma unroll
      for (int mt = 0; mt < 2; ++mt)
#pragma unroll
        for (int j = 0; j < 2; ++j) acc[mt][j] = __builtin_amdgcn_mfma_f32_16x16x32_bf16(f.a[ks][mt], f.b[ks][j], acc[mt][j], 0, 0, 0);
#pragma unroll
    for (int mt = 0; mt < 2; ++mt)
#pragma unroll
      for (int j = 0; j < 2; ++j) {
        const int nt = (w & 3) * 2 + j;
#pragma unroll
        for (int r = 0; r < 4; ++r) {
          const int key = nt * 16 + l16;
          sS[((mt * 16 + quad * 4 + r) * 2 + pp) * 128 + key] = (f2ukey(acc[mt][j][r]) & ~127u) | (unsigned)(127 - key);
        }
      }
  }
  __syncthreads();
  int* ebuf = (int*)(p.ws + OFF_M);
  float* gbuf = (float*)(p.ws + OFF_M + 17301504ull);
  unsigned k0[8], k1[8], T[8];
#pragma unroll
  for (int c = 0; c < 8; ++c) {
    const unsigned* row = sS + ((w * 4 + (c >> 1)) * 2 + (c & 1)) * 128;
    k0[c] = row[lane]; k1[c] = row[64 + lane]; T[c] = 0u;
  }
#pragma unroll 1
  for (int bit = 31; bit >= 7; --bit) {
    const unsigned bm = 1u << bit;
#pragma unroll
    for (int c = 0; c < 8; ++c) {
      const unsigned cand = T[c] | bm;
      const int cnt = popc64(__builtin_amdgcn_ballot_w64(k0[c] >= cand)) + popc64(__builtin_amdgcn_ballot_w64(k1[c] >= cand));
      T[c] = (cnt >= 16) ? cand : T[c];
    }
  }
  {
    bool need = false;
#pragma unroll
    for (int c = 0; c < 8; ++c) {
      const int cnt = popc64(__builtin_amdgcn_ballot_w64(k0[c] >= T[c])) + popc64(__builtin_amdgcn_ballot_w64(k1[c] >= T[c]));
      need = need || (cnt > 16);
    }
    if (need) {
#pragma unroll 1
      for (int bit = 6; bit >= 0; --bit) {
        const unsigned bm = 1u << bit;
#pragma unroll
        for (int c = 0; c < 8; ++c) {
          const unsigned cand = T[c] | bm;
          const int cnt = popc64(__builtin_amdgcn_ballot_w64(k0[c] >= cand)) + popc64(__builtin_amdgcn_ballot_w64(k1[c] >= cand));
          T[c] = (cnt >= 16) ? cand : T[c];
        }
      }
    }
  }
#pragma unroll
  for (int c = 0; c < 8; ++c) {
    const unsigned long long m0 = __builtin_amdgcn_ballot_w64(k0[c] >= T[c]);
    const unsigned long long m1 = __builtin_amdgcn_ballot_w64(k1[c] >= T[c]);
    const int s0 = mbcnt64(m0), s1 = popc64(m0) + mbcnt64(m1);
    if (k0[c] >= T[c]) wtop[c * 16 + s0] = k0[c];
    if (k1[c] >= T[c]) wtop[c * 16 + s1] = k1[c];
  }
  asm volatile("s_waitcnt lgkmcnt(0)" ::: "memory");
#define ROR_CNT(S) { const unsigned o_ = (unsigned)__builtin_amdgcn_update_dpp(0, (int)key_, 0x120 + (S), 0xf, 0xf, true); rk_ += (o_ > key_) ? 1 : 0; }
#pragma unroll
  for (int pass = 0; pass < 2; ++pass) {
    const int L = pass * 4 + (lane >> 4);
    const unsigned key_ = wtop[L * 16 + (lane & 15)];
    int rk_ = 0;
    ROR_CNT(1) ROR_CNT(2) ROR_CNT(3) ROR_CNT(4) ROR_CNT(5) ROR_CNT(6) ROR_CNT(7) ROR_CNT(8)
    ROR_CNT(9) ROR_CNT(10) ROR_CNT(11) ROR_CNT(12) ROR_CNT(13) ROR_CNT(14) ROR_CNT(15)
    wtop[L * 16 + rk_] = key_;
  }
  asm volatile("s_waitcnt lgkmcnt(0)" ::: "memory");
  int ci = (lane >= 16) + (lane >= 24) + (lane >= 29) + (lane >= 33) + (lane >= 36) + (lane >= 38) + (lane >= 40) + (lane >= 42);
#pragma unroll
  for (int t = 43; t < 50; ++t) ci += (lane >= t);
  int cstart = 0;
  cstart = (ci >= 1) ? 16 : cstart; cstart = (ci >= 2) ? 24 : cstart; cstart = (ci >= 3) ? 29 : cstart; cstart = (ci >= 4) ? 33 : cstart;
  cstart = (ci >= 5) ? 36 : cstart; cstart = (ci >= 6) ? 38 : cstart; cstart = (ci >= 7) ? 40 : cstart; cstart = (ci >= 8) ? 42 : cstart;
  cstart = (ci >= 9) ? (34 + ci) : cstart;
  const int cj = lane - cstart;
  const bool cvalid = lane < 50;
  unsigned kav[4], kbv[4], ck[4], T2[4]; float cs[4];
#pragma unroll
  for (int t = 0; t < 4; ++t) {
    kav[t] = 0u; kbv[t] = 0u; cs[t] = 0.f; ck[t] = 0u; T2[t] = 0u;
    if (cvalid) {
      kav[t] = wtop[(t * 2) * 16 + ci]; kbv[t] = wtop[(t * 2 + 1) * 16 + cj];
      cs[t] = ukey2f(kav[t]) + ukey2f(kbv[t]);
      ck[t] = ((f2ukey(cs[t]) & ~63u) | (unsigned)(63 - lane)) | 0u;
      ck[t] = (ck[t] == 0u) ? 1u : ck[t];
    }
  }
#pragma unroll 1
  for (int bit = 31; bit >= 6; --bit) {
    const unsigned bm = 1u << bit;
#pragma unroll
    for (int t = 0; t < 4; ++t) {
      const unsigned cand = T2[t] | bm;
      const int cnt = popc64(__builtin_amdgcn_ballot_w64(ck[t] >= cand));
      T2[t] = (cnt >= 16) ? cand : T2[t];
    }
  }
  {
    bool need = false;
#pragma unroll
    for (int t = 0; t < 4; ++t) need = need || (popc64(__builtin_amdgcn_ballot_w64(ck[t] >= T2[t])) > 16);
    if (need) {
#pragma unroll 1
      for (int bit = 5; bit >= 0; --bit) {
        const unsigned bm = 1u << bit;
#pragma unroll
        for (int t = 0; t < 4; ++t) {
          const unsigned cand = T2[t] | bm;
          const int cnt = popc64(__builtin_amdgcn_ballot_w64(ck[t] >= cand));
          T2[t] = (cnt >= 16) ? cand : T2[t];
        }
      }
    }
  }
  int* weid = (int*)(wexp + 64);
#pragma unroll
  for (int t = 0; t < 4; ++t) {
    const float cT = ukey2f(T2[t]);
    const bool win = ck[t] >= T2[t];
    const int sl = mbcnt64(__builtin_amdgcn_ballot_w64(win));
    if (win) {
      wexp[t * 16 + sl] = __expf(fminf(cs[t] - cT, 60.f));
      weid[t * 16 + sl] = (127 - (int)(kav[t] & 127u)) * 128 + (127 - (int)(kbv[t] & 127u));
    }
  }
  asm volatile("s_waitcnt lgkmcnt(0)" ::: "memory");
  {
    const int t = lane >> 4, sl = lane & 15;
    float es = 0.f;
#pragma unroll
    for (int q = 0; q < 4; ++q) { const float4 ee = *(const float4*)(wexp + t * 16 + q * 4); es += ee.x + ee.y + ee.z + ee.w; }
    const float e = wexp[t * 16 + sl];
    const int id = weid[t * 16 + sl];
    const size_t o = (size_t)(tok0 + w * 4 + t) * 128 + h * 16 + sl;
    ebuf[o] = id;
    gbuf[o] = e / es;
  }
  asm volatile("s_waitcnt lgkmcnt(0)" ::: "memory");
}

struct EpiStoreBf16 { bf16_t* dst; int ld; __device__ void operator()(int r, int c, float v) const { dst[(size_t)r * ld + c] = f2bf(v); } };
struct EpiGlu { const bf16_t* z; const float* bias; bf16_t* mix; __device__ void operator()(int r, int c, float v) const {
  float zz = bf2f(z[(size_t)r * 512 + c]); float s = v + bias[c]; mix[(size_t)r * 1024 + 512 + c] = f2bf(zz / (1.f + __expf(-s))); } };
struct EpiRes0 { const float* xp; const float* xs; float* xres; __device__ void operator()(int r, int c, float v) const {
  float x = (r < T_P) ? xp[(size_t)r * 1024 + c] : xs[(size_t)(r - T_P) * 1024 + c]; xres[(size_t)r * 1024 + c] = x + v; } };
struct EpiRes1 { float* xres; __device__ void operator()(int r, int c, float v) const { xres[(size_t)r * 1024 + c] += v; } };
struct EpiPool { bf16_t* mix; const float* scale; int g; __device__ void operator()(int r, int c, float v) const {
  mix[(size_t)r * 1024 + g * 128 + c] = f2bf(v * scale[g * 128 + c]); } };
struct EpiKup { bf16_t* dst; int rowsPerB; int keyOff; int bStride; __device__ void operator()(int r, int c, float v) const {
  int b = r / rowsPerB, key = r % rowsPerB + keyOff; dst[((size_t)b * bStride + key) * 512 + c] = f2bf(v); } };
struct EpiVt { bf16_t* dst; int rowsPerB; int keyOff; int ldv; __device__ void operator()(int r, int c, float v) const {
  int b = r / rowsPerB, key = r % rowsPerB + keyOff; dst[((size_t)(b * 8 + (c >> 6)) * 64 + (c & 63)) * ldv + key] = f2bf(v); } };


typedef const Params __attribute__((address_space(4))) KParams;

constexpr size_t OFF_BAR = WS_NEED;
__device__ __forceinline__ void grid_barrier(unsigned* ctr, unsigned target) {
  asm volatile("s_waitcnt vmcnt(0)" ::: "memory");
  __syncthreads();
  if (threadIdx.x == 0) {
    __builtin_amdgcn_fence(__ATOMIC_RELEASE, "agent");
    asm volatile("s_waitcnt vmcnt(0)" ::: "memory");
    __hip_atomic_fetch_add(ctr, 1u, __ATOMIC_RELAXED, __HIP_MEMORY_SCOPE_AGENT);
    unsigned spins = 0;
    while (__hip_atomic_load(ctr, __ATOMIC_RELAXED, __HIP_MEMORY_SCOPE_AGENT) < target) {
      __builtin_amdgcn_s_sleep(1);
      if (++spins > (1u << 27)) break;
    }
    __builtin_amdgcn_fence(__ATOMIC_ACQUIRE, "agent");
    asm volatile("s_waitcnt vmcnt(0)" ::: "memory");
  }
  __syncthreads();
}
#define GRID_BAR() { unsigned* ctr_ = (unsigned*)(((KParams*)__builtin_amdgcn_kernarg_segment_ptr())->ws + OFF_BAR); bar_k += 1; grid_barrier(ctr_, (unsigned)bar_k * gridDim.x); }
#define PHASE_BEGIN \
  Params p; \
  { KParams* kp_ = (KParams*)__builtin_amdgcn_kernarg_segment_ptr(); asm volatile("" : "+s"(kp_)); \
    _Pragma("unroll") for (int i_ = 0; i_ < 38; ++i_) p.in[i_] = kp_->in[i_]; \
    p.out = kp_->out; p.ws = kp_->ws; } \
  int tid = threadIdx.x; asm volatile("" : "+v"(tid)); \
  const int lane = tid & 63, w = __builtin_amdgcn_readfirstlane(tid >> 6); \
  const int gw = blockIdx.x * 8 + w, nw = gridDim.x * 8; \
  const size_t gtid = (size_t)blockIdx.x * NT + tid, gthreads = (size_t)gridDim.x * NT; \
  bf16_t* wt = (bf16_t*)(p.ws + OFF_WT); \
  bf16_t* proj = (bf16_t*)(p.ws + OFF_PROJ); \
  bf16_t* mix = (bf16_t*)(p.ws + OFF_MIX); \
  bf16_t* qbuf = (bf16_t*)(p.ws + OFF_QBUF); \
  bf16_t* zbuf = (bf16_t*)(p.ws + OFF_Z); \
  float* xres = p.out + O_Y; \
  (void)lane; (void)gw; (void)nw; (void)gtid; (void)gthreads; (void)wt; (void)proj; (void)mix; (void)qbuf; (void)zbuf; (void)xres;

template <int LAYER>
__device__ __forceinline__ void peer_phases(int& bar_k, unsigned char* smem) {
  const int layer = LAYER;
    for (int rep_ = 0; rep_ < NREP(7); ++rep_)
    {
    PHASE_BEGIN
      int vb = 0;
      gemm_run<2>(tid, smem, xres, xres, T_TOT, 1024, p.in[10] + layer * 1024, wt + WT_PQ + (size_t)layer * 1048576, T_TOT, 1024, 1024, vb, EpiStoreBf16{qbuf, 1024});
    }
    GRID_BAR();
    for (int rep_ = 0; rep_ < NREP(8); ++rep_) {
    PHASE_BEGIN
    {
      TopkFrags fr;
      int item = blockIdx.x;
      if (item < 1056 * 8) topk_load(fr, tid, p, layer, item);
      for (; item < 1056 * 8; item += gridDim.x) {
        TopkFrags cur = fr;
        const int nxt = item + gridDim.x;
        if (nxt < 1056 * 8) topk_load(fr, tid, p, layer, nxt);
        peer_topk_item(tid, smem, p, cur, item);
      }
    }
    }
    GRID_BAR();
    for (int rep_ = 0; rep_ < NREP(9); ++rep_) {
    PHASE_BEGIN
      int j = blockIdx.x & 7, lb = blockIdx.x >> 3, nb = ((int)gridDim.x - j + 7) >> 3;
      {
        unsigned* cnt_ = (unsigned*)(p.ws + OFF_BAR) + 16;
        bool ok_ = true;
#pragma unroll
        for (int x_ = 0; x_ < 16; ++x_) {
          const unsigned c_ = __hip_atomic_load(&cnt_[x_], __ATOMIC_RELAXED, __HIP_MEMORY_SCOPE_AGENT);
          ok_ = ok_ && ((x_ < 8) ? (c_ > 0u) : (c_ == 0u));
        }
        if (ok_) {
          j = ((const int*)(smem + 45040))[0]; lb = ((const int*)(smem + 45040))[1];
          nb = (int)__hip_atomic_load(&cnt_[j], __ATOMIC_RELAXED, __HIP_MEMORY_SCOPE_AGENT);
        }
      }
      for (int tok = lb * 8 + w; tok < T_TOT; tok += nb * 8) peer9a_token(tid, p, layer, tok, j);
    }
    GRID_BAR();
    for (int rep_ = 0; rep_ < NREP(9); ++rep_) {
    PHASE_BEGIN
      for (int tok = gw; tok < T_TOT; tok += nw) peer9m_token(tid, smem, p, tok);
    }
    GRID_BAR();
    for (int rep_ = 0; rep_ < NREP(9); ++rep_) {
    PHASE_BEGIN
      int j = blockIdx.x & 7, lb = blockIdx.x >> 3, nb = ((int)gridDim.x - j + 7) >> 3;
      {
        unsigned* cnt_ = (unsigned*)(p.ws + OFF_BAR) + 16;
        bool ok_ = true;
#pragma unroll
        for (int x_ = 0; x_ < 16; ++x_) {
          const unsigned c_ = __hip_atomic_load(&cnt_[x_], __ATOMIC_RELAXED, __HIP_MEMORY_SCOPE_AGENT);
          ok_ = ok_ && ((x_ < 8) ? (c_ > 0u) : (c_ == 0u));
        }
        if (ok_) {
          j = ((const int*)(smem + 45040))[0]; lb = ((const int*)(smem + 45040))[1];
          nb = (int)__hip_atomic_load(&cnt_[j], __ATOMIC_RELAXED, __HIP_MEMORY_SCOPE_AGENT);
        }
      }
      for (int tok = lb * 8 + w; tok < T_TOT; tok += nb * 8) peer9b_token(tid, p, tok, j);
    }
    if (layer == 1) {
      GRID_BAR();
      for (int rep_ = 0; rep_ < NREP(9); ++rep_) {
      PHASE_BEGIN
        for (int tok = gw; tok < T_TOT; tok += nw) final_norm_token(tid, p, tok);
      }
    }
}

__global__ void __launch_bounds__(NT) mega(Params kparams_) {
  cg::grid_group grid = cg::this_grid();
  int bar_k = 0;
  __shared__ __attribute__((aligned(16))) unsigned char smem[45056];
  if (threadIdx.x == 0) {
    unsigned* cnt_ = (unsigned*)(((KParams*)__builtin_amdgcn_kernarg_segment_ptr())->ws + OFF_BAR) + 16;
    const unsigned xcc_ = (unsigned)__builtin_amdgcn_s_getreg((3 << 11) | 20) & 0xFu;
    const unsigned rank_ = __hip_atomic_fetch_add(&cnt_[xcc_], 1u, __ATOMIC_RELAXED, __HIP_MEMORY_SCOPE_AGENT);
    ((int*)(smem + 45040))[0] = (int)xcc_;
    ((int*)(smem + 45040))[1] = (int)rank_;
  }

  for (int rep_ = 0; rep_ < NREP(0); ++rep_)
  {
    PHASE_BEGIN
    int vb = 0;
    transpose_convert(tid, smem, p.in[12], wt + WT_IN_E, 1024, 1280, vb);
    transpose_convert(tid, smem, p.in[13], wt + WT_OUT_E, 1024, 1024, vb);
    transpose_convert(tid, smem, p.in[23], wt + WT_GLU, 512, 512, vb);
    transpose_convert(tid, smem, p.in[25], wt + WT_IN_O, 1024, 1312, vb);
    transpose_convert(tid, smem, p.in[26], wt + WT_OUT_O, 1024, 1024, vb);
    for (int g = 0; g < 4; ++g) transpose_convert(tid, smem, p.in[27] + g * 16384, wt + WT_POOL + g * 16384, 128, 128, vb);
    transpose_convert(tid, smem, p.in[31], wt + WT_UQ, 512, 768, vb);
    transpose_convert(tid, smem, p.in[32], wt + WT_UK, 256, 512, vb);
    transpose_convert(tid, smem, p.in[33], wt + WT_UV, 256, 512, vb);
    transpose_convert(tid, smem, p.in[34], wt + WT_PQ, 1024, 1024, vb);
    transpose_convert(tid, smem, p.in[34] + 1048576, wt + WT_PQ + 1048576, 1024, 1024, vb);
    convert_plain(tid, p.in[35], wt + WT_KEYS, 262144);
    quant_rows(p.in[36], p.ws + OFF_TAB, (float*)(p.ws + OFF_TAB + TAB_SU_OFF), gw, nw, tid);
    quant_rows(p.in[37], p.ws + OFF_TAB + TAB_V_OFF, (float*)(p.ws + OFF_TAB + TAB_SV_OFF), gw, nw, tid);
  }
  grid.sync();

  for (int rep_ = 0; rep_ < NREP(1); ++rep_)
  {
    PHASE_BEGIN
    int vb = 0;
    gemm_run<2>(tid, smem, p.in[0], p.in[1], T_P, 1024, p.in[9], wt + WT_IN_E, T_TOT, 1280, 1024, vb, EpiStoreBf16{proj, 1280});
  }
  GRID_BAR();

  for (int rep_ = 0; rep_ < NREP(2); ++rep_)
  {
    PHASE_BEGIN
    bf16_t* vt0 = (bf16_t*)(p.ws + OFF_VT0);
    bf16_t* kall = (bf16_t*)(p.ws + OFF_KALL);
    bf16_t* vtall = (bf16_t*)(p.ws + OFF_VTALL);
    for (int tok = gw; tok < T_TOT; tok += nw) {
      const bool isS = tok >= T_P;
      int b, t, pos;
      if (!isS) { b = tok >> 12; t = tok & 4095; pos = t; } else { int s = tok - T_P; b = s >> 5; t = s & 31; pos = 2048 + t; }
      bf16_t* row = proj + (size_t)tok * 1280;
      const int lm = lane & 7;
      float sn[8], cs[8];
#pragma unroll
      for (int j = 0; j < 8; ++j) { float inv = exp2f(-(float)j * (LOG2_THETA / 8.f)); sincos_rev((float)pos * inv, sn[j], cs[j]); }
      {
        uint4 qv = *(const uint4*)(row + lane * 8);
        float x[8]; unpack8(qv, x);
#pragma unroll
        for (int j = 0; j < 8; ++j) {
          float other = __shfl_xor(x[j], 1);
          if (lm == 0) x[j] = x[j] * cs[j] - other * sn[j];
          else if (lm == 1) x[j] = x[j] * cs[j] + other * sn[j];
        }
        *(uint4*)(row + lane * 8) = pack8(x);
      }
      {
        uint4 kv = make_uint4(0, 0, 0, 0);
        if (lane < 32) kv = *(const uint4*)(row + 512 + lane * 8);
        float x[8]; unpack8(kv, x);
#pragma unroll
        for (int j = 0; j < 8; ++j) {
          float other = __shfl_xor(x[j], 1);
          if (lane < 16) {
            if (lm == 0) x[j] = x[j] * cs[j] - other * sn[j];
            else if (lm == 1) x[j] = x[j] * cs[j] + other * sn[j];
          }
        }
        if (lane < 32) {
          const uint4 pk = pack8(x);
          const int e0 = (lane & 15) * 8;
          if (!isS) {
            if (lane < 16) *(uint4*)(row + 512 + lane * 8) = pk;
            else {
              const int kvh = e0 >> 6, d0 = e0 & 63;
#pragma unroll
              for (int j = 0; j < 8; ++j) vt0[((size_t)(b * 2 + kvh) * 64 + d0 + j) * 4096 + t] = f2bf(x[j]);
            }
            if (t >= 3968) {
              float* dst = p.out + ((lane < 16) ? O_SWAK_P : O_SWAV_P) + ((size_t)(b * 128 + (t - 3968)) * 128 + e0);
              *(float4*)dst = make_float4(x[0], x[1], x[2], x[3]);
              *(float4*)(dst + 4) = make_float4(x[4], x[5], x[6], x[7]);
            }
          } else {
            float* dst = p.out + ((lane < 16) ? O_SWAK_S : O_SWAV_S) + ((size_t)(b * 128 + 96 + t) * 128 + e0);
            *(float4*)dst = make_float4(x[0], x[1], x[2], x[3]);
            *(float4*)(dst + 4) = make_float4(x[4], x[5], x[6], x[7]);
            if (lane < 16) *(uint4*)(kall + (size_t)(b * 160 + 128 + t) * 128 + e0) = pk;
            else {
              const int kvh = e0 >> 6, d0 = e0 & 63;
#pragma unroll
              for (int j = 0; j < 8; ++j) vtall[((size_t)(b * 2 + kvh) * 64 + d0 + j) * 192 + 128 + t] = f2bf(x[j]);
            }
          }
        }
      }
    }
    for (size_t idx = gtid; idx < (size_t)32 * 96 * 128; idx += gthreads) {
      const int e = (int)(idx & 127); const int wd = (int)((idx >> 7) % 96); const int b = (int)(idx / (96 * 128));
      const size_t src = ((size_t)(b * 128 + 32 + wd)) * 128 + e, dst = ((size_t)(b * 128 + wd)) * 128 + e;
      p.out[O_SWAK_S + dst] = p.in[2][src];
      p.out[O_SWAV_S + dst] = p.in[3][src];
    }
    for (size_t idx = gtid; idx < (size_t)32 * 128 * 128; idx += gthreads) {
      const int e = (int)(idx & 127); const int key = (int)((idx >> 7) & 127); const int b = (int)(idx >> 14);
      kall[(size_t)(b * 160 + key) * 128 + e] = f2bf(p.in[2][idx]);
      vtall[((size_t)(b * 2 + (e >> 6)) * 64 + (e & 63)) * 192 + key] = f2bf(p.in[3][idx]);
    }
    for (size_t idx = gtid; idx < (size_t)32 * 2 * 64 * 32; idx += gthreads) {
      const int kk = (int)(idx & 31); const size_t rr = idx >> 5;
      vtall[rr * 192 + 160 + kk] = 0;
    }
    float* sUw = (float*)smem + w * 512;
    for (int item = gw; item < 32768; item += nw) s5_item<0>(tid, sUw, p, item);
  }
  GRID_BAR();

  for (int rep_ = 0; rep_ < NREP(3); ++rep_)
  {
    PHASE_BEGIN
    if (gtid < 16384) {
      const int n = (int)(gtid & 63), g = (int)((gtid >> 6) & 31), b = (int)(gtid >> 11);
      const int gn = g * 64 + n;
      const float lr = fminf(p.in[15][gn], -1e-4f), li = p.in[16][gn];
      const float dt = __expf(p.in[17][g]);
      const float mag = __expf(lr * dt);
      float sn, cs; sincos_rev(li * dt, sn, cs);
      float ar = mag * cs, ai = mag * sn;
#pragma unroll
      for (int i = 0; i < 5; ++i) { float nr = ar * ar - ai * ai, ni = 2.f * ar * ai; ar = nr; ai = ni; }
      const float* s1re = (const float*)(p.ws + OFF_QMLA);
      const float* s1im = s1re + 2097152;
      float* hinre = (float*)(p.ws + OFF_QMLA) + 2 * 2097152;
      float* hinim = hinre + 2097152;
      float hr = 0.f, hi = 0.f;
#pragma unroll 8
      for (int c = 0; c < 128; ++c) {
        const size_t idx = ((size_t)(b * 128 + c) * 32 + g) * 64 + n;
        hinre[idx] = hr; hinim[idx] = hi;
        const float sr = s1re[idx], si = s1im[idx];
        const float nhr = ar * hr - ai * hi + sr, nhi = ar * hi + ai * hr + si;
        hr = nhr; hi = nhi;
      }
      p.out[O_SSMRE_P + (size_t)(b * 32 + g) * 64 + n] = hr;
      p.out[O_SSMIM_P + (size_t)(b * 32 + g) * 64 + n] = hi;
    }
    const bf16_t* vt0 = (const bf16_t*)(p.ws + OFF_VT0);
    const bf16_t* kall = (const bf16_t*)(p.ws + OFF_KALL);
    const bf16_t* vtall = (const bf16_t*)(p.ws + OFF_VTALL);
    const float* sink = p.in[14];
    for (int item = blockIdx.x; item < 2048 + 256; item += gridDim.x) {
      AttnDesc d;
      d.scale = 0.125f; d.kx = nullptr; d.pos0 = 0;
      if (item < 2048) {
        const int h = item & 7, pr = (item >> 3) & 31, b = item >> 8;
        const int kvh = h >> 2;
        const int chunk = pr * 2 + (w >> 2);
        const int tok = b * 4096 + chunk * 64 + (w & 3) * 16;
        d.q = proj + (size_t)tok * 1280 + h * 64; d.ldq = 1280; d.active = 1;
        d.kt_lo = max(0, chunk - 2); d.kt_hi = chunk + 1;
        d.out = mix + (size_t)tok * 1024 + h * 64; d.ldo = 1024;
        d.m0 = sink[h]; d.l0 = 1.f;
        d.k = proj + (size_t)(b * 4096) * 1280 + 512 + kvh * 64; d.ldk = 1280;
        d.vt = vt0 + (size_t)(b * 2 + kvh) * 64 * 4096; d.ldv = 4096; d.nkeys = 4096;
        d.bt_lo = max(0, pr * 2 - 2); d.bt_hi = pr * 2 + 2;
      } else {
        const int it = item - 2048;
        const int h = it & 7, b = it >> 3;
        const int kvh = h >> 2;
        const int tok = T_P + b * 32 + (w & 1) * 16;
        d.q = proj + (size_t)tok * 1280 + h * 64; d.ldq = 1280; d.active = (w < 2);
        d.kt_lo = 0; d.kt_hi = 3;
        d.out = mix + (size_t)tok * 1024 + h * 64; d.ldo = 1024;
        d.m0 = sink[h]; d.l0 = 1.f;
        d.k = kall + (size_t)(b * 160) * 128 + kvh * 64; d.ldk = 128;
        d.vt = vtall + (size_t)(b * 2 + kvh) * 64 * 192; d.ldv = 192; d.nkeys = 160;
        d.bt_lo = 0; d.bt_hi = 3;
      }
      attn_item<64>(tid, smem, d);
    }
  }
  GRID_BAR();

  for (int rep_ = 0; rep_ < NREP(4); ++rep_)
  {
    PHASE_BEGIN
    float* sUw = (float*)smem + w * 512;
    for (int item = gw; item < 33792; item += nw) s5_item<1>(tid, sUw, p, item);
  }
  GRID_BAR();

  for (int rep_ = 0; rep_ < NREP(5); ++rep_)
  {
    PHASE_BEGIN
    int vb = 0;
    gemm_run<0>(tid, smem, zbuf, zbuf, T_TOT, 512, nullptr, wt + WT_GLU, T_TOT, 512, 512, vb, EpiGlu{zbuf, p.in[24], mix});
  }
  GRID_BAR();

  for (int rep_ = 0; rep_ < NREP(6); ++rep_)
  {
    PHASE_BEGIN
    int vb = 0;
    gemm_run<0>(tid, smem, mix, mix, T_TOT, 1024, nullptr, wt + WT_OUT_E, T_TOT, 1024, 1024, vb, EpiRes0{p.in[0], p.in[1], xres});
  }
  GRID_BAR();

  peer_phases<0>(bar_k, smem);
  GRID_BAR();
      for (int rep_ = 0; rep_ < NREP(10); ++rep_)
      {
    PHASE_BEGIN
        int vb = 0;
        gemm_run<2>(tid, smem, xres, xres, T_TOT, 1024, p.in[9] + 1024, wt + WT_IN_O, T_TOT, 1312, 1024, vb, EpiStoreBf16{proj, 1312});
      }
      GRID_BAR();
      for (int rep_ = 0; rep_ < NREP(11); ++rep_)
      {
    PHASE_BEGIN
        bf16_t* cqn = zbuf;
        bf16_t* mbuf = (bf16_t*)(p.ws + OFF_M);
        bf16_t* cbuf = (bf16_t*)(p.ws + OFF_C);
        bf16_t* kpbuf = (bf16_t*)(p.ws + OFF_KP);
        bf16_t* kps = (bf16_t*)(p.ws + OFF_KPS);
        for (int tok = gw; tok < T_TOT; tok += nw) {
          const bool isS = tok >= T_P;
          int b, t, pos;
          if (!isS) { b = tok >> 12; t = tok & 4095; pos = t; } else { int s = tok - T_P; b = s >> 5; t = s & 31; pos = 2048 + t; }
          const bf16_t* row = proj + (size_t)tok * 1312;
          {
            uint4 v = *(const uint4*)(row + lane * 8);
            float x[8]; unpack8(v, x);
            float ss = 0.f;
#pragma unroll
            for (int j = 0; j < 8; ++j) ss += x[j] * x[j];
            ss = wave_sum(ss);
            const float rs = rsqrtf(ss * (1.f / 512.f) + 1e-6f);
            const float4 g0 = *(const float4*)(p.in[29] + lane * 8), g1 = *(const float4*)(p.in[29] + lane * 8 + 4);
            x[0] *= rs * g0.x; x[1] *= rs * g0.y; x[2] *= rs * g0.z; x[3] *= rs * g0.w;
            x[4] *= rs * g1.x; x[5] *= rs * g1.y; x[6] *= rs * g1.z; x[7] *= rs * g1.w;
            *(uint4*)(cqn + (size_t)tok * 512 + lane * 8) = pack8(x);
          }
          {
            uint2 v = *(const uint2*)(row + 512 + lane * 4);
            float x0 = lo2f(v.x), x1 = hi2f(v.x), x2 = lo2f(v.y), x3 = hi2f(v.y);
            float ss = wave_sum(x0 * x0 + x1 * x1 + x2 * x2 + x3 * x3);
            const float rs = rsqrtf(ss * (1.f / 256.f) + 1e-6f);
            const float4 g = *(const float4*)(p.in[30] + lane * 4);
            x0 *= rs * g.x; x1 *= rs * g.y; x2 *= rs * g.z; x3 *= rs * g.w;
            uint2 o; o.x = pack2(x0, x1); o.y = pack2(x2, x3);
            *(uint2*)(cbuf + (size_t)tok * 256 + lane * 4) = o;
            float* dst = isS ? (p.out + O_CKV_S + (size_t)(tok - T_P) * 256 + lane * 4) : (p.out + O_CKV_P + (size_t)tok * 256 + lane * 4);
            *(float4*)dst = make_float4(x0, x1, x2, x3);
          }
          {
            float xv = 0.f;
            if (lane < 32) xv = bf2f(row[768 + lane]);
            const float other = __shfl_xor(xv, 16);
            const int f = lane & 15;
            const float inv = exp2f(-(float)f * (LOG2_THETA / 16.f));
            float sn, cs; sincos_rev((float)pos * inv, sn, cs);
            const float r = (lane < 16) ? (xv * cs - other * sn) : (xv * cs + other * sn);
            if (lane < 32) {
              kpbuf[(size_t)tok * 32 + lane] = f2bf(r);
              if (isS) { p.out[O_KPE_S + (size_t)(tok - T_P) * 32 + lane] = r; kps[((size_t)b * 2112 + 2048 + t) * 32 + lane] = f2bf(r); }
              else p.out[O_KPE_P + (size_t)tok * 32 + lane] = r;
            }
          }
          {
            const int gi = lane >> 4; const int wlen = 2 << gi;
            float tot[8], cur[8];
#pragma unroll
            for (int j = 0; j < 8; ++j) tot[j] = 0.f;
            uint4 v = *(const uint4*)(row + 800 + lane * 8);
            unpack8(v, cur);
#pragma unroll
            for (int j = 0; j < 8; ++j) tot[j] = cur[j];
            for (int jb = 1; jb < 16; ++jb) {
              if (jb < wlen) {
                const int tt = t - jb;
                if (tt >= 0) {
                  uint4 pv = *(const uint4*)(row - (size_t)jb * 1312 + 800 + lane * 8);
                  float y[8]; unpack8(pv, y);
#pragma unroll
                  for (int j = 0; j < 8; ++j) tot[j] += y[j];
                } else if (isS) {
                  const float* sp = p.in[6] + ((size_t)b * 15 + (15 + tt)) * 512 + lane * 8;
                  float4 a = *(const float4*)sp, bq = *(const float4*)(sp + 4);
                  tot[0] += a.x; tot[1] += a.y; tot[2] += a.z; tot[3] += a.w; tot[4] += bq.x; tot[5] += bq.y; tot[6] += bq.z; tot[7] += bq.w;
                }
              }
            }
            const float cnt = (float)min(pos + 1, wlen);
            float mm[8];
#pragma unroll
            for (int j = 0; j < 8; ++j) mm[j] = tot[j] / cnt - cur[j];
            *(uint4*)(mbuf + (size_t)tok * 512 + lane * 8) = pack8(mm);
            const int tlen = isS ? 32 : 4096;
            if (t >= tlen - 15) {
              const int i = t - (tlen - 15);
              float* dst = isS ? (p.out + O_POOL_S + ((size_t)b * 15 + i) * 512 + lane * 8) : (p.out + O_POOL_P + ((size_t)b * 15 + i) * 512 + lane * 8);
              *(float4*)dst = make_float4(cur[0], cur[1], cur[2], cur[3]);
              *(float4*)(dst + 4) = make_float4(cur[4], cur[5], cur[6], cur[7]);
            }
          }
        }
        for (size_t idx = gtid; idx < (size_t)32 * 2048 * 32; idx += gthreads) {
          const int e = (int)(idx & 31); const int key = (int)((idx >> 5) & 2047); const int b = (int)(idx >> 16);
          kps[((size_t)b * 2112 + key) * 32 + e] = f2bf(p.in[8][idx]);
        }
      }
      GRID_BAR();
      for (int rep_ = 0; rep_ < NREP(12); ++rep_)
      {
    PHASE_BEGIN
        bf16_t* cqn = zbuf;
        bf16_t* mbuf = (bf16_t*)(p.ws + OFF_M);
        bf16_t* cbuf = (bf16_t*)(p.ws + OFF_C);
        bf16_t* qmla = (bf16_t*)(p.ws + OFF_QMLA);
        bf16_t* kupp = qbuf;
        bf16_t* vtp = qbuf + 16777216;
        bf16_t* kups = (bf16_t*)(p.ws + OFF_KUPS);
        bf16_t* vts = (bf16_t*)(p.ws + OFF_VTS);
        for (size_t idx = gtid; idx < (size_t)32 * 8 * 64 * 32; idx += gthreads) {
          const int kk = (int)(idx & 31); const size_t rr = idx >> 5;
          vts[rr * 2112 + 2080 + kk] = 0;
        }
        int vb = 0;
        gemm_run<1>(tid, smem, p.in[7], p.in[7], 65536, 256, nullptr, wt + WT_UK, 65536, 512, 256, vb, EpiKup{kups, 2048, 0, 2112});
        gemm_run<1>(tid, smem, p.in[7], p.in[7], 65536, 256, nullptr, wt + WT_UV, 65536, 512, 256, vb, EpiVt{vts, 2048, 0, 2112});
        gemm_run<0>(tid, smem, cqn, cqn, T_TOT, 512, nullptr, wt + WT_UQ, T_TOT, 768, 512, vb, EpiStoreBf16{qmla, 768});
        gemm_run<0>(tid, smem, cbuf, cbuf, T_P, 256, nullptr, wt + WT_UK, T_P, 512, 256, vb, EpiKup{kupp, 4096, 0, 4096});
        gemm_run<0>(tid, smem, cbuf, cbuf, T_P, 256, nullptr, wt + WT_UV, T_P, 512, 256, vb, EpiVt{vtp, 4096, 0, 4096});
        gemm_run<0>(tid, smem, cbuf + (size_t)T_P * 256, cbuf, 1024, 256, nullptr, wt + WT_UK, 1024, 512, 256, vb, EpiKup{kups, 32, 2048, 2112});
        gemm_run<0>(tid, smem, cbuf + (size_t)T_P * 256, cbuf, 1024, 256, nullptr, wt + WT_UV, 1024, 512, 256, vb, EpiVt{vts, 32, 2048, 2112});
        for (int g = 0; g < 4; ++g)
          gemm_run<0>(tid, smem, mbuf + g * 128, mbuf, T_TOT, 512, nullptr, wt + WT_POOL + g * 16384, T_TOT, 128, 128, vb, EpiPool{mix, p.in[28], g});
      }
      GRID_BAR();
      for (int rep_ = 0; rep_ < NREP(13); ++rep_)
      {
    PHASE_BEGIN
        const bf16_t* qmla = (const bf16_t*)(p.ws + OFF_QMLA);
        const bf16_t* kupp = qbuf;
        const bf16_t* vtp = qbuf + 16777216;
        const bf16_t* kups = (const bf16_t*)(p.ws + OFF_KUPS);
        const bf16_t* vts = (const bf16_t*)(p.ws + OFF_VTS);
        const bf16_t* kpbuf = (const bf16_t*)(p.ws + OFF_KP);
        const bf16_t* kps = (const bf16_t*)(p.ws + OFF_KPS);
        const int G = gridDim.x;
        const bool xsched = (G == 256);
        const int nitems = 2048 + 256;
        const int xcd = blockIdx.x & 7, loc = blockIdx.x >> 3;
        for (int k = 0;; ++k) {
          int pit, sit = -1;
          if (xsched) {
            if (k >= 9) break;
            if (k == 0) { pit = -1; sit = blockIdx.x; }
            else {
              const int r = k - 1;
              const int grp = xcd + 8 * r;
              const int pr = (r & 1) ? (31 - loc) : loc;
              pit = ((31 - pr) << 6) | grp;
            }
          } else {
            const int posn = (k & 1) ? (G - 1 - (int)blockIdx.x) : (int)blockIdx.x;
            const int v = k * G + posn;
            if (k * G >= nitems) break;
            if (v >= nitems) continue;
            if (v < 1024) pit = v; else if (v < 1280) { pit = -1; sit = v - 1024; } else pit = v - 256;
          }
          AttnDesc d;
          d.scale = 0.10206207261596575f; d.m0 = -1e30f; d.l0 = 0.f;
          if (pit >= 0) {
            const int pr = 31 - (pit >> 6); const int h = pit & 7, b = (pit >> 3) & 7;
            const int chunk = pr * 2 + (w >> 2);
            const int tok = b * 4096 + chunk * 64 + (w & 3) * 16;
            d.q = qmla + (size_t)tok * 768 + h * 96; d.ldq = 768; d.active = 1; d.pos0 = chunk * 64 + (w & 3) * 16;
            d.kt_lo = 0; d.kt_hi = chunk + 1;
            d.out = mix + (size_t)tok * 1024 + 512 + h * 64; d.ldo = 1024;
            d.k = kupp + (size_t)(b * 4096) * 512 + h * 64; d.ldk = 512;
            d.kx = kpbuf + (size_t)(b * 4096) * 32;
            d.vt = vtp + (size_t)(b * 8 + h) * 64 * 4096; d.ldv = 4096; d.nkeys = 4096;
            d.bt_lo = 0; d.bt_hi = pr * 2 + 2;
          } else {
            const int h = sit & 7, b = sit >> 3;
            const int tok = T_P + b * 32 + (w & 1) * 16;
            d.q = qmla + (size_t)tok * 768 + h * 96; d.ldq = 768; d.active = (w < 2); d.pos0 = 2048 + (w & 1) * 16;
            d.kt_lo = 0; d.kt_hi = 33;
            d.out = mix + (size_t)tok * 1024 + 512 + h * 64; d.ldo = 1024;
            d.k = kups + (size_t)(b * 2112) * 512 + h * 64; d.ldk = 512;
            d.kx = kps + (size_t)(b * 2112) * 32;
            d.vt = vts + (size_t)(b * 8 + h) * 64 * 2112; d.ldv = 2112; d.nkeys = 2080;
            d.bt_lo = 0; d.bt_hi = 33;
          }
          attn_item<96>(tid, smem, d);
        }
      }
      GRID_BAR();
      for (int rep_ = 0; rep_ < NREP(14); ++rep_)
      {
    PHASE_BEGIN
        quant_rows(p.in[36] + 16777216, p.ws + OFF_TAB, (float*)(p.ws + OFF_TAB + TAB_SU_OFF), gw, nw, tid);
        quant_rows(p.in[37] + 16777216, p.ws + OFF_TAB + TAB_V_OFF, (float*)(p.ws + OFF_TAB + TAB_SV_OFF), gw, nw, tid);
        int vb = 0;
        gemm_run<0>(tid, smem, mix, mix, T_TOT, 1024, nullptr, wt + WT_OUT_O, T_TOT, 1024, 1024, vb, EpiRes1{xres});
      }
      GRID_BAR();
  peer_phases<1>(bar_k, smem);
}

extern "C" void kernel_launch(void* const* d_in, const int* in_sizes, int n_in, void* d_out, int out_size, void* d_ws, size_t ws_size, hipStream_t stream) {
  static int grid_blocks = 0;
  if (grid_blocks == 0) {
    int dev = 0, cus = 0, per_cu = 0;
    hipGetDevice(&dev);
    hipDeviceGetAttribute(&cus, hipDeviceAttributeMultiprocessorCount, dev);
    hipOccupancyMaxActiveBlocksPerMultiprocessor(&per_cu, (const void*)mega, NT, 0);
    if (per_cu < 1) per_cu = 1;
    if (per_cu > 1) per_cu = 1;
    grid_blocks = cus * per_cu;
    if (ws_size < WS_NEED + 256) fprintf(stderr, "kernel_launch: workspace too small: %zu < %zu\n", ws_size, (size_t)WS_NEED);
  }
  hipMemsetAsync((unsigned char*)d_ws + OFF_BAR, 0, 256, stream);
  Params p{};
  for (int i = 0; i < 38; ++i) p.in[i] = (const float*)d_in[i];
  p.out = (float*)d_out;
  p.ws = (unsigned char*)d_ws;
  void* args[] = {&p};
  hipError_t e = hipLaunchCooperativeKernel((const void*)mega, dim3(grid_blocks), dim3(NT), args, 0, stream);
  if (e != hipSuccess) fprintf(stderr, "cooperative launch failed: %s (grid %d)\n", hipGetErrorString(e), grid_blocks);
}
```

```cpp
#include <hip/hip_runtime.h>
#include <hip/hip_bf16.h>
#include <hip/hip_cooperative_groups.h>
#include <cstdio>
namespace cg = cooperative_groups;

typedef unsigned short bf16_t;
using bf16x8 = __attribute__((ext_vector_type(8))) short;
using f32x4 = __attribute__((ext_vector_type(4))) float;

#ifndef PH
#define PH 0xFFFFFFu
#endif
#ifndef DBL
#define DBL 0u
#endif
#define NREP(n) ((int)((PH >> (n)) & 1u) * (1 + (int)((DBL >> (n)) & 1u)))
#define NT 512
#define DYN_LDS 81920
#define T_TOT 33792
#define T_P 32768
#define LOG2_THETA 18.931568569324174f

#define O_Y 0
#define O_SWAK_P 34603008
#define O_SWAV_P 34734080
#define O_SSMRE_P 34865152
#define O_SSMIM_P 34881536
#define O_POOL_P 34897920
#define O_CKV_P 34959360
#define O_KPE_P 43347968
#define O_SWAK_S 44396544
#define O_SWAV_S 44920832
#define O_SSMRE_S 45445120
#define O_SSMIM_S 45510656
#define O_POOL_S 45576192
#define O_CKV_S 45821952
#define O_KPE_S 46084096

constexpr size_t OFF_PROJ = 0;
constexpr size_t OFF_TAB = OFF_PROJ + 88670208ull;
constexpr size_t OFF_MIX = OFF_TAB + 67108864ull;
constexpr size_t OFF_QBUF = OFF_MIX + 69206016ull;
constexpr size_t OFF_QMLA = OFF_QBUF + 69206016ull;
constexpr size_t OFF_Z = OFF_QMLA + 51904512ull;
constexpr size_t OFF_M = OFF_Z + 34603008ull;
constexpr size_t OFF_C = OFF_M + 34603008ull;
constexpr size_t OFF_KP = OFF_C + 17301504ull;
constexpr size_t OFF_VT0 = OFF_KP + 2162688ull;
constexpr size_t OFF_KALL = OFF_VT0 + 8388608ull;
constexpr size_t OFF_VTALL = OFF_KALL + 1327104ull;
constexpr size_t OFF_KPS = OFF_VTALL + 1572864ull;
constexpr size_t OFF_WT = OFF_KPS + 4325376ull;
constexpr size_t WS_NEED = OFF_WT + 16187392ull;
constexpr size_t OFF_KUPS = OFF_PROJ;
constexpr size_t OFF_VTS = OFF_PROJ + 69206016ull;
constexpr size_t WT_IN_E = 0;
constexpr size_t WT_OUT_E = WT_IN_E + 1310720;
constexpr size_t WT_GLU = WT_OUT_E + 1048576;
constexpr size_t WT_IN_O = WT_GLU + 262144;
constexpr size_t WT_OUT_O = WT_IN_O + 1343488;
constexpr size_t WT_POOL = WT_OUT_O + 1048576;
constexpr size_t WT_UQ = WT_POOL + 65536;
constexpr size_t WT_UK = WT_UQ + 393216;
constexpr size_t WT_UV = WT_UK + 131072;
constexpr size_t WT_PQ = WT_UV + 131072;
constexpr size_t WT_KEYS = WT_PQ + 2097152;

struct Params {
  const float* in[38];
  float* out;
  unsigned char* ws;
};

typedef __bf16 bf16x2_t __attribute__((ext_vector_type(2)));
typedef float float2_t __attribute__((ext_vector_type(2)));
__device__ __forceinline__ unsigned pack2(float a, float b) {
  float2_t f = {a, b};
  bf16x2_t h = __builtin_convertvector(f, bf16x2_t);
  return __builtin_bit_cast(unsigned, h);
}
__device__ __forceinline__ unsigned short f2bf(float f) { return (unsigned short)(pack2(f, 0.f) & 0xffffu); }
__device__ __forceinline__ float bf2f(unsigned short b) { return __uint_as_float(((unsigned)b) << 16); }
__device__ __forceinline__ float lo2f(unsigned u) { return __uint_as_float(u << 16); }
__device__ __forceinline__ float hi2f(unsigned u) { return __uint_as_float(u & 0xffff0000u); }
__device__ __forceinline__ void unpack8(uint4 v, float* x) {
  x[0] = lo2f(v.x); x[1] = hi2f(v.x); x[2] = lo2f(v.y); x[3] = hi2f(v.y);
  x[4] = lo2f(v.z); x[5] = hi2f(v.z); x[6] = lo2f(v.w); x[7] = hi2f(v.w);
}
__device__ __forceinline__ uint4 pack8(const float* x) {
  uint4 v; v.x = pack2(x[0], x[1]); v.y = pack2(x[2], x[3]); v.z = pack2(x[4], x[5]); v.w = pack2(x[6], x[7]); return v;
}
template <int CTRL> __device__ __forceinline__ float dpp_f(float v) {
  return __int_as_float(__builtin_amdgcn_update_dpp(0, __float_as_int(v), CTRL, 0xf, 0xf, true));
}
__device__ __forceinline__ float row16_max(float v) {
  v = fmaxf(v, dpp_f<0xB1>(v)); v = fmaxf(v, dpp_f<0x4E>(v)); v = fmaxf(v, dpp_f<0x141>(v)); v = fmaxf(v, dpp_f<0x140>(v)); return v;
}
__device__ __forceinline__ float row16_sum(float v) {
  v += dpp_f<0xB1>(v); v += dpp_f<0x4E>(v); v += dpp_f<0x141>(v); v += dpp_f<0x140>(v); return v;
}
__device__ __forceinline__ float wave_sum(float v) {
  v = row16_sum(v);
  const float a = __int_as_float(__builtin_amdgcn_readlane(__float_as_int(v), 0));
  const float b = __int_as_float(__builtin_amdgcn_readlane(__float_as_int(v), 16));
  const float c = __int_as_float(__builtin_amdgcn_readlane(__float_as_int(v), 32));
  const float d = __int_as_float(__builtin_amdgcn_readlane(__float_as_int(v), 48));
  return (a + b) + (c + d);
}
__device__ __forceinline__ void sincos_rev(float ang, float& s, float& c) {
  float rev = ang * 0.15915494309189535f;
  rev = rev - floorf(rev);
  s = __builtin_amdgcn_sinf(rev);
  c = __builtin_amdgcn_cosf(rev);
}
__device__ __forceinline__ float gelu_tanh(float x) {
  float y = 0.7978845608028654f * (x + 0.044715f * x * x * x);
  float t = 1.f - 2.f / (1.f + __expf(2.f * y));
  return 0.5f * x * (1.f + t);
}
__device__ __forceinline__ float gelu_erf(float x) { return 0.5f * x * (1.f + erff(x * 0.7071067811865476f)); }
__device__ __forceinline__ int logical_bid() {
  const int G = (int)gridDim.x, b = (int)blockIdx.x;
  return ((G & 7) == 0) ? ((b & 7) * (G >> 3) + (b >> 3)) : b;
}
__device__ __forceinline__ int rot_start(int vbase) {
  int G = (int)gridDim.x;
  int s = (logical_bid() - vbase) % G;
  if (s < 0) s += G;
  return s;
}

__device__ __forceinline__ void transpose_convert(int tid, unsigned char* smem, const float* __restrict__ src, bf16_t* __restrict__ dst, int K, int N, int& vbase) {
  float* tl = (float*)smem;
  const int tk = K / 64, tn = (N + 63) / 64;
  const int ntiles = tk * tn;
  for (int tile = rot_start(vbase); tile < ntiles; tile += gridDim.x) {
    const int k0 = (tile / tn) * 64, n0 = (tile % tn) * 64;
    __syncthreads();
#pragma unroll
    for (int i = 0; i < 2; ++i) {
      int r = (tid >> 4) + 32 * i, c4 = (tid & 15) * 4;
      float4 v = make_float4(0.f, 0.f, 0.f, 0.f);
      if (n0 + c4 < N) v = *(const float4*)(src + (size_t)(k0 + r) * N + n0 + c4);
      tl[r * 65 + c4 + 0] = v.x; tl[r * 65 + c4 + 1] = v.y; tl[r * 65 + c4 + 2] = v.z; tl[r * 65 + c4 + 3] = v.w;
    }
    __syncthreads();
    int n = tid >> 3, k8 = (tid & 7) * 8;
    if (n0 + n < N) {
      float x[8];
#pragma unroll
      for (int j = 0; j < 8; ++j) x[j] = tl[(k8 + j) * 65 + n];
      *(uint4*)(dst + (size_t)(n0 + n) * K + k0 + k8) = pack8(x);
    }
  }
  vbase += ntiles;
}

__device__ __forceinline__ void convert_plain(int tid, const float* __restrict__ src, bf16_t* __restrict__ dst, size_t n) {
  size_t i = ((size_t)blockIdx.x * NT + tid) * 8;
  const size_t stride = (size_t)gridDim.x * NT * 8;
  for (; i < n; i += stride) {
    float4 a = *(const float4*)(src + i), b = *(const float4*)(src + i + 4);
    uint4 v; v.x = pack2(a.x, a.y); v.y = pack2(a.z, a.w); v.z = pack2(b.x, b.y); v.w = pack2(b.z, b.w);
    *(uint4*)(dst + i) = v;
  }
}

template <int V> struct IC { static constexpr int value = V; };
template <int AMODE, class Epi>
__device__ __forceinline__ void gemm_run(int tid, unsigned char* smem, const void* A, const void* A2, int splitRow, int lda,
                                         const float* __restrict__ gain, const bf16_t* __restrict__ Bt,
                                         int M, int N, int K, int& vbase, Epi epi) {
  bf16_t* sA0 = (bf16_t*)smem;
  bf16_t* sB0 = sA0 + 128 * 72;
  bf16_t* sA1 = sB0 + 128 * 72;
  bf16_t* sB1 = sA1 + 128 * 72;
  float* sR = (float*)(sB1 + 128 * 72);
  float* sG = sR + 128;
  if (AMODE == 2) {
    __syncthreads();
    sG[tid] = gain[tid]; sG[tid + 512] = gain[tid + 512];
    __syncthreads();
  }
  const int lane = tid & 63, w = tid >> 6;
  const int l16 = lane & 15, quad = lane >> 4;
  const int wm = w >> 1, wn = w & 1;
  const int tilesN = (N + 127) / 128, tilesM = M / 128;
  const int ntiles = tilesM * tilesN;
  const int arow = tid >> 2, aseg = (tid & 3) * 16;
  const int nk = K / 64;
  for (int tile = rot_start(vbase); tile < ntiles; tile += gridDim.x) {
    const int tm = tile / tilesN, tn = tile % tilesN;
    const int m0 = tm * 128, n0 = tn * 128;
    const int grow = m0 + arow;
    const unsigned char* aptr;
    if (AMODE == 0) aptr = (grow < splitRow) ? (const unsigned char*)A + (size_t)grow * lda * 2 : (const unsigned char*)A2 + (size_t)(grow - splitRow) * lda * 2;
    else aptr = (grow < splitRow) ? (const unsigned char*)A + (size_t)grow * lda * 4 : (const unsigned char*)A2 + (size_t)(grow - splitRow) * lda * 4;
    const bool bvalid = (n0 + arow) < N;
    const bf16_t* bptr = Bt + (size_t)(n0 + arow) * K + aseg;
    f32x4 acc[2][4];
#pragma unroll
    for (int i = 0; i < 2; ++i)
#pragma unroll
      for (int j = 0; j < 4; ++j) acc[i][j] = (f32x4){0.f, 0.f, 0.f, 0.f};
    float ss = 0.f;
    float4 af0[4], af1[4];
    uint4 ab0[2], ab1[2];
    uint4 bb0[2], bb1[2];
#define GLOAD(AF, AB, BB, KT) { \
      const int k0_ = (KT) * 64; \
      if (AMODE == 0) { AB[0] = *(const uint4*)(aptr + (size_t)(k0_ + aseg) * 2); AB[1] = *(const uint4*)(aptr + (size_t)(k0_ + aseg + 8) * 2); } \
      else { \
        _Pragma("unroll") for (int i = 0; i < 4; ++i) AF[i] = *(const float4*)(aptr + (size_t)(k0_ + aseg + 4 * i) * 4); \
      } \
      if (bvalid) { BB[0] = *(const uint4*)(bptr + k0_); BB[1] = *(const uint4*)(bptr + k0_ + 8); } \
      else { BB[0] = make_uint4(0, 0, 0, 0); BB[1] = BB[0]; } }
#define LSTORE(AF, AB, BB, KT, sA, sB) { \
      uint4 s0, s1; \
      if (AMODE == 0) { s0 = AB[0]; s1 = AB[1]; } \
      else { \
        if (AMODE == 2) { \
          const float* gp = sG + (KT) * 64 + aseg; \
          _Pragma("unroll") for (int i = 0; i < 4; ++i) { \
            float4 g = *(const float4*)(gp + 4 * i); \
            ss += AF[i].x * AF[i].x + AF[i].y * AF[i].y + AF[i].z * AF[i].z + AF[i].w * AF[i].w; \
            AF[i].x *= g.x; AF[i].y *= g.y; AF[i].z *= g.z; AF[i].w *= g.w; \
          } \
        } \
        s0.x = pack2(AF[0].x, AF[0].y); s0.y = pack2(AF[0].z, AF[0].w); s0.z = pack2(AF[1].x, AF[1].y); s0.w = pack2(AF[1].z, AF[1].w); \
        s1.x = pack2(AF[2].x, AF[2].y); s1.y = pack2(AF[2].z, AF[2].w); s1.z = pack2(AF[3].x, AF[3].y); s1.w = pack2(AF[3].z, AF[3].w); \
      } \
      *(uint4*)(sA + arow * 72 + aseg) = s0; \
      *(uint4*)(sA + arow * 72 + aseg + 8) = s1; \
      *(uint4*)(sB + arow * 72 + aseg) = BB[0]; \
      *(uint4*)(sB + arow * 72 + aseg + 8) = BB[1]; }
#define GCOMPUTE(sA, sB) { \
      _Pragma("unroll") for (int ks = 0; ks < 2; ++ks) { \
        bf16x8 a[2], b[4]; \
        _Pragma("unroll") for (int i = 0; i < 2; ++i) a[i] = *(const bf16x8*)(sA + (wm * 32 + i * 16 + l16) * 72 + ks * 32 + quad * 8); \
        _Pragma("unroll") for (int j = 0; j < 4; ++j) b[j] = *(const bf16x8*)(sB + (wn * 64 + j * 16 + l16) * 72 + ks * 32 + quad * 8); \
        _Pragma("unroll") for (int i = 0; i < 2; ++i) \
          _Pragma("unroll") for (int j = 0; j < 4; ++j) acc[i][j] = __builtin_amdgcn_mfma_f32_16x16x32_bf16(a[i], b[j], acc[i][j], 0, 0, 0); \
      } }
    __syncthreads();
    GLOAD(af0, ab0, bb0, 0);
    GLOAD(af1, ab1, bb1, 1);
    LSTORE(af0, ab0, bb0, 0, sA0, sB0);
    if (2 < nk) GLOAD(af0, ab0, bb0, 2);
    for (int kt = 0; kt < nk; kt += 2) {
      __syncthreads();
      LSTORE(af1, ab1, bb1, kt + 1, sA1, sB1);
      if (kt + 3 < nk) GLOAD(af1, ab1, bb1, kt + 3);
      GCOMPUTE(sA0, sB0);
      __syncthreads();
      if (kt + 2 < nk) {
        LSTORE(af0, ab0, bb0, kt + 2, sA0, sB0);
        if (kt + 4 < nk) GLOAD(af0, ab0, bb0, kt + 4);
      }
      GCOMPUTE(sA1, sB1);
    }
    if (AMODE == 2) {
      ss += __shfl_xor(ss, 1);
      ss += __shfl_xor(ss, 2);
      if ((tid & 3) == 0) sR[arow] = rsqrtf(ss / (float)K + 1e-6f);
      __syncthreads();
    }
#pragma unroll
    for (int i = 0; i < 2; ++i)
#pragma unroll
      for (int r = 0; r < 4; ++r) {
        const int rl = wm * 32 + i * 16 + quad * 4 + r;
        const float rs = (AMODE == 2) ? sR[rl] : 1.f;
#pragma unroll
        for (int j = 0; j < 4; ++j) {
          const int col = n0 + wn * 64 + j * 16 + l16;
          if (col < N) epi(m0 + rl, col, acc[i][j][r] * rs);
        }
      }
  }
  vbase += ntiles;
}

struct AttnDesc {
  const bf16_t* q; int ldq; int active; int kt_lo, kt_hi; bf16_t* out; int ldo; float m0, l0; int pos0;
  const bf16_t* k; int ldk; const bf16_t* kx; const bf16_t* vt; int ldv; int nkeys; int bt_lo, bt_hi; float scale;
};

template <int DQK>
__device__ __forceinline__ void attn_item(int tid, unsigned char* smem, const AttnDesc& d) {
  constexpr int LDK = DQK + 8;
  bf16_t* sK = (bf16_t*)smem;
  bf16_t* sVt = sK + 64 * 104;
  bf16_t* sP = sVt + 64 * 72;
  const int lane = tid & 63, w = tid >> 6;
  const int l16 = lane & 15, quad = lane >> 4;
  bf16_t* sPw = sP + w * 16 * 72;
  bf16x8 qf[DQK / 32];
  if (d.active) {
#pragma unroll
    for (int ks = 0; ks < DQK / 32; ++ks) {
      const bf16_t* qp = d.q + (size_t)l16 * d.ldq + ks * 32 + quad * 8;
      uint4 v = *(const uint4*)qp;
      if (DQK == 96 && ks == 2) {
        const int pq = (quad < 2) ? 16 : -16;
        uint4 pv = *(const uint4*)(qp + pq);
        float x[8], y[8];
        unpack8(v, x); unpack8(pv, y);
        const float pos = (float)(d.pos0 + l16);
#pragma unroll
        for (int j = 0; j < 8; ++j) {
          const int f = (quad & 1) * 8 + j;
          float inv = exp2f(-(float)f * (LOG2_THETA / 16.f));
          float sn, cs; sincos_rev(pos * inv, sn, cs);
          x[j] = (quad < 2) ? (x[j] * cs - y[j] * sn) : (x[j] * cs + y[j] * sn);
        }
        v = pack8(x);
      }
      qf[ks] = *(bf16x8*)&v;
    }
  }
  f32x4 o[4];
#pragma unroll
  for (int i = 0; i < 4; ++i) o[i] = (f32x4){0.f, 0.f, 0.f, 0.f};
  float m[4], l[4];
#pragma unroll
  for (int r = 0; r < 4; ++r) { m[r] = d.m0; l[r] = d.l0; }

  const int key = tid >> 3, seg = tid & 7;
  const int key2 = (tid >> 2) & 63, seg2 = tid & 3;
  uint4 kv_r = make_uint4(0, 0, 0, 0), vv_r = kv_r, xv_r = kv_r;
  if (d.bt_lo < d.bt_hi) {
    kv_r = *(const uint4*)(d.k + (size_t)(d.bt_lo * 64 + key) * d.ldk + seg * 8);
    vv_r = *(const uint4*)(d.vt + (size_t)key * d.ldv + d.bt_lo * 64 + seg * 8);
    if (DQK == 96 && tid < 256) xv_r = *(const uint4*)(d.kx + (size_t)(d.bt_lo * 64 + key2) * 32 + seg2 * 8);
  }
  for (int kt = d.bt_lo; kt < d.bt_hi; ++kt) {
    __syncthreads();
    *(uint4*)(sK + key * LDK + seg * 8) = kv_r;
    *(uint4*)(sVt + key * 72 + seg * 8) = vv_r;
    if (DQK == 96 && tid < 256) *(uint4*)(sK + key2 * LDK + 64 + seg2 * 8) = xv_r;
    __syncthreads();
    if (kt + 1 < d.bt_hi) {
      kv_r = *(const uint4*)(d.k + (size_t)((kt + 1) * 64 + key) * d.ldk + seg * 8);
      vv_r = *(const uint4*)(d.vt + (size_t)key * d.ldv + (kt + 1) * 64 + seg * 8);
      if (DQK == 96 && tid < 256) xv_r = *(const uint4*)(d.kx + (size_t)((kt + 1) * 64 + key2) * 32 + seg2 * 8);
    }
    if (d.active && kt >= d.kt_lo && kt < d.kt_hi) {
      f32x4 s[4];
#pragma unroll
      for (int i = 0; i < 4; ++i) s[i] = (f32x4){0.f, 0.f, 0.f, 0.f};
#pragma unroll
      for (int ks = 0; ks < DQK / 32; ++ks)
#pragma unroll
        for (int nt = 0; nt < 4; ++nt) {
          bf16x8 b = *(const bf16x8*)(sK + (nt * 16 + l16) * LDK + ks * 32 + quad * 8);
          s[nt] = __builtin_amdgcn_mfma_f32_16x16x32_bf16(qf[ks], b, s[nt], 0, 0, 0);
        }
#pragma unroll
      for (int nt = 0; nt < 4; ++nt) {
        const bool valid = (kt * 64 + nt * 16 + l16) < d.nkeys;
#pragma unroll
        for (int r = 0; r < 4; ++r) s[nt][r] = valid ? s[nt][r] * d.scale : -1e30f;
      }
#pragma unroll
      for (int r = 0; r < 4; ++r) {
        float mx = fmaxf(fmaxf(s[0][r], s[1][r]), fmaxf(s[2][r], s[3][r]));
        mx = row16_max(mx);
        const float mnew = fmaxf(m[r], mx);
        const float alpha = __expf(m[r] - mnew);
        float p0 = __expf(s[0][r] - mnew), p1 = __expf(s[1][r] - mnew), p2 = __expf(s[2][r] - mnew), p3 = __expf(s[3][r] - mnew);
        float rs = p0 + p1 + p2 + p3;
        rs = row16_sum(rs);
        l[r] = l[r] * alpha + rs;
        m[r] = mnew;
#pragma unroll
        for (int dt = 0; dt < 4; ++dt) o[dt][r] *= alpha;
        bf16_t* pr = sPw + (quad * 4 + r) * 72 + l16;
        pr[0] = f2bf(p0); pr[16] = f2bf(p1); pr[32] = f2bf(p2); pr[48] = f2bf(p3);
      }
      asm volatile("s_waitcnt lgkmcnt(0)" ::: "memory");
#pragma unroll
      for (int ks = 0; ks < 2; ++ks) {
        bf16x8 a = *(const bf16x8*)(sPw + l16 * 72 + ks * 32 + quad * 8);
#pragma unroll
        for (int dt = 0; dt < 4; ++dt) {
          bf16x8 b = *(const bf16x8*)(sVt + (dt * 16 + l16) * 72 + ks * 32 + quad * 8);
          o[dt] = __builtin_amdgcn_mfma_f32_16x16x32_bf16(a, b, o[dt], 0, 0, 0);
        }
      }
      asm volatile("s_waitcnt lgkmcnt(0)" ::: "memory");
    }
  }
  if (d.active) {
#pragma unroll
    for (int r = 0; r < 4; ++r) {
      const float il = 1.f / l[r];
#pragma unroll
      for (int dt = 0; dt < 4; ++dt) d.out[(size_t)(quad * 4 + r) * d.ldo + dt * 16 + l16] = f2bf(o[dt][r] * il);
    }
  }
}

template <int MODE>
__device__ __forceinline__ void s5_item(int tid, float* sUw, const Params& p, int item) {
  const int lane = tid & 63;
  const bf16_t* proj = (const bf16_t*)(p.ws + OFF_PROJ);
  int b, chunk, g, tok0; bool isS;
  if (item < 32768) { isS = false; g = item & 31; chunk = (item >> 5) & 127; b = item >> 12; tok0 = b * 4096 + chunk * 32; }
  else { isS = true; int it = item - 32768; g = it & 31; b = it >> 5; chunk = 0; tok0 = T_P + b * 32; }
  const int n = lane;
  const int gn = g * 64 + n;
  const float lr = fminf(p.in[15][gn], -1e-4f), li = p.in[16][gn];
  const float dt = __expf(p.in[17][g]);
  const float mag = __expf(lr * dt);
  float sn, cs; sincos_rev(li * dt, sn, cs);
  const float abr = mag * cs, abi = mag * sn;
  const float den = lr * lr + li * li;
  const float nr = abr - 1.f, ni = abi;
  const float fre = (nr * lr + ni * li) / den, fim = (ni * lr - nr * li) / den;
  float bbr[16], bbi[16];
  {
    const float4* br4 = (const float4*)(p.in[18] + (size_t)gn * 16);
    const float4* bi4 = (const float4*)(p.in[19] + (size_t)gn * 16);
#pragma unroll
    for (int i = 0; i < 4; ++i) {
      float4 r4 = br4[i], i4 = bi4[i];
      bbr[4 * i + 0] = fre * r4.x - fim * i4.x; bbi[4 * i + 0] = fre * i4.x + fim * r4.x;
      bbr[4 * i + 1] = fre * r4.y - fim * i4.y; bbi[4 * i + 1] = fre * i4.y + fim * r4.y;
      bbr[4 * i + 2] = fre * r4.z - fim * i4.z; bbi[4 * i + 2] = fre * i4.z + fim * r4.z;
      bbr[4 * i + 3] = fre * r4.w - fim * i4.w; bbi[4 * i + 3] = fre * i4.w + fim * r4.w;
    }
  }
  {
    const int t = lane >> 1, c8 = (lane & 1) * 8;
    uint4 uv = *(const uint4*)(proj + (size_t)(tok0 + t) * 1280 + 768 + g * 16 + c8);
    float x[8]; unpack8(uv, x);
    *(float4*)(sUw + t * 16 + c8) = make_float4(x[0], x[1], x[2], x[3]);
    *(float4*)(sUw + t * 16 + c8 + 4) = make_float4(x[4], x[5], x[6], x[7]);
  }
  asm volatile("s_waitcnt lgkmcnt(0)" ::: "memory");
  float hr = 0.f, hi = 0.f;
  if (MODE == 0) {
#pragma unroll 4
    for (int t = 0; t < 32; ++t) {
      float uu[16];
#pragma unroll
      for (int i = 0; i < 4; ++i) { float4 v = *(const float4*)(sUw + t * 16 + 4 * i); uu[4 * i] = v.x; uu[4 * i + 1] = v.y; uu[4 * i + 2] = v.z; uu[4 * i + 3] = v.w; }
      float bur = 0.f, bui = 0.f;
#pragma unroll
      for (int c = 0; c < 16; ++c) { bur += bbr[c] * uu[c]; bui += bbi[c] * uu[c]; }
      const float nhr = abr * hr - abi * hi + bur, nhi = abr * hi + abi * hr + bui;
      hr = nhr; hi = nhi;
    }
    float* s1re = (float*)(p.ws + OFF_QMLA);
    float* s1im = s1re + 2097152;
    const size_t idx = ((size_t)(b * 128 + chunk) * 32 + g) * 64 + n;
    s1re[idx] = hr; s1im[idx] = hi;
    asm volatile("s_waitcnt lgkmcnt(0)" ::: "memory");
    return;
  } else {
    float cr[16], ci[16];
#pragma unroll
    for (int c = 0; c < 16; ++c) { cr[c] = p.in[20][(size_t)(g * 16 + c) * 64 + n]; ci[c] = p.in[21][(size_t)(g * 16 + c) * 64 + n]; }
    if (isS) { hr = p.in[4][(size_t)(b * 32 + g) * 64 + n]; hi = p.in[5][(size_t)(b * 32 + g) * 64 + n]; }
    else {
      const float* hinre = (const float*)(p.ws + OFF_QMLA) + 2 * 2097152;
      const float* hinim = hinre + 2097152;
      const size_t idx = ((size_t)(b * 128 + chunk) * 32 + g) * 64 + n;
      hr = hinre[idx]; hi = hinim[idx];
    }
    const int b0 = lane & 1, b1 = (lane >> 1) & 1, b2 = (lane >> 2) & 1, b3 = (lane >> 3) & 1;
    const int cc = b0 * 8 + b1 * 4 + b2 * 2 + b3;
    const int quad = lane >> 4;
    const float dsk = p.in[22][g * 16 + cc];
    bf16_t* zbuf = (bf16_t*)(p.ws + OFF_Z);
    float zkeep = 0.f;
#pragma unroll 2
    for (int t = 0; t < 32; ++t) {
      float uu[16];
#pragma unroll
      for (int i = 0; i < 4; ++i) { float4 v = *(const float4*)(sUw + t * 16 + 4 * i); uu[4 * i] = v.x; uu[4 * i + 1] = v.y; uu[4 * i + 2] = v.z; uu[4 * i + 3] = v.w; }
      float bur = 0.f, bui = 0.f;
#pragma unroll
      for (int c = 0; c < 16; ++c) { bur += bbr[c] * uu[c]; bui += bbi[c] * uu[c]; }
      const float nhr = abr * hr - abi * hi + bur, nhi = abr * hi + abi * hr + bui;
      hr = nhr; hi = nhi;
      float v16[16];
#pragma unroll
      for (int c = 0; c < 16; ++c) v16[c] = hr * cr[c] - hi * ci[c];
      float v8[8], v4[4], v2[2], v1;
#pragma unroll
      for (int i = 0; i < 8; ++i) { float keep = b0 ? v16[8 + i] : v16[i]; float send = b0 ? v16[i] : v16[8 + i]; v8[i] = keep + __shfl_xor(send, 1); }
#pragma unroll
      for (int i = 0; i < 4; ++i) { float keep = b1 ? v8[4 + i] : v8[i]; float send = b1 ? v8[i] : v8[4 + i]; v4[i] = keep + __shfl_xor(send, 2); }
#pragma unroll
      for (int i = 0; i < 2; ++i) { float keep = b2 ? v4[2 + i] : v4[i]; float send = b2 ? v4[i] : v4[2 + i]; v2[i] = keep + __shfl_xor(send, 4); }
      { float keep = b3 ? v2[1] : v2[0]; float send = b3 ? v2[0] : v2[1]; v1 = keep + __shfl_xor(send, 8); }
      v1 += __shfl_xor(v1, 16);
      v1 += __shfl_xor(v1, 32);
      const float y = v1 + dsk * sUw[t * 16 + cc];
      const float z = gelu_tanh(y);
      if (quad == (t & 3)) zkeep = z;
      if ((t & 3) == 3) zbuf[(size_t)(tok0 + t - 3 + quad) * 512 + g * 16 + cc] = f2bf(zkeep);
    }
    if (isS) {
      p.out[O_SSMRE_S + (size_t)(b * 32 + g) * 64 + n] = hr;
      p.out[O_SSMIM_S + (size_t)(b * 32 + g) * 64 + n] = hi;
    }
    asm volatile("s_waitcnt lgkmcnt(0)" ::: "memory");
  }
}

#define TAB_V_OFF 16777216ull
#define TAB_SU_OFF 33554432ull
#define TAB_SV_OFF (33554432ull + 65536ull)
__device__ __forceinline__ void quant_rows(const float* __restrict__ src, unsigned char* __restrict__ dst, float* __restrict__ scales, int gw, int nw, int tid) {
  const int lane = tid & 63;
  for (int row = gw; row < 16384; row += nw) {
    const float* r = src + (size_t)row * 1024 + lane * 16;
    float x[16];
#pragma unroll
    for (int i = 0; i < 4; ++i) { float4 v = *(const float4*)(r + 4 * i); x[4 * i] = v.x; x[4 * i + 1] = v.y; x[4 * i + 2] = v.z; x[4 * i + 3] = v.w; }
    float am = 0.f;
#pragma unroll
    for (int i = 0; i < 16; ++i) am = fmaxf(am, fabsf(x[i]));
#pragma unroll
    for (int o = 32; o; o >>= 1) am = fmaxf(am, __shfl_xor(am, o));
    const float inv = (am > 0.f) ? 127.f / am : 0.f;
    unsigned q[4];
#pragma unroll
    for (int i = 0; i < 4; ++i) {
      unsigned b0 = (unsigned)((int)rintf(x[4 * i] * inv)) & 255u, b1 = (unsigned)((int)rintf(x[4 * i + 1] * inv)) & 255u;
      unsigned b2 = (unsigned)((int)rintf(x[4 * i + 2] * inv)) & 255u, b3 = (unsigned)((int)rintf(x[4 * i + 3] * inv)) & 255u;
      q[i] = b0 | (b1 << 8) | (b2 << 16) | (b3 << 24);
    }
    *(uint4*)(dst + (size_t)row * 1024 + lane * 16) = make_uint4(q[0], q[1], q[2], q[3]);
    if (lane == 0) scales[row] = am * (1.f / 127.f);
  }
}

__device__ __forceinline__ float ub0(unsigned u) { return (float)(u & 0xffu); }
__device__ __forceinline__ float ub1(unsigned u) { return (float)((u >> 8) & 0xffu); }
__device__ __forceinline__ float ub2(unsigned u) { return (float)((u >> 16) & 0xffu); }
__device__ __forceinline__ float ub3(unsigned u) { return (float)(u >> 24); }
__device__ __forceinline__ float dot16(const float* xn, uint4 u) {
  float d = 0.f;
  d += xn[0] * ub0(u.x); d += xn[1] * ub1(u.x); d += xn[2] * ub2(u.x); d += xn[3] * ub3(u.x);
  d += xn[4] * ub0(u.y); d += xn[5] * ub1(u.y); d += xn[6] * ub2(u.y); d += xn[7] * ub3(u.y);
  d += xn[8] * ub0(u.z); d += xn[9] * ub1(u.z); d += xn[10] * ub2(u.z); d += xn[11] * ub3(u.z);
  d += xn[12] * ub0(u.w); d += xn[13] * ub1(u.w); d += xn[14] * ub2(u.w); d += xn[15] * ub3(u.w);
  return d;
}
__device__ __forceinline__ void axpy16(float* acc, float a, uint4 u) {
  acc[0] += a * ub0(u.x); acc[1] += a * ub1(u.x); acc[2] += a * ub2(u.x); acc[3] += a * ub3(u.x);
  acc[4] += a * ub0(u.y); acc[5] += a * ub1(u.y); acc[6] += a * ub2(u.y); acc[7] += a * ub3(u.y);
  acc[8] += a * ub0(u.z); acc[9] += a * ub1(u.z); acc[10] += a * ub2(u.z); acc[11] += a * ub3(u.z);
  acc[12] += a * ub0(u.w); acc[13] += a * ub1(u.w); acc[14] += a * ub2(u.w); acc[15] += a * ub3(u.w);
}

template <bool FINAL, bool DRY>
__device__ __forceinline__ void peer_token(int tid, const Params& p, int layer, int tok) {
  const int lane = tid & 63;
  float* xres = p.out + O_Y;
  const float* gain = p.in[10] + layer * 1024;
  const unsigned char* U = p.ws + OFF_TAB;
  const unsigned char* V = U + TAB_V_OFF;
  const int* ebuf = (const int*)(p.ws + OFF_M);
  const float* gbuf = (const float*)(p.ws + OFF_M + 17301504ull);
  const float* sus = (const float*)(p.ws + OFF_TAB + TAB_SU_OFF);
  const float* svs = (const float*)(p.ws + OFF_TAB + TAB_SV_OFF);
  float* xr = xres + (size_t)tok * 1024 + lane * 16;
  float x[16], xn[16], acc[16];
  float ss = 0.f, sx = 0.f;
#pragma unroll
  for (int i = 0; i < 4; ++i) {
    float4 v = *(const float4*)(xr + 4 * i);
    float4 g = *(const float4*)(gain + lane * 16 + 4 * i);
    x[4 * i] = v.x; x[4 * i + 1] = v.y; x[4 * i + 2] = v.z; x[4 * i + 3] = v.w;
    xn[4 * i] = v.x * g.x; xn[4 * i + 1] = v.y * g.y; xn[4 * i + 2] = v.z * g.z; xn[4 * i + 3] = v.w * g.w;
    ss += v.x * v.x + v.y * v.y + v.z * v.z + v.w * v.w;
    sx += xn[4 * i] + xn[4 * i + 1] + xn[4 * i + 2] + xn[4 * i + 3];
  }
  ss = wave_sum(ss);
  sx = wave_sum(sx);
  const float rstd = rsqrtf(ss * (1.f / 1024.f) + 1e-6f);
#pragma unroll
  for (int i = 0; i < 16; ++i) acc[i] = 0.f;
  float sumA = 0.f;
  const int b0 = lane & 1, b1 = (lane >> 1) & 1, b2 = (lane >> 2) & 1;
  const int pe = b0 * 4 + b1 * 2 + b2;
  const size_t pbase = (size_t)tok * 128 + pe;
#pragma unroll 1
  for (int kb = 0; kb < 16; ++kb) {
    const int myeid = ebuf[pbase + kb * 8];
    const float myg = gbuf[pbase + kb * 8] * svs[myeid];
    const float mysu = sus[myeid];
    uint4 uu[8], vv[8];
#pragma unroll
    for (int j = 0; j < 8; ++j) {
      const int src = ((j & 1) << 2) | (j & 2) | ((j >> 2) & 1);
      const int eid = __builtin_amdgcn_readlane(myeid, src);
      uu[j] = *(const uint4*)(U + (size_t)eid * 1024 + lane * 16);
      vv[j] = *(const uint4*)(V + (size_t)eid * 1024 + lane * 16);
    }
    float d[8];
#pragma unroll
    for (int j = 0; j < 8; ++j) d[j] = dot16(xn, uu[j]);
    float w4[4], w2[2], w1;
#pragma unroll
    for (int i = 0; i < 4; ++i) { float keep = b0 ? d[4 + i] : d[i]; float send = b0 ? d[i] : d[4 + i]; w4[i] = keep + __shfl_xor(send, 1); }
#pragma unroll
    for (int i = 0; i < 2; ++i) { float keep = b1 ? w4[2 + i] : w4[i]; float send = b1 ? w4[i] : w4[2 + i]; w2[i] = keep + __shfl_xor(send, 2); }
    { float keep = b2 ? w2[1] : w2[0]; float send = b2 ? w2[0] : w2[1]; w1 = keep + __shfl_xor(send, 4); }
    w1 += __shfl_xor(w1, 8); w1 += __shfl_xor(w1, 16); w1 += __shfl_xor(w1, 32);
    const float dot = rstd * mysu * (w1 - 128.f * sx);
    const float a = gelu_erf(dot) * myg;
#pragma unroll
    for (int j = 0; j < 8; ++j) {
      const int src = ((j & 1) << 2) | (j & 2) | ((j >> 2) & 1);
      const float A = __int_as_float(__builtin_amdgcn_readlane(__float_as_int(a), src));
      sumA += A;
      axpy16(acc, A, vv[j]);
    }
  }
  float y[16];
#pragma unroll
  for (int i = 0; i < 16; ++i) y[i] = x[i] + acc[i] - 128.f * sumA;
  if (FINAL) {
    float s2 = 0.f;
#pragma unroll
    for (int i = 0; i < 16; ++i) s2 += y[i] * y[i];
    s2 = wave_sum(s2);
    const float r2 = rsqrtf(s2 * (1.f / 1024.f) + 1e-6f);
    const float* gf = p.in[11] + lane * 16;
#pragma unroll
    for (int i = 0; i < 4; ++i) {
      float4 g = *(const float4*)(gf + 4 * i);
      y[4 * i] *= r2 * g.x; y[4 * i + 1] *= r2 * g.y; y[4 * i + 2] *= r2 * g.z; y[4 * i + 3] *= r2 * g.w;
    }
  }
  if (DRY && ss != -1.f) return;
#pragma unroll
  for (int i = 0; i < 4; ++i) *(float4*)(xr + 4 * i) = make_float4(y[4 * i], y[4 * i + 1], y[4 * i + 2], y[4 * i + 3]);
}

#define OFF_PD OFF_MIX
#define OFF_PSS OFF_KP
#define OFF_PSX (OFF_KP + 1081344ull)
template <int CTRL> __device__ __forceinline__ int dpp_i(int v) { return __builtin_amdgcn_update_dpp(0, v, CTRL, 0xf, 0xf, true); }
__device__ __forceinline__ unsigned packq4(float a, float b, float c, float d, float inv) {
  const unsigned q0 = (unsigned)((int)rintf(a * inv)) & 255u, q1 = (unsigned)((int)rintf(b * inv)) & 255u;
  const unsigned q2 = (unsigned)((int)rintf(c * inv)) & 255u, q3 = (unsigned)((int)rintf(d * inv));
  return q0 | (q1 << 8) | (q2 << 16) | (q3 << 24);
}
__device__ __forceinline__ void peer9a_token(int tid, const Params& p, int layer, int tok, int j) {
  const int lane = tid & 63, g8 = lane >> 3, sub = lane & 7;
  const float* xr = p.out + O_Y + (size_t)tok * 1024 + j * 128 + sub * 16;
  const float* gn = p.in[10] + layer * 1024 + j * 128 + sub * 16;
  const unsigned char* U = p.ws + OFF_TAB + j * 128 + sub * 16;
  const int* eb = (const int*)(p.ws + OFF_M) + (size_t)tok * 128 + g8;
  float* pd = (float*)(p.ws + OFF_PD) + ((size_t)tok * 8 + j) * 128;
  int eid[16];
#pragma unroll
  for (int k = 0; k < 16; ++k) eid[k] = eb[k * 8];
  float xs[16];
  float ss = 0.f, am = 0.f;
#pragma unroll
  for (int i = 0; i < 4; ++i) {
    float4 v = *(const float4*)(xr + 4 * i);
    float4 g = *(const float4*)(gn + 4 * i);
    xs[4 * i] = v.x * g.x; xs[4 * i + 1] = v.y * g.y; xs[4 * i + 2] = v.z * g.z; xs[4 * i + 3] = v.w * g.w;
    ss += v.x * v.x + v.y * v.y + v.z * v.z + v.w * v.w;
    am = fmaxf(fmaxf(am, fmaxf(fabsf(xs[4 * i]), fabsf(xs[4 * i + 1]))), fmaxf(fabsf(xs[4 * i + 2]), fabsf(xs[4 * i + 3])));
  }
  uint4 rows[16];
#pragma unroll
  for (int k = 0; k < 16; ++k) rows[k] = *(const uint4*)(U + (size_t)eid[k] * 1024);
  am = fmaxf(am, dpp_f<0xB1>(am)); am = fmaxf(am, dpp_f<0x4E>(am)); am = fmaxf(am, dpp_f<0x141>(am));
  const float inv = (am > 0.f) ? 127.f / am : 0.f;
  const float xscale = am * (1.f / 127.f);
  int xq[4];
#pragma unroll
  for (int d = 0; d < 4; ++d) xq[d] = (int)packq4(xs[4 * d], xs[4 * d + 1], xs[4 * d + 2], xs[4 * d + 3], inv);
  int keep0 = 0, keep1 = 0;
#pragma unroll
  for (int k = 0; k < 16; ++k) {
    int D = __builtin_amdgcn_sdot4((int)rows[k].x, xq[0], 0, false);
    D = __builtin_amdgcn_sdot4((int)rows[k].y, xq[1], D, false);
    D = __builtin_amdgcn_sdot4((int)rows[k].z, xq[2], D, false);
    D = __builtin_amdgcn_sdot4((int)rows[k].w, xq[3], D, false);
    D += dpp_i<0xB1>(D); D += dpp_i<0x4E>(D); D += dpp_i<0x141>(D);
    if (k < 8) keep0 = (sub == k) ? D : keep0; else keep1 = (sub == k - 8) ? D : keep1;
  }
  pd[sub * 8 + g8] = (float)keep0 * xscale;
  pd[64 + sub * 8 + g8] = (float)keep1 * xscale;
  ss += dpp_f<0xB1>(ss); ss += dpp_f<0x4E>(ss); ss += dpp_f<0x141>(ss);
  if (lane == 0) ((float*)(p.ws + OFF_PSS))[(size_t)tok * 8 + j] = ss;
}

__device__ __forceinline__ void peer9m_token(int tid, unsigned char* smem, const Params& p, int tok) {
  const int lane = tid & 63, w = __builtin_amdgcn_readfirstlane(tid >> 6);
  unsigned char* sAq = smem + w * 128;
  const float* pd = (const float*)(p.ws + OFF_PD) + (size_t)tok * 1024;
  float* pss = (float*)(p.ws + OFF_PSS) + (size_t)tok * 8;
  const int* ebuf = (const int*)(p.ws + OFF_M) + (size_t)tok * 128;
  float* gbuf = (float*)(p.ws + OFF_M + 17301504ull) + (size_t)tok * 128;
  const float* sus = (const float*)(p.ws + OFF_TAB + TAB_SU_OFF);
  const float* svs = (const float*)(p.ws + OFF_TAB + TAB_SV_OFF);
  float ss = 0.f, d0 = 0.f, d1 = 0.f;
#pragma unroll
  for (int j = 0; j < 8; ++j) { ss += pss[j]; d0 += pd[j * 128 + lane]; d1 += pd[j * 128 + 64 + lane]; }
  const int e0 = ebuf[lane], e1 = ebuf[64 + lane];
  const float rstd = rsqrtf(ss * (1.f / 1024.f) + 1e-6f);
  const float a0 = gelu_erf(rstd * sus[e0] * d0) * gbuf[lane] * svs[e0];
  const float a1 = gelu_erf(rstd * sus[e1] * d1) * gbuf[64 + lane] * svs[e1];
  float am = row16_max(fmaxf(fabsf(a0), fabsf(a1)));
  {
    const float m0 = __int_as_float(__builtin_amdgcn_readlane(__float_as_int(am), 0)), m1 = __int_as_float(__builtin_amdgcn_readlane(__float_as_int(am), 16));
    const float m2 = __int_as_float(__builtin_amdgcn_readlane(__float_as_int(am), 32)), m3 = __int_as_float(__builtin_amdgcn_readlane(__float_as_int(am), 48));
    am = fmaxf(fmaxf(m0, m1), fmaxf(m2, m3));
  }
  const float inv = (am > 0.f) ? 127.f / am : 0.f;
  const int addr0 = (lane & 7) * 16 + (lane >> 3);
  sAq[addr0] = (unsigned char)((int)rintf(a0 * inv) & 255);
  sAq[addr0 + 8] = (unsigned char)((int)rintf(a1 * inv) & 255);
  asm volatile("s_waitcnt lgkmcnt(0)" ::: "memory");
  unsigned pk = 0u;
  if (lane < 32) pk = ((const unsigned*)sAq)[lane];
  asm volatile("s_waitcnt vmcnt(0) lgkmcnt(0)" ::: "memory");
  if (lane < 32) ((unsigned*)gbuf)[lane] = pk;
  if (lane == 0) pss[0] = am * (1.f / 127.f);
  asm volatile("s_waitcnt lgkmcnt(0)" ::: "memory");
}

__device__ __forceinline__ void peer9b_token(int tid, const Params& p, int tok, int j) {
  const int lane = tid & 63, g8 = lane >> 3, sub = lane & 7;
  float* xr = p.out + O_Y + (size_t)tok * 1024 + j * 128 + sub * 16;
  const unsigned char* V = p.ws + OFF_TAB + TAB_V_OFF + j * 128 + sub * 16;
  const int* eb = (const int*)(p.ws + OFF_M) + (size_t)tok * 128 + g8;
  const uint4 apk = *(const uint4*)((const unsigned*)(p.ws + OFF_M + 17301504ull) + (size_t)tok * 128 + g8 * 4);
  const float scaleA = ((const float*)(p.ws + OFF_PSS))[(size_t)tok * 8];
  int eid[16];
#pragma unroll
  for (int k = 0; k < 16; ++k) eid[k] = eb[k * 8];
  uint4 rows[16];
#pragma unroll
  for (int k = 0; k < 16; ++k) rows[k] = *(const uint4*)(V + (size_t)eid[k] * 1024);
  int acci[16];
#pragma unroll
  for (int i = 0; i < 16; ++i) acci[i] = 0;
#define P9B_DW(DWF, DW, AP, KQ) { \
    const unsigned r0 = rows[(KQ) * 4 + 0].DWF, r1 = rows[(KQ) * 4 + 1].DWF, r2 = rows[(KQ) * 4 + 2].DWF, r3 = rows[(KQ) * 4 + 3].DWF; \
    const unsigned t0 = __builtin_amdgcn_perm(r1, r0, 0x05010400u), t1 = __builtin_amdgcn_perm(r1, r0, 0x07030602u); \
    const unsigned t2 = __builtin_amdgcn_perm(r3, r2, 0x05010400u), t3 = __builtin_amdgcn_perm(r3, r2, 0x07030602u); \
    acci[(DW) * 4 + 0] = __builtin_amdgcn_sdot4((int)__builtin_amdgcn_perm(t2, t0, 0x05040100u), (int)(AP), acci[(DW) * 4 + 0], false); \
    acci[(DW) * 4 + 1] = __builtin_amdgcn_sdot4((int)__builtin_amdgcn_perm(t2, t0, 0x07060302u), (int)(AP), acci[(DW) * 4 + 1], false); \
    acci[(DW) * 4 + 2] = __builtin_amdgcn_sdot4((int)__builtin_amdgcn_perm(t3, t1, 0x05040100u), (int)(AP), acci[(DW) * 4 + 2], false); \
    acci[(DW) * 4 + 3] = __builtin_amdgcn_sdot4((int)__builtin_amdgcn_perm(t3, t1, 0x07060302u), (int)(AP), acci[(DW) * 4 + 3], false); }
#define P9B_KQ(AP, KQ) { P9B_DW(x, 0, AP, KQ) P9B_DW(y, 1, AP, KQ) P9B_DW(z, 2, AP, KQ) P9B_DW(w, 3, AP, KQ) }
  P9B_KQ(apk.x, 0) P9B_KQ(apk.y, 1) P9B_KQ(apk.z, 2) P9B_KQ(apk.w, 3)
  float acc[16];
#pragma unroll
  for (int i = 0; i < 16; ++i) acc[i] = (float)acci[i] * scaleA;
  const int b3 = (lane >> 3) & 1, b4 = (lane >> 4) & 1, b5 = (lane >> 5) & 1;
  float v8[8], v4[4], v2[2];
#pragma unroll
  for (int i = 0; i < 8; ++i) { float keep = b3 ? acc[8 + i] : acc[i]; float send = b3 ? acc[i] : acc[8 + i]; v8[i] = keep + dpp_f<0x128>(send); }
#pragma unroll
  for (int i = 0; i < 4; ++i) { float keep = b4 ? v8[4 + i] : v8[i]; float send = b4 ? v8[i] : v8[4 + i]; v4[i] = keep + __shfl_xor(send, 16); }
#pragma unroll
  for (int i = 0; i < 2; ++i) { float keep = b5 ? v4[2 + i] : v4[i]; float send = b5 ? v4[i] : v4[2 + i]; v2[i] = keep + __shfl_xor(send, 32); }
  const int c = b3 * 8 + b4 * 4 + b5 * 2;
  float2 xv = *(const float2*)(xr + c);
  xv.x += v2[0];
  xv.y += v2[1];
  *(float2*)(xr + c) = xv;
}

__device__ __forceinline__ void final_norm_token(int tid, const Params& p, int tok) {
  const int lane = tid & 63;
  float* xr = p.out + O_Y + (size_t)tok * 1024 + lane * 16;
  const float* gf = p.in[11] + lane * 16;
  float y[16]; float s2 = 0.f;
#pragma unroll
  for (int i = 0; i < 4; ++i) { float4 v = *(const float4*)(xr + 4 * i); y[4 * i] = v.x; y[4 * i + 1] = v.y; y[4 * i + 2] = v.z; y[4 * i + 3] = v.w; s2 += v.x * v.x + v.y * v.y + v.z * v.z + v.w * v.w; }
  s2 = wave_sum(s2);
  const float r2 = rsqrtf(s2 * (1.f / 1024.f) + 1e-6f);
#pragma unroll
  for (int i = 0; i < 4; ++i) {
    float4 g = *(const float4*)(gf + 4 * i);
    *(float4*)(xr + 4 * i) = make_float4(y[4 * i] * r2 * g.x, y[4 * i + 1] * r2 * g.y, y[4 * i + 2] * r2 * g.z, y[4 * i + 3] * r2 * g.w);
  }
}

__device__ __forceinline__ unsigned f2ukey(float v) { unsigned u = __float_as_uint(v); return (u & 0x80000000u) ? ~u : (u | 0x80000000u); }
__device__ __forceinline__ float ukey2f(unsigned k) { unsigned u = (k & 0x80000000u) ? (k & 0x7fffffffu) : ~k; return __uint_as_float(u); }
__device__ __forceinline__ int popc64(unsigned long long m) { return __builtin_popcountll(m); }
__device__ __forceinline__ int mbcnt64(unsigned long long m) { return (int)__builtin_amdgcn_mbcnt_hi((unsigned)(m >> 32), __builtin_amdgcn_mbcnt_lo((unsigned)m, 0u)); }

struct TopkFrags { bf16x8 a[2][2]; bf16x8 b[2][2]; };
__device__ __forceinline__ void topk_load(TopkFrags& f, int tid, const Params& p, int layer, int item) {
  const int lane = tid & 63, w = __builtin_amdgcn_readfirstlane(tid >> 6);
  const int l16 = lane & 15, quad = lane >> 4;
  const int h = item & 7, tok0 = (item >> 3) * 32;
  const int pp = w >> 2;
  const bf16_t* qb = (const bf16_t*)(p.ws + OFF_QBUF);
  const bf16_t* keys = (const bf16_t*)(p.ws + OFF_WT) + WT_KEYS + (size_t)((layer * 8 + h) * 2 + pp) * 8192;
#pragma unroll
  for (int ks = 0; ks < 2; ++ks) {
#pragma unroll
    for (int mt = 0; mt < 2; ++mt) f.a[ks][mt] = *(const bf16x8*)(qb + (size_t)(tok0 + mt * 16 + l16) * 1024 + h * 128 + pp * 64 + ks * 32 + quad * 8);
#pragma unroll
    for (int j = 0; j < 2; ++j) {
      const int nt = (w & 3) * 2 + j;
      f.b[ks][j] = *(const bf16x8*)(keys + (nt * 16 + l16) * 64 + ks * 32 + quad * 8);
    }
  }
}

__device__ __forceinline__ void peer_topk_item(int tid, unsigned char* smem, const Params& p, const TopkFrags& f, int item) {
  unsigned* sS = (unsigned*)smem;
  const int lane = tid & 63, w = __builtin_amdgcn_readfirstlane(tid >> 6);
  const int l16 = lane & 15, quad = lane >> 4;
  const int h = item & 7, tile = item >> 3;
  const int tok0 = tile * 32;
  unsigned* wtop = (unsigned*)(smem + 32768) + w * 256;
  float* wexp = (float*)(wtop + 128);
  __syncthreads();
  {
    const int pp = w >> 2;
    f32x4 acc[2][2];
#pragma unroll
    for (int i = 0; i < 2; ++i)
#pragma unroll
      for (int j = 0; j < 2; ++j) acc[i][j] = (f32x4){0.f, 0.f, 0.f, 0.f};
#pragma unroll
    for (int ks = 0; ks < 2; ++ks)
#pragma unroll
      for (int mt = 0; mt < 2; ++mt)
#pragma unroll
        for (int j = 0; j < 2; ++j) acc[mt][j] = __builtin_amdgcn_mfma_f32_16x16x32_bf16(f.a[ks][mt], f.b[ks][j], acc[mt][j], 0, 0, 0);
#pragma unroll
    for (int mt = 0; mt < 2; ++mt)
#pragma unroll
      for (int j = 0; j < 2; ++j) {
        const int nt = (w & 3) * 2 + j;
#pragma unroll
        for (int r = 0; r < 4; ++r) {
          const int key = nt * 16 + l16;
          sS[((mt * 16 + quad * 4 + r) * 2 + pp) * 128 + key] = (f2ukey(acc[mt][j][r]) & ~127u) | (unsigned)(127 - key);
        }
      }
  }
  __syncthreads();
  int* ebuf = (int*)(p.ws + OFF_M);
  float* gbuf = (float*)(p.ws + OFF_M + 17301504ull);
  unsigned k0[8], k1[8], T[8];
#pragma unroll
  for (int c = 0; c < 8; ++c) {
    const unsigned* row = sS + ((w * 4 + (c >> 1)) * 2 + (c & 1)) * 128;
    k0[c] = row[lane]; k1[c] = row[64 + lane]; T[c] = 0u;
  }
#pragma unroll 1
  for (int bit = 31; bit >= 7; --bit) {
    const unsigned bm = 1u << bit;
#pragma unroll
    for (int c = 0; c < 8; ++c) {
      const unsigned cand = T[c] | bm;
      const int cnt = popc64(__builtin_amdgcn_ballot_w64(k0[c] >= cand)) + popc64(__builtin_amdgcn_ballot_w64(k1[c] >= cand));
      T[c] = (cnt >= 16) ? cand : T[c];
    }
  }
  {
    bool need = false;
#pragma unroll
    for (int c = 0; c < 8; ++c) {
      const int cnt = popc64(__builtin_amdgcn_ballot_w64(k0[c] >= T[c])) + popc64(__builtin_amdgcn_ballot_w64(k1[c] >= T[c]));
      need = need || (cnt > 16);
    }
    if (need) {
#pragma unroll 1
      for (int bit = 6; bit >= 0; --bit) {
        const unsigned bm = 1u << bit;
#pragma unroll
        for (int c = 0; c < 8; ++c) {
          const unsigned cand = T[c] | bm;
          const int cnt = popc64(__builtin_amdgcn_ballot_w64(k0[c] >= cand)) + popc64(__builtin_amdgcn_ballot_w64(k1[c] >= cand));
          T[c] = (cnt >= 16) ? cand : T[c];
        }
      }
    }
  }
#pragma unroll
  for (int c = 0; c < 8; ++c) {
    const unsigned long long m0 = __builtin_amdgcn_ballot_w64(k0[c] >= T[c]);
    const unsigned long long m1 = __builtin_amdgcn_ballot_w64(k1[c] >= T[c]);
    const int s0 = mbcnt64(m0), s1 = popc64(m0) + mbcnt64(m1);
    if (k0[c] >= T[c]) wtop[c * 16 + s0] = k0[c];
    if (k1[c] >= T[c]) wtop[c * 16 + s1] = k1[c];
  }
  asm volatile("s_waitcnt lgkmcnt(0)" ::: "memory");
#define ROR_CNT(S) { const unsigned o_ = (unsigned)__builtin_amdgcn_update_dpp(0, (int)key_, 0x120 + (S), 0xf, 0xf, true); rk_ += (o_ > key_) ? 1 : 0; }
#pragma unroll
  for (int pass = 0; pass < 2; ++pass) {
    const int L = pass * 4 + (lane >> 4);
    const unsigned key_ = wtop[L * 16 + (lane & 15)];
    int rk_ = 0;
    ROR_CNT(1) ROR_CNT(2) ROR_CNT(3) ROR_CNT(4) ROR_CNT(5) ROR_CNT(6) ROR_CNT(7) ROR_CNT(8)
    ROR_CNT(9) ROR_CNT(10) ROR_CNT(11) ROR_CNT(12) ROR_CNT(13) ROR_CNT(14) ROR_CNT(15)
    wtop[L * 16 + rk_] = key_;
  }
  asm volatile("s_waitcnt lgkmcnt(0)" ::: "memory");
  int ci = (lane >= 16) + (lane >= 24) + (lane >= 29) + (lane >= 33) + (lane >= 36) + (lane >= 38) + (lane >= 40) + (lane >= 42);
#pragma unroll
  for (int t = 43; t < 50; ++t) ci += (lane >= t);
  int cstart = 0;
  cstart = (ci >= 1) ? 16 : cstart; cstart = (ci >= 2) ? 24 : cstart; cstart = (ci >= 3) ? 29 : cstart; cstart = (ci >= 4) ? 33 : cstart;
  cstart = (ci >= 5) ? 36 : cstart; cstart = (ci >= 6) ? 38 : cstart; cstart = (ci >= 7) ? 40 : cstart; cstart = (ci >= 8) ? 42 : cstart;
  cstart = (ci >= 9) ? (34 + ci) : cstart;
  const int cj = lane - cstart;
  const bool cvalid = lane < 50;
  unsigned kav[4], kbv[4], ck[4], T2[4]; float cs[4];
#pragma unroll
  for (int t = 0; t < 4; ++t) {
    kav[t] = 0u; kbv[t] = 0u; cs[t] = 0.f; ck[t] = 0u; T2[t] = 0u;
    if (cvalid) {
      kav[t] = wtop[(t * 2) * 16 + ci]; kbv[t] = wtop[(t * 2 + 1) * 16 + cj];
      cs[t] = ukey2f(kav[t]) + ukey2f(kbv[t]);
      ck[t] = ((f2ukey(cs[t]) & ~63u) | (unsigned)(63 - lane)) | 0u;
      ck[t] = (ck[t] == 0u) ? 1u : ck[t];
    }
  }
#pragma unroll 1
  for (int bit = 31; bit >= 6; --bit) {
    const unsigned bm = 1u << bit;
#pragma unroll
    for (int t = 0; t < 4; ++t) {
      const unsigned cand = T2[t] | bm;
      const int cnt = popc64(__builtin_amdgcn_ballot_w64(ck[t] >= cand));
      T2[t] = (cnt >= 16) ? cand : T2[t];
    }
  }
  {
    bool need = false;
#pragma unroll
    for (int t = 0; t < 4; ++t) need = need || (popc64(__builtin_amdgcn_ballot_w64(ck[t] >= T2[t])) > 16);
    if (need) {
#pragma unroll 1
      for (int bit = 5; bit >= 0; --bit) {
        const unsigned bm = 1u << bit;
#pragma unroll
        for (int t = 0; t < 4; ++t) {
          const unsigned cand = T2[t] | bm;
          const int cnt = popc64(__builtin_amdgcn_ballot_w64(ck[t] >= cand));
          T2[t] = (cnt >= 16) ? cand : T2[t];
        }
      }
    }
  }
  int* weid = (int*)(wexp + 64);
#pragma unroll
  for (int t = 0; t < 4; ++t) {
    const float cT = ukey2f(T2[t]);
    const bool win = ck[t] >= T2[t];
    const int sl = mbcnt64(__builtin_amdgcn_ballot_w64(win));
    if (win) {
      wexp[t * 16 + sl] = __expf(fminf(cs[t] - cT, 60.f));
      weid[t * 16 + sl] = (127 - (int)(kav[t] & 127u)) * 128 + (127 - (int)(kbv[t] & 127u));
    }
  }
  asm volatile("s_waitcnt lgkmcnt(0)" ::: "memory");
  {
    const int t = lane >> 4, sl = lane & 15;
    float es = 0.f;
#pragma unroll
    for (int q = 0; q < 4; ++q) { const float4 ee = *(const float4*)(wexp + t * 16 + q * 4); es += ee.x + ee.y + ee.z + ee.w; }
    const float e = wexp[t * 16 + sl];
    const int id = weid[t * 16 + sl];
    const size_t o = (size_t)(tok0 + w * 4 + t) * 128 + h * 16 + sl;
    ebuf[o] = id;
    gbuf[o] = e / es;
  }
  asm volatile("s_waitcnt lgkmcnt(0)" ::: "memory");
}

struct EpiStoreBf16 { bf16_t* dst; int ld; __device__ void operator()(int r, int c, float v) const { dst[(size_t)r * ld + c] = f2bf(v); } };
struct EpiGlu { const bf16_t* z; const float* bias; bf16_t* mix; __device__ void operator()(int r, int c, float v) const {
  float zz = bf2f(z[(size_t)r * 512 + c]); float s = v + bias[c]; mix[(size_t)r * 1024 + 512 + c] = f2bf(zz / (1.f + __expf(-s))); } };
struct EpiRes0 { const float* xp; const float* xs; float* xres; __device__ void operator()(int r, int c, float v) const {
  float x = (r < T_P) ? xp[(size_t)r * 1024 + c] : xs[(size_t)(r - T_P) * 1024 + c]; xres[(size_t)r * 1024 + c] = x + v; } };
struct EpiRes1 { float* xres; __device__ void operator()(int r, int c, float v) const { xres[(size_t)r * 1024 + c] += v; } };
struct EpiPool { bf16_t* mix; const float* scale; int g; __device__ void operator()(int r, int c, float v) const {
  mix[(size_t)r * 1024 + g * 128 + c] = f2bf(v * scale[g * 128 + c]); } };
struct EpiKup { bf16_t* dst; int rowsPerB; int keyOff; int bStride; __device__ void operator()(int r, int c, float v) const {
  int b = r / rowsPerB, key = r % rowsPerB + keyOff; dst[((size_t)b * bStride + key) * 512 + c] = f2bf(v); } };
struct EpiVt { bf16_t* dst; int rowsPerB; int keyOff; int ldv; __device__ void operator()(int r, int c, float v) const {
  int b = r / rowsPerB, key = r % rowsPerB + keyOff; dst[((size_t)(b * 8 + (c >> 6)) * 64 + (c & 63)) * ldv + key] = f2bf(v); } };


typedef const Params __attribute__((address_space(4))) KParams;

constexpr size_t OFF_BAR = WS_NEED;
__device__ __forceinline__ void grid_barrier(unsigned* ctr, unsigned target) {
  asm volatile("s_waitcnt vmcnt(0)" ::: "memory");
  __syncthreads();
  if (threadIdx.x == 0) {
    __builtin_amdgcn_fence(__ATOMIC_RELEASE, "agent");
    asm volatile("s_waitcnt vmcnt(0)" ::: "memory");
    __hip_atomic_fetch_add(ctr, 1u, __ATOMIC_RELAXED, __HIP_MEMORY_SCOPE_AGENT);
    unsigned spins = 0;
    while (__hip_atomic_load(ctr, __ATOMIC_RELAXED, __HIP_MEMORY_SCOPE_AGENT) < target) {
      __builtin_amdgcn_s_sleep(1);
      if (++spins > (1u << 27)) break;
    }
    __builtin_amdgcn_fence(__ATOMIC_ACQUIRE, "agent");
    asm volatile("s_waitcnt vmcnt(0)" ::: "memory");
  }
  __syncthreads();
}
#define GRID_BAR() { unsigned* ctr_ = (unsigned*)(((KParams*)__builtin_amdgcn_kernarg_segment_ptr())->ws + OFF_BAR); bar_k += 1; grid_barrier(ctr_, (unsigned)bar_k * gridDim.x); }
#define PHASE_BEGIN \
  Params p; \
  { KParams* kp_ = (KParams*)__builtin_amdgcn_kernarg_segment_ptr(); asm volatile("" : "+s"(kp_)); \
    _Pragma("unroll") for (int i_ = 0; i_ < 38; ++i_) p.in[i_] = kp_->in[i_]; \
    p.out = kp_->out; p.ws = kp_->ws; } \
  int tid = threadIdx.x; asm volatile("" : "+v"(tid)); \
  const int lane = tid & 63, w = __builtin_amdgcn_readfirstlane(tid >> 6); \
  const int gw = blockIdx.x * 8 + w, nw = gridDim.x * 8; \
  const size_t gtid = (size_t)blockIdx.x * NT + tid, gthreads = (size_t)gridDim.x * NT; \
  bf16_t* wt = (bf16_t*)(p.ws + OFF_WT); \
  bf16_t* proj = (bf16_t*)(p.ws + OFF_PROJ); \
  bf16_t* mix = (bf16_t*)(p.ws + OFF_MIX); \
  bf16_t* qbuf = (bf16_t*)(p.ws + OFF_QBUF); \
  bf16_t* zbuf = (bf16_t*)(p.ws + OFF_Z); \
  float* xres = p.out + O_Y; \
  (void)lane; (void)gw; (void)nw; (void)gtid; (void)gthreads; (void)wt; (void)proj; (void)mix; (void)qbuf; (void)zbuf; (void)xres;

template <int LAYER>
__device__ __forceinline__ void peer_phases(int& bar_k, unsigned char* smem) {
  const int layer = LAYER;
    for (int rep_ = 0; rep_ < NREP(7); ++rep_)
    {
    PHASE_BEGIN
      int vb = 0;
      gemm_run<2>(tid, smem, xres, xres, T_TOT, 1024, p.in[10] + layer * 1024, wt + WT_PQ + (size_t)layer * 1048576, T_TOT, 1024, 1024, vb, EpiStoreBf16{qbuf, 1024});
    }
    GRID_BAR();
    for (int rep_ = 0; rep_ < NREP(8); ++rep_) {
    PHASE_BEGIN
    {
      TopkFrags fr;
      int item = blockIdx.x;
      if (item < 1056 * 8) topk_load(fr, tid, p, layer, item);
      for (; item < 1056 * 8; item += gridDim.x) {
        TopkFrags cur = fr;
        const int nxt = item + gridDim.x;
        if (nxt < 1056 * 8) topk_load(fr, tid, p, layer, nxt);
        peer_topk_item(tid, smem, p, cur, item);
      }
    }
    }
    GRID_BAR();
    for (int rep_ = 0; rep_ < NREP(9); ++rep_) {
    PHASE_BEGIN
      int j = blockIdx.x & 7, lb = blockIdx.x >> 3, nb = ((int)gridDim.x - j + 7) >> 3;
      {
        unsigned* cnt_ = (unsigned*)(p.ws + OFF_BAR) + 16;
        bool ok_ = true;
#pragma unroll
        for (int x_ = 0; x_ < 16; ++x_) {
          const unsigned c_ = __hip_atomic_load(&cnt_[x_], __ATOMIC_RELAXED, __HIP_MEMORY_SCOPE_AGENT);
          ok_ = ok_ && ((x_ < 8) ? (c_ > 0u) : (c_ == 0u));
        }
        if (ok_) {
          j = ((const int*)(smem + (DYN_LDS - 16)))[0]; lb = ((const int*)(smem + (DYN_LDS - 16)))[1];
          nb = (int)__hip_atomic_load(&cnt_[j], __ATOMIC_RELAXED, __HIP_MEMORY_SCOPE_AGENT);
        }
      }
      for (int tok = lb * 8 + w; tok < T_TOT; tok += nb * 8) peer9a_token(tid, p, layer, tok, j);
    }
    GRID_BAR();
    for (int rep_ = 0; rep_ < NREP(9); ++rep_) {
    PHASE_BEGIN
      for (int tok = gw; tok < T_TOT; tok += nw) peer9m_token(tid, smem, p, tok);
    }
    GRID_BAR();
    for (int rep_ = 0; rep_ < NREP(9); ++rep_) {
    PHASE_BEGIN
      int j = blockIdx.x & 7, lb = blockIdx.x >> 3, nb = ((int)gridDim.x - j + 7) >> 3;
      {
        unsigned* cnt_ = (unsigned*)(p.ws + OFF_BAR) + 16;
        bool ok_ = true;
#pragma unroll
        for (int x_ = 0; x_ < 16; ++x_) {
          const unsigned c_ = __hip_atomic_load(&cnt_[x_], __ATOMIC_RELAXED, __HIP_MEMORY_SCOPE_AGENT);
          ok_ = ok_ && ((x_ < 8) ? (c_ > 0u) : (c_ == 0u));
        }
        if (ok_) {
          j = ((const int*)(smem + (DYN_LDS - 16)))[0]; lb = ((const int*)(smem + (DYN_LDS - 16)))[1];
          nb = (int)__hip_atomic_load(&cnt_[j], __ATOMIC_RELAXED, __HIP_MEMORY_SCOPE_AGENT);
        }
      }
      for (int tok = lb * 8 + w; tok < T_TOT; tok += nb * 8) peer9b_token(tid, p, tok, j);
    }
    if (layer == 1) {
      GRID_BAR();
      for (int rep_ = 0; rep_ < NREP(9); ++rep_) {
      PHASE_BEGIN
        for (int tok = gw; tok < T_TOT; tok += nw) final_norm_token(tid, p, tok);
      }
    }
}

__global__ void __launch_bounds__(NT) mega(Params kparams_) {
  cg::grid_group grid = cg::this_grid();
  int bar_k = 0;
  extern __shared__ __attribute__((aligned(16))) unsigned char smem[];
  if (threadIdx.x == 0) {
    unsigned* cnt_ = (unsigned*)(((KParams*)__builtin_amdgcn_kernarg_segment_ptr())->ws + OFF_BAR) + 16;
    const unsigned xcc_ = (unsigned)__builtin_amdgcn_s_getreg((3 << 11) | 20) & 0xFu;
    const unsigned rank_ = __hip_atomic_fetch_add(&cnt_[xcc_], 1u, __ATOMIC_RELAXED, __HIP_MEMORY_SCOPE_AGENT);
    ((int*)(smem + (DYN_LDS - 16)))[0] = (int)xcc_;
    ((int*)(smem + (DYN_LDS - 16)))[1] = (int)rank_;
  }

  for (int rep_ = 0; rep_ < NREP(0); ++rep_)
  {
    PHASE_BEGIN
    int vb = 0;
    transpose_convert(tid, smem, p.in[12], wt + WT_IN_E, 1024, 1280, vb);
    transpose_convert(tid, smem, p.in[13], wt + WT_OUT_E, 1024, 1024, vb);
    transpose_convert(tid, smem, p.in[23], wt + WT_GLU, 512, 512, vb);
    transpose_convert(tid, smem, p.in[25], wt + WT_IN_O, 1024, 1312, vb);
    transpose_convert(tid, smem, p.in[26], wt + WT_OUT_O, 1024, 1024, vb);
    for (int g = 0; g < 4; ++g) transpose_convert(tid, smem, p.in[27] + g * 16384, wt + WT_POOL + g * 16384, 128, 128, vb);
    transpose_convert(tid, smem, p.in[31], wt + WT_UQ, 512, 768, vb);
    transpose_convert(tid, smem, p.in[32], wt + WT_UK, 256, 512, vb);
    transpose_convert(tid, smem, p.in[33], wt + WT_UV, 256, 512, vb);
    transpose_convert(tid, smem, p.in[34], wt + WT_PQ, 1024, 1024, vb);
    transpose_convert(tid, smem, p.in[34] + 1048576, wt + WT_PQ + 1048576, 1024, 1024, vb);
    convert_plain(tid, p.in[35], wt + WT_KEYS, 262144);
    quant_rows(p.in[36], p.ws + OFF_TAB, (float*)(p.ws + OFF_TAB + TAB_SU_OFF), gw, nw, tid);
    quant_rows(p.in[37], p.ws + OFF_TAB + TAB_V_OFF, (float*)(p.ws + OFF_TAB + TAB_SV_OFF), gw, nw, tid);
  }
  grid.sync();

  for (int rep_ = 0; rep_ < NREP(1); ++rep_)
  {
    PHASE_BEGIN
    int vb = 0;
    gemm_run<2>(tid, smem, p.in[0], p.in[1], T_P, 1024, p.in[9], wt + WT_IN_E, T_TOT, 1280, 1024, vb, EpiStoreBf16{proj, 1280});
  }
  GRID_BAR();

  for (int rep_ = 0; rep_ < NREP(2); ++rep_)
  {
    PHASE_BEGIN
    bf16_t* vt0 = (bf16_t*)(p.ws + OFF_VT0);
    bf16_t* kall = (bf16_t*)(p.ws + OFF_KALL);
    bf16_t* vtall = (bf16_t*)(p.ws + OFF_VTALL);
    for (int tok = gw; tok < T_TOT; tok += nw) {
      const bool isS = tok >= T_P;
      int b, t, pos;
      if (!isS) { b = tok >> 12; t = tok & 4095; pos = t; } else { int s = tok - T_P; b = s >> 5; t = s & 31; pos = 2048 + t; }
      bf16_t* row = proj + (size_t)tok * 1280;
      const int lm = lane & 7;
      float sn[8], cs[8];
#pragma unroll
      for (int j = 0; j < 8; ++j) { float inv = exp2f(-(float)j * (LOG2_THETA / 8.f)); sincos_rev((float)pos * inv, sn[j], cs[j]); }
      {
        uint4 qv = *(const uint4*)(row + lane * 8);
        float x[8]; unpack8(qv, x);
#pragma unroll
        for (int j = 0; j < 8; ++j) {
          float other = __shfl_xor(x[j], 1);
          if (lm == 0) x[j] = x[j] * cs[j] - other * sn[j];
          else if (lm == 1) x[j] = x[j] * cs[j] + other * sn[j];
        }
        *(uint4*)(row + lane * 8) = pack8(x);
      }
      {
        uint4 kv = make_uint4(0, 0, 0, 0);
        if (lane < 32) kv = *(const uint4*)(row + 512 + lane * 8);
        float x[8]; unpack8(kv, x);
#pragma unroll
        for (int j = 0; j < 8; ++j) {
          float other = __shfl_xor(x[j], 1);
          if (lane < 16) {
            if (lm == 0) x[j] = x[j] * cs[j] - other * sn[j];
            else if (lm == 1) x[j] = x[j] * cs[j] + other * sn[j];
          }
        }
        if (lane < 32) {
          const uint4 pk = pack8(x);
          const int e0 = (lane & 15) * 8;
          if (!isS) {
            if (lane < 16) *(uint4*)(row + 512 + lane * 8) = pk;
            else {
              const int kvh = e0 >> 6, d0 = e0 & 63;
#pragma unroll
              for (int j = 0; j < 8; ++j) vt0[((size_t)(b * 2 + kvh) * 64 + d0 + j) * 4096 + t] = f2bf(x[j]);
            }
            if (t >= 3968) {
              float* dst = p.out + ((lane < 16) ? O_SWAK_P : O_SWAV_P) + ((size_t)(b * 128 + (t - 3968)) * 128 + e0);
              *(float4*)dst = make_float4(x[0], x[1], x[2], x[3]);
              *(float4*)(dst + 4) = make_float4(x[4], x[5], x[6], x[7]);
            }
          } else {
            float* dst = p.out + ((lane < 16) ? O_SWAK_S : O_SWAV_S) + ((size_t)(b * 128 + 96 + t) * 128 + e0);
            *(float4*)dst = make_float4(x[0], x[1], x[2], x[3]);
            *(float4*)(dst + 4) = make_float4(x[4], x[5], x[6], x[7]);
            if (lane < 16) *(uint4*)(kall + (size_t)(b * 160 + 128 + t) * 128 + e0) = pk;
            else {
              const int kvh = e0 >> 6, d0 = e0 & 63;
#pragma unroll
              for (int j = 0; j < 8; ++j) vtall[((size_t)(b * 2 + kvh) * 64 + d0 + j) * 192 + 128 + t] = f2bf(x[j]);
            }
          }
        }
      }
    }
    for (size_t idx = gtid; idx < (size_t)32 * 96 * 128; idx += gthreads) {
      const int e = (int)(idx & 127); const int wd = (int)((idx >> 7) % 96); const int b = (int)(idx / (96 * 128));
      const size_t src = ((size_t)(b * 128 + 32 + wd)) * 128 + e, dst = ((size_t)(b * 128 + wd)) * 128 + e;
      p.out[O_SWAK_S + dst] = p.in[2][src];
      p.out[O_SWAV_S + dst] = p.in[3][src];
    }
    for (size_t idx = gtid; idx < (size_t)32 * 128 * 128; idx += gthreads) {
      const int e = (int)(idx & 127); const int key = (int)((idx >> 7) & 127); const int b = (int)(idx >> 14);
      kall[(size_t)(b * 160 + key) * 128 + e] = f2bf(p.in[2][idx]);
      vtall[((size_t)(b * 2 + (e >> 6)) * 64 + (e & 63)) * 192 + key] = f2bf(p.in[3][idx]);
    }
    for (size_t idx = gtid; idx < (size_t)32 * 2 * 64 * 32; idx += gthreads) {
      const int kk = (int)(idx & 31); const size_t rr = idx >> 5;
      vtall[rr * 192 + 160 + kk] = 0;
    }
    float* sUw = (float*)smem + w * 512;
    for (int item = gw; item < 32768; item += nw) s5_item<0>(tid, sUw, p, item);
  }
  GRID_BAR();

  for (int rep_ = 0; rep_ < NREP(3); ++rep_)
  {
    PHASE_BEGIN
    if (gtid < 16384) {
      const int n = (int)(gtid & 63), g = (int)((gtid >> 6) & 31), b = (int)(gtid >> 11);
      const int gn = g * 64 + n;
      const float lr = fminf(p.in[15][gn], -1e-4f), li = p.in[16][gn];
      const float dt = __expf(p.in[17][g]);
      const float mag = __expf(lr * dt);
      float sn, cs; sincos_rev(li * dt, sn, cs);
      float ar = mag * cs, ai = mag * sn;
#pragma unroll
      for (int i = 0; i < 5; ++i) { float nr = ar * ar - ai * ai, ni = 2.f * ar * ai; ar = nr; ai = ni; }
      const float* s1re = (const float*)(p.ws + OFF_QMLA);
      const float* s1im = s1re + 2097152;
      float* hinre = (float*)(p.ws + OFF_QMLA) + 2 * 2097152;
      float* hinim = hinre + 2097152;
      float hr = 0.f, hi = 0.f;
#pragma unroll 8
      for (int c = 0; c < 128; ++c) {
        const size_t idx = ((size_t)(b * 128 + c) * 32 + g) * 64 + n;
        hinre[idx] = hr; hinim[idx] = hi;
        const float sr = s1re[idx], si = s1im[idx];
        const float nhr = ar * hr - ai * hi + sr, nhi = ar * hi + ai * hr + si;
        hr = nhr; hi = nhi;
      }
      p.out[O_SSMRE_P + (size_t)(b * 32 + g) * 64 + n] = hr;
      p.out[O_SSMIM_P + (size_t)(b * 32 + g) * 64 + n] = hi;
    }
    const bf16_t* vt0 = (const bf16_t*)(p.ws + OFF_VT0);
    const bf16_t* kall = (const bf16_t*)(p.ws + OFF_KALL);
    const bf16_t* vtall = (const bf16_t*)(p.ws + OFF_VTALL);
    const float* sink = p.in[14];
    for (int item = blockIdx.x; item < 2048 + 256; item += gridDim.x) {
      AttnDesc d;
      d.scale = 0.125f; d.kx = nullptr; d.pos0 = 0;
      if (item < 2048) {
        const int h = item & 7, pr = (item >> 3) & 31, b = item >> 8;
        const int kvh = h >> 2;
        const int chunk = pr * 2 + (w >> 2);
        const int tok = b * 4096 + chunk * 64 + (w & 3) * 16;
        d.q = proj + (size_t)tok * 1280 + h * 64; d.ldq = 1280; d.active = 1;
        d.kt_lo = max(0, chunk - 2); d.kt_hi = chunk + 1;
        d.out = mix + (size_t)tok * 1024 + h * 64; d.ldo = 1024;
        d.m0 = sink[h]; d.l0 = 1.f;
        d.k = proj + (size_t)(b * 4096) * 1280 + 512 + kvh * 64; d.ldk = 1280;
        d.vt = vt0 + (size_t)(b * 2 + kvh) * 64 * 4096; d.ldv = 4096; d.nkeys = 4096;
        d.bt_lo = max(0, pr * 2 - 2); d.bt_hi = pr * 2 + 2;
      } else {
        const int it = item - 2048;
        const int h = it & 7, b = it >> 3;
        const int kvh = h >> 2;
        const int tok = T_P + b * 32 + (w & 1) * 16;
        d.q = proj + (size_t)tok * 1280 + h * 64; d.ldq = 1280; d.active = (w < 2);
        d.kt_lo = 0; d.kt_hi = 3;
        d.out = mix + (size_t)tok * 1024 + h * 64; d.ldo = 1024;
        d.m0 = sink[h]; d.l0 = 1.f;
        d.k = kall + (size_t)(b * 160) * 128 + kvh * 64; d.ldk = 128;
        d.vt = vtall + (size_t)(b * 2 + kvh) * 64 * 192; d.ldv = 192; d.nkeys = 160;
        d.bt_lo = 0; d.bt_hi = 3;
      }
      attn_item<64>(tid, smem, d);
    }
  }
  GRID_BAR();

  for (int rep_ = 0; rep_ < NREP(4); ++rep_)
  {
    PHASE_BEGIN
    float* sUw = (float*)smem + w * 512;
    for (int item = gw; item < 33792; item += nw) s5_item<1>(tid, sUw, p, item);
  }
  GRID_BAR();

  for (int rep_ = 0; rep_ < NREP(5); ++rep_)
  {
    PHASE_BEGIN
    int vb = 0;
    gemm_run<0>(tid, smem, zbuf, zbuf, T_TOT, 512, nullptr, wt + WT_GLU, T_TOT, 512, 512, vb, EpiGlu{zbuf, p.in[24], mix});
  }
  GRID_BAR();

  for (int rep_ = 0; rep_ < NREP(6); ++rep_)
  {
    PHASE_BEGIN
    int vb = 0;
    gemm_run<0>(tid, smem, mix, mix, T_TOT, 1024, nullptr, wt + WT_OUT_E, T_TOT, 1024, 1024, vb, EpiRes0{p.in[0], p.in[1], xres});
  }
  GRID_BAR();

  peer_phases<0>(bar_k, smem);
  GRID_BAR();
      for (int rep_ = 0; rep_ < NREP(10); ++rep_)
      {
    PHASE_BEGIN
        int vb = 0;
        gemm_run<2>(tid, smem, xres, xres, T_TOT, 1024, p.in[9] + 1024, wt + WT_IN_O, T_TOT, 1312, 1024, vb, EpiStoreBf16{proj, 1312});
      }
      GRID_BAR();
      for (int rep_ = 0; rep_ < NREP(11); ++rep_)
      {
    PHASE_BEGIN
        bf16_t* cqn = zbuf;
        bf16_t* mbuf = (bf16_t*)(p.ws + OFF_M);
        bf16_t* cbuf = (bf16_t*)(p.ws + OFF_C);
        bf16_t* kpbuf = (bf16_t*)(p.ws + OFF_KP);
        bf16_t* kps = (bf16_t*)(p.ws + OFF_KPS);
        for (int tok = gw; tok < T_TOT; tok += nw) {
          const bool isS = tok >= T_P;
          int b, t, pos;
          if (!isS) { b = tok >> 12; t = tok & 4095; pos = t; } else { int s = tok - T_P; b = s >> 5; t = s & 31; pos = 2048 + t; }
          const bf16_t* row = proj + (size_t)tok * 1312;
          {
            uint4 v = *(const uint4*)(row + lane * 8);
            float x[8]; unpack8(v, x);
            float ss = 0.f;
#pragma unroll
            for (int j = 0; j < 8; ++j) ss += x[j] * x[j];
            ss = wave_sum(ss);
            const float rs = rsqrtf(ss * (1.f / 512.f) + 1e-6f);
            const float4 g0 = *(const float4*)(p.in[29] + lane * 8), g1 = *(const float4*)(p.in[29] + lane * 8 + 4);
            x[0] *= rs * g0.x; x[1] *= rs * g0.y; x[2] *= rs * g0.z; x[3] *= rs * g0.w;
            x[4] *= rs * g1.x; x[5] *= rs * g1.y; x[6] *= rs * g1.z; x[7] *= rs * g1.w;
            *(uint4*)(cqn + (size_t)tok * 512 + lane * 8) = pack8(x);
          }
          {
            uint2 v = *(const uint2*)(row + 512 + lane * 4);
            float x0 = lo2f(v.x), x1 = hi2f(v.x), x2 = lo2f(v.y), x3 = hi2f(v.y);
            float ss = wave_sum(x0 * x0 + x1 * x1 + x2 * x2 + x3 * x3);
            const float rs = rsqrtf(ss * (1.f / 256.f) + 1e-6f);
            const float4 g = *(const float4*)(p.in[30] + lane * 4);
            x0 *= rs * g.x; x1 *= rs * g.y; x2 *= rs * g.z; x3 *= rs * g.w;
            uint2 o; o.x = pack2(x0, x1); o.y = pack2(x2, x3);
            *(uint2*)(cbuf + (size_t)tok * 256 + lane * 4) = o;
            float* dst = isS ? (p.out + O_CKV_S + (size_t)(tok - T_P) * 256 + lane * 4) : (p.out + O_CKV_P + (size_t)tok * 256 + lane * 4);
            *(float4*)dst = make_float4(x0, x1, x2, x3);
          }
          {
            float xv = 0.f;
            if (lane < 32) xv = bf2f(row[768 + lane]);
            const float other = __shfl_xor(xv, 16);
            const int f = lane & 15;
            const float inv = exp2f(-(float)f * (LOG2_THETA / 16.f));
            float sn, cs; sincos_rev((float)pos * inv, sn, cs);
            const float r = (lane < 16) ? (xv * cs - other * sn) : (xv * cs + other * sn);
            if (lane < 32) {
              kpbuf[(size_t)tok * 32 + lane] = f2bf(r);
              if (isS) { p.out[O_KPE_S + (size_t)(tok - T_P) * 32 + lane] = r; kps[((size_t)b * 2112 + 2048 + t) * 32 + lane] = f2bf(r); }
              else p.out[O_KPE_P + (size_t)tok * 32 + lane] = r;
            }
          }
          {
            const int gi = lane >> 4; const int wlen = 2 << gi;
            float tot[8], cur[8];
#pragma unroll
            for (int j = 0; j < 8; ++j) tot[j] = 0.f;
            uint4 v = *(const uint4*)(row + 800 + lane * 8);
            unpack8(v, cur);
#pragma unroll
            for (int j = 0; j < 8; ++j) tot[j] = cur[j];
            for (int jb = 1; jb < 16; ++jb) {
              if (jb < wlen) {
                const int tt = t - jb;
                if (tt >= 0) {
                  uint4 pv = *(const uint4*)(row - (size_t)jb * 1312 + 800 + lane * 8);
                  float y[8]; unpack8(pv, y);
#pragma unroll
                  for (int j = 0; j < 8; ++j) tot[j] += y[j];
                } else if (isS) {
                  const float* sp = p.in[6] + ((size_t)b * 15 + (15 + tt)) * 512 + lane * 8;
                  float4 a = *(const float4*)sp, bq = *(const float4*)(sp + 4);
                  tot[0] += a.x; tot[1] += a.y; tot[2] += a.z; tot[3] += a.w; tot[4] += bq.x; tot[5] += bq.y; tot[6] += bq.z; tot[7] += bq.w;
                }
              }
            }
            const float cnt = (float)min(pos + 1, wlen);
            float mm[8];
#pragma unroll
            for (int j = 0; j < 8; ++j) mm[j] = tot[j] / cnt - cur[j];
            *(uint4*)(mbuf + (size_t)tok * 512 + lane * 8) = pack8(mm);
            const int tlen = isS ? 32 : 4096;
            if (t >= tlen - 15) {
              const int i = t - (tlen - 15);
              float* dst = isS ? (p.out + O_POOL_S + ((size_t)b * 15 + i) * 512 + lane * 8) : (p.out + O_POOL_P + ((size_t)b * 15 + i) * 512 + lane * 8);
              *(float4*)dst = make_float4(cur[0], cur[1], cur[2], cur[3]);
              *(float4*)(dst + 4) = make_float4(cur[4], cur[5], cur[6], cur[7]);
            }
          }
        }
        for (size_t idx = gtid; idx < (size_t)32 * 2048 * 32; idx += gthreads) {
          const int e = (int)(idx & 31); const int key = (int)((idx >> 5) & 2047); const int b = (int)(idx >> 16);
          kps[((size_t)b * 2112 + key) * 32 + e] = f2bf(p.in[8][idx]);
        }
      }
      GRID_BAR();
      for (int rep_ = 0; rep_ < NREP(12); ++rep_)
      {
    PHASE_BEGIN
        bf16_t* cqn = zbuf;
        bf16_t* mbuf = (bf16_t*)(p.ws + OFF_M);
        bf16_t* cbuf = (bf16_t*)(p.ws + OFF_C);
        bf16_t* qmla = (bf16_t*)(p.ws + OFF_QMLA);
        bf16_t* kupp = qbuf;
        bf16_t* vtp = qbuf + 16777216;
        bf16_t* kups = (bf16_t*)(p.ws + OFF_KUPS);
        bf16_t* vts = (bf16_t*)(p.ws + OFF_VTS);
        for (size_t idx = gtid; idx < (size_t)32 * 8 * 64 * 32; idx += gthreads) {
          const int kk = (int)(idx & 31); const size_t rr = idx >> 5;
          vts[rr * 2112 + 2080 + kk] = 0;
        }
        int vb = 0;
        gemm_run<1>(tid, smem, p.in[7], p.in[7], 65536, 256, nullptr, wt + WT_UK, 65536, 512, 256, vb, EpiKup{kups, 2048, 0, 2112});
        gemm_run<1>(tid, smem, p.in[7], p.in[7], 65536, 256, nullptr, wt + WT_UV, 65536, 512, 256, vb, EpiVt{vts, 2048, 0, 2112});
        gemm_run<0>(tid, smem, cqn, cqn, T_TOT, 512, nullptr, wt + WT_UQ, T_TOT, 768, 512, vb, EpiStoreBf16{qmla, 768});
        gemm_run<0>(tid, smem, cbuf, cbuf, T_P, 256, nullptr, wt + WT_UK, T_P, 512, 256, vb, EpiKup{kupp, 4096, 0, 4096});
        gemm_run<0>(tid, smem, cbuf, cbuf, T_P, 256, nullptr, wt + WT_UV, T_P, 512, 256, vb, EpiVt{vtp, 4096, 0, 4096});
        gemm_run<0>(tid, smem, cbuf + (size_t)T_P * 256, cbuf, 1024, 256, nullptr, wt + WT_UK, 1024, 512, 256, vb, EpiKup{kups, 32, 2048, 2112});
        gemm_run<0>(tid, smem, cbuf + (size_t)T_P * 256, cbuf, 1024, 256, nullptr, wt + WT_UV, 1024, 512, 256, vb, EpiVt{vts, 32, 2048, 2112});
        for (int g = 0; g < 4; ++g)
          gemm_run<0>(tid, smem, mbuf + g * 128, mbuf, T_TOT, 512, nullptr, wt + WT_POOL + g * 16384, T_TOT, 128, 128, vb, EpiPool{mix, p.in[28], g});
      }
      GRID_BAR();
      for (int rep_ = 0; rep_ < NREP(13); ++rep_)
      {
    PHASE_BEGIN
        const bf16_t* qmla = (const bf16_t*)(p.ws + OFF_QMLA);
        const bf16_t* kupp = qbuf;
        const bf16_t* vtp = qbuf + 16777216;
        const bf16_t* kups = (const bf16_t*)(p.ws + OFF_KUPS);
        const bf16_t* vts = (const bf16_t*)(p.ws + OFF_VTS);
        const bf16_t* kpbuf = (const bf16_t*)(p.ws + OFF_KP);
        const bf16_t* kps = (const bf16_t*)(p.ws + OFF_KPS);
        const int G = gridDim.x;
        const bool xsched = (G == 256);
        const int nitems = 2048 + 256;
        const int xcd = blockIdx.x & 7, loc = blockIdx.x >> 3;
        for (int k = 0;; ++k) {
          int pit, sit = -1;
          if (xsched) {
            if (k >= 9) break;
            if (k == 0) { pit = -1; sit = blockIdx.x; }
            else {
              const int r = k - 1;
              const int grp = xcd + 8 * r;
              const int pr = (r & 1) ? (31 - loc) : loc;
              pit = ((31 - pr) << 6) | grp;
            }
          } else {
            const int posn = (k & 1) ? (G - 1 - (int)blockIdx.x) : (int)blockIdx.x;
            const int v = k * G + posn;
            if (k * G >= nitems) break;
            if (v >= nitems) continue;
            if (v < 1024) pit = v; else if (v < 1280) { pit = -1; sit = v - 1024; } else pit = v - 256;
          }
          AttnDesc d;
          d.scale = 0.10206207261596575f; d.m0 = -1e30f; d.l0 = 0.f;
          if (pit >= 0) {
            const int pr = 31 - (pit >> 6); const int h = pit & 7, b = (pit >> 3) & 7;
            const int chunk = pr * 2 + (w >> 2);
            const int tok = b * 4096 + chunk * 64 + (w & 3) * 16;
            d.q = qmla + (size_t)tok * 768 + h * 96; d.ldq = 768; d.active = 1; d.pos0 = chunk * 64 + (w & 3) * 16;
            d.kt_lo = 0; d.kt_hi = chunk + 1;
            d.out = mix + (size_t)tok * 1024 + 512 + h * 64; d.ldo = 1024;
            d.k = kupp + (size_t)(b * 4096) * 512 + h * 64; d.ldk = 512;
            d.kx = kpbuf + (size_t)(b * 4096) * 32;
            d.vt = vtp + (size_t)(b * 8 + h) * 64 * 4096; d.ldv = 4096; d.nkeys = 4096;
            d.bt_lo = 0; d.bt_hi = pr * 2 + 2;
          } else {
            const int h = sit & 7, b = sit >> 3;
            const int tok = T_P + b * 32 + (w & 1) * 16;
            d.q = qmla + (size_t)tok * 768 + h * 96; d.ldq = 768; d.active = (w < 2); d.pos0 = 2048 + (w & 1) * 16;
            d.kt_lo = 0; d.kt_hi = 33;
            d.out = mix + (size_t)tok * 1024 + 512 + h * 64; d.ldo = 1024;
            d.k = kups + (size_t)(b * 2112) * 512 + h * 64; d.ldk = 512;
            d.kx = kps + (size_t)(b * 2112) * 32;
            d.vt = vts + (size_t)(b * 8 + h) * 64 * 2112; d.ldv = 2112; d.nkeys = 2080;
            d.bt_lo = 0; d.bt_hi = 33;
          }
          attn_item<96>(tid, smem, d);
        }
      }
      GRID_BAR();
      for (int rep_ = 0; rep_ < NREP(14); ++rep_)
      {
    PHASE_BEGIN
        quant_rows(p.in[36] + 16777216, p.ws + OFF_TAB, (float*)(p.ws + OFF_TAB + TAB_SU_OFF), gw, nw, tid);
        quant_rows(p.in[37] + 16777216, p.ws + OFF_TAB + TAB_V_OFF, (float*)(p.ws + OFF_TAB + TAB_SV_OFF), gw, nw, tid);
        int vb = 0;
        gemm_run<0>(tid, smem, mix, mix, T_TOT, 1024, nullptr, wt + WT_OUT_O, T_TOT, 1024, 1024, vb, EpiRes1{xres});
      }
      GRID_BAR();
  peer_phases<1>(bar_k, smem);
}

extern "C" void kernel_launch(void* const* d_in, const int* in_sizes, int n_in, void* d_out, int out_size, void* d_ws, size_t ws_size, hipStream_t stream) {
  static int grid_blocks = 0;
  if (grid_blocks == 0) {
    int dev = 0, cus = 0, per_cu = 0;
    hipGetDevice(&dev);
    hipDeviceGetAttribute(&cus, hipDeviceAttributeMultiprocessorCount, dev);
    hipFuncSetAttribute((const void*)mega, hipFuncAttributeMaxDynamicSharedMemorySize, DYN_LDS);
    hipOccupancyMaxActiveBlocksPerMultiprocessor(&per_cu, (const void*)mega, NT, DYN_LDS);
    if (per_cu < 1) per_cu = 1;
    if (per_cu > 1) per_cu = 1;
    grid_blocks = cus * per_cu;
    if (ws_size < WS_NEED + 256) fprintf(stderr, "kernel_launch: workspace too small: %zu < %zu\n", ws_size, (size_t)WS_NEED);
  }
  hipMemsetAsync((unsigned char*)d_ws + OFF_BAR, 0, 256, stream);
  Params p{};
  for (int i = 0; i < 38; ++i) p.in[i] = (const float*)d_in[i];
  p.out = (float*)d_out;
  p.ws = (unsigned char*)d_ws;
  void* args[] = {&p};
  hipError_t e = hipLaunchCooperativeKernel((const void*)mega, dim3(grid_blocks), dim3(NT), args, DYN_LDS, stream);
  if (e != hipSuccess) fprintf(stderr, "cooperative launch failed: %s (grid %d)\n", hipGetErrorString(e), grid_blocks);
}
```

```cpp
#include <hip/hip_runtime.h>
#include <hip/hip_bf16.h>
#include <hip/hip_cooperative_groups.h>
#include <cstdio>
namespace cg = cooperative_groups;

typedef unsigned short bf16_t;
using bf16x8 = __attribute__((ext_vector_type(8))) short;
using f32x4 = __attribute__((ext_vector_type(4))) float;

#ifndef PH
#define PH 0xFFFFFFu
#endif
#ifndef DBL
#define DBL 0u
#endif
#define NREP(n) ((int)((PH >> (n)) & 1u) * (1 + (int)((DBL >> (n)) & 1u)))
#define NT 512
#define DYN_LDS 81920
#define T_TOT 33792
#define T_P 32768
#define LOG2_THETA 18.931568569324174f

#define O_Y 0
#define O_SWAK_P 34603008
#define O_SWAV_P 34734080
#define O_SSMRE_P 34865152
#define O_SSMIM_P 34881536
#define O_POOL_P 34897920
#define O_CKV_P 34959360
#define O_KPE_P 43347968
#define O_SWAK_S 44396544
#define O_SWAV_S 44920832
#define O_SSMRE_S 45445120
#define O_SSMIM_S 45510656
#define O_POOL_S 45576192
#define O_CKV_S 45821952
#define O_KPE_S 46084096

constexpr size_t OFF_PROJ = 0;
constexpr size_t OFF_TAB = OFF_PROJ + 88670208ull;
constexpr size_t OFF_MIX = OFF_TAB + 67108864ull;
constexpr size_t OFF_QBUF = OFF_MIX + 69206016ull;
constexpr size_t OFF_QMLA = OFF_QBUF + 69206016ull;
constexpr size_t OFF_Z = OFF_QMLA + 51904512ull;
constexpr size_t OFF_M = OFF_Z + 34603008ull;
constexpr size_t OFF_C = OFF_M + 34603008ull;
constexpr size_t OFF_KP = OFF_C + 17301504ull;
constexpr size_t OFF_VT0 = OFF_KP + 2162688ull;
constexpr size_t OFF_KALL = OFF_VT0 + 8388608ull;
constexpr size_t OFF_VTALL = OFF_KALL + 1327104ull;
constexpr size_t OFF_KPS = OFF_VTALL + 1572864ull;
constexpr size_t OFF_WT = OFF_KPS + 4325376ull;
constexpr size_t WS_NEED = OFF_WT + 16187392ull;
constexpr size_t OFF_KUPS = OFF_PROJ;
constexpr size_t OFF_VTS = OFF_PROJ + 69206016ull;
constexpr size_t WT_IN_E = 0;
constexpr size_t WT_OUT_E = WT_IN_E + 1310720;
constexpr size_t WT_GLU = WT_OUT_E + 1048576;
constexpr size_t WT_IN_O = WT_GLU + 262144;
constexpr size_t WT_OUT_O = WT_IN_O + 1343488;
constexpr size_t WT_POOL = WT_OUT_O + 1048576;
constexpr size_t WT_UQ = WT_POOL + 65536;
constexpr size_t WT_UK = WT_UQ + 393216;
constexpr size_t WT_UV = WT_UK + 131072;
constexpr size_t WT_PQ = WT_UV + 131072;
constexpr size_t WT_KEYS = WT_PQ + 2097152;

struct Params {
  const float* in[38];
  float* out;
  unsigned char* ws;
};

typedef __bf16 bf16x2_t __attribute__((ext_vector_type(2)));
typedef float float2_t __attribute__((ext_vector_type(2)));
__device__ __forceinline__ unsigned pack2(float a, float b) {
  float2_t f = {a, b};
  bf16x2_t h = __builtin_convertvector(f, bf16x2_t);
  return __builtin_bit_cast(unsigned, h);
}
__device__ __forceinline__ unsigned short f2bf(float f) { return (unsigned short)(pack2(f, 0.f) & 0xffffu); }
__device__ __forceinline__ float bf2f(unsigned short b) { return __uint_as_float(((unsigned)b) << 16); }
__device__ __forceinline__ float lo2f(unsigned u) { return __uint_as_float(u << 16); }
__device__ __forceinline__ float hi2f(unsigned u) { return __uint_as_float(u & 0xffff0000u); }
__device__ __forceinline__ void unpack8(uint4 v, float* x) {
  x[0] = lo2f(v.x); x[1] = hi2f(v.x); x[2] = lo2f(v.y); x[3] = hi2f(v.y);
  x[4] = lo2f(v.z); x[5] = hi2f(v.z); x[6] = lo2f(v.w); x[7] = hi2f(v.w);
}
__device__ __forceinline__ uint4 pack8(const float* x) {
  uint4 v; v.x = pack2(x[0], x[1]); v.y = pack2(x[2], x[3]); v.z = pack2(x[4], x[5]); v.w = pack2(x[6], x[7]); return v;
}
template <int CTRL> __device__ __forceinline__ float dpp_f(float v) {
  return __int_as_float(__builtin_amdgcn_update_dpp(0, __float_as_int(v), CTRL, 0xf, 0xf, true));
}
__device__ __forceinline__ float row16_max(float v) {
  v = fmaxf(v, dpp_f<0xB1>(v)); v = fmaxf(v, dpp_f<0x4E>(v)); v = fmaxf(v, dpp_f<0x141>(v)); v = fmaxf(v, dpp_f<0x140>(v)); return v;
}
__device__ __forceinline__ float row16_sum(float v) {
  v += dpp_f<0xB1>(v); v += dpp_f<0x4E>(v); v += dpp_f<0x141>(v); v += dpp_f<0x140>(v); return v;
}
__device__ __forceinline__ float wave_sum(float v) {
  v = row16_sum(v);
  const float a = __int_as_float(__builtin_amdgcn_readlane(__float_as_int(v), 0));
  const float b = __int_as_float(__builtin_amdgcn_readlane(__float_as_int(v), 16));
  const float c = __int_as_float(__builtin_amdgcn_readlane(__float_as_int(v), 32));
  const float d = __int_as_float(__builtin_amdgcn_readlane(__float_as_int(v), 48));
  return (a + b) + (c + d);
}
__device__ __forceinline__ void sincos_rev(float ang, float& s, float& c) {
  float rev = ang * 0.15915494309189535f;
  rev = rev - floorf(rev);
  s = __builtin_amdgcn_sinf(rev);
  c = __builtin_amdgcn_cosf(rev);
}
__device__ __forceinline__ float gelu_tanh(float x) {
  float y = 0.7978845608028654f * (x + 0.044715f * x * x * x);
  float t = 1.f - 2.f / (1.f + __expf(2.f * y));
  return 0.5f * x * (1.f + t);
}
__device__ __forceinline__ float gelu_erf(float x) { return 0.5f * x * (1.f + erff(x * 0.7071067811865476f)); }
__device__ __forceinline__ int logical_bid() {
  const int G = (int)gridDim.x, b = (int)blockIdx.x;
  return ((G & 7) == 0) ? ((b & 7) * (G >> 3) + (b >> 3)) : b;
}
__device__ __forceinline__ int rot_start(int vbase) {
  int G = (int)gridDim.x;
  int s = (logical_bid() - vbase) % G;
  if (s < 0) s += G;
  return s;
}

__device__ __forceinline__ void transpose_convert(int tid, unsigned char* smem, const float* __restrict__ src, bf16_t* __restrict__ dst, int K, int N, int& vbase) {
  float* tl = (float*)smem;
  const int tk = K / 64, tn = (N + 63) / 64;
  const int ntiles = tk * tn;
  for (int tile = rot_start(vbase); tile < ntiles; tile += gridDim.x) {
    const int k0 = (tile / tn) * 64, n0 = (tile % tn) * 64;
    __syncthreads();
#pragma unroll
    for (int i = 0; i < 2; ++i) {
      int r = (tid >> 4) + 32 * i, c4 = (tid & 15) * 4;
      float4 v = make_float4(0.f, 0.f, 0.f, 0.f);
      if (n0 + c4 < N) v = *(const float4*)(src + (size_t)(k0 + r) * N + n0 + c4);
      tl[r * 65 + c4 + 0] = v.x; tl[r * 65 + c4 + 1] = v.y; tl[r * 65 + c4 + 2] = v.z; tl[r * 65 + c4 + 3] = v.w;
    }
    __syncthreads();
    int n = tid >> 3, k8 = (tid & 7) * 8;
    if (n0 + n < N) {
      float x[8];
#pragma unroll
      for (int j = 0; j < 8; ++j) x[j] = tl[(k8 + j) * 65 + n];
      *(uint4*)(dst + (size_t)(n0 + n) * K + k0 + k8) = pack8(x);
    }
  }
  vbase += ntiles;
}

__device__ __forceinline__ void convert_plain(int tid, const float* __restrict__ src, bf16_t* __restrict__ dst, size_t n) {
  size_t i = ((size_t)blockIdx.x * NT + tid) * 8;
  const size_t stride = (size_t)gridDim.x * NT * 8;
  for (; i < n; i += stride) {
    float4 a = *(const float4*)(src + i), b = *(const float4*)(src + i + 4);
    uint4 v; v.x = pack2(a.x, a.y); v.y = pack2(a.z, a.w); v.z = pack2(b.x, b.y); v.w = pack2(b.z, b.w);
    *(uint4*)(dst + i) = v;
  }
}

template <int V> struct IC { static constexpr int value = V; };
template <int AMODE, class Epi>
__device__ __forceinline__ void gemm_run(int tid, unsigned char* smem, const void* A, const void* A2, int splitRow, int lda,
                                         const float* __restrict__ gain, const bf16_t* __restrict__ Bt,
                                         int M, int N, int K, int& vbase, Epi epi) {
  bf16_t* sA0 = (bf16_t*)smem;
  bf16_t* sB0 = sA0 + 128 * 72;
  bf16_t* sA1 = sB0 + 128 * 72;
  bf16_t* sB1 = sA1 + 128 * 72;
  float* sR = (float*)(sB1 + 128 * 72);
  float* sG = sR + 128;
  if (AMODE == 2) {
    __syncthreads();
    sG[tid] = gain[tid]; sG[tid + 512] = gain[tid + 512];
    __syncthreads();
  }
  const int lane = tid & 63, w = tid >> 6;
  const int l16 = lane & 15, quad = lane >> 4;
  const int wm = w >> 1, wn = w & 1;
  const int tilesN = (N + 127) / 128, tilesM = M / 128;
  const int ntiles = tilesM * tilesN;
  const int arow = tid >> 2, q4 = tid & 3;
  const int nk = K / 64;
  for (int tile = rot_start(vbase); tile < ntiles; tile += gridDim.x) {
    const int tm = tile / tilesN, tn = tile % tilesN;
    const int m0 = tm * 128, n0 = tn * 128;
    const int grow = m0 + arow;
    const unsigned char* aptr;
    if (AMODE == 0) aptr = (grow < splitRow) ? (const unsigned char*)A + (size_t)grow * lda * 2 : (const unsigned char*)A2 + (size_t)(grow - splitRow) * lda * 2;
    else aptr = (grow < splitRow) ? (const unsigned char*)A + (size_t)grow * lda * 4 : (const unsigned char*)A2 + (size_t)(grow - splitRow) * lda * 4;
    const bool bvalid = (n0 + arow) < N;
    const bf16_t* bptr = Bt + (size_t)(n0 + arow) * K + q4 * 8;
    f32x4 acc[2][4];
#pragma unroll
    for (int i = 0; i < 2; ++i)
#pragma unroll
      for (int j = 0; j < 4; ++j) acc[i][j] = (f32x4){0.f, 0.f, 0.f, 0.f};
    float ss = 0.f;
    float4 af0[4], af1[4];
    uint4 ab0_0, ab0_1, ab1_0, ab1_1;
    uint4 bb0_0, bb0_1, bb1_0, bb1_1;
#define GLOAD(AF, AB, BB, KT) { \
      const int k0_ = (KT) * 64; \
      if (AMODE == 0) { AB##_0 = *(const uint4*)(aptr + (size_t)(k0_ + q4 * 8) * 2); AB##_1 = *(const uint4*)(aptr + (size_t)(k0_ + 32 + q4 * 8) * 2); } \
      else { \
        _Pragma("unroll") for (int i = 0; i < 4; ++i) AF[i] = *(const float4*)(aptr + (size_t)(k0_ + 16 * i + q4 * 4) * 4); \
      } \
      if (bvalid) { BB##_0 = *(const uint4*)(bptr + k0_); BB##_1 = *(const uint4*)(bptr + k0_ + 32); } \
      else { BB##_0 = make_uint4(0, 0, 0, 0); BB##_1 = BB##_0; } }
#define LSTORE(AF, AB, BB, KT, sA, sB) { \
      if (AMODE == 0) { \
        *(uint4*)(sA + arow * 72 + q4 * 8) = AB##_0; \
        *(uint4*)(sA + arow * 72 + 32 + q4 * 8) = AB##_1; \
      } else { \
        if (AMODE == 2) { \
          const float* gp = sG + (KT) * 64 + q4 * 4; \
          _Pragma("unroll") for (int i = 0; i < 4; ++i) { \
            float4 g = *(const float4*)(gp + 16 * i); \
            ss += AF[i].x * AF[i].x + AF[i].y * AF[i].y + AF[i].z * AF[i].z + AF[i].w * AF[i].w; \
            AF[i].x *= g.x; AF[i].y *= g.y; AF[i].z *= g.z; AF[i].w *= g.w; \
          } \
        } \
        *(uint2*)(sA + arow * 72 + q4 * 4) = make_uint2(pack2(AF[0].x, AF[0].y), pack2(AF[0].z, AF[0].w)); \
        *(uint2*)(sA + arow * 72 + 16 + q4 * 4) = make_uint2(pack2(AF[1].x, AF[1].y), pack2(AF[1].z, AF[1].w)); \
        *(uint2*)(sA + arow * 72 + 32 + q4 * 4) = make_uint2(pack2(AF[2].x, AF[2].y), pack2(AF[2].z, AF[2].w)); \
        *(uint2*)(sA + arow * 72 + 48 + q4 * 4) = make_uint2(pack2(AF[3].x, AF[3].y), pack2(AF[3].z, AF[3].w)); \
      } \
      *(uint4*)(sB + arow * 72 + q4 * 8) = BB##_0; \
      *(uint4*)(sB + arow * 72 + 32 + q4 * 8) = BB##_1; }
#define GCOMPUTE(sA, sB) { \
      _Pragma("unroll") for (int ks = 0; ks < 2; ++ks) { \
        bf16x8 a[2], b[4]; \
        _Pragma("unroll") for (int i = 0; i < 2; ++i) a[i] = *(const bf16x8*)(sA + (wm * 32 + i * 16 + l16) * 72 + ks * 32 + quad * 8); \
        _Pragma("unroll") for (int j = 0; j < 4; ++j) b[j] = *(const bf16x8*)(sB + (wn * 64 + j * 16 + l16) * 72 + ks * 32 + quad * 8); \
        _Pragma("unroll") for (int i = 0; i < 2; ++i) \
          _Pragma("unroll") for (int j = 0; j < 4; ++j) acc[i][j] = __builtin_amdgcn_mfma_f32_16x16x32_bf16(a[i], b[j], acc[i][j], 0, 0, 0); \
      } }
    __syncthreads();
    GLOAD(af0, ab0, bb0, 0);
    GLOAD(af1, ab1, bb1, 1);
    LSTORE(af0, ab0, bb0, 0, sA0, sB0);
    if (2 < nk) GLOAD(af0, ab0, bb0, 2);
    for (int kt = 0; kt < nk; kt += 2) {
      __syncthreads();
      LSTORE(af1, ab1, bb1, kt + 1, sA1, sB1);
      if (kt + 3 < nk) GLOAD(af1, ab1, bb1, kt + 3);
      GCOMPUTE(sA0, sB0);
      __syncthreads();
      if (kt + 2 < nk) {
        LSTORE(af0, ab0, bb0, kt + 2, sA0, sB0);
        if (kt + 4 < nk) GLOAD(af0, ab0, bb0, kt + 4);
      }
      GCOMPUTE(sA1, sB1);
    }
    if (AMODE == 2) {
      ss += __shfl_xor(ss, 1);
      ss += __shfl_xor(ss, 2);
      if ((tid & 3) == 0) sR[arow] = rsqrtf(ss / (float)K + 1e-6f);
      __syncthreads();
    }
#pragma unroll
    for (int i = 0; i < 2; ++i)
#pragma unroll
      for (int r = 0; r < 4; ++r) {
        const int rl = wm * 32 + i * 16 + quad * 4 + r;
        const float rs = (AMODE == 2) ? sR[rl] : 1.f;
#pragma unroll
        for (int j = 0; j < 4; ++j) {
          const int col = n0 + wn * 64 + j * 16 + l16;
          if (col < N) epi(m0 + rl, col, acc[i][j][r] * rs);
        }
      }
  }
  vbase += ntiles;
}

struct AttnDesc {
  const bf16_t* q; int ldq; int active; int kt_lo, kt_hi; bf16_t* out; int ldo; float m0, l0; int pos0;
  const bf16_t* k; int ldk; const bf16_t* kx; const bf16_t* vt; int ldv; int vts; int nkeys; int bt_lo, bt_hi; float scale;
};

template <int DQK>
__device__ __forceinline__ void attn_item(int tid, unsigned char* smem, const AttnDesc& d) {
  constexpr int LDK = DQK + 8;
  bf16_t* sK = (bf16_t*)smem;
  bf16_t* sVt = sK + 64 * 104;
  bf16_t* sP = sVt + 64 * 72;
  const int lane = tid & 63, w = tid >> 6;
  const int l16 = lane & 15, quad = lane >> 4;
  bf16_t* sPw = sP + w * 16 * 72;
  bf16x8 qf[DQK / 32];
  if (d.active) {
#pragma unroll
    for (int ks = 0; ks < DQK / 32; ++ks) {
      const bf16_t* qp = d.q + (size_t)l16 * d.ldq + ks * 32 + quad * 8;
      uint4 v = *(const uint4*)qp;
      if (DQK == 96 && ks == 2) {
        const int pq = (quad < 2) ? 16 : -16;
        uint4 pv = *(const uint4*)(qp + pq);
        float x[8], y[8];
        unpack8(v, x); unpack8(pv, y);
        const float pos = (float)(d.pos0 + l16);
#pragma unroll
        for (int j = 0; j < 8; ++j) {
          const int f = (quad & 1) * 8 + j;
          float inv = exp2f(-(float)f * (LOG2_THETA / 16.f));
          float sn, cs; sincos_rev(pos * inv, sn, cs);
          x[j] = (quad < 2) ? (x[j] * cs - y[j] * sn) : (x[j] * cs + y[j] * sn);
        }
        v = pack8(x);
      }
      qf[ks] = *(bf16x8*)&v;
    }
  }
  f32x4 o[4];
#pragma unroll
  for (int i = 0; i < 4; ++i) o[i] = (f32x4){0.f, 0.f, 0.f, 0.f};
  float m[4], l[4];
#pragma unroll
  for (int r = 0; r < 4; ++r) { m[r] = d.m0; l[r] = d.l0; }

  const int key = tid >> 3, seg = tid & 7;
  const int key2 = (tid >> 2) & 63, seg2 = tid & 3;
  uint4 kv_r = make_uint4(0, 0, 0, 0), vv_r = kv_r, xv_r = kv_r;
  if (d.bt_lo < d.bt_hi) {
    kv_r = *(const uint4*)(d.k + (size_t)(d.bt_lo * 64 + key) * d.ldk + seg * 8);
    vv_r = *(const uint4*)(d.vt + (size_t)d.bt_lo * d.vts + (size_t)key * d.ldv + seg * 8);
    if (DQK == 96 && tid < 256) xv_r = *(const uint4*)(d.kx + (size_t)(d.bt_lo * 64 + key2) * 32 + seg2 * 8);
  }
  for (int kt = d.bt_lo; kt < d.bt_hi; ++kt) {
    __syncthreads();
    *(uint4*)(sK + key * LDK + seg * 8) = kv_r;
    *(uint4*)(sVt + key * 72 + seg * 8) = vv_r;
    if (DQK == 96 && tid < 256) *(uint4*)(sK + key2 * LDK + 64 + seg2 * 8) = xv_r;
    __syncthreads();
    if (kt + 1 < d.bt_hi) {
      kv_r = *(const uint4*)(d.k + (size_t)((kt + 1) * 64 + key) * d.ldk + seg * 8);
      vv_r = *(const uint4*)(d.vt + (size_t)(kt + 1) * d.vts + (size_t)key * d.ldv + seg * 8);
      if (DQK == 96 && tid < 256) xv_r = *(const uint4*)(d.kx + (size_t)((kt + 1) * 64 + key2) * 32 + seg2 * 8);
    }
    if (d.active && kt >= d.kt_lo && kt < d.kt_hi) {
      f32x4 s[4];
#pragma unroll
      for (int i = 0; i < 4; ++i) s[i] = (f32x4){0.f, 0.f, 0.f, 0.f};
#pragma unroll
      for (int ks = 0; ks < DQK / 32; ++ks)
#pragma unroll
        for (int nt = 0; nt < 4; ++nt) {
          bf16x8 b = *(const bf16x8*)(sK + (nt * 16 + l16) * LDK + ks * 32 + quad * 8);
          s[nt] = __builtin_amdgcn_mfma_f32_16x16x32_bf16(qf[ks], b, s[nt], 0, 0, 0);
        }
#pragma unroll
      for (int nt = 0; nt < 4; ++nt) {
        const bool valid = (kt * 64 + nt * 16 + l16) < d.nkeys;
#pragma unroll
        for (int r = 0; r < 4; ++r) s[nt][r] = valid ? s[nt][r] * d.scale : -1e30f;
      }
#pragma unroll
      for (int r = 0; r < 4; ++r) {
        float mx = fmaxf(fmaxf(s[0][r], s[1][r]), fmaxf(s[2][r], s[3][r]));
        mx = row16_max(mx);
        const float mnew = fmaxf(m[r], mx);
        const float alpha = __expf(m[r] - mnew);
        float p0 = __expf(s[0][r] - mnew), p1 = __expf(s[1][r] - mnew), p2 = __expf(s[2][r] - mnew), p3 = __expf(s[3][r] - mnew);
        float rs = p0 + p1 + p2 + p3;
        rs = row16_sum(rs);
        l[r] = l[r] * alpha + rs;
        m[r] = mnew;
#pragma unroll
        for (int dt = 0; dt < 4; ++dt) o[dt][r] *= alpha;
        bf16_t* pr = sPw + (quad * 4 + r) * 72 + l16;
        pr[0] = f2bf(p0); pr[16] = f2bf(p1); pr[32] = f2bf(p2); pr[48] = f2bf(p3);
      }
      asm volatile("s_waitcnt lgkmcnt(0)" ::: "memory");
#pragma unroll
      for (int ks = 0; ks < 2; ++ks) {
        bf16x8 a = *(const bf16x8*)(sPw + l16 * 72 + ks * 32 + quad * 8);
#pragma unroll
        for (int dt = 0; dt < 4; ++dt) {
          bf16x8 b = *(const bf16x8*)(sVt + (dt * 16 + l16) * 72 + ks * 32 + quad * 8);
          o[dt] = __builtin_amdgcn_mfma_f32_16x16x32_bf16(a, b, o[dt], 0, 0, 0);
        }
      }
      asm volatile("s_waitcnt lgkmcnt(0)" ::: "memory");
    }
  }
  if (d.active) {
#pragma unroll
    for (int r = 0; r < 4; ++r) {
      const float il = 1.f / l[r];
#pragma unroll
      for (int dt = 0; dt < 4; ++dt) d.out[(size_t)(quad * 4 + r) * d.ldo + dt * 16 + l16] = f2bf(o[dt][r] * il);
    }
  }
}

template <int MODE>
__device__ __forceinline__ void s5_item(int tid, float* sUw, const Params& p, int item) {
  const int lane = tid & 63;
  const bf16_t* proj = (const bf16_t*)(p.ws + OFF_PROJ);
  int b, chunk, g, tok0; bool isS;
  if (item < 32768) { isS = false; g = item & 31; chunk = (item >> 5) & 127; b = item >> 12; tok0 = b * 4096 + chunk * 32; }
  else { isS = true; int it = item - 32768; g = it & 31; b = it >> 5; chunk = 0; tok0 = T_P + b * 32; }
  const int n = lane;
  const int gn = g * 64 + n;
  const float lr = fminf(p.in[15][gn], -1e-4f), li = p.in[16][gn];
  const float dt = __expf(p.in[17][g]);
  const float mag = __expf(lr * dt);
  float sn, cs; sincos_rev(li * dt, sn, cs);
  const float abr = mag * cs, abi = mag * sn;
  const float den = lr * lr + li * li;
  const float nr = abr - 1.f, ni = abi;
  const float fre = (nr * lr + ni * li) / den, fim = (ni * lr - nr * li) / den;
  float bbr[16], bbi[16];
  {
    const float4* br4 = (const float4*)(p.in[18] + (size_t)gn * 16);
    const float4* bi4 = (const float4*)(p.in[19] + (size_t)gn * 16);
#pragma unroll
    for (int i = 0; i < 4; ++i) {
      float4 r4 = br4[i], i4 = bi4[i];
      bbr[4 * i + 0] = fre * r4.x - fim * i4.x; bbi[4 * i + 0] = fre * i4.x + fim * r4.x;
      bbr[4 * i + 1] = fre * r4.y - fim * i4.y; bbi[4 * i + 1] = fre * i4.y + fim * r4.y;
      bbr[4 * i + 2] = fre * r4.z - fim * i4.z; bbi[4 * i + 2] = fre * i4.z + fim * r4.z;
      bbr[4 * i + 3] = fre * r4.w - fim * i4.w; bbi[4 * i + 3] = fre * i4.w + fim * r4.w;
    }
  }
  {
    const int t = lane >> 1, c8 = (lane & 1) * 8;
    uint4 uv = *(const uint4*)(proj + (size_t)(tok0 + t) * 1280 + 768 + g * 16 + c8);
    float x[8]; unpack8(uv, x);
    *(float4*)(sUw + t * 16 + c8) = make_float4(x[0], x[1], x[2], x[3]);
    *(float4*)(sUw + t * 16 + c8 + 4) = make_float4(x[4], x[5], x[6], x[7]);
  }
  asm volatile("s_waitcnt lgkmcnt(0)" ::: "memory");
  float hr = 0.f, hi = 0.f;
  if (MODE == 0) {
#pragma unroll 4
    for (int t = 0; t < 32; ++t) {
      float uu[16];
#pragma unroll
      for (int i = 0; i < 4; ++i) { float4 v = *(const float4*)(sUw + t * 16 + 4 * i); uu[4 * i] = v.x; uu[4 * i + 1] = v.y; uu[4 * i + 2] = v.z; uu[4 * i + 3] = v.w; }
      float bur = 0.f, bui = 0.f;
#pragma unroll
      for (int c = 0; c < 16; ++c) { bur += bbr[c] * uu[c]; bui += bbi[c] * uu[c]; }
      const float nhr = abr * hr - abi * hi + bur, nhi = abr * hi + abi * hr + bui;
      hr = nhr; hi = nhi;
    }
    float* s1re = (float*)(p.ws + OFF_QMLA);
    float* s1im = s1re + 2097152;
    const size_t idx = ((size_t)(b * 128 + chunk) * 32 + g) * 64 + n;
    s1re[idx] = hr; s1im[idx] = hi;
    asm volatile("s_waitcnt lgkmcnt(0)" ::: "memory");
    return;
  } else {
    float cr[16], ci[16];
#pragma unroll
    for (int c = 0; c < 16; ++c) { cr[c] = p.in[20][(size_t)(g * 16 + c) * 64 + n]; ci[c] = p.in[21][(size_t)(g * 16 + c) * 64 + n]; }
    if (isS) { hr = p.in[4][(size_t)(b * 32 + g) * 64 + n]; hi = p.in[5][(size_t)(b * 32 + g) * 64 + n]; }
    else {
      const float* hinre = (const float*)(p.ws + OFF_QMLA) + 2 * 2097152;
      const float* hinim = hinre + 2097152;
      const size_t idx = ((size_t)(b * 128 + chunk) * 32 + g) * 64 + n;
      hr = hinre[idx]; hi = hinim[idx];
    }
    const int b0 = lane & 1, b1 = (lane >> 1) & 1, b2 = (lane >> 2) & 1, b3 = (lane >> 3) & 1;
    const int cc = b0 * 8 + b1 * 4 + b2 * 2 + b3;
    const int quad = lane >> 4;
    const float dsk = p.in[22][g * 16 + cc];
    bf16_t* zbuf = (bf16_t*)(p.ws + OFF_Z);
    float zkeep = 0.f;
#pragma unroll 2
    for (int t = 0; t < 32; ++t) {
      float uu[16];
#pragma unroll
      for (int i = 0; i < 4; ++i) { float4 v = *(const float4*)(sUw + t * 16 + 4 * i); uu[4 * i] = v.x; uu[4 * i + 1] = v.y; uu[4 * i + 2] = v.z; uu[4 * i + 3] = v.w; }
      float bur = 0.f, bui = 0.f;
#pragma unroll
      for (int c = 0; c < 16; ++c) { bur += bbr[c] * uu[c]; bui += bbi[c] * uu[c]; }
      const float nhr = abr * hr - abi * hi + bur, nhi = abr * hi + abi * hr + bui;
      hr = nhr; hi = nhi;
      float v16[16];
#pragma unroll
      for (int c = 0; c < 16; ++c) v16[c] = hr * cr[c] - hi * ci[c];
      float v8[8], v4[4], v2[2], v1;
#pragma unroll
      for (int i = 0; i < 8; ++i) { float keep = b0 ? v16[8 + i] : v16[i]; float send = b0 ? v16[i] : v16[8 + i]; v8[i] = keep + __shfl_xor(send, 1); }
#pragma unroll
      for (int i = 0; i < 4; ++i) { float keep = b1 ? v8[4 + i] : v8[i]; float send = b1 ? v8[i] : v8[4 + i]; v4[i] = keep + __shfl_xor(send, 2); }
#pragma unroll
      for (int i = 0; i < 2; ++i) { float keep = b2 ? v4[2 + i] : v4[i]; float send = b2 ? v4[i] : v4[2 + i]; v2[i] = keep + __shfl_xor(send, 4); }
      { float keep = b3 ? v2[1] : v2[0]; float send = b3 ? v2[0] : v2[1]; v1 = keep + __shfl_xor(send, 8); }
      v1 += __shfl_xor(v1, 16);
      v1 += __shfl_xor(v1, 32);
      const float y = v1 + dsk * sUw[t * 16 + cc];
      const float z = gelu_tanh(y);
      if (quad == (t & 3)) zkeep = z;
      if ((t & 3) == 3) zbuf[(size_t)(tok0 + t - 3 + quad) * 512 + g * 16 + cc] = f2bf(zkeep);
    }
    if (isS) {
      p.out[O_SSMRE_S + (size_t)(b * 32 + g) * 64 + n] = hr;
      p.out[O_SSMIM_S + (size_t)(b * 32 + g) * 64 + n] = hi;
    }
    asm volatile("s_waitcnt lgkmcnt(0)" ::: "memory");
  }
}

#define TAB_V_OFF 16777216ull
#define TAB_SU_OFF 33554432ull
#define TAB_SV_OFF (33554432ull + 65536ull)
__device__ __forceinline__ void quant_rows(const float* __restrict__ src, unsigned char* __restrict__ dst, float* __restrict__ scales, int gw, int nw, int tid) {
  const int lane = tid & 63;
  for (int row = gw; row < 16384; row += nw) {
    const float* r = src + (size_t)row * 1024 + lane * 16;
    float x[16];
#pragma unroll
    for (int i = 0; i < 4; ++i) { float4 v = *(const float4*)(r + 4 * i); x[4 * i] = v.x; x[4 * i + 1] = v.y; x[4 * i + 2] = v.z; x[4 * i + 3] = v.w; }
    float am = 0.f;
#pragma unroll
    for (int i = 0; i < 16; ++i) am = fmaxf(am, fabsf(x[i]));
#pragma unroll
    for (int o = 32; o; o >>= 1) am = fmaxf(am, __shfl_xor(am, o));
    const float inv = (am > 0.f) ? 127.f / am : 0.f;
    unsigned q[4];
#pragma unroll
    for (int i = 0; i < 4; ++i) {
      unsigned b0 = (unsigned)((int)rintf(x[4 * i] * inv)) & 255u, b1 = (unsigned)((int)rintf(x[4 * i + 1] * inv)) & 255u;
      unsigned b2 = (unsigned)((int)rintf(x[4 * i + 2] * inv)) & 255u, b3 = (unsigned)((int)rintf(x[4 * i + 3] * inv)) & 255u;
      q[i] = b0 | (b1 << 8) | (b2 << 16) | (b3 << 24);
    }
    *(uint4*)(dst + (size_t)(lane >> 3) * 2097152 + (size_t)row * 128 + (lane & 7) * 16) = make_uint4(q[0], q[1], q[2], q[3]);
    if (lane == 0) scales[row] = am * (1.f / 127.f);
  }
}

__device__ __forceinline__ float ub0(unsigned u) { return (float)(u & 0xffu); }
__device__ __forceinline__ float ub1(unsigned u) { return (float)((u >> 8) & 0xffu); }
__device__ __forceinline__ float ub2(unsigned u) { return (float)((u >> 16) & 0xffu); }
__device__ __forceinline__ float ub3(unsigned u) { return (float)(u >> 24); }
__device__ __forceinline__ float dot16(const float* xn, uint4 u) {
  float d = 0.f;
  d += xn[0] * ub0(u.x); d += xn[1] * ub1(u.x); d += xn[2] * ub2(u.x); d += xn[3] * ub3(u.x);
  d += xn[4] * ub0(u.y); d += xn[5] * ub1(u.y); d += xn[6] * ub2(u.y); d += xn[7] * ub3(u.y);
  d += xn[8] * ub0(u.z); d += xn[9] * ub1(u.z); d += xn[10] * ub2(u.z); d += xn[11] * ub3(u.z);
  d += xn[12] * ub0(u.w); d += xn[13] * ub1(u.w); d += xn[14] * ub2(u.w); d += xn[15] * ub3(u.w);
  return d;
}
__device__ __forceinline__ void axpy16(float* acc, float a, uint4 u) {
  acc[0] += a * ub0(u.x); acc[1] += a * ub1(u.x); acc[2] += a * ub2(u.x); acc[3] += a * ub3(u.x);
  acc[4] += a * ub0(u.y); acc[5] += a * ub1(u.y); acc[6] += a * ub2(u.y); acc[7] += a * ub3(u.y);
  acc[8] += a * ub0(u.z); acc[9] += a * ub1(u.z); acc[10] += a * ub2(u.z); acc[11] += a * ub3(u.z);
  acc[12] += a * ub0(u.w); acc[13] += a * ub1(u.w); acc[14] += a * ub2(u.w); acc[15] += a * ub3(u.w);
}

template <bool FINAL, bool DRY>
__device__ __forceinline__ void peer_token(int tid, const Params& p, int layer, int tok) {
  const int lane = tid & 63;
  float* xres = p.out + O_Y;
  const float* gain = p.in[10] + layer * 1024;
  const unsigned char* U = p.ws + OFF_TAB;
  const unsigned char* V = U + TAB_V_OFF;
  const int* ebuf = (const int*)(p.ws + OFF_M);
  const float* gbuf = (const float*)(p.ws + OFF_M + 17301504ull);
  const float* sus = (const float*)(p.ws + OFF_TAB + TAB_SU_OFF);
  const float* svs = (const float*)(p.ws + OFF_TAB + TAB_SV_OFF);
  float* xr = xres + (size_t)tok * 1024 + lane * 16;
  float x[16], xn[16], acc[16];
  float ss = 0.f, sx = 0.f;
#pragma unroll
  for (int i = 0; i < 4; ++i) {
    float4 v = *(const float4*)(xr + 4 * i);
    float4 g = *(const float4*)(gain + lane * 16 + 4 * i);
    x[4 * i] = v.x; x[4 * i + 1] = v.y; x[4 * i + 2] = v.z; x[4 * i + 3] = v.w;
    xn[4 * i] = v.x * g.x; xn[4 * i + 1] = v.y * g.y; xn[4 * i + 2] = v.z * g.z; xn[4 * i + 3] = v.w * g.w;
    ss += v.x * v.x + v.y * v.y + v.z * v.z + v.w * v.w;
    sx += xn[4 * i] + xn[4 * i + 1] + xn[4 * i + 2] + xn[4 * i + 3];
  }
  ss = wave_sum(ss);
  sx = wave_sum(sx);
  const float rstd = rsqrtf(ss * (1.f / 1024.f) + 1e-6f);
#pragma unroll
  for (int i = 0; i < 16; ++i) acc[i] = 0.f;
  float sumA = 0.f;
  const int b0 = lane & 1, b1 = (lane >> 1) & 1, b2 = (lane >> 2) & 1;
  const int pe = b0 * 4 + b1 * 2 + b2;
  const size_t pbase = (size_t)tok * 128 + pe;
#pragma unroll 1
  for (int kb = 0; kb < 16; ++kb) {
    const int myeid = ebuf[pbase + kb * 8];
    const float myg = gbuf[pbase + kb * 8] * svs[myeid];
    const float mysu = sus[myeid];
    uint4 uu[8], vv[8];
#pragma unroll
    for (int j = 0; j < 8; ++j) {
      const int src = ((j & 1) << 2) | (j & 2) | ((j >> 2) & 1);
      const int eid = __builtin_amdgcn_readlane(myeid, src);
      uu[j] = *(const uint4*)(U + (size_t)eid * 1024 + lane * 16);
      vv[j] = *(const uint4*)(V + (size_t)eid * 1024 + lane * 16);
    }
    float d[8];
#pragma unroll
    for (int j = 0; j < 8; ++j) d[j] = dot16(xn, uu[j]);
    float w4[4], w2[2], w1;
#pragma unroll
    for (int i = 0; i < 4; ++i) { float keep = b0 ? d[4 + i] : d[i]; float send = b0 ? d[i] : d[4 + i]; w4[i] = keep + __shfl_xor(send, 1); }
#pragma unroll
    for (int i = 0; i < 2; ++i) { float keep = b1 ? w4[2 + i] : w4[i]; float send = b1 ? w4[i] : w4[2 + i]; w2[i] = keep + __shfl_xor(send, 2); }
    { float keep = b2 ? w2[1] : w2[0]; float send = b2 ? w2[0] : w2[1]; w1 = keep + __shfl_xor(send, 4); }
    w1 += __shfl_xor(w1, 8); w1 += __shfl_xor(w1, 16); w1 += __shfl_xor(w1, 32);
    const float dot = rstd * mysu * (w1 - 128.f * sx);
    const float a = gelu_erf(dot) * myg;
#pragma unroll
    for (int j = 0; j < 8; ++j) {
      const int src = ((j & 1) << 2) | (j & 2) | ((j >> 2) & 1);
      const float A = __int_as_float(__builtin_amdgcn_readlane(__float_as_int(a), src));
      sumA += A;
      axpy16(acc, A, vv[j]);
    }
  }
  float y[16];
#pragma unroll
  for (int i = 0; i < 16; ++i) y[i] = x[i] + acc[i] - 128.f * sumA;
  if (FINAL) {
    float s2 = 0.f;
#pragma unroll
    for (int i = 0; i < 16; ++i) s2 += y[i] * y[i];
    s2 = wave_sum(s2);
    const float r2 = rsqrtf(s2 * (1.f / 1024.f) + 1e-6f);
    const float* gf = p.in[11] + lane * 16;
#pragma unroll
    for (int i = 0; i < 4; ++i) {
      float4 g = *(const float4*)(gf + 4 * i);
      y[4 * i] *= r2 * g.x; y[4 * i + 1] *= r2 * g.y; y[4 * i + 2] *= r2 * g.z; y[4 * i + 3] *= r2 * g.w;
    }
  }
  if (DRY && ss != -1.f) return;
#pragma unroll
  for (int i = 0; i < 4; ++i) *(float4*)(xr + 4 * i) = make_float4(y[4 * i], y[4 * i + 1], y[4 * i + 2], y[4 * i + 3]);
}

#define OFF_PD OFF_MIX
#define OFF_PSS OFF_KP
#define OFF_PSX (OFF_KP + 1081344ull)
template <int CTRL> __device__ __forceinline__ int dpp_i(int v) { return __builtin_amdgcn_update_dpp(0, v, CTRL, 0xf, 0xf, true); }
__device__ __forceinline__ unsigned packq4(float a, float b, float c, float d, float inv) {
  const unsigned q0 = (unsigned)((int)rintf(a * inv)) & 255u, q1 = (unsigned)((int)rintf(b * inv)) & 255u;
  const unsigned q2 = (unsigned)((int)rintf(c * inv)) & 255u, q3 = (unsigned)((int)rintf(d * inv));
  return q0 | (q1 << 8) | (q2 << 16) | (q3 << 24);
}
__device__ __forceinline__ void peer9a_token(int tid, const Params& p, int layer, int tok, int j) {
  const int lane = tid & 63, g8 = lane >> 3, sub = lane & 7;
  const float* xr = p.out + O_Y + (size_t)tok * 1024 + j * 128 + sub * 16;
  const float* gn = p.in[10] + layer * 1024 + j * 128 + sub * 16;
  const unsigned char* U = p.ws + OFF_TAB + (size_t)j * 2097152 + sub * 16;
  const int* eb = (const int*)(p.ws + OFF_M) + (size_t)tok * 128 + g8;
  float* pd = (float*)(p.ws + OFF_PD) + ((size_t)tok * 8 + j) * 128;
  int eid[16];
#pragma unroll
  for (int k = 0; k < 16; ++k) eid[k] = eb[k * 8];
  float xs[16];
  float ss = 0.f, am = 0.f;
#pragma unroll
  for (int i = 0; i < 4; ++i) {
    float4 v = *(const float4*)(xr + 4 * i);
    float4 g = *(const float4*)(gn + 4 * i);
    xs[4 * i] = v.x * g.x; xs[4 * i + 1] = v.y * g.y; xs[4 * i + 2] = v.z * g.z; xs[4 * i + 3] = v.w * g.w;
    ss += v.x * v.x + v.y * v.y + v.z * v.z + v.w * v.w;
    am = fmaxf(fmaxf(am, fmaxf(fabsf(xs[4 * i]), fabsf(xs[4 * i + 1]))), fmaxf(fabsf(xs[4 * i + 2]), fabsf(xs[4 * i + 3])));
  }
  uint4 rows[16];
#pragma unroll
  for (int k = 0; k < 16; ++k) rows[k] = *(const uint4*)(U + (size_t)eid[k] * 128);
  am = fmaxf(am, dpp_f<0xB1>(am)); am = fmaxf(am, dpp_f<0x4E>(am)); am = fmaxf(am, dpp_f<0x141>(am));
  const float inv = (am > 0.f) ? 127.f / am : 0.f;
  const float xscale = am * (1.f / 127.f);
  int xq[4];
#pragma unroll
  for (int d = 0; d < 4; ++d) xq[d] = (int)packq4(xs[4 * d], xs[4 * d + 1], xs[4 * d + 2], xs[4 * d + 3], inv);
  int keep0 = 0, keep1 = 0;
#pragma unroll
  for (int k = 0; k < 16; ++k) {
    int D = __builtin_amdgcn_sdot4((int)rows[k].x, xq[0], 0, false);
    D = __builtin_amdgcn_sdot4((int)rows[k].y, xq[1], D, false);
    D = __builtin_amdgcn_sdot4((int)rows[k].z, xq[2], D, false);
    D = __builtin_amdgcn_sdot4((int)rows[k].w, xq[3], D, false);
    D += dpp_i<0xB1>(D); D += dpp_i<0x4E>(D); D += dpp_i<0x141>(D);
    if (k < 8) keep0 = (sub == k) ? D : keep0; else keep1 = (sub == k - 8) ? D : keep1;
  }
  pd[sub * 8 + g8] = (float)keep0 * xscale;
  pd[64 + sub * 8 + g8] = (float)keep1 * xscale;
  ss += dpp_f<0xB1>(ss); ss += dpp_f<0x4E>(ss); ss += dpp_f<0x141>(ss);
  if (lane == 0) ((float*)(p.ws + OFF_PSS))[(size_t)tok * 8 + j] = ss;
}

__device__ __forceinline__ void peer9m_token(int tid, unsigned char* smem, const Params& p, int tok) {
  const int lane = tid & 63, w = __builtin_amdgcn_readfirstlane(tid >> 6);
  unsigned char* sAq = smem + w * 128;
  const float* pd = (const float*)(p.ws + OFF_PD) + (size_t)tok * 1024;
  float* pss = (float*)(p.ws + OFF_PSS) + (size_t)tok * 8;
  const int* ebuf = (const int*)(p.ws + OFF_M) + (size_t)tok * 128;
  float* gbuf = (float*)(p.ws + OFF_M + 17301504ull) + (size_t)tok * 128;
  const float* sus = (const float*)(p.ws + OFF_TAB + TAB_SU_OFF);
  const float* svs = (const float*)(p.ws + OFF_TAB + TAB_SV_OFF);
  float ss = 0.f, d0 = 0.f, d1 = 0.f;
#pragma unroll
  for (int j = 0; j < 8; ++j) { ss += pss[j]; d0 += pd[j * 128 + lane]; d1 += pd[j * 128 + 64 + lane]; }
  const int e0 = ebuf[lane], e1 = ebuf[64 + lane];
  const float rstd = rsqrtf(ss * (1.f / 1024.f) + 1e-6f);
  const float a0 = gelu_erf(rstd * sus[e0] * d0) * gbuf[lane] * svs[e0];
  const float a1 = gelu_erf(rstd * sus[e1] * d1) * gbuf[64 + lane] * svs[e1];
  float am = row16_max(fmaxf(fabsf(a0), fabsf(a1)));
  {
    const float m0 = __int_as_float(__builtin_amdgcn_readlane(__float_as_int(am), 0)), m1 = __int_as_float(__builtin_amdgcn_readlane(__float_as_int(am), 16));
    const float m2 = __int_as_float(__builtin_amdgcn_readlane(__float_as_int(am), 32)), m3 = __int_as_float(__builtin_amdgcn_readlane(__float_as_int(am), 48));
    am = fmaxf(fmaxf(m0, m1), fmaxf(m2, m3));
  }
  const float inv = (am > 0.f) ? 127.f / am : 0.f;
  const int addr0 = (lane & 7) * 16 + (lane >> 3);
  sAq[addr0] = (unsigned char)((int)rintf(a0 * inv) & 255);
  sAq[addr0 + 8] = (unsigned char)((int)rintf(a1 * inv) & 255);
  asm volatile("s_waitcnt lgkmcnt(0)" ::: "memory");
  unsigned pk = 0u;
  if (lane < 32) pk = ((const unsigned*)sAq)[lane];
  asm volatile("s_waitcnt vmcnt(0) lgkmcnt(0)" ::: "memory");
  if (lane < 32) ((unsigned*)gbuf)[lane] = pk;
  if (lane == 0) pss[0] = am * (1.f / 127.f);
  asm volatile("s_waitcnt lgkmcnt(0)" ::: "memory");
}

__device__ __forceinline__ void peer9b_token(int tid, const Params& p, int tok, int j) {
  const int lane = tid & 63, g8 = lane >> 3, sub = lane & 7;
  float* xr = p.out + O_Y + (size_t)tok * 1024 + j * 128 + sub * 16;
  const unsigned char* V = p.ws + OFF_TAB + TAB_V_OFF + (size_t)j * 2097152 + sub * 16;
  const int* eb = (const int*)(p.ws + OFF_M) + (size_t)tok * 128 + g8;
  const uint4 apk = *(const uint4*)((const unsigned*)(p.ws + OFF_M + 17301504ull) + (size_t)tok * 128 + g8 * 4);
  const float scaleA = ((const float*)(p.ws + OFF_PSS))[(size_t)tok * 8];
  int eid[16];
#pragma unroll
  for (int k = 0; k < 16; ++k) eid[k] = eb[k * 8];
  uint4 rows[16];
#pragma unroll
  for (int k = 0; k < 16; ++k) rows[k] = *(const uint4*)(V + (size_t)eid[k] * 128);
  int acci[16];
#pragma unroll
  for (int i = 0; i < 16; ++i) acci[i] = 0;
#define P9B_DW(DWF, DW, AP, KQ) { \
    const unsigned r0 = rows[(KQ) * 4 + 0].DWF, r1 = rows[(KQ) * 4 + 1].DWF, r2 = rows[(KQ) * 4 + 2].DWF, r3 = rows[(KQ) * 4 + 3].DWF; \
    const unsigned t0 = __builtin_amdgcn_perm(r1, r0, 0x05010400u), t1 = __builtin_amdgcn_perm(r1, r0, 0x07030602u); \
    const unsigned t2 = __builtin_amdgcn_perm(r3, r2, 0x05010400u), t3 = __builtin_amdgcn_perm(r3, r2, 0x07030602u); \
    acci[(DW) * 4 + 0] = __builtin_amdgcn_sdot4((int)__builtin_amdgcn_perm(t2, t0, 0x05040100u), (int)(AP), acci[(DW) * 4 + 0], false); \
    acci[(DW) * 4 + 1] = __builtin_amdgcn_sdot4((int)__builtin_amdgcn_perm(t2, t0, 0x07060302u), (int)(AP), acci[(DW) * 4 + 1], false); \
    acci[(DW) * 4 + 2] = __builtin_amdgcn_sdot4((int)__builtin_amdgcn_perm(t3, t1, 0x05040100u), (int)(AP), acci[(DW) * 4 + 2], false); \
    acci[(DW) * 4 + 3] = __builtin_amdgcn_sdot4((int)__builtin_amdgcn_perm(t3, t1, 0x07060302u), (int)(AP), acci[(DW) * 4 + 3], false); }
#define P9B_KQ(AP, KQ) { P9B_DW(x, 0, AP, KQ) P9B_DW(y, 1, AP, KQ) P9B_DW(z, 2, AP, KQ) P9B_DW(w, 3, AP, KQ) }
  P9B_KQ(apk.x, 0) P9B_KQ(apk.y, 1) P9B_KQ(apk.z, 2) P9B_KQ(apk.w, 3)
  float acc[16];
#pragma unroll
  for (int i = 0; i < 16; ++i) acc[i] = (float)acci[i] * scaleA;
  const int b3 = (lane >> 3) & 1, b4 = (lane >> 4) & 1, b5 = (lane >> 5) & 1;
  float v8[8], v4[4], v2[2];
#pragma unroll
  for (int i = 0; i < 8; ++i) { float keep = b3 ? acc[8 + i] : acc[i]; float send = b3 ? acc[i] : acc[8 + i]; v8[i] = keep + dpp_f<0x128>(send); }
#pragma unroll
  for (int i = 0; i < 4; ++i) { float keep = b4 ? v8[4 + i] : v8[i]; float send = b4 ? v8[i] : v8[4 + i]; v4[i] = keep + __shfl_xor(send, 16); }
#pragma unroll
  for (int i = 0; i < 2; ++i) { float keep = b5 ? v4[2 + i] : v4[i]; float send = b5 ? v4[i] : v4[2 + i]; v2[i] = keep + __shfl_xor(send, 32); }
  const int c = b3 * 8 + b4 * 4 + b5 * 2;
  float2 xv = *(const float2*)(xr + c);
  xv.x += v2[0];
  xv.y += v2[1];
  *(float2*)(xr + c) = xv;
}

__device__ __forceinline__ void final_norm_token(int tid, const Params& p, int tok) {
  const int lane = tid & 63;
  float* xr = p.out + O_Y + (size_t)tok * 1024 + lane * 16;
  const float* gf = p.in[11] + lane * 16;
  float y[16]; float s2 = 0.f;
#pragma unroll
  for (int i = 0; i < 4; ++i) { float4 v = *(const float4*)(xr + 4 * i); y[4 * i] = v.x; y[4 * i + 1] = v.y; y[4 * i + 2] = v.z; y[4 * i + 3] = v.w; s2 += v.x * v.x + v.y * v.y + v.z * v.z + v.w * v.w; }
  s2 = wave_sum(s2);
  const float r2 = rsqrtf(s2 * (1.f / 1024.f) + 1e-6f);
#pragma unroll
  for (int i = 0; i < 4; ++i) {
    float4 g = *(const float4*)(gf + 4 * i);
    *(float4*)(xr + 4 * i) = make_float4(y[4 * i] * r2 * g.x, y[4 * i + 1] * r2 * g.y, y[4 * i + 2] * r2 * g.z, y[4 * i + 3] * r2 * g.w);
  }
}

__device__ __forceinline__ unsigned f2ukey(float v) { unsigned u = __float_as_uint(v); return (u & 0x80000000u) ? ~u : (u | 0x80000000u); }
__device__ __forceinline__ float ukey2f(unsigned k) { unsigned u = (k & 0x80000000u) ? (k & 0x7fffffffu) : ~k; return __uint_as_float(u); }
__device__ __forceinline__ int popc64(unsigned long long m) { return __builtin_popcountll(m); }
__device__ __forceinline__ int mbcnt64(unsigned long long m) { return (int)__builtin_amdgcn_mbcnt_hi((unsigned)(m >> 32), __builtin_amdgcn_mbcnt_lo((unsigned)m, 0u)); }

struct TopkFrags { bf16x8 a[2][2]; bf16x8 b[2][2]; };
__device__ __forceinline__ void topk_load(TopkFrags& f, int tid, const Params& p, int layer, int item) {
  const int lane = tid & 63, w = __builtin_amdgcn_readfirstlane(tid >> 6);
  const int l16 = lane & 15, quad = lane >> 4;
  const int h = item & 7, tok0 = (item >> 3) * 32;
  const int pp = w >> 2;
  const bf16_t* qb = (const bf16_t*)(p.ws + OFF_QBUF);
  const bf16_t* keys = (const bf16_t*)(p.ws + OFF_WT) + WT_KEYS + (size_t)((layer * 8 + h) * 2 + pp) * 8192;
#pragma unroll
  for (int ks = 0; ks < 2; ++ks) {
#pragma unroll
    for (int mt = 0; mt < 2; ++mt) f.a[ks][mt] = *(const bf16x8*)(qb + (size_t)(tok0 + mt * 16 + l16) * 1024 + h * 128 + pp * 64 + ks * 32 + quad * 8);
#pragma unroll
    for (int j = 0; j < 2; ++j) {
      const int nt = (w & 3) * 2 + j;
      f.b[ks][j] = *(const bf16x8*)(keys + (nt * 16 + l16) * 64 + ks * 32 + quad * 8);
    }
  }
}

__device__ __forceinline__ void peer_topk_item(int tid, unsigned char* smem, const Params& p, const TopkFrags& f, int item) {
  unsigned* sS = (unsigned*)smem;
  const int lane = tid & 63, w = __builtin_amdgcn_readfirstlane(tid >> 6);
  const int l16 = lane & 15, quad = lane >> 4;
  const int h = item & 7, tile = item >> 3;
  const int tok0 = tile * 32;
  unsigned* wtop = (unsigned*)(smem + 32768) + w * 256;
  float* wexp = (float*)(wtop + 128);
  __syncthreads();
  {
    const int pp = w >> 2;
    f32x4 acc[2][2];
#pragma unroll
    for (int i = 0; i < 2; ++i)
#pragma unroll
      for (int j = 0; j < 2; ++j) acc[i][j] = (f32x4){0.f, 0.f, 0.f, 0.f};
#pragma unroll
    for (int ks = 0; ks < 2; ++ks)
#pragma unroll
      for (int mt = 0; mt < 2; ++mt)
#pragma unroll
        for (int j = 0; j < 2; ++j) acc[mt][j] = __builtin_amdgcn_mfma_f32_16x16x32_bf16(f.a[ks][mt], f.b[ks][j], acc[mt][j], 0, 0, 0);
#pragma unroll
    for (int mt = 0; mt < 2; ++mt)
#pragma unroll
      for (int j = 0; j < 2; ++j) {
        const int nt = (w & 3) * 2 + j;
#pragma unroll
        for (int r = 0; r < 4; ++r) {
          const int key = nt * 16 + l16;
          sS[((mt * 16 + quad * 4 + r) * 2 + pp) * 128 + key] = (f2ukey(acc[mt][j][r]) & ~127u) | (unsigned)(127 - key);
        }
      }
  }
  __syncthreads();
  int* ebuf = (int*)(p.ws + OFF_M);
  float* gbuf = (float*)(p.ws + OFF_M + 17301504ull);
  unsigned k0[8], k1[8], T[8];
#pragma unroll
  for (int c = 0; c < 8; ++c) {
    const unsigned* row = sS + ((w * 4 + (c >> 1)) * 2 + (c & 1)) * 128;
    k0[c] = row[lane]; k1[c] = row[64 + lane]; T[c] = 0u;
  }
#pragma unroll 1
  for (int bit = 31; bit >= 7; --bit) {
    const unsigned bm = 1u << bit;
#pragma unroll
    for (int c = 0; c < 8; ++c) {
      const unsigned cand = T[c] | bm;
      const int cnt = popc64(__builtin_amdgcn_ballot_w64(k0[c] >= cand)) + popc64(__builtin_amdgcn_ballot_w64(k1[c] >= cand));
      T[c] = (cnt >= 16) ? cand : T[c];
    }
  }
  {
    bool need = false;
#pragma unroll
    for (int c = 0; c < 8; ++c) {
      const int cnt = popc64(__builtin_amdgcn_ballot_w64(k0[c] >= T[c])) + popc64(__builtin_amdgcn_ballot_w64(k1[c] >= T[c]));
      need = need || (cnt > 16);
    }
    if (need) {
#pragma unroll 1
      for (int bit = 6; bit >= 0; --bit) {
        const unsigned bm = 1u << bit;
#pragma unroll
        for (int c = 0; c < 8; ++c) {
          const unsigned cand = T[c] | bm;
          const int cnt = popc64(__builtin_amdgcn_ballot_w64(k0[c] >= cand)) + popc64(__builtin_amdgcn_ballot_w64(k1[c] >= cand));
          T[c] = (cnt >= 16) ? cand : T[c];
        }
      }
    }
  }
#pragma unroll
  for (int c = 0; c < 8; ++c) {
    const unsigned long long m0 = __builtin_amdgcn_ballot_w64(k0[c] >= T[c]);
    const unsigned long long m1 = __builtin_amdgcn_ballot_w64(k1[c] >= T[c]);
    const int s0 = mbcnt64(m0), s1 = popc64(m0) + mbcnt64(m1);
    if (k0[c] >= T[c]) wtop[c * 16 + s0] = k0[c];
    if (k1[c] >= T[c]) wtop[c * 16 + s1] = k1[c];
  }
  asm volatile("s_waitcnt lgkmcnt(0)" ::: "memory");
#define ROR_CNT(S) { const unsigned o_ = (unsigned)__builtin_amdgcn_update_dpp(0, (int)key_, 0x120 + (S), 0xf, 0xf, true); rk_ += (o_ > key_) ? 1 : 0; }
#pragma unroll
  for (int pass = 0; pass < 2; ++pass) {
    const int L = pass * 4 + (lane >> 4);
    const unsigned key_ = wtop[L * 16 + (lane & 15)];
    int rk_ = 0;
    ROR_CNT(1) ROR_CNT(2) ROR_CNT(3) ROR_CNT(4) ROR_CNT(5) ROR_CNT(6) ROR_CNT(7) ROR_CNT(8)
    ROR_CNT(9) ROR_CNT(10) ROR_CNT(11) ROR_CNT(12) ROR_CNT(13) ROR_CNT(14) ROR_CNT(15)
    wtop[L * 16 + rk_] = key_;
  }
  asm volatile("s_waitcnt lgkmcnt(0)" ::: "memory");
  int ci = (lane >= 16) + (lane >= 24) + (lane >= 29) + (lane >= 33) + (lane >= 36) + (lane >= 38) + (lane >= 40) + (lane >= 42);
#pragma unroll
  for (int t = 43; t < 50; ++t) ci += (lane >= t);
  int cstart = 0;
  cstart = (ci >= 1) ? 16 : cstart; cstart = (ci >= 2) ? 24 : cstart; cstart = (ci >= 3) ? 29 : cstart; cstart = (ci >= 4) ? 33 : cstart;
  cstart = (ci >= 5) ? 36 : cstart; cstart = (ci >= 6) ? 38 : cstart; cstart = (ci >= 7) ? 40 : cstart; cstart = (ci >= 8) ? 42 : cstart;
  cstart = (ci >= 9) ? (34 + ci) : cstart;
  const int cj = lane - cstart;
  const bool cvalid = lane < 50;
  unsigned kav[4], kbv[4], ck[4], T2[4]; float cs[4];
#pragma unroll
  for (int t = 0; t < 4; ++t) {
    kav[t] = 0u; kbv[t] = 0u; cs[t] = 0.f; ck[t] = 0u; T2[t] = 0u;
    if (cvalid) {
      kav[t] = wtop[(t * 2) * 16 + ci]; kbv[t] = wtop[(t * 2 + 1) * 16 + cj];
      cs[t] = ukey2f(kav[t]) + ukey2f(kbv[t]);
      ck[t] = ((f2ukey(cs[t]) & ~63u) | (unsigned)(63 - lane)) | 0u;
      ck[t] = (ck[t] == 0u) ? 1u : ck[t];
    }
  }
#pragma unroll 1
  for (int bit = 31; bit >= 6; --bit) {
    const unsigned bm = 1u << bit;
#pragma unroll
    for (int t = 0; t < 4; ++t) {
      const unsigned cand = T2[t] | bm;
      const int cnt = popc64(__builtin_amdgcn_ballot_w64(ck[t] >= cand));
      T2[t] = (cnt >= 16) ? cand : T2[t];
    }
  }
  {
    bool need = false;
#pragma unroll
    for (int t = 0; t < 4; ++t) need = need || (popc64(__builtin_amdgcn_ballot_w64(ck[t] >= T2[t])) > 16);
    if (need) {
#pragma unroll 1
      for (int bit = 5; bit >= 0; --bit) {
        const unsigned bm = 1u << bit;
#pragma unroll
        for (int t = 0; t < 4; ++t) {
          const unsigned cand = T2[t] | bm;
          const int cnt = popc64(__builtin_amdgcn_ballot_w64(ck[t] >= cand));
          T2[t] = (cnt >= 16) ? cand : T2[t];
        }
      }
    }
  }
  int* weid = (int*)(wexp + 64);
#pragma unroll
  for (int t = 0; t < 4; ++t) {
    const float cT = ukey2f(T2[t]);
    const bool win = ck[t] >= T2[t];
    const int sl = mbcnt64(__builtin_amdgcn_ballot_w64(win));
    if (win) {
      wexp[t * 16 + sl] = __expf(fminf(cs[t] - cT, 60.f));
      weid[t * 16 + sl] = (127 - (int)(kav[t] & 127u)) * 128 + (127 - (int)(kbv[t] & 127u));
    }
  }
  asm volatile("s_waitcnt lgkmcnt(0)" ::: "memory");
  {
    const int t = lane >> 4, sl = lane & 15;
    float es = 0.f;
#pragma unroll
    for (int q = 0; q < 4; ++q) { const float4 ee = *(const float4*)(wexp + t * 16 + q * 4); es += ee.x + ee.y + ee.z + ee.w; }
    const float e = wexp[t * 16 + sl];
    const int id = weid[t * 16 + sl];
    const size_t o = (size_t)(tok0 + w * 4 + t) * 128 + h * 16 + sl;
    ebuf[o] = id;
    gbuf[o] = e / es;
  }
  asm volatile("s_waitcnt lgkmcnt(0)" ::: "memory");
}

struct EpiStoreBf16 { bf16_t* dst; int ld; __device__ void operator()(int r, int c, float v) const { dst[(size_t)r * ld + c] = f2bf(v); } };
struct EpiGlu { const bf16_t* z; const float* bias; bf16_t* mix; __device__ void operator()(int r, int c, float v) const {
  float zz = bf2f(z[(size_t)r * 512 + c]); float s = v + bias[c]; mix[(size_t)r * 1024 + 512 + c] = f2bf(zz / (1.f + __expf(-s))); } };
struct EpiRes0 { const float* xp; const float* xs; float* xres; __device__ void operator()(int r, int c, float v) const {
  float x = (r < T_P) ? xp[(size_t)r * 1024 + c] : xs[(size_t)(r - T_P) * 1024 + c]; xres[(size_t)r * 1024 + c] = x + v; } };
struct EpiRes1 { float* xres; __device__ void operator()(int r, int c, float v) const { xres[(size_t)r * 1024 + c] += v; } };
struct EpiPool { bf16_t* mix; const float* scale; int g; __device__ void operator()(int r, int c, float v) const {
  mix[(size_t)r * 1024 + g * 128 + c] = f2bf(v * scale[g * 128 + c]); } };
struct EpiKup { bf16_t* dst; int rowsPerB; int keyOff; int bStride; __device__ void operator()(int r, int c, float v) const {
  int b = r / rowsPerB, key = r % rowsPerB + keyOff; dst[((size_t)(b * 8 + (c >> 6)) * bStride + key) * 64 + (c & 63)] = f2bf(v); } };
struct EpiVt { bf16_t* dst; int rowsPerB; int keyOff; int ldv; __device__ void operator()(int r, int c, float v) const {
  int b = r / rowsPerB, key = r % rowsPerB + keyOff;
  dst[((size_t)(b * 8 + (c >> 6)) * (ldv >> 6) + (key >> 6)) * 4096 + (c & 63) * 64 + (key & 63)] = f2bf(v); } };


typedef const Params __attribute__((address_space(4))) KParams;

constexpr size_t OFF_BAR = WS_NEED;
__device__ __forceinline__ void grid_barrier(unsigned* ctr, unsigned target) {
  asm volatile("s_waitcnt vmcnt(0)" ::: "memory");
  __syncthreads();
  if (threadIdx.x == 0) {
    __builtin_amdgcn_fence(__ATOMIC_RELEASE, "agent");
    asm volatile("s_waitcnt vmcnt(0)" ::: "memory");
    __hip_atomic_fetch_add(ctr, 1u, __ATOMIC_RELAXED, __HIP_MEMORY_SCOPE_AGENT);
    unsigned spins = 0;
    while (__hip_atomic_load(ctr, __ATOMIC_RELAXED, __HIP_MEMORY_SCOPE_AGENT) < target) {
      __builtin_amdgcn_s_sleep(1);
      if (++spins > (1u << 27)) break;
    }
    __builtin_amdgcn_fence(__ATOMIC_ACQUIRE, "agent");
    asm volatile("s_waitcnt vmcnt(0)" ::: "memory");
  }
  __syncthreads();
}
#define GRID_BAR() { unsigned* ctr_ = (unsigned*)(((KParams*)__builtin_amdgcn_kernarg_segment_ptr())->ws + OFF_BAR); bar_k += 1; grid_barrier(ctr_, (unsigned)bar_k * gridDim.x); }
#define PHASE_BEGIN \
  Params p; \
  { KParams* kp_ = (KParams*)__builtin_amdgcn_kernarg_segment_ptr(); asm volatile("" : "+s"(kp_)); \
    _Pragma("unroll") for (int i_ = 0; i_ < 38; ++i_) p.in[i_] = kp_->in[i_]; \
    p.out = kp_->out; p.ws = kp_->ws; } \
  int tid = threadIdx.x; asm volatile("" : "+v"(tid)); \
  const int lane = tid & 63, w = __builtin_amdgcn_readfirstlane(tid >> 6); \
  const int gw = blockIdx.x * 8 + w, nw = gridDim.x * 8; \
  const size_t gtid = (size_t)blockIdx.x * NT + tid, gthreads = (size_t)gridDim.x * NT; \
  bf16_t* wt = (bf16_t*)(p.ws + OFF_WT); \
  bf16_t* proj = (bf16_t*)(p.ws + OFF_PROJ); \
  bf16_t* mix = (bf16_t*)(p.ws + OFF_MIX); \
  bf16_t* qbuf = (bf16_t*)(p.ws + OFF_QBUF); \
  bf16_t* zbuf = (bf16_t*)(p.ws + OFF_Z); \
  float* xres = p.out + O_Y; \
  (void)lane; (void)gw; (void)nw; (void)gtid; (void)gthreads; (void)wt; (void)proj; (void)mix; (void)qbuf; (void)zbuf; (void)xres;

template <int LAYER>
__device__ __forceinline__ void peer_phases(int& bar_k, unsigned char* smem) {
  const int layer = LAYER;
    for (int rep_ = 0; rep_ < NREP(7); ++rep_)
    {
    PHASE_BEGIN
      int vb = 0;
      gemm_run<2>(tid, smem, xres, xres, T_TOT, 1024, p.in[10] + layer * 1024, wt + WT_PQ + (size_t)layer * 1048576, T_TOT, 1024, 1024, vb, EpiStoreBf16{qbuf, 1024});
    }
    GRID_BAR();
    for (int rep_ = 0; rep_ < NREP(8); ++rep_) {
    PHASE_BEGIN
    {
      TopkFrags fr;
      int item = blockIdx.x;
      if (item < 1056 * 8) topk_load(fr, tid, p, layer, item);
      for (; item < 1056 * 8; item += gridDim.x) {
        TopkFrags cur = fr;
        const int nxt = item + gridDim.x;
        if (nxt < 1056 * 8) topk_load(fr, tid, p, layer, nxt);
        peer_topk_item(tid, smem, p, cur, item);
      }
    }
    }
    GRID_BAR();
    for (int rep_ = 0; rep_ < NREP(9); ++rep_) {
    PHASE_BEGIN
      int j = blockIdx.x & 7, lb = blockIdx.x >> 3, nb = ((int)gridDim.x - j + 7) >> 3;
      {
        unsigned* cnt_ = (unsigned*)(p.ws + OFF_BAR) + 16;
        bool ok_ = true;
#pragma unroll
        for (int x_ = 0; x_ < 16; ++x_) {
          const unsigned c_ = __hip_atomic_load(&cnt_[x_], __ATOMIC_RELAXED, __HIP_MEMORY_SCOPE_AGENT);
          ok_ = ok_ && ((x_ < 8) ? (c_ > 0u) : (c_ == 0u));
        }
        if (ok_) {
          j = ((const int*)(smem + (DYN_LDS - 16)))[0]; lb = ((const int*)(smem + (DYN_LDS - 16)))[1];
          nb = (int)__hip_atomic_load(&cnt_[j], __ATOMIC_RELAXED, __HIP_MEMORY_SCOPE_AGENT);
        }
      }
      for (int tok = lb * 8 + w; tok < T_TOT; tok += nb * 8) peer9a_token(tid, p, layer, tok, j);
    }
    GRID_BAR();
    for (int rep_ = 0; rep_ < NREP(9); ++rep_) {
    PHASE_BEGIN
      for (int tok = gw; tok < T_TOT; tok += nw) peer9m_token(tid, smem, p, tok);
    }
    GRID_BAR();
    for (int rep_ = 0; rep_ < NREP(9); ++rep_) {
    PHASE_BEGIN
      int j = blockIdx.x & 7, lb = blockIdx.x >> 3, nb = ((int)gridDim.x - j + 7) >> 3;
      {
        unsigned* cnt_ = (unsigned*)(p.ws + OFF_BAR) + 16;
        bool ok_ = true;
#pragma unroll
        for (int x_ = 0; x_ < 16; ++x_) {
          const unsigned c_ = __hip_atomic_load(&cnt_[x_], __ATOMIC_RELAXED, __HIP_MEMORY_SCOPE_AGENT);
          ok_ = ok_ && ((x_ < 8) ? (c_ > 0u) : (c_ == 0u));
        }
        if (ok_) {
          j = ((const int*)(smem + (DYN_LDS - 16)))[0]; lb = ((const int*)(smem + (DYN_LDS - 16)))[1];
          nb = (int)__hip_atomic_load(&cnt_[j], __ATOMIC_RELAXED, __HIP_MEMORY_SCOPE_AGENT);
        }
      }
      for (int tok = lb * 8 + w; tok < T_TOT; tok += nb * 8) peer9b_token(tid, p, tok, j);
    }
    if (layer == 1) {
      GRID_BAR();
      for (int rep_ = 0; rep_ < NREP(9); ++rep_) {
      PHASE_BEGIN
        for (int tok = gw; tok < T_TOT; tok += nw) final_norm_token(tid, p, tok);
      }
    }
}

__global__ void __launch_bounds__(NT) mega(Params kparams_) {
  cg::grid_group grid = cg::this_grid();
  int bar_k = 0;
  extern __shared__ __attribute__((aligned(16))) unsigned char smem[];
  if (threadIdx.x == 0) {
    unsigned* cnt_ = (unsigned*)(((KParams*)__builtin_amdgcn_kernarg_segment_ptr())->ws + OFF_BAR) + 16;
    const unsigned xcc_ = (unsigned)__builtin_amdgcn_s_getreg((3 << 11) | 20) & 0xFu;
    const unsigned rank_ = __hip_atomic_fetch_add(&cnt_[xcc_], 1u, __ATOMIC_RELAXED, __HIP_MEMORY_SCOPE_AGENT);
    ((int*)(smem + (DYN_LDS - 16)))[0] = (int)xcc_;
    ((int*)(smem + (DYN_LDS - 16)))[1] = (int)rank_;
  }

  for (int rep_ = 0; rep_ < NREP(0); ++rep_)
  {
    PHASE_BEGIN
    int vb = 0;
    transpose_convert(tid, smem, p.in[12], wt + WT_IN_E, 1024, 1280, vb);
    transpose_convert(tid, smem, p.in[13], wt + WT_OUT_E, 1024, 1024, vb);
    transpose_convert(tid, smem, p.in[23], wt + WT_GLU, 512, 512, vb);
    transpose_convert(tid, smem, p.in[25], wt + WT_IN_O, 1024, 1312, vb);
    transpose_convert(tid, smem, p.in[26], wt + WT_OUT_O, 1024, 1024, vb);
    for (int g = 0; g < 4; ++g) transpose_convert(tid, smem, p.in[27] + g * 16384, wt + WT_POOL + g * 16384, 128, 128, vb);
    transpose_convert(tid, smem, p.in[31], wt + WT_UQ, 512, 768, vb);
    transpose_convert(tid, smem, p.in[32], wt + WT_UK, 256, 512, vb);
    transpose_convert(tid, smem, p.in[33], wt + WT_UV, 256, 512, vb);
    transpose_convert(tid, smem, p.in[34], wt + WT_PQ, 1024, 1024, vb);
    transpose_convert(tid, smem, p.in[34] + 1048576, wt + WT_PQ + 1048576, 1024, 1024, vb);
    convert_plain(tid, p.in[35], wt + WT_KEYS, 262144);
    quant_rows(p.in[36], p.ws + OFF_TAB, (float*)(p.ws + OFF_TAB + TAB_SU_OFF), gw, nw, tid);
    quant_rows(p.in[37], p.ws + OFF_TAB + TAB_V_OFF, (float*)(p.ws + OFF_TAB + TAB_SV_OFF), gw, nw, tid);
  }
  grid.sync();

  for (int rep_ = 0; rep_ < NREP(1); ++rep_)
  {
    PHASE_BEGIN
    int vb = 0;
    gemm_run<2>(tid, smem, p.in[0], p.in[1], T_P, 1024, p.in[9], wt + WT_IN_E, T_TOT, 1280, 1024, vb, EpiStoreBf16{proj, 1280});
  }
  GRID_BAR();

  for (int rep_ = 0; rep_ < NREP(2); ++rep_)
  {
    PHASE_BEGIN
    bf16_t* vt0 = (bf16_t*)(p.ws + OFF_VT0);
    bf16_t* kall = (bf16_t*)(p.ws + OFF_KALL);
    bf16_t* vtall = (bf16_t*)(p.ws + OFF_VTALL);
    for (int tok = gw; tok < T_TOT; tok += nw) {
      const bool isS = tok >= T_P;
      int b, t, pos;
      if (!isS) { b = tok >> 12; t = tok & 4095; pos = t; } else { int s = tok - T_P; b = s >> 5; t = s & 31; pos = 2048 + t; }
      bf16_t* row = proj + (size_t)tok * 1280;
      const int lm = lane & 7;
      float sn[8], cs[8];
#pragma unroll
      for (int j = 0; j < 8; ++j) { float inv = exp2f(-(float)j * (LOG2_THETA / 8.f)); sincos_rev((float)pos * inv, sn[j], cs[j]); }
      {
        uint4 qv = *(const uint4*)(row + lane * 8);
        float x[8]; unpack8(qv, x);
#pragma unroll
        for (int j = 0; j < 8; ++j) {
          float other = __shfl_xor(x[j], 1);
          if (lm == 0) x[j] = x[j] * cs[j] - other * sn[j];
          else if (lm == 1) x[j] = x[j] * cs[j] + other * sn[j];
        }
        *(uint4*)(row + lane * 8) = pack8(x);
      }
      {
        uint4 kv = make_uint4(0, 0, 0, 0);
        if (lane < 32) kv = *(const uint4*)(row + 512 + lane * 8);
        float x[8]; unpack8(kv, x);
#pragma unroll
        for (int j = 0; j < 8; ++j) {
          float other = __shfl_xor(x[j], 1);
          if (lane < 16) {
            if (lm == 0) x[j] = x[j] * cs[j] - other * sn[j];
            else if (lm == 1) x[j] = x[j] * cs[j] + other * sn[j];
          }
        }
        if (lane < 32) {
          const uint4 pk = pack8(x);
          const int e0 = (lane & 15) * 8;
          if (!isS) {
            if (lane < 16) *(uint4*)(row + 512 + lane * 8) = pk;
            else {
              const int kvh = e0 >> 6, d0 = e0 & 63;
#pragma unroll
              for (int j = 0; j < 8; ++j) vt0[((size_t)(b * 2 + kvh) * 64 + d0 + j) * 4096 + t] = f2bf(x[j]);
            }
            if (t >= 3968) {
              float* dst = p.out + ((lane < 16) ? O_SWAK_P : O_SWAV_P) + ((size_t)(b * 128 + (t - 3968)) * 128 + e0);
              *(float4*)dst = make_float4(x[0], x[1], x[2], x[3]);
              *(float4*)(dst + 4) = make_float4(x[4], x[5], x[6], x[7]);
            }
          } else {
            float* dst = p.out + ((lane < 16) ? O_SWAK_S : O_SWAV_S) + ((size_t)(b * 128 + 96 + t) * 128 + e0);
            *(float4*)dst = make_float4(x[0], x[1], x[2], x[3]);
            *(float4*)(dst + 4) = make_float4(x[4], x[5], x[6], x[7]);
            if (lane < 16) *(uint4*)(kall + (size_t)(b * 160 + 128 + t) * 128 + e0) = pk;
            else {
              const int kvh = e0 >> 6, d0 = e0 & 63;
#pragma unroll
              for (int j = 0; j < 8; ++j) vtall[((size_t)(b * 2 + kvh) * 64 + d0 + j) * 192 + 128 + t] = f2bf(x[j]);
            }
          }
        }
      }
    }
    for (size_t idx = gtid; idx < (size_t)32 * 96 * 128; idx += gthreads) {
      const int e = (int)(idx & 127); const int wd = (int)((idx >> 7) % 96); const int b = (int)(idx / (96 * 128));
      const size_t src = ((size_t)(b * 128 + 32 + wd)) * 128 + e, dst = ((size_t)(b * 128 + wd)) * 128 + e;
      p.out[O_SWAK_S + dst] = p.in[2][src];
      p.out[O_SWAV_S + dst] = p.in[3][src];
    }
    for (size_t idx = gtid; idx < (size_t)32 * 128 * 128; idx += gthreads) {
      const int e = (int)(idx & 127); const int key = (int)((idx >> 7) & 127); const int b = (int)(idx >> 14);
      kall[(size_t)(b * 160 + key) * 128 + e] = f2bf(p.in[2][idx]);
      vtall[((size_t)(b * 2 + (e >> 6)) * 64 + (e & 63)) * 192 + key] = f2bf(p.in[3][idx]);
    }
    for (size_t idx = gtid; idx < (size_t)32 * 2 * 64 * 32; idx += gthreads) {
      const int kk = (int)(idx & 31); const size_t rr = idx >> 5;
      vtall[rr * 192 + 160 + kk] = 0;
    }
    float* sUw = (float*)smem + w * 512;
    for (int item = gw; item < 32768; item += nw) s5_item<0>(tid, sUw, p, item);
  }
  GRID_BAR();

  for (int rep_ = 0; rep_ < NREP(3); ++rep_)
  {
    PHASE_BEGIN
    if (gtid < 16384) {
      const int n = (int)(gtid & 63), g = (int)((gtid >> 6) & 31), b = (int)(gtid >> 11);
      const int gn = g * 64 + n;
      const float lr = fminf(p.in[15][gn], -1e-4f), li = p.in[16][gn];
      const float dt = __expf(p.in[17][g]);
      const float mag = __expf(lr * dt);
      float sn, cs; sincos_rev(li * dt, sn, cs);
      float ar = mag * cs, ai = mag * sn;
#pragma unroll
      for (int i = 0; i < 5; ++i) { float nr = ar * ar - ai * ai, ni = 2.f * ar * ai; ar = nr; ai = ni; }
      const float* s1re = (const float*)(p.ws + OFF_QMLA);
      const float* s1im = s1re + 2097152;
      float* hinre = (float*)(p.ws + OFF_QMLA) + 2 * 2097152;
      float* hinim = hinre + 2097152;
      float hr = 0.f, hi = 0.f;
#pragma unroll 8
      for (int c = 0; c < 128; ++c) {
        const size_t idx = ((size_t)(b * 128 + c) * 32 + g) * 64 + n;
        hinre[idx] = hr; hinim[idx] = hi;
        const float sr = s1re[idx], si = s1im[idx];
        const float nhr = ar * hr - ai * hi + sr, nhi = ar * hi + ai * hr + si;
        hr = nhr; hi = nhi;
      }
      p.out[O_SSMRE_P + (size_t)(b * 32 + g) * 64 + n] = hr;
      p.out[O_SSMIM_P + (size_t)(b * 32 + g) * 64 + n] = hi;
    }
    const bf16_t* vt0 = (const bf16_t*)(p.ws + OFF_VT0);
    const bf16_t* kall = (const bf16_t*)(p.ws + OFF_KALL);
    const bf16_t* vtall = (const bf16_t*)(p.ws + OFF_VTALL);
    const float* sink = p.in[14];
    for (int item = blockIdx.x; item < 2048 + 256; item += gridDim.x) {
      AttnDesc d;
      d.scale = 0.125f; d.kx = nullptr; d.pos0 = 0;
      if (item < 2048) {
        const int h = item & 7, pr = (item >> 3) & 31, b = item >> 8;
        const int kvh = h >> 2;
        const int chunk = pr * 2 + (w >> 2);
        const int tok = b * 4096 + chunk * 64 + (w & 3) * 16;
        d.q = proj + (size_t)tok * 1280 + h * 64; d.ldq = 1280; d.active = 1;
        d.kt_lo = max(0, chunk - 2); d.kt_hi = chunk + 1;
        d.out = mix + (size_t)tok * 1024 + h * 64; d.ldo = 1024;
        d.m0 = sink[h]; d.l0 = 1.f;
        d.k = proj + (size_t)(b * 4096) * 1280 + 512 + kvh * 64; d.ldk = 1280;
        d.vt = vt0 + (size_t)(b * 2 + kvh) * 64 * 4096; d.ldv = 4096; d.vts = 64; d.nkeys = 4096;
        d.bt_lo = max(0, pr * 2 - 2); d.bt_hi = pr * 2 + 2;
      } else {
        const int it = item - 2048;
        const int h = it & 7, b = it >> 3;
        const int kvh = h >> 2;
        const int tok = T_P + b * 32 + (w & 1) * 16;
        d.q = proj + (size_t)tok * 1280 + h * 64; d.ldq = 1280; d.active = (w < 2);
        d.kt_lo = 0; d.kt_hi = 3;
        d.out = mix + (size_t)tok * 1024 + h * 64; d.ldo = 1024;
        d.m0 = sink[h]; d.l0 = 1.f;
        d.k = kall + (size_t)(b * 160) * 128 + kvh * 64; d.ldk = 128;
        d.vt = vtall + (size_t)(b * 2 + kvh) * 64 * 192; d.ldv = 192; d.vts = 64; d.nkeys = 160;
        d.bt_lo = 0; d.bt_hi = 3;
      }
      attn_item<64>(tid, smem, d);
    }
  }
  GRID_BAR();

  for (int rep_ = 0; rep_ < NREP(4); ++rep_)
  {
    PHASE_BEGIN
    float* sUw = (float*)smem + w * 512;
    for (int item = gw; item < 33792; item += nw) s5_item<1>(tid, sUw, p, item);
  }
  GRID_BAR();

  for (int rep_ = 0; rep_ < NREP(5); ++rep_)
  {
    PHASE_BEGIN
    int vb = 0;
    gemm_run<0>(tid, smem, zbuf, zbuf, T_TOT, 512, nullptr, wt + WT_GLU, T_TOT, 512, 512, vb, EpiGlu{zbuf, p.in[24], mix});
  }
  GRID_BAR();

  for (int rep_ = 0; rep_ < NREP(6); ++rep_)
  {
    PHASE_BEGIN
    int vb = 0;
    gemm_run<0>(tid, smem, mix, mix, T_TOT, 1024, nullptr, wt + WT_OUT_E, T_TOT, 1024, 1024, vb, EpiRes0{p.in[0], p.in[1], xres});
  }
  GRID_BAR();

  peer_phases<0>(bar_k, smem);
  GRID_BAR();
      for (int rep_ = 0; rep_ < NREP(10); ++rep_)
      {
    PHASE_BEGIN
        int vb = 0;
        gemm_run<2>(tid, smem, xres, xres, T_TOT, 1024, p.in[9] + 1024, wt + WT_IN_O, T_TOT, 1312, 1024, vb, EpiStoreBf16{proj, 1312});
      }
      GRID_BAR();
      for (int rep_ = 0; rep_ < NREP(11); ++rep_)
      {
    PHASE_BEGIN
        bf16_t* cqn = zbuf;
        bf16_t* mbuf = (bf16_t*)(p.ws + OFF_M);
        bf16_t* cbuf = (bf16_t*)(p.ws + OFF_C);
        bf16_t* kpbuf = (bf16_t*)(p.ws + OFF_KP);
        bf16_t* kps = (bf16_t*)(p.ws + OFF_KPS);
        for (int tok = gw; tok < T_TOT; tok += nw) {
          const bool isS = tok >= T_P;
          int b, t, pos;
          if (!isS) { b = tok >> 12; t = tok & 4095; pos = t; } else { int s = tok - T_P; b = s >> 5; t = s & 31; pos = 2048 + t; }
          const bf16_t* row = proj + (size_t)tok * 1312;
          {
            uint4 v = *(const uint4*)(row + lane * 8);
            float x[8]; unpack8(v, x);
            float ss = 0.f;
#pragma unroll
            for (int j = 0; j < 8; ++j) ss += x[j] * x[j];
            ss = wave_sum(ss);
            const float rs = rsqrtf(ss * (1.f / 512.f) + 1e-6f);
            const float4 g0 = *(const float4*)(p.in[29] + lane * 8), g1 = *(const float4*)(p.in[29] + lane * 8 + 4);
            x[0] *= rs * g0.x; x[1] *= rs * g0.y; x[2] *= rs * g0.z; x[3] *= rs * g0.w;
            x[4] *= rs * g1.x; x[5] *= rs * g1.y; x[6] *= rs * g1.z; x[7] *= rs * g1.w;
            *(uint4*)(cqn + (size_t)tok * 512 + lane * 8) = pack8(x);
          }
          {
            uint2 v = *(const uint2*)(row + 512 + lane * 4);
            float x0 = lo2f(v.x), x1 = hi2f(v.x), x2 = lo2f(v.y), x3 = hi2f(v.y);
            float ss = wave_sum(x0 * x0 + x1 * x1 + x2 * x2 + x3 * x3);
            const float rs = rsqrtf(ss * (1.f / 256.f) + 1e-6f);
            const float4 g = *(const float4*)(p.in[30] + lane * 4);
            x0 *= rs * g.x; x1 *= rs * g.y; x2 *= rs * g.z; x3 *= rs * g.w;
            uint2 o; o.x = pack2(x0, x1); o.y = pack2(x2, x3);
            *(uint2*)(cbuf + (size_t)tok * 256 + lane * 4) = o;
            float* dst = isS ? (p.out + O_CKV_S + (size_t)(tok - T_P) * 256 + lane * 4) : (p.out + O_CKV_P + (size_t)tok * 256 + lane * 4);
            *(float4*)dst = make_float4(x0, x1, x2, x3);
          }
          {
            float xv = 0.f;
            if (lane < 32) xv = bf2f(row[768 + lane]);
            const float other = __shfl_xor(xv, 16);
            const int f = lane & 15;
            const float inv = exp2f(-(float)f * (LOG2_THETA / 16.f));
            float sn, cs; sincos_rev((float)pos * inv, sn, cs);
            const float r = (lane < 16) ? (xv * cs - other * sn) : (xv * cs + other * sn);
            if (lane < 32) {
              kpbuf[(size_t)tok * 32 + lane] = f2bf(r);
              if (isS) { p.out[O_KPE_S + (size_t)(tok - T_P) * 32 + lane] = r; kps[((size_t)b * 2112 + 2048 + t) * 32 + lane] = f2bf(r); }
              else p.out[O_KPE_P + (size_t)tok * 32 + lane] = r;
            }
          }
          {
            const int gi = lane >> 4; const int wlen = 2 << gi;
            float tot[8], cur[8];
#pragma unroll
            for (int j = 0; j < 8; ++j) tot[j] = 0.f;
            uint4 v = *(const uint4*)(row + 800 + lane * 8);
            unpack8(v, cur);
#pragma unroll
            for (int j = 0; j < 8; ++j) tot[j] = cur[j];
            for (int jb = 1; jb < 16; ++jb) {
              if (jb < wlen) {
                const int tt = t - jb;
                if (tt >= 0) {
                  uint4 pv = *(const uint4*)(row - (size_t)jb * 1312 + 800 + lane * 8);
                  float y[8]; unpack8(pv, y);
#pragma unroll
                  for (int j = 0; j < 8; ++j) tot[j] += y[j];
                } else if (isS) {
                  const float* sp = p.in[6] + ((size_t)b * 15 + (15 + tt)) * 512 + lane * 8;
                  float4 a = *(const float4*)sp, bq = *(const float4*)(sp + 4);
                  tot[0] += a.x; tot[1] += a.y; tot[2] += a.z; tot[3] += a.w; tot[4] += bq.x; tot[5] += bq.y; tot[6] += bq.z; tot[7] += bq.w;
                }
              }
            }
            const float cnt = (float)min(pos + 1, wlen);
            float mm[8];
#pragma unroll
            for (int j = 0; j < 8; ++j) mm[j] = tot[j] / cnt - cur[j];
            *(uint4*)(mbuf + (size_t)tok * 512 + lane * 8) = pack8(mm);
            const int tlen = isS ? 32 : 4096;
            if (t >= tlen - 15) {
              const int i = t - (tlen - 15);
              float* dst = isS ? (p.out + O_POOL_S + ((size_t)b * 15 + i) * 512 + lane * 8) : (p.out + O_POOL_P + ((size_t)b * 15 + i) * 512 + lane * 8);
              *(float4*)dst = make_float4(cur[0], cur[1], cur[2], cur[3]);
              *(float4*)(dst + 4) = make_float4(cur[4], cur[5], cur[6], cur[7]);
            }
          }
        }
        for (size_t idx = gtid; idx < (size_t)32 * 2048 * 32; idx += gthreads) {
          const int e = (int)(idx & 31); const int key = (int)((idx >> 5) & 2047); const int b = (int)(idx >> 16);
          kps[((size_t)b * 2112 + key) * 32 + e] = f2bf(p.in[8][idx]);
        }
      }
      GRID_BAR();
      for (int rep_ = 0; rep_ < NREP(12); ++rep_)
      {
    PHASE_BEGIN
        bf16_t* cqn = zbuf;
        bf16_t* mbuf = (bf16_t*)(p.ws + OFF_M);
        bf16_t* cbuf = (bf16_t*)(p.ws + OFF_C);
        bf16_t* qmla = (bf16_t*)(p.ws + OFF_QMLA);
        bf16_t* kupp = qbuf;
        bf16_t* vtp = qbuf + 16777216;
        bf16_t* kups = (bf16_t*)(p.ws + OFF_KUPS);
        bf16_t* vts = (bf16_t*)(p.ws + OFF_VTS);
        for (size_t idx = gtid; idx < (size_t)32 * 8 * 64 * 32; idx += gthreads) {
          const int kk = (int)(idx & 31); const size_t rr = idx >> 5;
          vts[((rr >> 6) * 33 + 32) * 4096 + (rr & 63) * 64 + 32 + kk] = 0;
        }
        int vb = 0;
        gemm_run<1>(tid, smem, p.in[7], p.in[7], 65536, 256, nullptr, wt + WT_UK, 65536, 512, 256, vb, EpiKup{kups, 2048, 0, 2112});
        gemm_run<1>(tid, smem, p.in[7], p.in[7], 65536, 256, nullptr, wt + WT_UV, 65536, 512, 256, vb, EpiVt{vts, 2048, 0, 2112});
        gemm_run<0>(tid, smem, cqn, cqn, T_TOT, 512, nullptr, wt + WT_UQ, T_TOT, 768, 512, vb, EpiStoreBf16{qmla, 768});
        gemm_run<0>(tid, smem, cbuf, cbuf, T_P, 256, nullptr, wt + WT_UK, T_P, 512, 256, vb, EpiKup{kupp, 4096, 0, 4096});
        gemm_run<0>(tid, smem, cbuf, cbuf, T_P, 256, nullptr, wt + WT_UV, T_P, 512, 256, vb, EpiVt{vtp, 4096, 0, 4096});
        gemm_run<0>(tid, smem, cbuf + (size_t)T_P * 256, cbuf, 1024, 256, nullptr, wt + WT_UK, 1024, 512, 256, vb, EpiKup{kups, 32, 2048, 2112});
        gemm_run<0>(tid, smem, cbuf + (size_t)T_P * 256, cbuf, 1024, 256, nullptr, wt + WT_UV, 1024, 512, 256, vb, EpiVt{vts, 32, 2048, 2112});
        for (int g = 0; g < 4; ++g)
          gemm_run<0>(tid, smem, mbuf + g * 128, mbuf, T_TOT, 512, nullptr, wt + WT_POOL + g * 16384, T_TOT, 128, 128, vb, EpiPool{mix, p.in[28], g});
      }
      GRID_BAR();
      for (int rep_ = 0; rep_ < NREP(13); ++rep_)
      {
    PHASE_BEGIN
        const bf16_t* qmla = (const bf16_t*)(p.ws + OFF_QMLA);
        const bf16_t* kupp = qbuf;
        const bf16_t* vtp = qbuf + 16777216;
        const bf16_t* kups = (const bf16_t*)(p.ws + OFF_KUPS);
        const bf16_t* vts = (const bf16_t*)(p.ws + OFF_VTS);
        const bf16_t* kpbuf = (const bf16_t*)(p.ws + OFF_KP);
        const bf16_t* kps = (const bf16_t*)(p.ws + OFF_KPS);
        const int G = gridDim.x;
        const bool xsched = (G == 256);
        const int nitems = 2048 + 256;
        const int xcd = blockIdx.x & 7, loc = blockIdx.x >> 3;
        for (int k = 0;; ++k) {
          int pit, sit = -1;
          if (xsched) {
            if (k >= 9) break;
            if (k == 0) { pit = -1; sit = blockIdx.x; }
            else {
              const int r = k - 1;
              const int grp = xcd + 8 * r;
              const int pr = (r & 1) ? (31 - loc) : loc;
              pit = ((31 - pr) << 6) | grp;
            }
          } else {
            const int posn = (k & 1) ? (G - 1 - (int)blockIdx.x) : (int)blockIdx.x;
            const int v = k * G + posn;
            if (k * G >= nitems) break;
            if (v >= nitems) continue;
            if (v < 1024) pit = v; else if (v < 1280) { pit = -1; sit = v - 1024; } else pit = v - 256;
          }
          AttnDesc d;
          d.scale = 0.10206207261596575f; d.m0 = -1e30f; d.l0 = 0.f;
          if (pit >= 0) {
            const int pr = 31 - (pit >> 6); const int h = pit & 7, b = (pit >> 3) & 7;
            const int chunk = pr * 2 + (w >> 2);
            const int tok = b * 4096 + chunk * 64 + (w & 3) * 16;
            d.q = qmla + (size_t)tok * 768 + h * 96; d.ldq = 768; d.active = 1; d.pos0 = chunk * 64 + (w & 3) * 16;
            d.kt_lo = 0; d.kt_hi = chunk + 1;
            d.out = mix + (size_t)tok * 1024 + 512 + h * 64; d.ldo = 1024;
            d.k = kupp + (size_t)(b * 8 + h) * 4096 * 64; d.ldk = 64;
            d.kx = kpbuf + (size_t)(b * 4096) * 32;
            d.vt = vtp + (size_t)(b * 8 + h) * 64 * 4096; d.ldv = 64; d.vts = 4096; d.nkeys = 4096;
            d.bt_lo = 0; d.bt_hi = pr * 2 + 2;
          } else {
            const int h = sit & 7, b = sit >> 3;
            const int tok = T_P + b * 32 + (w & 1) * 16;
            d.q = qmla + (size_t)tok * 768 + h * 96; d.ldq = 768; d.active = (w < 2); d.pos0 = 2048 + (w & 1) * 16;
            d.kt_lo = 0; d.kt_hi = 33;
            d.out = mix + (size_t)tok * 1024 + 512 + h * 64; d.ldo = 1024;
            d.k = kups + (size_t)(b * 8 + h) * 2112 * 64; d.ldk = 64;
            d.kx = kps + (size_t)(b * 2112) * 32;
            d.vt = vts + (size_t)(b * 8 + h) * 64 * 2112; d.ldv = 64; d.vts = 4096; d.nkeys = 2080;
            d.bt_lo = 0; d.bt_hi = 33;
          }
          attn_item<96>(tid, smem, d);
        }
      }
      GRID_BAR();
      for (int rep_ = 0; rep_ < NREP(14); ++rep_)
      {
    PHASE_BEGIN
        quant_rows(p.in[36] + 16777216, p.ws + OFF_TAB, (float*)(p.ws + OFF_TAB + TAB_SU_OFF), gw, nw, tid);
        quant_rows(p.in[37] + 16777216, p.ws + OFF_TAB + TAB_V_OFF, (float*)(p.ws + OFF_TAB + TAB_SV_OFF), gw, nw, tid);
        int vb = 0;
        gemm_run<0>(tid, smem, mix, mix, T_TOT, 1024, nullptr, wt + WT_OUT_O, T_TOT, 1024, 1024, vb, EpiRes1{xres});
      }
      GRID_BAR();
  peer_phases<1>(bar_k, smem);
}

extern "C" void kernel_launch(void* const* d_in, const int* in_sizes, int n_in, void* d_out, int out_size, void* d_ws, size_t ws_size, hipStream_t stream) {
  static int grid_blocks = 0;
  if (grid_blocks == 0) {
    int dev = 0, cus = 0, per_cu = 0;
    hipGetDevice(&dev);
    hipDeviceGetAttribute(&cus, hipDeviceAttributeMultiprocessorCount, dev);
    hipFuncSetAttribute((const void*)mega, hipFuncAttributeMaxDynamicSharedMemorySize, DYN_LDS);
    hipOccupancyMaxActiveBlocksPerMultiprocessor(&per_cu, (const void*)mega, NT, DYN_LDS);
    if (per_cu < 1) per_cu = 1;
    if (per_cu > 1) per_cu = 1;
    grid_blocks = cus * per_cu;
    if (ws_size < WS_NEED + 256) fprintf(stderr, "kernel_launch: workspace too small: %zu < %zu\n", ws_size, (size_t)WS_NEED);
  }
  hipMemsetAsync((unsigned char*)d_ws + OFF_BAR, 0, 256, stream);
  Params p{};
  for (int i = 0; i < 38; ++i) p.in[i] = (const float*)d_in[i];
  p.out = (float*)d_out;
  p.ws = (unsigned char*)d_ws;
  void* args[] = {&p};
  hipError_t e = hipLaunchCooperativeKernel((const void*)mega, dim3(grid_blocks), dim3(NT), args, DYN_LDS, stream);
  if (e != hipSuccess) fprintf(stderr, "cooperative launch failed: %s (grid %d)\n", hipGetErrorString(e), grid_blocks);
}
```

```cpp
#include <hip/hip_runtime.h>
#include <hip/hip_bf16.h>
#include <hip/hip_cooperative_groups.h>
#include <cstdio>
namespace cg = cooperative_groups;

typedef unsigned short bf16_t;
using bf16x8 = __attribute__((ext_vector_type(8))) short;
using f32x4 = __attribute__((ext_vector_type(4))) float;

#ifndef PH
#define PH 0xFFFFFFu
#endif
#ifndef DBL
#define DBL 0u
#endif
#define NREP(n) ((int)((PH >> (n)) & 1u) * (1 + (int)((DBL >> (n)) & 1u)))
#define NT 512
#define DYN_LDS 81920
#define T_TOT 33792
#define T_P 32768
#define LOG2_THETA 18.931568569324174f

#define O_Y 0
#define O_SWAK_P 34603008
#define O_SWAV_P 34734080
#define O_SSMRE_P 34865152
#define O_SSMIM_P 34881536
#define O_POOL_P 34897920
#define O_CKV_P 34959360
#define O_KPE_P 43347968
#define O_SWAK_S 44396544
#define O_SWAV_S 44920832
#define O_SSMRE_S 45445120
#define O_SSMIM_S 45510656
#define O_POOL_S 45576192
#define O_CKV_S 45821952
#define O_KPE_S 46084096

constexpr size_t OFF_PROJ = 0;
constexpr size_t OFF_TAB = OFF_PROJ + 88670208ull;
constexpr size_t OFF_MIX = OFF_TAB + 67108864ull;
constexpr size_t OFF_QBUF = OFF_MIX + 69206016ull;
constexpr size_t OFF_QMLA = OFF_QBUF + 69206016ull;
constexpr size_t OFF_Z = OFF_QMLA + 51904512ull;
constexpr size_t OFF_M = OFF_Z + 34603008ull;
constexpr size_t OFF_C = OFF_M + 34603008ull;
constexpr size_t OFF_KP = OFF_C + 17301504ull;
constexpr size_t OFF_VT0 = OFF_KP + 2162688ull;
constexpr size_t OFF_KALL = OFF_VT0 + 8388608ull;
constexpr size_t OFF_VTALL = OFF_KALL + 1327104ull;
constexpr size_t OFF_KPS = OFF_VTALL + 1572864ull;
constexpr size_t OFF_WT = OFF_KPS + 4325376ull;
constexpr size_t WS_NEED = OFF_WT + 16187392ull;
constexpr size_t OFF_KUPS = OFF_PROJ;
constexpr size_t OFF_VTS = OFF_PROJ + 69206016ull;
constexpr size_t WT_IN_E = 0;
constexpr size_t WT_OUT_E = WT_IN_E + 1310720;
constexpr size_t WT_GLU = WT_OUT_E + 1048576;
constexpr size_t WT_IN_O = WT_GLU + 262144;
constexpr size_t WT_OUT_O = WT_IN_O + 1343488;
constexpr size_t WT_POOL = WT_OUT_O + 1048576;
constexpr size_t WT_UQ = WT_POOL + 65536;
constexpr size_t WT_UK = WT_UQ + 393216;
constexpr size_t WT_UV = WT_UK + 131072;
constexpr size_t WT_PQ = WT_UV + 131072;
constexpr size_t WT_KEYS = WT_PQ + 2097152;

struct Params {
  const float* in[38];
  float* out;
  unsigned char* ws;
};

typedef __bf16 bf16x2_t __attribute__((ext_vector_type(2)));
typedef float float2_t __attribute__((ext_vector_type(2)));
__device__ __forceinline__ unsigned pack2(float a, float b) {
  float2_t f = {a, b};
  bf16x2_t h = __builtin_convertvector(f, bf16x2_t);
  return __builtin_bit_cast(unsigned, h);
}
__device__ __forceinline__ unsigned short f2bf(float f) { return (unsigned short)(pack2(f, 0.f) & 0xffffu); }
__device__ __forceinline__ float bf2f(unsigned short b) { return __uint_as_float(((unsigned)b) << 16); }
__device__ __forceinline__ float lo2f(unsigned u) { return __uint_as_float(u << 16); }
__device__ __forceinline__ float hi2f(unsigned u) { return __uint_as_float(u & 0xffff0000u); }
__device__ __forceinline__ void unpack8(uint4 v, float* x) {
  x[0] = lo2f(v.x); x[1] = hi2f(v.x); x[2] = lo2f(v.y); x[3] = hi2f(v.y);
  x[4] = lo2f(v.z); x[5] = hi2f(v.z); x[6] = lo2f(v.w); x[7] = hi2f(v.w);
}
__device__ __forceinline__ uint4 pack8(const float* x) {
  uint4 v; v.x = pack2(x[0], x[1]); v.y = pack2(x[2], x[3]); v.z = pack2(x[4], x[5]); v.w = pack2(x[6], x[7]); return v;
}
template <int CTRL> __device__ __forceinline__ float dpp_f(float v) {
  return __int_as_float(__builtin_amdgcn_update_dpp(0, __float_as_int(v), CTRL, 0xf, 0xf, true));
}
__device__ __forceinline__ float row16_max(float v) {
  v = fmaxf(v, dpp_f<0xB1>(v)); v = fmaxf(v, dpp_f<0x4E>(v)); v = fmaxf(v, dpp_f<0x141>(v)); v = fmaxf(v, dpp_f<0x140>(v)); return v;
}
__device__ __forceinline__ float row16_sum(float v) {
  v += dpp_f<0xB1>(v); v += dpp_f<0x4E>(v); v += dpp_f<0x141>(v); v += dpp_f<0x140>(v); return v;
}
__device__ __forceinline__ float wave_sum(float v) {
  v = row16_sum(v);
  const float a = __int_as_float(__builtin_amdgcn_readlane(__float_as_int(v), 0));
  const float b = __int_as_float(__builtin_amdgcn_readlane(__float_as_int(v), 16));
  const float c = __int_as_float(__builtin_amdgcn_readlane(__float_as_int(v), 32));
  const float d = __int_as_float(__builtin_amdgcn_readlane(__float_as_int(v), 48));
  return (a + b) + (c + d);
}
__device__ __forceinline__ void sincos_rev(float ang, float& s, float& c) {
  float rev = ang * 0.15915494309189535f;
  rev = rev - floorf(rev);
  s = __builtin_amdgcn_sinf(rev);
  c = __builtin_amdgcn_cosf(rev);
}
__device__ __forceinline__ float gelu_tanh(float x) {
  float y = 0.7978845608028654f * (x + 0.044715f * x * x * x);
  float t = 1.f - 2.f / (1.f + __expf(2.f * y));
  return 0.5f * x * (1.f + t);
}
__device__ __forceinline__ float gelu_erf(float x) { return 0.5f * x * (1.f + erff(x * 0.7071067811865476f)); }
__device__ __forceinline__ int logical_bid() {
  const int G = (int)gridDim.x, b = (int)blockIdx.x;
  return ((G & 7) == 0) ? ((b & 7) * (G >> 3) + (b >> 3)) : b;
}
__device__ __forceinline__ int rot_start(int vbase) {
  int G = (int)gridDim.x;
  int s = (logical_bid() - vbase) % G;
  if (s < 0) s += G;
  return s;
}

__device__ __forceinline__ void transpose_convert(int tid, unsigned char* smem, const float* __restrict__ src, bf16_t* __restrict__ dst, int K, int N, int& vbase) {
  float* tl = (float*)smem;
  const int tk = K / 64, tn = (N + 63) / 64;
  const int ntiles = tk * tn;
  for (int tile = rot_start(vbase); tile < ntiles; tile += gridDim.x) {
    const int k0 = (tile / tn) * 64, n0 = (tile % tn) * 64;
    __syncthreads();
#pragma unroll
    for (int i = 0; i < 2; ++i) {
      int r = (tid >> 4) + 32 * i, c4 = (tid & 15) * 4;
      float4 v = make_float4(0.f, 0.f, 0.f, 0.f);
      if (n0 + c4 < N) v = *(const float4*)(src + (size_t)(k0 + r) * N + n0 + c4);
      tl[r * 65 + c4 + 0] = v.x; tl[r * 65 + c4 + 1] = v.y; tl[r * 65 + c4 + 2] = v.z; tl[r * 65 + c4 + 3] = v.w;
    }
    __syncthreads();
    int n = tid >> 3, k8 = (tid & 7) * 8;
    if (n0 + n < N) {
      float x[8];
#pragma unroll
      for (int j = 0; j < 8; ++j) x[j] = tl[(k8 + j) * 65 + n];
      *(uint4*)(dst + (size_t)(n0 + n) * K + k0 + k8) = pack8(x);
    }
  }
  vbase += ntiles;
}

__device__ __forceinline__ void convert_plain(int tid, const float* __restrict__ src, bf16_t* __restrict__ dst, size_t n) {
  size_t i = ((size_t)blockIdx.x * NT + tid) * 8;
  const size_t stride = (size_t)gridDim.x * NT * 8;
  for (; i < n; i += stride) {
    float4 a = *(const float4*)(src + i), b = *(const float4*)(src + i + 4);
    uint4 v; v.x = pack2(a.x, a.y); v.y = pack2(a.z, a.w); v.z = pack2(b.x, b.y); v.w = pack2(b.z, b.w);
    *(uint4*)(dst + i) = v;
  }
}

template <int V> struct IC { static constexpr int value = V; };
template <int AMODE, class Epi>
__device__ __forceinline__ void gemm_run(int tid, unsigned char* smem, const void* A, const void* A2, int splitRow, int lda,
                                         const float* __restrict__ gain, const bf16_t* __restrict__ Bt,
                                         int M, int N, int K, int& vbase, Epi epi) {
  bf16_t* sA0 = (bf16_t*)smem;
  bf16_t* sB0 = sA0 + 128 * 72;
  bf16_t* sA1 = sB0 + 128 * 72;
  bf16_t* sB1 = sA1 + 128 * 72;
  float* sR = (float*)(sB1 + 128 * 72);
  float* sG = sR + 128;
  if (AMODE == 2) {
    __syncthreads();
    sG[tid] = gain[tid]; sG[tid + 512] = gain[tid + 512];
    __syncthreads();
  }
  const int lane = tid & 63, w = tid >> 6;
  const int l16 = lane & 15, quad = lane >> 4;
  const int wm = w >> 1, wn = w & 1;
  const int tilesN = (N + 127) / 128, tilesM = M / 128;
  const int ntiles = tilesM * tilesN;
  const int arow = tid >> 2, q4 = tid & 3;
  const int nk = K / 64;
  for (int tile = rot_start(vbase); tile < ntiles; tile += gridDim.x) {
    const int tm = tile / tilesN, tn = tile % tilesN;
    const int m0 = tm * 128, n0 = tn * 128;
    const int grow = m0 + arow;
    const unsigned char* aptr;
    if (AMODE == 0) aptr = (grow < splitRow) ? (const unsigned char*)A + (size_t)grow * lda * 2 : (const unsigned char*)A2 + (size_t)(grow - splitRow) * lda * 2;
    else aptr = (grow < splitRow) ? (const unsigned char*)A + (size_t)grow * lda * 4 : (const unsigned char*)A2 + (size_t)(grow - splitRow) * lda * 4;
    const bool bvalid = (n0 + arow) < N;
    const bf16_t* bptr = Bt + (size_t)(n0 + arow) * K + q4 * 8;
    f32x4 acc[2][4];
#pragma unroll
    for (int i = 0; i < 2; ++i)
#pragma unroll
      for (int j = 0; j < 4; ++j) acc[i][j] = (f32x4){0.f, 0.f, 0.f, 0.f};
    float ss = 0.f;
    float4 af0[4], af1[4];
    uint4 ab0_0, ab0_1, ab1_0, ab1_1;
    uint4 bb0_0, bb0_1, bb1_0, bb1_1;
#define GLOAD(AF, AB, BB, KT) { \
      const int k0_ = (KT) * 64; \
      if (AMODE == 0) { AB##_0 = *(const uint4*)(aptr + (size_t)(k0_ + q4 * 8) * 2); AB##_1 = *(const uint4*)(aptr + (size_t)(k0_ + 32 + q4 * 8) * 2); } \
      else { \
        _Pragma("unroll") for (int i = 0; i < 4; ++i) AF[i] = *(const float4*)(aptr + (size_t)(k0_ + 16 * i + q4 * 4) * 4); \
      } \
      if (bvalid) { BB##_0 = *(const uint4*)(bptr + k0_); BB##_1 = *(const uint4*)(bptr + k0_ + 32); } \
      else { BB##_0 = make_uint4(0, 0, 0, 0); BB##_1 = BB##_0; } }
#define LSTORE(AF, AB, BB, KT, sA, sB) { \
      if (AMODE == 0) { \
        *(uint4*)(sA + arow * 72 + q4 * 8) = AB##_0; \
        *(uint4*)(sA + arow * 72 + 32 + q4 * 8) = AB##_1; \
      } else { \
        if (AMODE == 2) { \
          const float* gp = sG + (KT) * 64 + q4 * 4; \
          _Pragma("unroll") for (int i = 0; i < 4; ++i) { \
            float4 g = *(const float4*)(gp + 16 * i); \
            ss += AF[i].x * AF[i].x + AF[i].y * AF[i].y + AF[i].z * AF[i].z + AF[i].w * AF[i].w; \
            AF[i].x *= g.x; AF[i].y *= g.y; AF[i].z *= g.z; AF[i].w *= g.w; \
          } \
        } \
        *(uint2*)(sA + arow * 72 + q4 * 4) = make_uint2(pack2(AF[0].x, AF[0].y), pack2(AF[0].z, AF[0].w)); \
        *(uint2*)(sA + arow * 72 + 16 + q4 * 4) = make_uint2(pack2(AF[1].x, AF[1].y), pack2(AF[1].z, AF[1].w)); \
        *(uint2*)(sA + arow * 72 + 32 + q4 * 4) = make_uint2(pack2(AF[2].x, AF[2].y), pack2(AF[2].z, AF[2].w)); \
        *(uint2*)(sA + arow * 72 + 48 + q4 * 4) = make_uint2(pack2(AF[3].x, AF[3].y), pack2(AF[3].z, AF[3].w)); \
      } \
      *(uint4*)(sB + arow * 72 + q4 * 8) = BB##_0; \
      *(uint4*)(sB + arow * 72 + 32 + q4 * 8) = BB##_1; }
#define GCOMPUTE(sA, sB) { \
      _Pragma("unroll") for (int ks = 0; ks < 2; ++ks) { \
        bf16x8 a[2], b[4]; \
        _Pragma("unroll") for (int i = 0; i < 2; ++i) a[i] = *(const bf16x8*)(sA + (wm * 32 + i * 16 + l16) * 72 + ks * 32 + quad * 8); \
        _Pragma("unroll") for (int j = 0; j < 4; ++j) b[j] = *(const bf16x8*)(sB + (wn * 64 + j * 16 + l16) * 72 + ks * 32 + quad * 8); \
        _Pragma("unroll") for (int i = 0; i < 2; ++i) \
          _Pragma("unroll") for (int j = 0; j < 4; ++j) acc[i][j] = __builtin_amdgcn_mfma_f32_16x16x32_bf16(a[i], b[j], acc[i][j], 0, 0, 0); \
      } }
    __syncthreads();
    GLOAD(af0, ab0, bb0, 0);
    GLOAD(af1, ab1, bb1, 1);
    LSTORE(af0, ab0, bb0, 0, sA0, sB0);
    if (2 < nk) GLOAD(af0, ab0, bb0, 2);
    for (int kt = 0; kt < nk; kt += 2) {
      __syncthreads();
      LSTORE(af1, ab1, bb1, kt + 1, sA1, sB1);
      if (kt + 3 < nk) GLOAD(af1, ab1, bb1, kt + 3);
      GCOMPUTE(sA0, sB0);
      __syncthreads();
      if (kt + 2 < nk) {
        LSTORE(af0, ab0, bb0, kt + 2, sA0, sB0);
        if (kt + 4 < nk) GLOAD(af0, ab0, bb0, kt + 4);
      }
      GCOMPUTE(sA1, sB1);
    }
    if (AMODE == 2) {
      ss += __shfl_xor(ss, 1);
      ss += __shfl_xor(ss, 2);
      if ((tid & 3) == 0) sR[arow] = rsqrtf(ss / (float)K + 1e-6f);
      __syncthreads();
    }
    if (Epi::CHUNK) {
      float* sC = (float*)smem;
      __syncthreads();
#pragma unroll
      for (int i = 0; i < 2; ++i)
#pragma unroll
        for (int r = 0; r < 4; ++r) {
          const int rl = wm * 32 + i * 16 + quad * 4 + r;
          const float rs = (AMODE == 2) ? sR[rl] : 1.f;
#pragma unroll
          for (int j = 0; j < 4; ++j) sC[rl * 132 + wn * 64 + j * 16 + l16] = acc[i][j][r] * rs;
        }
      __syncthreads();
      if (Epi::CHUNK == 1) {
#pragma unroll
        for (int it = 0; it < 4; ++it) {
          const int chunk = tid + it * 512;
          const int row = chunk >> 4, c8 = (chunk & 15) * 8;
          if (n0 + c8 < N) {
            const float4 v0 = *(const float4*)(sC + row * 132 + c8), v1 = *(const float4*)(sC + row * 132 + c8 + 4);
            const float v[8] = {v0.x, v0.y, v0.z, v0.w, v1.x, v1.y, v1.z, v1.w};
            epi.chunk(m0 + row, n0 + c8, v);
          }
        }
      } else {
#pragma unroll
        for (int it = 0; it < 4; ++it) {
          const int chunk = tid + it * 512;
          const int col = chunk & 127, r8 = (chunk >> 7) * 8;
          if (n0 + col < N) {
            float v[8];
#pragma unroll
            for (int i = 0; i < 8; ++i) v[i] = sC[(r8 + i) * 132 + col];
            epi.chunk(m0 + r8, n0 + col, v);
          }
        }
      }
    } else {
#pragma unroll
    for (int i = 0; i < 2; ++i)
#pragma unroll
      for (int r = 0; r < 4; ++r) {
        const int rl = wm * 32 + i * 16 + quad * 4 + r;
        const float rs = (AMODE == 2) ? sR[rl] : 1.f;
#pragma unroll
        for (int j = 0; j < 4; ++j) {
          const int col = n0 + wn * 64 + j * 16 + l16;
          if (col < N) epi(m0 + rl, col, acc[i][j][r] * rs);
        }
      }
    }
  }
  vbase += ntiles;
}

struct AttnDesc {
  const bf16_t* q; int ldq; int active; int kt_lo, kt_hi; bf16_t* out; int ldo; float m0, l0; int pos0;
  const bf16_t* k; int ldk; const bf16_t* kx; const bf16_t* vt; int ldv; int vts; int nkeys; int bt_lo, bt_hi; float scale;
};

template <int DQK>
__device__ __forceinline__ void attn_item(int tid, unsigned char* smem, const AttnDesc& d) {
  constexpr int LDK = DQK + 8;
  bf16_t* sK = (bf16_t*)smem;
  bf16_t* sVt = sK + 64 * 104;
  bf16_t* sP = sVt + 64 * 72;
  const int lane = tid & 63, w = tid >> 6;
  const int l16 = lane & 15, quad = lane >> 4;
  bf16_t* sPw = sP + w * 16 * 72;
  bf16x8 qf[DQK / 32];
  if (d.active) {
#pragma unroll
    for (int ks = 0; ks < DQK / 32; ++ks) {
      const bf16_t* qp = d.q + (size_t)l16 * d.ldq + ks * 32 + quad * 8;
      uint4 v = *(const uint4*)qp;
      if (DQK == 96 && ks == 2) {
        const int pq = (quad < 2) ? 16 : -16;
        uint4 pv = *(const uint4*)(qp + pq);
        float x[8], y[8];
        unpack8(v, x); unpack8(pv, y);
        const float pos = (float)(d.pos0 + l16);
#pragma unroll
        for (int j = 0; j < 8; ++j) {
          const int f = (quad & 1) * 8 + j;
          float inv = exp2f(-(float)f * (LOG2_THETA / 16.f));
          float sn, cs; sincos_rev(pos * inv, sn, cs);
          x[j] = (quad < 2) ? (x[j] * cs - y[j] * sn) : (x[j] * cs + y[j] * sn);
        }
        v = pack8(x);
      }
      qf[ks] = *(bf16x8*)&v;
    }
  }
  f32x4 o[4];
#pragma unroll
  for (int i = 0; i < 4; ++i) o[i] = (f32x4){0.f, 0.f, 0.f, 0.f};
  float m[4], l[4];
#pragma unroll
  for (int r = 0; r < 4; ++r) { m[r] = d.m0; l[r] = d.l0; }

  const int key = tid >> 3, seg = tid & 7;
  const int key2 = (tid >> 2) & 63, seg2 = tid & 3;
  uint4 kv_r = make_uint4(0, 0, 0, 0), vv_r = kv_r, xv_r = kv_r;
  if (d.bt_lo < d.bt_hi) {
    kv_r = *(const uint4*)(d.k + (size_t)(d.bt_lo * 64 + key) * d.ldk + seg * 8);
    vv_r = *(const uint4*)(d.vt + (size_t)d.bt_lo * d.vts + (size_t)key * d.ldv + seg * 8);
    if (DQK == 96 && tid < 256) xv_r = *(const uint4*)(d.kx + (size_t)(d.bt_lo * 64 + key2) * 32 + seg2 * 8);
  }
  for (int kt = d.bt_lo; kt < d.bt_hi; ++kt) {
    __syncthreads();
    *(uint4*)(sK + key * LDK + seg * 8) = kv_r;
    *(uint4*)(sVt + key * 72 + seg * 8) = vv_r;
    if (DQK == 96 && tid < 256) *(uint4*)(sK + key2 * LDK + 64 + seg2 * 8) = xv_r;
    __syncthreads();
    if (kt + 1 < d.bt_hi) {
      kv_r = *(const uint4*)(d.k + (size_t)((kt + 1) * 64 + key) * d.ldk + seg * 8);
      vv_r = *(const uint4*)(d.vt + (size_t)(kt + 1) * d.vts + (size_t)key * d.ldv + seg * 8);
      if (DQK == 96 && tid < 256) xv_r = *(const uint4*)(d.kx + (size_t)((kt + 1) * 64 + key2) * 32 + seg2 * 8);
    }
    if (d.active && kt >= d.kt_lo && kt < d.kt_hi) {
      f32x4 s[4];
#pragma unroll
      for (int i = 0; i < 4; ++i) s[i] = (f32x4){0.f, 0.f, 0.f, 0.f};
#pragma unroll
      for (int ks = 0; ks < DQK / 32; ++ks)
#pragma unroll
        for (int nt = 0; nt < 4; ++nt) {
          bf16x8 b = *(const bf16x8*)(sK + (nt * 16 + l16) * LDK + ks * 32 + quad * 8);
          s[nt] = __builtin_amdgcn_mfma_f32_16x16x32_bf16(qf[ks], b, s[nt], 0, 0, 0);
        }
#pragma unroll
      for (int nt = 0; nt < 4; ++nt) {
        const bool valid = (kt * 64 + nt * 16 + l16) < d.nkeys;
#pragma unroll
        for (int r = 0; r < 4; ++r) s[nt][r] = valid ? s[nt][r] * d.scale : -1e30f;
      }
#pragma unroll
      for (int r = 0; r < 4; ++r) {
        float mx = fmaxf(fmaxf(s[0][r], s[1][r]), fmaxf(s[2][r], s[3][r]));
        mx = row16_max(mx);
        const float mnew = fmaxf(m[r], mx);
        const float alpha = __expf(m[r] - mnew);
        float p0 = __expf(s[0][r] - mnew), p1 = __expf(s[1][r] - mnew), p2 = __expf(s[2][r] - mnew), p3 = __expf(s[3][r] - mnew);
        float rs = p0 + p1 + p2 + p3;
        rs = row16_sum(rs);
        l[r] = l[r] * alpha + rs;
        m[r] = mnew;
#pragma unroll
        for (int dt = 0; dt < 4; ++dt) o[dt][r] *= alpha;
        bf16_t* pr = sPw + (quad * 4 + r) * 72 + l16;
        pr[0] = f2bf(p0); pr[16] = f2bf(p1); pr[32] = f2bf(p2); pr[48] = f2bf(p3);
      }
      asm volatile("s_waitcnt lgkmcnt(0)" ::: "memory");
#pragma unroll
      for (int ks = 0; ks < 2; ++ks) {
        bf16x8 a = *(const bf16x8*)(sPw + l16 * 72 + ks * 32 + quad * 8);
#pragma unroll
        for (int dt = 0; dt < 4; ++dt) {
          bf16x8 b = *(const bf16x8*)(sVt + (dt * 16 + l16) * 72 + ks * 32 + quad * 8);
          o[dt] = __builtin_amdgcn_mfma_f32_16x16x32_bf16(a, b, o[dt], 0, 0, 0);
        }
      }
      asm volatile("s_waitcnt lgkmcnt(0)" ::: "memory");
    }
  }
  if (d.active) {
#pragma unroll
    for (int r = 0; r < 4; ++r) {
      const float il = 1.f / l[r];
#pragma unroll
      for (int dt = 0; dt < 4; ++dt) d.out[(size_t)(quad * 4 + r) * d.ldo + dt * 16 + l16] = f2bf(o[dt][r] * il);
    }
  }
}

template <int MODE>
__device__ __forceinline__ void s5_item(int tid, float* sUw, const Params& p, int item) {
  const int lane = tid & 63;
  const bf16_t* proj = (const bf16_t*)(p.ws + OFF_PROJ);
  int b, chunk, g, tok0; bool isS;
  if (item < 32768) { isS = false; g = item & 31; chunk = (item >> 5) & 127; b = item >> 12; tok0 = b * 4096 + chunk * 32; }
  else { isS = true; int it = item - 32768; g = it & 31; b = it >> 5; chunk = 0; tok0 = T_P + b * 32; }
  const int n = lane;
  const int gn = g * 64 + n;
  const float lr = fminf(p.in[15][gn], -1e-4f), li = p.in[16][gn];
  const float dt = __expf(p.in[17][g]);
  const float mag = __expf(lr * dt);
  float sn, cs; sincos_rev(li * dt, sn, cs);
  const float abr = mag * cs, abi = mag * sn;
  const float den = lr * lr + li * li;
  const float nr = abr - 1.f, ni = abi;
  const float fre = (nr * lr + ni * li) / den, fim = (ni * lr - nr * li) / den;
  float2_t bb2[16];
  {
    const float4* br4 = (const float4*)(p.in[18] + (size_t)gn * 16);
    const float4* bi4 = (const float4*)(p.in[19] + (size_t)gn * 16);
#pragma unroll
    for (int i = 0; i < 4; ++i) {
      float4 r4 = br4[i], i4 = bi4[i];
      bb2[4 * i + 0] = (float2_t){fre * r4.x - fim * i4.x, fre * i4.x + fim * r4.x};
      bb2[4 * i + 1] = (float2_t){fre * r4.y - fim * i4.y, fre * i4.y + fim * r4.y};
      bb2[4 * i + 2] = (float2_t){fre * r4.z - fim * i4.z, fre * i4.z + fim * r4.z};
      bb2[4 * i + 3] = (float2_t){fre * r4.w - fim * i4.w, fre * i4.w + fim * r4.w};
    }
  }
  {
    const int t = lane >> 1, c8 = (lane & 1) * 8;
    uint4 uv = *(const uint4*)(proj + (size_t)(tok0 + t) * 1280 + 768 + g * 16 + c8);
    float x[8]; unpack8(uv, x);
    *(float4*)(sUw + t * 16 + c8) = make_float4(x[0], x[1], x[2], x[3]);
    *(float4*)(sUw + t * 16 + c8 + 4) = make_float4(x[4], x[5], x[6], x[7]);
  }
  asm volatile("s_waitcnt lgkmcnt(0)" ::: "memory");
  float hr = 0.f, hi = 0.f;
  if (MODE == 0) {
#pragma unroll 4
    for (int t = 0; t < 32; ++t) {
      float uu[16];
#pragma unroll
      for (int i = 0; i < 4; ++i) { float4 v = *(const float4*)(sUw + t * 16 + 4 * i); uu[4 * i] = v.x; uu[4 * i + 1] = v.y; uu[4 * i + 2] = v.z; uu[4 * i + 3] = v.w; }
      float2_t bu2 = {0.f, 0.f};
#pragma unroll
      for (int c = 0; c < 16; ++c) bu2 += bb2[c] * (float2_t){uu[c], uu[c]};
      const float nhr = abr * hr - abi * hi + bu2.x, nhi = abr * hi + abi * hr + bu2.y;
      hr = nhr; hi = nhi;
    }
    float* s1re = (float*)(p.ws + OFF_QMLA);
    float* s1im = s1re + 2097152;
    const size_t idx = ((size_t)(b * 128 + chunk) * 32 + g) * 64 + n;
    s1re[idx] = hr; s1im[idx] = hi;
    asm volatile("s_waitcnt lgkmcnt(0)" ::: "memory");
    return;
  } else {
    float2_t cr2[8], ci2[8];
#pragma unroll
    for (int c = 0; c < 8; ++c) {
      cr2[c] = (float2_t){p.in[20][(size_t)(g * 16 + 2 * c) * 64 + n], p.in[20][(size_t)(g * 16 + 2 * c + 1) * 64 + n]};
      ci2[c] = (float2_t){p.in[21][(size_t)(g * 16 + 2 * c) * 64 + n], p.in[21][(size_t)(g * 16 + 2 * c + 1) * 64 + n]};
    }
    if (isS) { hr = p.in[4][(size_t)(b * 32 + g) * 64 + n]; hi = p.in[5][(size_t)(b * 32 + g) * 64 + n]; }
    else {
      const float* hinre = (const float*)(p.ws + OFF_QMLA) + 2 * 2097152;
      const float* hinim = hinre + 2097152;
      const size_t idx = ((size_t)(b * 128 + chunk) * 32 + g) * 64 + n;
      hr = hinre[idx]; hi = hinim[idx];
    }
    const int b0 = lane & 1, b1 = (lane >> 1) & 1, b2 = (lane >> 2) & 1, b3 = (lane >> 3) & 1;
    const int cc = b0 * 8 + b1 * 4 + b2 * 2 + b3;
    const int quad = lane >> 4;
    const float dsk = p.in[22][g * 16 + cc];
    bf16_t* zbuf = (bf16_t*)(p.ws + OFF_Z);
    float zkeep = 0.f;
#pragma unroll 2
    for (int t = 0; t < 32; ++t) {
      float uu[16];
#pragma unroll
      for (int i = 0; i < 4; ++i) { float4 v = *(const float4*)(sUw + t * 16 + 4 * i); uu[4 * i] = v.x; uu[4 * i + 1] = v.y; uu[4 * i + 2] = v.z; uu[4 * i + 3] = v.w; }
      float2_t bu2 = {0.f, 0.f};
#pragma unroll
      for (int c = 0; c < 16; ++c) bu2 += bb2[c] * (float2_t){uu[c], uu[c]};
      const float nhr = abr * hr - abi * hi + bu2.x, nhi = abr * hi + abi * hr + bu2.y;
      hr = nhr; hi = nhi;
      float v16[16];
#pragma unroll
      for (int c = 0; c < 8; ++c) {
        const float2_t vv = cr2[c] * (float2_t){hr, hr} - ci2[c] * (float2_t){hi, hi};
        v16[2 * c] = vv.x; v16[2 * c + 1] = vv.y;
      }
      float v8[8], v4[4], v2[2], v1;
#pragma unroll
      for (int i = 0; i < 8; ++i) { float keep = b0 ? v16[8 + i] : v16[i]; float send = b0 ? v16[i] : v16[8 + i]; v8[i] = keep + __shfl_xor(send, 1); }
#pragma unroll
      for (int i = 0; i < 4; ++i) { float keep = b1 ? v8[4 + i] : v8[i]; float send = b1 ? v8[i] : v8[4 + i]; v4[i] = keep + __shfl_xor(send, 2); }
#pragma unroll
      for (int i = 0; i < 2; ++i) { float keep = b2 ? v4[2 + i] : v4[i]; float send = b2 ? v4[i] : v4[2 + i]; v2[i] = keep + __shfl_xor(send, 4); }
      { float keep = b3 ? v2[1] : v2[0]; float send = b3 ? v2[0] : v2[1]; v1 = keep + __shfl_xor(send, 8); }
      v1 += __shfl_xor(v1, 16);
      v1 += __shfl_xor(v1, 32);
      const float y = v1 + dsk * sUw[t * 16 + cc];
      const float z = gelu_tanh(y);
      if (quad == (t & 3)) zkeep = z;
      if ((t & 3) == 3) zbuf[(size_t)(tok0 + t - 3 + quad) * 512 + g * 16 + cc] = f2bf(zkeep);
    }
    if (isS) {
      p.out[O_SSMRE_S + (size_t)(b * 32 + g) * 64 + n] = hr;
      p.out[O_SSMIM_S + (size_t)(b * 32 + g) * 64 + n] = hi;
    }
    asm volatile("s_waitcnt lgkmcnt(0)" ::: "memory");
  }
}

#define TAB_V_OFF 16777216ull
#define TAB_SU_OFF 33554432ull
#define TAB_SV_OFF (33554432ull + 65536ull)
__device__ __forceinline__ void quant_rows(const float* __restrict__ src, unsigned char* __restrict__ dst, float* __restrict__ scales, int gw, int nw, int tid) {
  const int lane = tid & 63;
  for (int row = gw; row < 16384; row += nw) {
    const float* r = src + (size_t)row * 1024 + lane * 16;
    float x[16];
#pragma unroll
    for (int i = 0; i < 4; ++i) { float4 v = *(const float4*)(r + 4 * i); x[4 * i] = v.x; x[4 * i + 1] = v.y; x[4 * i + 2] = v.z; x[4 * i + 3] = v.w; }
    float am = 0.f;
#pragma unroll
    for (int i = 0; i < 16; ++i) am = fmaxf(am, fabsf(x[i]));
#pragma unroll
    for (int o = 32; o; o >>= 1) am = fmaxf(am, __shfl_xor(am, o));
    const float inv = (am > 0.f) ? 127.f / am : 0.f;
    unsigned q[4];
#pragma unroll
    for (int i = 0; i < 4; ++i) {
      unsigned b0 = (unsigned)((int)rintf(x[4 * i] * inv)) & 255u, b1 = (unsigned)((int)rintf(x[4 * i + 1] * inv)) & 255u;
      unsigned b2 = (unsigned)((int)rintf(x[4 * i + 2] * inv)) & 255u, b3 = (unsigned)((int)rintf(x[4 * i + 3] * inv)) & 255u;
      q[i] = b0 | (b1 << 8) | (b2 << 16) | (b3 << 24);
    }
    *(uint4*)(dst + (size_t)(lane >> 3) * 2097152 + (size_t)row * 128 + (lane & 7) * 16) = make_uint4(q[0], q[1], q[2], q[3]);
    if (lane == 0) scales[row] = am * (1.f / 127.f);
  }
}

__device__ __forceinline__ float ub0(unsigned u) { return (float)(u & 0xffu); }
__device__ __forceinline__ float ub1(unsigned u) { return (float)((u >> 8) & 0xffu); }
__device__ __forceinline__ float ub2(unsigned u) { return (float)((u >> 16) & 0xffu); }
__device__ __forceinline__ float ub3(unsigned u) { return (float)(u >> 24); }
__device__ __forceinline__ float dot16(const float* xn, uint4 u) {
  float d = 0.f;
  d += xn[0] * ub0(u.x); d += xn[1] * ub1(u.x); d += xn[2] * ub2(u.x); d += xn[3] * ub3(u.x);
  d += xn[4] * ub0(u.y); d += xn[5] * ub1(u.y); d += xn[6] * ub2(u.y); d += xn[7] * ub3(u.y);
  d += xn[8] * ub0(u.z); d += xn[9] * ub1(u.z); d += xn[10] * ub2(u.z); d += xn[11] * ub3(u.z);
  d += xn[12] * ub0(u.w); d += xn[13] * ub1(u.w); d += xn[14] * ub2(u.w); d += xn[15] * ub3(u.w);
  return d;
}
__device__ __forceinline__ void axpy16(float* acc, float a, uint4 u) {
  acc[0] += a * ub0(u.x); acc[1] += a * ub1(u.x); acc[2] += a * ub2(u.x); acc[3] += a * ub3(u.x);
  acc[4] += a * ub0(u.y); acc[5] += a * ub1(u.y); acc[6] += a * ub2(u.y); acc[7] += a * ub3(u.y);
  acc[8] += a * ub0(u.z); acc[9] += a * ub1(u.z); acc[10] += a * ub2(u.z); acc[11] += a * ub3(u.z);
  acc[12] += a * ub0(u.w); acc[13] += a * ub1(u.w); acc[14] += a * ub2(u.w); acc[15] += a * ub3(u.w);
}

template <bool FINAL, bool DRY>
__device__ __forceinline__ void peer_token(int tid, const Params& p, int layer, int tok) {
  const int lane = tid & 63;
  float* xres = p.out + O_Y;
  const float* gain = p.in[10] + layer * 1024;
  const unsigned char* U = p.ws + OFF_TAB;
  const unsigned char* V = U + TAB_V_OFF;
  const int* ebuf = (const int*)(p.ws + OFF_M);
  const float* gbuf = (const float*)(p.ws + OFF_M + 17301504ull);
  const float* sus = (const float*)(p.ws + OFF_TAB + TAB_SU_OFF);
  const float* svs = (const float*)(p.ws + OFF_TAB + TAB_SV_OFF);
  float* xr = xres + (size_t)tok * 1024 + lane * 16;
  float x[16], xn[16], acc[16];
  float ss = 0.f, sx = 0.f;
#pragma unroll
  for (int i = 0; i < 4; ++i) {
    float4 v = *(const float4*)(xr + 4 * i);
    float4 g = *(const float4*)(gain + lane * 16 + 4 * i);
    x[4 * i] = v.x; x[4 * i + 1] = v.y; x[4 * i + 2] = v.z; x[4 * i + 3] = v.w;
    xn[4 * i] = v.x * g.x; xn[4 * i + 1] = v.y * g.y; xn[4 * i + 2] = v.z * g.z; xn[4 * i + 3] = v.w * g.w;
    ss += v.x * v.x + v.y * v.y + v.z * v.z + v.w * v.w;
    sx += xn[4 * i] + xn[4 * i + 1] + xn[4 * i + 2] + xn[4 * i + 3];
  }
  ss = wave_sum(ss);
  sx = wave_sum(sx);
  const float rstd = rsqrtf(ss * (1.f / 1024.f) + 1e-6f);
#pragma unroll
  for (int i = 0; i < 16; ++i) acc[i] = 0.f;
  float sumA = 0.f;
  const int b0 = lane & 1, b1 = (lane >> 1) & 1, b2 = (lane >> 2) & 1;
  const int pe = b0 * 4 + b1 * 2 + b2;
  const size_t pbase = (size_t)tok * 128 + pe;
#pragma unroll 1
  for (int kb = 0; kb < 16; ++kb) {
    const int myeid = ebuf[pbase + kb * 8];
    const float myg = gbuf[pbase + kb * 8] * svs[myeid];
    const float mysu = sus[myeid];
    uint4 uu[8], vv[8];
#pragma unroll
    for (int j = 0; j < 8; ++j) {
      const int src = ((j & 1) << 2) | (j & 2) | ((j >> 2) & 1);
      const int eid = __builtin_amdgcn_readlane(myeid, src);
      uu[j] = *(const uint4*)(U + (size_t)eid * 1024 + lane * 16);
      vv[j] = *(const uint4*)(V + (size_t)eid * 1024 + lane * 16);
    }
    float d[8];
#pragma unroll
    for (int j = 0; j < 8; ++j) d[j] = dot16(xn, uu[j]);
    float w4[4], w2[2], w1;
#pragma unroll
    for (int i = 0; i < 4; ++i) { float keep = b0 ? d[4 + i] : d[i]; float send = b0 ? d[i] : d[4 + i]; w4[i] = keep + __shfl_xor(send, 1); }
#pragma unroll
    for (int i = 0; i < 2; ++i) { float keep = b1 ? w4[2 + i] : w4[i]; float send = b1 ? w4[i] : w4[2 + i]; w2[i] = keep + __shfl_xor(send, 2); }
    { float keep = b2 ? w2[1] : w2[0]; float send = b2 ? w2[0] : w2[1]; w1 = keep + __shfl_xor(send, 4); }
    w1 += __shfl_xor(w1, 8); w1 += __shfl_xor(w1, 16); w1 += __shfl_xor(w1, 32);
    const float dot = rstd * mysu * (w1 - 128.f * sx);
    const float a = gelu_erf(dot) * myg;
#pragma unroll
    for (int j = 0; j < 8; ++j) {
      const int src = ((j & 1) << 2) | (j & 2) | ((j >> 2) & 1);
      const float A = __int_as_float(__builtin_amdgcn_readlane(__float_as_int(a), src));
      sumA += A;
      axpy16(acc, A, vv[j]);
    }
  }
  float y[16];
#pragma unroll
  for (int i = 0; i < 16; ++i) y[i] = x[i] + acc[i] - 128.f * sumA;
  if (FINAL) {
    float s2 = 0.f;
#pragma unroll
    for (int i = 0; i < 16; ++i) s2 += y[i] * y[i];
    s2 = wave_sum(s2);
    const float r2 = rsqrtf(s2 * (1.f / 1024.f) + 1e-6f);
    const float* gf = p.in[11] + lane * 16;
#pragma unroll
    for (int i = 0; i < 4; ++i) {
      float4 g = *(const float4*)(gf + 4 * i);
      y[4 * i] *= r2 * g.x; y[4 * i + 1] *= r2 * g.y; y[4 * i + 2] *= r2 * g.z; y[4 * i + 3] *= r2 * g.w;
    }
  }
  if (DRY && ss != -1.f) return;
#pragma unroll
  for (int i = 0; i < 4; ++i) *(float4*)(xr + 4 * i) = make_float4(y[4 * i], y[4 * i + 1], y[4 * i + 2], y[4 * i + 3]);
}

#define OFF_PD OFF_MIX
#define OFF_PSS OFF_KP
#define OFF_PSX (OFF_KP + 1081344ull)
template <int CTRL> __device__ __forceinline__ int dpp_i(int v) { return __builtin_amdgcn_update_dpp(0, v, CTRL, 0xf, 0xf, true); }
__device__ __forceinline__ unsigned packq4(float a, float b, float c, float d, float inv) {
  const unsigned q0 = (unsigned)((int)rintf(a * inv)) & 255u, q1 = (unsigned)((int)rintf(b * inv)) & 255u;
  const unsigned q2 = (unsigned)((int)rintf(c * inv)) & 255u, q3 = (unsigned)((int)rintf(d * inv));
  return q0 | (q1 << 8) | (q2 << 16) | (q3 << 24);
}
__device__ __forceinline__ void peer9a_token(int tid, const Params& p, int layer, int tok, int j) {
  const int lane = tid & 63, g8 = lane >> 3, sub = lane & 7;
  const float* xr = p.out + O_Y + (size_t)tok * 1024 + j * 128 + sub * 16;
  const float* gn = p.in[10] + layer * 1024 + j * 128 + sub * 16;
  const unsigned char* U = p.ws + OFF_TAB + (size_t)j * 2097152 + sub * 16;
  const int* eb = (const int*)(p.ws + OFF_M) + (size_t)tok * 128 + g8;
  float* pd = (float*)(p.ws + OFF_PD) + ((size_t)tok * 8 + j) * 128;
  int eid[16];
#pragma unroll
  for (int k = 0; k < 16; ++k) eid[k] = eb[k * 8];
  float xs[16];
  float ss = 0.f, am = 0.f;
#pragma unroll
  for (int i = 0; i < 4; ++i) {
    float4 v = *(const float4*)(xr + 4 * i);
    float4 g = *(const float4*)(gn + 4 * i);
    xs[4 * i] = v.x * g.x; xs[4 * i + 1] = v.y * g.y; xs[4 * i + 2] = v.z * g.z; xs[4 * i + 3] = v.w * g.w;
    ss += v.x * v.x + v.y * v.y + v.z * v.z + v.w * v.w;
    am = fmaxf(fmaxf(am, fmaxf(fabsf(xs[4 * i]), fabsf(xs[4 * i + 1]))), fmaxf(fabsf(xs[4 * i + 2]), fabsf(xs[4 * i + 3])));
  }
  uint4 rows[16];
#pragma unroll
  for (int k = 0; k < 16; ++k) rows[k] = *(const uint4*)(U + (size_t)eid[k] * 128);
  am = fmaxf(am, dpp_f<0xB1>(am)); am = fmaxf(am, dpp_f<0x4E>(am)); am = fmaxf(am, dpp_f<0x141>(am));
  const float inv = (am > 0.f) ? 127.f / am : 0.f;
  const float xscale = am * (1.f / 127.f);
  int xq[4];
#pragma unroll
  for (int d = 0; d < 4; ++d) xq[d] = (int)packq4(xs[4 * d], xs[4 * d + 1], xs[4 * d + 2], xs[4 * d + 3], inv);
  int keep0 = 0, keep1 = 0;
#pragma unroll
  for (int k = 0; k < 16; ++k) {
    int D = __builtin_amdgcn_sdot4((int)rows[k].x, xq[0], 0, false);
    D = __builtin_amdgcn_sdot4((int)rows[k].y, xq[1], D, false);
    D = __builtin_amdgcn_sdot4((int)rows[k].z, xq[2], D, false);
    D = __builtin_amdgcn_sdot4((int)rows[k].w, xq[3], D, false);
    D += dpp_i<0xB1>(D); D += dpp_i<0x4E>(D); D += dpp_i<0x141>(D);
    if (k < 8) keep0 = (sub == k) ? D : keep0; else keep1 = (sub == k - 8) ? D : keep1;
  }
  pd[sub * 8 + g8] = (float)keep0 * xscale;
  pd[64 + sub * 8 + g8] = (float)keep1 * xscale;
  ss += dpp_f<0xB1>(ss); ss += dpp_f<0x4E>(ss); ss += dpp_f<0x141>(ss);
  if (lane == 0) ((float*)(p.ws + OFF_PSS))[(size_t)tok * 8 + j] = ss;
}

__device__ __forceinline__ void peer9m_token(int tid, unsigned char* smem, const Params& p, int tok) {
  const int lane = tid & 63, w = __builtin_amdgcn_readfirstlane(tid >> 6);
  unsigned char* sAq = smem + w * 128;
  const float* pd = (const float*)(p.ws + OFF_PD) + (size_t)tok * 1024;
  float* pss = (float*)(p.ws + OFF_PSS) + (size_t)tok * 8;
  const int* ebuf = (const int*)(p.ws + OFF_M) + (size_t)tok * 128;
  float* gbuf = (float*)(p.ws + OFF_M + 17301504ull) + (size_t)tok * 128;
  const float* sus = (const float*)(p.ws + OFF_TAB + TAB_SU_OFF);
  const float* svs = (const float*)(p.ws + OFF_TAB + TAB_SV_OFF);
  float ss = 0.f, d0 = 0.f, d1 = 0.f;
#pragma unroll
  for (int j = 0; j < 8; ++j) { ss += pss[j]; d0 += pd[j * 128 + lane]; d1 += pd[j * 128 + 64 + lane]; }
  const int e0 = ebuf[lane], e1 = ebuf[64 + lane];
  const float rstd = rsqrtf(ss * (1.f / 1024.f) + 1e-6f);
  const float a0 = gelu_erf(rstd * sus[e0] * d0) * gbuf[lane] * svs[e0];
  const float a1 = gelu_erf(rstd * sus[e1] * d1) * gbuf[64 + lane] * svs[e1];
  float am = row16_max(fmaxf(fabsf(a0), fabsf(a1)));
  {
    const float m0 = __int_as_float(__builtin_amdgcn_readlane(__float_as_int(am), 0)), m1 = __int_as_float(__builtin_amdgcn_readlane(__float_as_int(am), 16));
    const float m2 = __int_as_float(__builtin_amdgcn_readlane(__float_as_int(am), 32)), m3 = __int_as_float(__builtin_amdgcn_readlane(__float_as_int(am), 48));
    am = fmaxf(fmaxf(m0, m1), fmaxf(m2, m3));
  }
  const float inv = (am > 0.f) ? 127.f / am : 0.f;
  const int addr0 = (lane & 7) * 16 + (lane >> 3);
  sAq[addr0] = (unsigned char)((int)rintf(a0 * inv) & 255);
  sAq[addr0 + 8] = (unsigned char)((int)rintf(a1 * inv) & 255);
  asm volatile("s_waitcnt lgkmcnt(0)" ::: "memory");
  unsigned pk = 0u;
  if (lane < 32) pk = ((const unsigned*)sAq)[lane];
  asm volatile("s_waitcnt vmcnt(0) lgkmcnt(0)" ::: "memory");
  if (lane < 32) ((unsigned*)gbuf)[lane] = pk;
  if (lane == 0) pss[0] = am * (1.f / 127.f);
  asm volatile("s_waitcnt lgkmcnt(0)" ::: "memory");
}

__device__ __forceinline__ void peer9b_token(int tid, const Params& p, int tok, int j) {
  const int lane = tid & 63, g8 = lane >> 3, sub = lane & 7;
  float* xr = p.out + O_Y + (size_t)tok * 1024 + j * 128 + sub * 16;
  const unsigned char* V = p.ws + OFF_TAB + TAB_V_OFF + (size_t)j * 2097152 + sub * 16;
  const int* eb = (const int*)(p.ws + OFF_M) + (size_t)tok * 128 + g8;
  const uint4 apk = *(const uint4*)((const unsigned*)(p.ws + OFF_M + 17301504ull) + (size_t)tok * 128 + g8 * 4);
  const float scaleA = ((const float*)(p.ws + OFF_PSS))[(size_t)tok * 8];
  int eid[16];
#pragma unroll
  for (int k = 0; k < 16; ++k) eid[k] = eb[k * 8];
  uint4 rows[16];
#pragma unroll
  for (int k = 0; k < 16; ++k) rows[k] = *(const uint4*)(V + (size_t)eid[k] * 128);
  int acci[16];
#pragma unroll
  for (int i = 0; i < 16; ++i) acci[i] = 0;
#define P9B_DW(DWF, DW, AP, KQ) { \
    const unsigned r0 = rows[(KQ) * 4 + 0].DWF, r1 = rows[(KQ) * 4 + 1].DWF, r2 = rows[(KQ) * 4 + 2].DWF, r3 = rows[(KQ) * 4 + 3].DWF; \
    const unsigned t0 = __builtin_amdgcn_perm(r1, r0, 0x05010400u), t1 = __builtin_amdgcn_perm(r1, r0, 0x07030602u); \
    const unsigned t2 = __builtin_amdgcn_perm(r3, r2, 0x05010400u), t3 = __builtin_amdgcn_perm(r3, r2, 0x07030602u); \
    acci[(DW) * 4 + 0] = __builtin_amdgcn_sdot4((int)__builtin_amdgcn_perm(t2, t0, 0x05040100u), (int)(AP), acci[(DW) * 4 + 0], false); \
    acci[(DW) * 4 + 1] = __builtin_amdgcn_sdot4((int)__builtin_amdgcn_perm(t2, t0, 0x07060302u), (int)(AP), acci[(DW) * 4 + 1], false); \
    acci[(DW) * 4 + 2] = __builtin_amdgcn_sdot4((int)__builtin_amdgcn_perm(t3, t1, 0x05040100u), (int)(AP), acci[(DW) * 4 + 2], false); \
    acci[(DW) * 4 + 3] = __builtin_amdgcn_sdot4((int)__builtin_amdgcn_perm(t3, t1, 0x07060302u), (int)(AP), acci[(DW) * 4 + 3], false); }
#define P9B_KQ(AP, KQ) { P9B_DW(x, 0, AP, KQ) P9B_DW(y, 1, AP, KQ) P9B_DW(z, 2, AP, KQ) P9B_DW(w, 3, AP, KQ) }
  P9B_KQ(apk.x, 0) P9B_KQ(apk.y, 1) P9B_KQ(apk.z, 2) P9B_KQ(apk.w, 3)
  float acc[16];
#pragma unroll
  for (int i = 0; i < 16; ++i) acc[i] = (float)acci[i] * scaleA;
  const int b3 = (lane >> 3) & 1, b4 = (lane >> 4) & 1, b5 = (lane >> 5) & 1;
  float v8[8], v4[4], v2[2];
#pragma unroll
  for (int i = 0; i < 8; ++i) { float keep = b3 ? acc[8 + i] : acc[i]; float send = b3 ? acc[i] : acc[8 + i]; v8[i] = keep + dpp_f<0x128>(send); }
#pragma unroll
  for (int i = 0; i < 4; ++i) { float keep = b4 ? v8[4 + i] : v8[i]; float send = b4 ? v8[i] : v8[4 + i]; v4[i] = keep + __shfl_xor(send, 16); }
#pragma unroll
  for (int i = 0; i < 2; ++i) { float keep = b5 ? v4[2 + i] : v4[i]; float send = b5 ? v4[i] : v4[2 + i]; v2[i] = keep + __shfl_xor(send, 32); }
  const int c = b3 * 8 + b4 * 4 + b5 * 2;
  float2 xv = *(const float2*)(xr + c);
  xv.x += v2[0];
  xv.y += v2[1];
  *(float2*)(xr + c) = xv;
}

__device__ __forceinline__ void final_norm_token(int tid, const Params& p, int tok) {
  const int lane = tid & 63;
  float* xr = p.out + O_Y + (size_t)tok * 1024 + lane * 16;
  const float* gf = p.in[11] + lane * 16;
  float y[16]; float s2 = 0.f;
#pragma unroll
  for (int i = 0; i < 4; ++i) { float4 v = *(const float4*)(xr + 4 * i); y[4 * i] = v.x; y[4 * i + 1] = v.y; y[4 * i + 2] = v.z; y[4 * i + 3] = v.w; s2 += v.x * v.x + v.y * v.y + v.z * v.z + v.w * v.w; }
  s2 = wave_sum(s2);
  const float r2 = rsqrtf(s2 * (1.f / 1024.f) + 1e-6f);
#pragma unroll
  for (int i = 0; i < 4; ++i) {
    float4 g = *(const float4*)(gf + 4 * i);
    *(float4*)(xr + 4 * i) = make_float4(y[4 * i] * r2 * g.x, y[4 * i + 1] * r2 * g.y, y[4 * i + 2] * r2 * g.z, y[4 * i + 3] * r2 * g.w);
  }
}

__device__ __forceinline__ unsigned f2ukey(float v) { unsigned u = __float_as_uint(v); return (u & 0x80000000u) ? ~u : (u | 0x80000000u); }
__device__ __forceinline__ float ukey2f(unsigned k) { unsigned u = (k & 0x80000000u) ? (k & 0x7fffffffu) : ~k; return __uint_as_float(u); }
__device__ __forceinline__ int popc64(unsigned long long m) { return __builtin_popcountll(m); }
__device__ __forceinline__ int mbcnt64(unsigned long long m) { return (int)__builtin_amdgcn_mbcnt_hi((unsigned)(m >> 32), __builtin_amdgcn_mbcnt_lo((unsigned)m, 0u)); }

struct TopkFrags { bf16x8 a[2][2]; bf16x8 b[2][2]; };
__device__ __forceinline__ void topk_load(TopkFrags& f, int tid, const Params& p, int layer, int item) {
  const int lane = tid & 63, w = __builtin_amdgcn_readfirstlane(tid >> 6);
  const int l16 = lane & 15, quad = lane >> 4;
  const int h = item & 7, tok0 = (item >> 3) * 32;
  const int pp = w >> 2;
  const bf16_t* qb = (const bf16_t*)(p.ws + OFF_QBUF);
  const bf16_t* keys = (const bf16_t*)(p.ws + OFF_WT) + WT_KEYS + (size_t)((layer * 8 + h) * 2 + pp) * 8192;
#pragma unroll
  for (int ks = 0; ks < 2; ++ks) {
#pragma unroll
    for (int mt = 0; mt < 2; ++mt) f.a[ks][mt] = *(const bf16x8*)(qb + (size_t)(tok0 + mt * 16 + l16) * 1024 + h * 128 + pp * 64 + ks * 32 + quad * 8);
#pragma unroll
    for (int j = 0; j < 2; ++j) {
      const int nt = (w & 3) * 2 + j;
      f.b[ks][j] = *(const bf16x8*)(keys + (nt * 16 + l16) * 64 + ks * 32 + quad * 8);
    }
  }
}

__device__ __forceinline__ void peer_topk_item(int tid, unsigned char* smem, const Params& p, const TopkFrags& f, int item) {
  unsigned* sS = (unsigned*)smem;
  const int lane = tid & 63, w = __builtin_amdgcn_readfirstlane(tid >> 6);
  const int l16 = lane & 15, quad = lane >> 4;
  const int h = item & 7, tile = item >> 3;
  const int tok0 = tile * 32;
  unsigned* wtop = (unsigned*)(smem + 32768) + w * 256;
  float* wexp = (float*)(wtop + 128);
  __syncthreads();
  {
    const int pp = w >> 2;
    f32x4 acc[2][2];
#pragma unroll
    for (int i = 0; i < 2; ++i)
#pragma unroll
      for (int j = 0; j < 2; ++j) acc[i][j] = (f32x4){0.f, 0.f, 0.f, 0.f};
#pragma unroll
    for (int ks = 0; ks < 2; ++ks)
#pragma unroll
      for (int mt = 0; mt < 2; ++mt)
#pragma unroll
        for (int j = 0; j < 2; ++j) acc[mt][j] = __builtin_amdgcn_mfma_f32_16x16x32_bf16(f.a[ks][mt], f.b[ks][j], acc[mt][j], 0, 0, 0);
#pragma unroll
    for (int mt = 0; mt < 2; ++mt)
#pragma unroll
      for (int j = 0; j < 2; ++j) {
        const int nt = (w & 3) * 2 + j;
#pragma unroll
        for (int r = 0; r < 4; ++r) {
          const int key = nt * 16 + l16;
          sS[((mt * 16 + quad * 4 + r) * 2 + pp) * 128 + key] = (f2ukey(acc[mt][j][r]) & ~127u) | (unsigned)(127 - key);
        }
      }
  }
  __syncthreads();
  int* ebuf = (int*)(p.ws + OFF_M);
  float* gbuf = (float*)(p.ws + OFF_M + 17301504ull);
  unsigned k0[8], k1[8], T[8];
#pragma unroll
  for (int c = 0; c < 8; ++c) {
    const unsigned* row = sS + ((w * 4 + (c >> 1)) * 2 + (c & 1)) * 128;
    k0[c] = row[lane]; k1[c] = row[64 + lane]; T[c] = 0u;
  }
#pragma unroll 1
  for (int bit = 31; bit >= 7; --bit) {
    const unsigned bm = 1u << bit;
#pragma unroll
    for (int c = 0; c < 8; ++c) {
      const unsigned cand = T[c] | bm;
      const int cnt = popc64(__builtin_amdgcn_ballot_w64(k0[c] >= cand)) + popc64(__builtin_amdgcn_ballot_w64(k1[c] >= cand));
      T[c] = (cnt >= 16) ? cand : T[c];
    }
  }
  {
    bool need = false;
#pragma unroll
    for (int c = 0; c < 8; ++c) {
      const int cnt = popc64(__builtin_amdgcn_ballot_w64(k0[c] >= T[c])) + popc64(__builtin_amdgcn_ballot_w64(k1[c] >= T[c]));
      need = need || (cnt > 16);
    }
    if (need) {
#pragma unroll 1
      for (int bit = 6; bit >= 0; --bit) {
        const unsigned bm = 1u << bit;
#pragma unroll
        for (int c = 0; c < 8; ++c) {
          const unsigned cand = T[c] | bm;
          const int cnt = popc64(__builtin_amdgcn_ballot_w64(k0[c] >= cand)) + popc64(__builtin_amdgcn_ballot_w64(k1[c] >= cand));
          T[c] = (cnt >= 16) ? cand : T[c];
        }
      }
    }
  }
#pragma unroll
  for (int c = 0; c < 8; ++c) {
    const unsigned long long m0 = __builtin_amdgcn_ballot_w64(k0[c] >= T[c]);
    const unsigned long long m1 = __builtin_amdgcn_ballot_w64(k1[c] >= T[c]);
    const int s0 = mbcnt64(m0), s1 = popc64(m0) + mbcnt64(m1);
    if (k0[c] >= T[c]) wtop[c * 16 + s0] = k0[c];
    if (k1[c] >= T[c]) wtop[c * 16 + s1] = k1[c];
  }
  asm volatile("s_waitcnt lgkmcnt(0)" ::: "memory");
#define ROR_CNT(S) { const unsigned o_ = (unsigned)__builtin_amdgcn_update_dpp(0, (int)key_, 0x120 + (S), 0xf, 0xf, true); rk_ += (o_ > key_) ? 1 : 0; }
#pragma unroll
  for (int pass = 0; pass < 2; ++pass) {
    const int L = pass * 4 + (lane >> 4);
    const unsigned key_ = wtop[L * 16 + (lane & 15)];
    int rk_ = 0;
    ROR_CNT(1) ROR_CNT(2) ROR_CNT(3) ROR_CNT(4) ROR_CNT(5) ROR_CNT(6) ROR_CNT(7) ROR_CNT(8)
    ROR_CNT(9) ROR_CNT(10) ROR_CNT(11) ROR_CNT(12) ROR_CNT(13) ROR_CNT(14) ROR_CNT(15)
    wtop[L * 16 + rk_] = key_;
  }
  asm volatile("s_waitcnt lgkmcnt(0)" ::: "memory");
  int ci = (lane >= 16) + (lane >= 24) + (lane >= 29) + (lane >= 33) + (lane >= 36) + (lane >= 38) + (lane >= 40) + (lane >= 42);
#pragma unroll
  for (int t = 43; t < 50; ++t) ci += (lane >= t);
  int cstart = 0;
  cstart = (ci >= 1) ? 16 : cstart; cstart = (ci >= 2) ? 24 : cstart; cstart = (ci >= 3) ? 29 : cstart; cstart = (ci >= 4) ? 33 : cstart;
  cstart = (ci >= 5) ? 36 : cstart; cstart = (ci >= 6) ? 38 : cstart; cstart = (ci >= 7) ? 40 : cstart; cstart = (ci >= 8) ? 42 : cstart;
  cstart = (ci >= 9) ? (34 + ci) : cstart;
  const int cj = lane - cstart;
  const bool cvalid = lane < 50;
  unsigned kav[4], kbv[4], ck[4], T2[4]; float cs[4];
#pragma unroll
  for (int t = 0; t < 4; ++t) {
    kav[t] = 0u; kbv[t] = 0u; cs[t] = 0.f; ck[t] = 0u; T2[t] = 0u;
    if (cvalid) {
      kav[t] = wtop[(t * 2) * 16 + ci]; kbv[t] = wtop[(t * 2 + 1) * 16 + cj];
      cs[t] = ukey2f(kav[t]) + ukey2f(kbv[t]);
      ck[t] = ((f2ukey(cs[t]) & ~63u) | (unsigned)(63 - lane)) | 0u;
      ck[t] = (ck[t] == 0u) ? 1u : ck[t];
    }
  }
#pragma unroll 1
  for (int bit = 31; bit >= 6; --bit) {
    const unsigned bm = 1u << bit;
#pragma unroll
    for (int t = 0; t < 4; ++t) {
      const unsigned cand = T2[t] | bm;
      const int cnt = popc64(__builtin_amdgcn_ballot_w64(ck[t] >= cand));
      T2[t] = (cnt >= 16) ? cand : T2[t];
    }
  }
  {
    bool need = false;
#pragma unroll
    for (int t = 0; t < 4; ++t) need = need || (popc64(__builtin_amdgcn_ballot_w64(ck[t] >= T2[t])) > 16);
    if (need) {
#pragma unroll 1
      for (int bit = 5; bit >= 0; --bit) {
        const unsigned bm = 1u << bit;
#pragma unroll
        for (int t = 0; t < 4; ++t) {
          const unsigned cand = T2[t] | bm;
          const int cnt = popc64(__builtin_amdgcn_ballot_w64(ck[t] >= cand));
          T2[t] = (cnt >= 16) ? cand : T2[t];
        }
      }
    }
  }
  int* weid = (int*)(wexp + 64);
#pragma unroll
  for (int t = 0; t < 4; ++t) {
    const float cT = ukey2f(T2[t]);
    const bool win = ck[t] >= T2[t];
    const int sl = mbcnt64(__builtin_amdgcn_ballot_w64(win));
    if (win) {
      wexp[t * 16 + sl] = __expf(fminf(cs[t] - cT, 60.f));
      weid[t * 16 + sl] = (127 - (int)(kav[t] & 127u)) * 128 + (127 - (int)(kbv[t] & 127u));
    }
  }
  asm volatile("s_waitcnt lgkmcnt(0)" ::: "memory");
  {
    const int t = lane >> 4, sl = lane & 15;
    float es = 0.f;
#pragma unroll
    for (int q = 0; q < 4; ++q) { const float4 ee = *(const float4*)(wexp + t * 16 + q * 4); es += ee.x + ee.y + ee.z + ee.w; }
    const float e = wexp[t * 16 + sl];
    const int id = weid[t * 16 + sl];
    const size_t o = (size_t)(tok0 + w * 4 + t) * 128 + h * 16 + sl;
    ebuf[o] = id;
    gbuf[o] = e / es;
  }
  asm volatile("s_waitcnt lgkmcnt(0)" ::: "memory");
}

struct EpiStoreBf16 { bf16_t* dst; int ld; static constexpr int CHUNK = 1;
  __device__ void operator()(int r, int c, float v) const { dst[(size_t)r * ld + c] = f2bf(v); }
  __device__ void chunk(int r, int c, const float* v) const { *(uint4*)(dst + (size_t)r * ld + c) = pack8(v); } };
struct EpiGlu { const bf16_t* z; const float* bias; bf16_t* mix; static constexpr int CHUNK = 1;
  __device__ void operator()(int r, int c, float v) const {
    float zz = bf2f(z[(size_t)r * 512 + c]); float s = v + bias[c]; mix[(size_t)r * 1024 + 512 + c] = f2bf(zz / (1.f + __expf(-s))); }
  __device__ void chunk(int r, int c, const float* v) const {
    float zz[8]; unpack8(*(const uint4*)(z + (size_t)r * 512 + c), zz);
    const float4 b0 = *(const float4*)(bias + c), b1 = *(const float4*)(bias + c + 4);
    const float bb[8] = {b0.x, b0.y, b0.z, b0.w, b1.x, b1.y, b1.z, b1.w};
    float o[8];
#pragma unroll
    for (int i = 0; i < 8; ++i) o[i] = zz[i] / (1.f + __expf(-(v[i] + bb[i])));
    *(uint4*)(mix + (size_t)r * 1024 + 512 + c) = pack8(o); } };
struct EpiRes0 { const float* xp; const float* xs; float* xres; static constexpr int CHUNK = 1;
  __device__ void operator()(int r, int c, float v) const {
    float x = (r < T_P) ? xp[(size_t)r * 1024 + c] : xs[(size_t)(r - T_P) * 1024 + c]; xres[(size_t)r * 1024 + c] = x + v; }
  __device__ void chunk(int r, int c, const float* v) const {
    const float* src = (r < T_P) ? xp + (size_t)r * 1024 + c : xs + (size_t)(r - T_P) * 1024 + c;
    const float4 a = *(const float4*)src, b = *(const float4*)(src + 4);
    float* d = xres + (size_t)r * 1024 + c;
    *(float4*)d = make_float4(a.x + v[0], a.y + v[1], a.z + v[2], a.w + v[3]);
    *(float4*)(d + 4) = make_float4(b.x + v[4], b.y + v[5], b.z + v[6], b.w + v[7]); } };
struct EpiRes1 { float* xres; static constexpr int CHUNK = 1;
  __device__ void operator()(int r, int c, float v) const { xres[(size_t)r * 1024 + c] += v; }
  __device__ void chunk(int r, int c, const float* v) const {
    float* d = xres + (size_t)r * 1024 + c;
    const float4 a = *(const float4*)d, b = *(const float4*)(d + 4);
    *(float4*)d = make_float4(a.x + v[0], a.y + v[1], a.z + v[2], a.w + v[3]);
    *(float4*)(d + 4) = make_float4(b.x + v[4], b.y + v[5], b.z + v[6], b.w + v[7]); } };
struct EpiPool { bf16_t* mix; const float* scale; int g; static constexpr int CHUNK = 0;
  __device__ void operator()(int r, int c, float v) const { mix[(size_t)r * 1024 + g * 128 + c] = f2bf(v * scale[g * 128 + c]); }
  __device__ void chunk(int, int, const float*) const {} };
struct EpiKup { bf16_t* dst; int rowsPerB; int keyOff; int bStride; static constexpr int CHUNK = 1;
  __device__ void operator()(int r, int c, float v) const {
    int b = r / rowsPerB, key = r % rowsPerB + keyOff; dst[((size_t)(b * 8 + (c >> 6)) * bStride + key) * 64 + (c & 63)] = f2bf(v); }
  __device__ void chunk(int r, int c, const float* v) const {
    int b = r / rowsPerB, key = r % rowsPerB + keyOff; *(uint4*)(dst + ((size_t)(b * 8 + (c >> 6)) * bStride + key) * 64 + (c & 63)) = pack8(v); } };
struct EpiVt { bf16_t* dst; int rowsPerB; int keyOff; int ldv; static constexpr int CHUNK = 2;
  __device__ void operator()(int r, int c, float v) const {
    int b = r / rowsPerB, key = r % rowsPerB + keyOff;
    dst[((size_t)(b * 8 + (c >> 6)) * (ldv >> 6) + (key >> 6)) * 4096 + (c & 63) * 64 + (key & 63)] = f2bf(v); }
  __device__ void chunk(int r, int c, const float* v) const {
    int b = r / rowsPerB, key = r % rowsPerB + keyOff;
    *(uint4*)(dst + ((size_t)(b * 8 + (c >> 6)) * (ldv >> 6) + (key >> 6)) * 4096 + (c & 63) * 64 + (key & 63)) = pack8(v); } };


typedef const Params __attribute__((address_space(4))) KParams;

constexpr size_t OFF_BAR = WS_NEED;
__device__ __forceinline__ void grid_barrier(unsigned* ctr, unsigned target) {
  asm volatile("s_waitcnt vmcnt(0)" ::: "memory");
  __syncthreads();
  if (threadIdx.x == 0) {
    __builtin_amdgcn_fence(__ATOMIC_RELEASE, "agent");
    asm volatile("s_waitcnt vmcnt(0)" ::: "memory");
    __hip_atomic_fetch_add(ctr, 1u, __ATOMIC_RELAXED, __HIP_MEMORY_SCOPE_AGENT);
    unsigned spins = 0;
    while (__hip_atomic_load(ctr, __ATOMIC_RELAXED, __HIP_MEMORY_SCOPE_AGENT) < target) {
      __builtin_amdgcn_s_sleep(1);
      if (++spins > (1u << 27)) break;
    }
    __builtin_amdgcn_fence(__ATOMIC_ACQUIRE, "agent");
    asm volatile("s_waitcnt vmcnt(0)" ::: "memory");
  }
  __syncthreads();
}
#define GRID_BAR() { unsigned* ctr_ = (unsigned*)(((KParams*)__builtin_amdgcn_kernarg_segment_ptr())->ws + OFF_BAR); bar_k += 1; grid_barrier(ctr_, (unsigned)bar_k * gridDim.x); }
#define PHASE_BEGIN \
  Params p; \
  { KParams* kp_ = (KParams*)__builtin_amdgcn_kernarg_segment_ptr(); asm volatile("" : "+s"(kp_)); \
    _Pragma("unroll") for (int i_ = 0; i_ < 38; ++i_) p.in[i_] = kp_->in[i_]; \
    p.out = kp_->out; p.ws = kp_->ws; } \
  int tid = threadIdx.x; asm volatile("" : "+v"(tid)); \
  const int lane = tid & 63, w = __builtin_amdgcn_readfirstlane(tid >> 6); \
  const int gw = blockIdx.x * 8 + w, nw = gridDim.x * 8; \
  const size_t gtid = (size_t)blockIdx.x * NT + tid, gthreads = (size_t)gridDim.x * NT; \
  bf16_t* wt = (bf16_t*)(p.ws + OFF_WT); \
  bf16_t* proj = (bf16_t*)(p.ws + OFF_PROJ); \
  bf16_t* mix = (bf16_t*)(p.ws + OFF_MIX); \
  bf16_t* qbuf = (bf16_t*)(p.ws + OFF_QBUF); \
  bf16_t* zbuf = (bf16_t*)(p.ws + OFF_Z); \
  float* xres = p.out + O_Y; \
  (void)lane; (void)gw; (void)nw; (void)gtid; (void)gthreads; (void)wt; (void)proj; (void)mix; (void)qbuf; (void)zbuf; (void)xres;

template <int LAYER>
__device__ __forceinline__ void peer_phases(int& bar_k, unsigned char* smem) {
  const int layer = LAYER;
    for (int rep_ = 0; rep_ < NREP(7); ++rep_)
    {
    PHASE_BEGIN
      int vb = 0;
      gemm_run<2>(tid, smem, xres, xres, T_TOT, 1024, p.in[10] + layer * 1024, wt + WT_PQ + (size_t)layer * 1048576, T_TOT, 1024, 1024, vb, EpiStoreBf16{qbuf, 1024});
    }
    GRID_BAR();
    for (int rep_ = 0; rep_ < NREP(8); ++rep_) {
    PHASE_BEGIN
    {
      TopkFrags fr;
      int item = blockIdx.x;
      if (item < 1056 * 8) topk_load(fr, tid, p, layer, item);
      for (; item < 1056 * 8; item += gridDim.x) {
        TopkFrags cur = fr;
        const int nxt = item + gridDim.x;
        if (nxt < 1056 * 8) topk_load(fr, tid, p, layer, nxt);
        peer_topk_item(tid, smem, p, cur, item);
      }
    }
    }
    GRID_BAR();
    for (int rep_ = 0; rep_ < NREP(9); ++rep_) {
    PHASE_BEGIN
      int j = blockIdx.x & 7, lb = blockIdx.x >> 3, nb = ((int)gridDim.x - j + 7) >> 3;
      {
        unsigned* cnt_ = (unsigned*)(p.ws + OFF_BAR) + 16;
        bool ok_ = true;
#pragma unroll
        for (int x_ = 0; x_ < 16; ++x_) {
          const unsigned c_ = __hip_atomic_load(&cnt_[x_], __ATOMIC_RELAXED, __HIP_MEMORY_SCOPE_AGENT);
          ok_ = ok_ && ((x_ < 8) ? (c_ > 0u) : (c_ == 0u));
        }
        if (ok_) {
          j = ((const int*)(smem + (DYN_LDS - 16)))[0]; lb = ((const int*)(smem + (DYN_LDS - 16)))[1];
          nb = (int)__hip_atomic_load(&cnt_[j], __ATOMIC_RELAXED, __HIP_MEMORY_SCOPE_AGENT);
        }
      }
      for (int tok = lb * 8 + w; tok < T_TOT; tok += nb * 8) peer9a_token(tid, p, layer, tok, j);
    }
    GRID_BAR();
    for (int rep_ = 0; rep_ < NREP(9); ++rep_) {
    PHASE_BEGIN
      for (int tok = gw; tok < T_TOT; tok += nw) peer9m_token(tid, smem, p, tok);
    }
    GRID_BAR();
    for (int rep_ = 0; rep_ < NREP(9); ++rep_) {
    PHASE_BEGIN
      int j = blockIdx.x & 7, lb = blockIdx.x >> 3, nb = ((int)gridDim.x - j + 7) >> 3;
      {
        unsigned* cnt_ = (unsigned*)(p.ws + OFF_BAR) + 16;
        bool ok_ = true;
#pragma unroll
        for (int x_ = 0; x_ < 16; ++x_) {
          const unsigned c_ = __hip_atomic_load(&cnt_[x_], __ATOMIC_RELAXED, __HIP_MEMORY_SCOPE_AGENT);
          ok_ = ok_ && ((x_ < 8) ? (c_ > 0u) : (c_ == 0u));
        }
        if (ok_) {
          j = ((const int*)(smem + (DYN_LDS - 16)))[0]; lb = ((const int*)(smem + (DYN_LDS - 16)))[1];
          nb = (int)__hip_atomic_load(&cnt_[j], __ATOMIC_RELAXED, __HIP_MEMORY_SCOPE_AGENT);
        }
      }
      for (int tok = lb * 8 + w; tok < T_TOT; tok += nb * 8) peer9b_token(tid, p, tok, j);
    }
    if (layer == 1) {
      GRID_BAR();
      for (int rep_ = 0; rep_ < NREP(9); ++rep_) {
      PHASE_BEGIN
        for (int tok = gw; tok < T_TOT; tok += nw) final_norm_token(tid, p, tok);
      }
    }
}

__global__ void __launch_bounds__(NT) mega(Params kparams_) {
  cg::grid_group grid = cg::this_grid();
  int bar_k = 0;
  extern __shared__ __attribute__((aligned(16))) unsigned char smem[];
  if (threadIdx.x == 0) {
    unsigned* cnt_ = (unsigned*)(((KParams*)__builtin_amdgcn_kernarg_segment_ptr())->ws + OFF_BAR) + 16;
    const unsigned xcc_ = (unsigned)__builtin_amdgcn_s_getreg((3 << 11) | 20) & 0xFu;
    const unsigned rank_ = __hip_atomic_fetch_add(&cnt_[xcc_], 1u, __ATOMIC_RELAXED, __HIP_MEMORY_SCOPE_AGENT);
    ((int*)(smem + (DYN_LDS - 16)))[0] = (int)xcc_;
    ((int*)(smem + (DYN_LDS - 16)))[1] = (int)rank_;
  }

  for (int rep_ = 0; rep_ < NREP(0); ++rep_)
  {
    PHASE_BEGIN
    int vb = 0;
    transpose_convert(tid, smem, p.in[12], wt + WT_IN_E, 1024, 1280, vb);
    transpose_convert(tid, smem, p.in[13], wt + WT_OUT_E, 1024, 1024, vb);
    transpose_convert(tid, smem, p.in[23], wt + WT_GLU, 512, 512, vb);
    transpose_convert(tid, smem, p.in[25], wt + WT_IN_O, 1024, 1312, vb);
    transpose_convert(tid, smem, p.in[26], wt + WT_OUT_O, 1024, 1024, vb);
    for (int g = 0; g < 4; ++g) transpose_convert(tid, smem, p.in[27] + g * 16384, wt + WT_POOL + g * 16384, 128, 128, vb);
    transpose_convert(tid, smem, p.in[31], wt + WT_UQ, 512, 768, vb);
    transpose_convert(tid, smem, p.in[32], wt + WT_UK, 256, 512, vb);
    transpose_convert(tid, smem, p.in[33], wt + WT_UV, 256, 512, vb);
    transpose_convert(tid, smem, p.in[34], wt + WT_PQ, 1024, 1024, vb);
    transpose_convert(tid, smem, p.in[34] + 1048576, wt + WT_PQ + 1048576, 1024, 1024, vb);
    convert_plain(tid, p.in[35], wt + WT_KEYS, 262144);
    quant_rows(p.in[36], p.ws + OFF_TAB, (float*)(p.ws + OFF_TAB + TAB_SU_OFF), gw, nw, tid);
    quant_rows(p.in[37], p.ws + OFF_TAB + TAB_V_OFF, (float*)(p.ws + OFF_TAB + TAB_SV_OFF), gw, nw, tid);
  }
  grid.sync();

  for (int rep_ = 0; rep_ < NREP(1); ++rep_)
  {
    PHASE_BEGIN
    int vb = 0;
    gemm_run<2>(tid, smem, p.in[0], p.in[1], T_P, 1024, p.in[9], wt + WT_IN_E, T_TOT, 1280, 1024, vb, EpiStoreBf16{proj, 1280});
  }
  GRID_BAR();

  for (int rep_ = 0; rep_ < NREP(2); ++rep_)
  {
    PHASE_BEGIN
    bf16_t* vt0 = (bf16_t*)(p.ws + OFF_VT0);
    bf16_t* kall = (bf16_t*)(p.ws + OFF_KALL);
    bf16_t* vtall = (bf16_t*)(p.ws + OFF_VTALL);
    for (int tok = gw; tok < T_TOT; tok += nw) {
      const bool isS = tok >= T_P;
      int b, t, pos;
      if (!isS) { b = tok >> 12; t = tok & 4095; pos = t; } else { int s = tok - T_P; b = s >> 5; t = s & 31; pos = 2048 + t; }
      bf16_t* row = proj + (size_t)tok * 1280;
      const int lm = lane & 7;
      float sn[8], cs[8];
#pragma unroll
      for (int j = 0; j < 8; ++j) { float inv = exp2f(-(float)j * (LOG2_THETA / 8.f)); sincos_rev((float)pos * inv, sn[j], cs[j]); }
      {
        uint4 qv = *(const uint4*)(row + lane * 8);
        float x[8]; unpack8(qv, x);
#pragma unroll
        for (int j = 0; j < 8; ++j) {
          float other = __shfl_xor(x[j], 1);
          if (lm == 0) x[j] = x[j] * cs[j] - other * sn[j];
          else if (lm == 1) x[j] = x[j] * cs[j] + other * sn[j];
        }
        *(uint4*)(row + lane * 8) = pack8(x);
      }
      {
        uint4 kv = make_uint4(0, 0, 0, 0);
        if (lane < 32) kv = *(const uint4*)(row + 512 + lane * 8);
        float x[8]; unpack8(kv, x);
#pragma unroll
        for (int j = 0; j < 8; ++j) {
          float other = __shfl_xor(x[j], 1);
          if (lane < 16) {
            if (lm == 0) x[j] = x[j] * cs[j] - other * sn[j];
            else if (lm == 1) x[j] = x[j] * cs[j] + other * sn[j];
          }
        }
        if (lane < 32) {
          const uint4 pk = pack8(x);
          const int e0 = (lane & 15) * 8;
          if (!isS) {
            if (lane < 16) *(uint4*)(row + 512 + lane * 8) = pk;
            else {
              const int kvh = e0 >> 6, d0 = e0 & 63;
#pragma unroll
              for (int j = 0; j < 8; ++j) vt0[((size_t)(b * 2 + kvh) * 64 + d0 + j) * 4096 + t] = f2bf(x[j]);
            }
            if (t >= 3968) {
              float* dst = p.out + ((lane < 16) ? O_SWAK_P : O_SWAV_P) + ((size_t)(b * 128 + (t - 3968)) * 128 + e0);
              *(float4*)dst = make_float4(x[0], x[1], x[2], x[3]);
              *(float4*)(dst + 4) = make_float4(x[4], x[5], x[6], x[7]);
            }
          } else {
            float* dst = p.out + ((lane < 16) ? O_SWAK_S : O_SWAV_S) + ((size_t)(b * 128 + 96 + t) * 128 + e0);
            *(float4*)dst = make_float4(x[0], x[1], x[2], x[3]);
            *(float4*)(dst + 4) = make_float4(x[4], x[5], x[6], x[7]);
            if (lane < 16) *(uint4*)(kall + (size_t)(b * 160 + 128 + t) * 128 + e0) = pk;
            else {
              const int kvh = e0 >> 6, d0 = e0 & 63;
#pragma unroll
              for (int j = 0; j < 8; ++j) vtall[((size_t)(b * 2 + kvh) * 64 + d0 + j) * 192 + 128 + t] = f2bf(x[j]);
            }
          }
        }
      }
    }
    for (size_t idx = gtid; idx < (size_t)32 * 96 * 128; idx += gthreads) {
      const int e = (int)(idx & 127); const int wd = (int)((idx >> 7) % 96); const int b = (int)(idx / (96 * 128));
      const size_t src = ((size_t)(b * 128 + 32 + wd)) * 128 + e, dst = ((size_t)(b * 128 + wd)) * 128 + e;
      p.out[O_SWAK_S + dst] = p.in[2][src];
      p.out[O_SWAV_S + dst] = p.in[3][src];
    }
    for (size_t idx = gtid; idx < (size_t)32 * 128 * 128; idx += gthreads) {
      const int e = (int)(idx & 127); const int key = (int)((idx >> 7) & 127); const int b = (int)(idx >> 14);
      kall[(size_t)(b * 160 + key) * 128 + e] = f2bf(p.in[2][idx]);
      vtall[((size_t)(b * 2 + (e >> 6)) * 64 + (e & 63)) * 192 + key] = f2bf(p.in[3][idx]);
    }
    for (size_t idx = gtid; idx < (size_t)32 * 2 * 64 * 32; idx += gthreads) {
      const int kk = (int)(idx & 31); const size_t rr = idx >> 5;
      vtall[rr * 192 + 160 + kk] = 0;
    }
    float* sUw = (float*)smem + w * 512;
    for (int item = gw; item < 32768; item += nw) s5_item<0>(tid, sUw, p, item);
  }
  GRID_BAR();

  for (int rep_ = 0; rep_ < NREP(3); ++rep_)
  {
    PHASE_BEGIN
    if (gtid < 16384) {
      const int n = (int)(gtid & 63), g = (int)((gtid >> 6) & 31), b = (int)(gtid >> 11);
      const int gn = g * 64 + n;
      const float lr = fminf(p.in[15][gn], -1e-4f), li = p.in[16][gn];
      const float dt = __expf(p.in[17][g]);
      const float mag = __expf(lr * dt);
      float sn, cs; sincos_rev(li * dt, sn, cs);
      float ar = mag * cs, ai = mag * sn;
#pragma unroll
      for (int i = 0; i < 5; ++i) { float nr = ar * ar - ai * ai, ni = 2.f * ar * ai; ar = nr; ai = ni; }
      const float* s1re = (const float*)(p.ws + OFF_QMLA);
      const float* s1im = s1re + 2097152;
      float* hinre = (float*)(p.ws + OFF_QMLA) + 2 * 2097152;
      float* hinim = hinre + 2097152;
      float hr = 0.f, hi = 0.f;
#pragma unroll 8
      for (int c = 0; c < 128; ++c) {
        const size_t idx = ((size_t)(b * 128 + c) * 32 + g) * 64 + n;
        hinre[idx] = hr; hinim[idx] = hi;
        const float sr = s1re[idx], si = s1im[idx];
        const float nhr = ar * hr - ai * hi + sr, nhi = ar * hi + ai * hr + si;
        hr = nhr; hi = nhi;
      }
      p.out[O_SSMRE_P + (size_t)(b * 32 + g) * 64 + n] = hr;
      p.out[O_SSMIM_P + (size_t)(b * 32 + g) * 64 + n] = hi;
    }
    const bf16_t* vt0 = (const bf16_t*)(p.ws + OFF_VT0);
    const bf16_t* kall = (const bf16_t*)(p.ws + OFF_KALL);
    const bf16_t* vtall = (const bf16_t*)(p.ws + OFF_VTALL);
    const float* sink = p.in[14];
    for (int item = blockIdx.x; item < 2048 + 256; item += gridDim.x) {
      AttnDesc d;
      d.scale = 0.125f; d.kx = nullptr; d.pos0 = 0;
      if (item < 2048) {
        const int h = item & 7, pr = (item >> 3) & 31, b = item >> 8;
        const int kvh = h >> 2;
        const int chunk = pr * 2 + (w >> 2);
        const int tok = b * 4096 + chunk * 64 + (w & 3) * 16;
        d.q = proj + (size_t)tok * 1280 + h * 64; d.ldq = 1280; d.active = 1;
        d.kt_lo = max(0, chunk - 2); d.kt_hi = chunk + 1;
        d.out = mix + (size_t)tok * 1024 + h * 64; d.ldo = 1024;
        d.m0 = sink[h]; d.l0 = 1.f;
        d.k = proj + (size_t)(b * 4096) * 1280 + 512 + kvh * 64; d.ldk = 1280;
        d.vt = vt0 + (size_t)(b * 2 + kvh) * 64 * 4096; d.ldv = 4096; d.vts = 64; d.nkeys = 4096;
        d.bt_lo = max(0, pr * 2 - 2); d.bt_hi = pr * 2 + 2;
      } else {
        const int it = item - 2048;
        const int h = it & 7, b = it >> 3;
        const int kvh = h >> 2;
        const int tok = T_P + b * 32 + (w & 1) * 16;
        d.q = proj + (size_t)tok * 1280 + h * 64; d.ldq = 1280; d.active = (w < 2);
        d.kt_lo = 0; d.kt_hi = 3;
        d.out = mix + (size_t)tok * 1024 + h * 64; d.ldo = 1024;
        d.m0 = sink[h]; d.l0 = 1.f;
        d.k = kall + (size_t)(b * 160) * 128 + kvh * 64; d.ldk = 128;
        d.vt = vtall + (size_t)(b * 2 + kvh) * 64 * 192; d.ldv = 192; d.vts = 64; d.nkeys = 160;
        d.bt_lo = 0; d.bt_hi = 3;
      }
      attn_item<64>(tid, smem, d);
    }
  }
  GRID_BAR();

  for (int rep_ = 0; rep_ < NREP(4); ++rep_)
  {
    PHASE_BEGIN
    float* sUw = (float*)smem + w * 512;
    for (int item = gw; item < 33792; item += nw) s5_item<1>(tid, sUw, p, item);
  }
  GRID_BAR();

  for (int rep_ = 0; rep_ < NREP(5); ++rep_)
  {
    PHASE_BEGIN
    int vb = 0;
    gemm_run<0>(tid, smem, zbuf, zbuf, T_TOT, 512, nullptr, wt + WT_GLU, T_TOT, 512, 512, vb, EpiGlu{zbuf, p.in[24], mix});
  }
  GRID_BAR();

  for (int rep_ = 0; rep_ < NREP(6); ++rep_)
  {
    PHASE_BEGIN
    int vb = 0;
    gemm_run<0>(tid, smem, mix, mix, T_TOT, 1024, nullptr, wt + WT_OUT_E, T_TOT, 1024, 1024, vb, EpiRes0{p.in[0], p.in[1], xres});
  }
  GRID_BAR();

  peer_phases<0>(bar_k, smem);
  GRID_BAR();
      for (int rep_ = 0; rep_ < NREP(10); ++rep_)
      {
    PHASE_BEGIN
        int vb = 0;
        gemm_run<2>(tid, smem, xres, xres, T_TOT, 1024, p.in[9] + 1024, wt + WT_IN_O, T_TOT, 1312, 1024, vb, EpiStoreBf16{proj, 1312});
      }
      GRID_BAR();
      for (int rep_ = 0; rep_ < NREP(11); ++rep_)
      {
    PHASE_BEGIN
        bf16_t* cqn = zbuf;
        bf16_t* mbuf = (bf16_t*)(p.ws + OFF_M);
        bf16_t* cbuf = (bf16_t*)(p.ws + OFF_C);
        bf16_t* kpbuf = (bf16_t*)(p.ws + OFF_KP);
        bf16_t* kps = (bf16_t*)(p.ws + OFF_KPS);
        for (int tok = gw; tok < T_TOT; tok += nw) {
          const bool isS = tok >= T_P;
          int b, t, pos;
          if (!isS) { b = tok >> 12; t = tok & 4095; pos = t; } else { int s = tok - T_P; b = s >> 5; t = s & 31; pos = 2048 + t; }
          const bf16_t* row = proj + (size_t)tok * 1312;
          {
            uint4 v = *(const uint4*)(row + lane * 8);
            float x[8]; unpack8(v, x);
            float ss = 0.f;
#pragma unroll
            for (int j = 0; j < 8; ++j) ss += x[j] * x[j];
            ss = wave_sum(ss);
            const float rs = rsqrtf(ss * (1.f / 512.f) + 1e-6f);
            const float4 g0 = *(const float4*)(p.in[29] + lane * 8), g1 = *(const float4*)(p.in[29] + lane * 8 + 4);
            x[0] *= rs * g0.x; x[1] *= rs * g0.y; x[2] *= rs * g0.z; x[3] *= rs * g0.w;
            x[4] *= rs * g1.x; x[5] *= rs * g1.y; x[6] *= rs * g1.z; x[7] *= rs * g1.w;
            *(uint4*)(cqn + (size_t)tok * 512 + lane * 8) = pack8(x);
          }
          {
            uint2 v = *(const uint2*)(row + 512 + lane * 4);
            float x0 = lo2f(v.x), x1 = hi2f(v.x), x2 = lo2f(v.y), x3 = hi2f(v.y);
            float ss = wave_sum(x0 * x0 + x1 * x1 + x2 * x2 + x3 * x3);
            const float rs = rsqrtf(ss * (1.f / 256.f) + 1e-6f);
            const float4 g = *(const float4*)(p.in[30] + lane * 4);
            x0 *= rs * g.x; x1 *= rs * g.y; x2 *= rs * g.z; x3 *= rs * g.w;
            uint2 o; o.x = pack2(x0, x1); o.y = pack2(x2, x3);
            *(uint2*)(cbuf + (size_t)tok * 256 + lane * 4) = o;
            float* dst = isS ? (p.out + O_CKV_S + (size_t)(tok - T_P) * 256 + lane * 4) : (p.out + O_CKV_P + (size_t)tok * 256 + lane * 4);
            *(float4*)dst = make_float4(x0, x1, x2, x3);
          }
          {
            float xv = 0.f;
            if (lane < 32) xv = bf2f(row[768 + lane]);
            const float other = __shfl_xor(xv, 16);
            const int f = lane & 15;
            const float inv = exp2f(-(float)f * (LOG2_THETA / 16.f));
            float sn, cs; sincos_rev((float)pos * inv, sn, cs);
            const float r = (lane < 16) ? (xv * cs - other * sn) : (xv * cs + other * sn);
            if (lane < 32) {
              kpbuf[(size_t)tok * 32 + lane] = f2bf(r);
              if (isS) { p.out[O_KPE_S + (size_t)(tok - T_P) * 32 + lane] = r; kps[((size_t)b * 2112 + 2048 + t) * 32 + lane] = f2bf(r); }
              else p.out[O_KPE_P + (size_t)tok * 32 + lane] = r;
            }
          }
          {
            const int gi = lane >> 4; const int wlen = 2 << gi;
            float tot[8], cur[8];
#pragma unroll
            for (int j = 0; j < 8; ++j) tot[j] = 0.f;
            uint4 v = *(const uint4*)(row + 800 + lane * 8);
            unpack8(v, cur);
#pragma unroll
            for (int j = 0; j < 8; ++j) tot[j] = cur[j];
            for (int jb = 1; jb < 16; ++jb) {
              if (jb < wlen) {
                const int tt = t - jb;
                if (tt >= 0) {
                  uint4 pv = *(const uint4*)(row - (size_t)jb * 1312 + 800 + lane * 8);
                  float y[8]; unpack8(pv, y);
#pragma unroll
                  for (int j = 0; j < 8; ++j) tot[j] += y[j];
                } else if (isS) {
                  const float* sp = p.in[6] + ((size_t)b * 15 + (15 + tt)) * 512 + lane * 8;
                  float4 a = *(const float4*)sp, bq = *(const float4*)(sp + 4);
                  tot[0] += a.x; tot[1] += a.y; tot[2] += a.z; tot[3] += a.w; tot[4] += bq.x; tot[5] += bq.y; tot[6] += bq.z; tot[7] += bq.w;
                }
              }
            }
            const float cnt = (float)min(pos + 1, wlen);
            float mm[8];
#pragma unroll
            for (int j = 0; j < 8; ++j) mm[j] = tot[j] / cnt - cur[j];
            *(uint4*)(mbuf + (size_t)tok * 512 + lane * 8) = pack8(mm);
            const int tlen = isS ? 32 : 4096;
            if (t >= tlen - 15) {
              const int i = t - (tlen - 15);
              float* dst = isS ? (p.out + O_POOL_S + ((size_t)b * 15 + i) * 512 + lane * 8) : (p.out + O_POOL_P + ((size_t)b * 15 + i) * 512 + lane * 8);
              *(float4*)dst = make_float4(cur[0], cur[1], cur[2], cur[3]);
              *(float4*)(dst + 4) = make_float4(cur[4], cur[5], cur[6], cur[7]);
            }
          }
        }
        for (size_t idx = gtid; idx < (size_t)32 * 2048 * 32; idx += gthreads) {
          const int e = (int)(idx & 31); const int key = (int)((idx >> 5) & 2047); const int b = (int)(idx >> 16);
          kps[((size_t)b * 2112 + key) * 32 + e] = f2bf(p.in[8][idx]);
        }
      }
      GRID_BAR();
      for (int rep_ = 0; rep_ < NREP(12); ++rep_)
      {
    PHASE_BEGIN
        bf16_t* cqn = zbuf;
        bf16_t* mbuf = (bf16_t*)(p.ws + OFF_M);
        bf16_t* cbuf = (bf16_t*)(p.ws + OFF_C);
        bf16_t* qmla = (bf16_t*)(p.ws + OFF_QMLA);
        bf16_t* kupp = qbuf;
        bf16_t* vtp = qbuf + 16777216;
        bf16_t* kups = (bf16_t*)(p.ws + OFF_KUPS);
        bf16_t* vts = (bf16_t*)(p.ws + OFF_VTS);
        for (size_t idx = gtid; idx < (size_t)32 * 8 * 64 * 32; idx += gthreads) {
          const int kk = (int)(idx & 31); const size_t rr = idx >> 5;
          vts[((rr >> 6) * 33 + 32) * 4096 + (rr & 63) * 64 + 32 + kk] = 0;
        }
        int vb = 0;
        gemm_run<1>(tid, smem, p.in[7], p.in[7], 65536, 256, nullptr, wt + WT_UK, 65536, 512, 256, vb, EpiKup{kups, 2048, 0, 2112});
        gemm_run<1>(tid, smem, p.in[7], p.in[7], 65536, 256, nullptr, wt + WT_UV, 65536, 512, 256, vb, EpiVt{vts, 2048, 0, 2112});
        gemm_run<0>(tid, smem, cqn, cqn, T_TOT, 512, nullptr, wt + WT_UQ, T_TOT, 768, 512, vb, EpiStoreBf16{qmla, 768});
        gemm_run<0>(tid, smem, cbuf, cbuf, T_P, 256, nullptr, wt + WT_UK, T_P, 512, 256, vb, EpiKup{kupp, 4096, 0, 4096});
        gemm_run<0>(tid, smem, cbuf, cbuf, T_P, 256, nullptr, wt + WT_UV, T_P, 512, 256, vb, EpiVt{vtp, 4096, 0, 4096});
        gemm_run<0>(tid, smem, cbuf + (size_t)T_P * 256, cbuf, 1024, 256, nullptr, wt + WT_UK, 1024, 512, 256, vb, EpiKup{kups, 32, 2048, 2112});
        gemm_run<0>(tid, smem, cbuf + (size_t)T_P * 256, cbuf, 1024, 256, nullptr, wt + WT_UV, 1024, 512, 256, vb, EpiVt{vts, 32, 2048, 2112});
        for (int g = 0; g < 4; ++g)
          gemm_run<0>(tid, smem, mbuf + g * 128, mbuf, T_TOT, 512, nullptr, wt + WT_POOL + g * 16384, T_TOT, 128, 128, vb, EpiPool{mix, p.in[28], g});
      }
      GRID_BAR();
      for (int rep_ = 0; rep_ < NREP(13); ++rep_)
      {
    PHASE_BEGIN
        const bf16_t* qmla = (const bf16_t*)(p.ws + OFF_QMLA);
        const bf16_t* kupp = qbuf;
        const bf16_t* vtp = qbuf + 16777216;
        const bf16_t* kups = (const bf16_t*)(p.ws + OFF_KUPS);
        const bf16_t* vts = (const bf16_t*)(p.ws + OFF_VTS);
        const bf16_t* kpbuf = (const bf16_t*)(p.ws + OFF_KP);
        const bf16_t* kps = (const bf16_t*)(p.ws + OFF_KPS);
        const int G = gridDim.x;
        const bool xsched = (G == 256);
        const int nitems = 2048 + 256;
        const int xcd = blockIdx.x & 7, loc = blockIdx.x >> 3;
        for (int k = 0;; ++k) {
          int pit, sit = -1;
          if (xsched) {
            if (k >= 9) break;
            if (k == 0) { pit = -1; sit = blockIdx.x; }
            else {
              const int r = k - 1;
              const int grp = xcd + 8 * r;
              const int pr = (r & 1) ? (31 - loc) : loc;
              pit = ((31 - pr) << 6) | grp;
            }
          } else {
            const int posn = (k & 1) ? (G - 1 - (int)blockIdx.x) : (int)blockIdx.x;
            const int v = k * G + posn;
            if (k * G >= nitems) break;
            if (v >= nitems) continue;
            if (v < 1024) pit = v; else if (v < 1280) { pit = -1; sit = v - 1024; } else pit = v - 256;
          }
          AttnDesc d;
          d.scale = 0.10206207261596575f; d.m0 = -1e30f; d.l0 = 0.f;
          if (pit >= 0) {
            const int pr = 31 - (pit >> 6); const int h = pit & 7, b = (pit >> 3) & 7;
            const int chunk = pr * 2 + (w >> 2);
            const int tok = b * 4096 + chunk * 64 + (w & 3) * 16;
            d.q = qmla + (size_t)tok * 768 + h * 96; d.ldq = 768; d.active = 1; d.pos0 = chunk * 64 + (w & 3) * 16;
            d.kt_lo = 0; d.kt_hi = chunk + 1;
            d.out = mix + (size_t)tok * 1024 + 512 + h * 64; d.ldo = 1024;
            d.k = kupp + (size_t)(b * 8 + h) * 4096 * 64; d.ldk = 64;
            d.kx = kpbuf + (size_t)(b * 4096) * 32;
            d.vt = vtp + (size_t)(b * 8 + h) * 64 * 4096; d.ldv = 64; d.vts = 4096; d.nkeys = 4096;
            d.bt_lo = 0; d.bt_hi = pr * 2 + 2;
          } else {
            const int h = sit & 7, b = sit >> 3;
            const int tok = T_P + b * 32 + (w & 1) * 16;
            d.q = qmla + (size_t)tok * 768 + h * 96; d.ldq = 768; d.active = (w < 2); d.pos0 = 2048 + (w & 1) * 16;
            d.kt_lo = 0; d.kt_hi = 33;
            d.out = mix + (size_t)tok * 1024 + 512 + h * 64; d.ldo = 1024;
            d.k = kups + (size_t)(b * 8 + h) * 2112 * 64; d.ldk = 64;
            d.kx = kps + (size_t)(b * 2112) * 32;
            d.vt = vts + (size_t)(b * 8 + h) * 64 * 2112; d.ldv = 64; d.vts = 4096; d.nkeys = 2080;
            d.bt_lo = 0; d.bt_hi = 33;
          }
          attn_item<96>(tid, smem, d);
        }
      }
      GRID_BAR();
      for (int rep_ = 0; rep_ < NREP(14); ++rep_)
      {
    PHASE_BEGIN
        quant_rows(p.in[36] + 16777216, p.ws + OFF_TAB, (float*)(p.ws + OFF_TAB + TAB_SU_OFF), gw, nw, tid);
        quant_rows(p.in[37] + 16777216, p.ws + OFF_TAB + TAB_V_OFF, (float*)(p.ws + OFF_TAB + TAB_SV_OFF), gw, nw, tid);
        int vb = 0;
        gemm_run<0>(tid, smem, mix, mix, T_TOT, 1024, nullptr, wt + WT_OUT_O, T_TOT, 1024, 1024, vb, EpiRes1{xres});
      }
      GRID_BAR();
  peer_phases<1>(bar_k, smem);
}

extern "C" void kernel_launch(void* const* d_in, const int* in_sizes, int n_in, void* d_out, int out_size, void* d_ws, size_t ws_size, hipStream_t stream) {
  static int grid_blocks = 0;
  if (grid_blocks == 0) {
    int dev = 0, cus = 0, per_cu = 0;
    hipGetDevice(&dev);
    hipDeviceGetAttribute(&cus, hipDeviceAttributeMultiprocessorCount, dev);
    hipFuncSetAttribute((const void*)mega, hipFuncAttributeMaxDynamicSharedMemorySize, DYN_LDS);
    hipOccupancyMaxActiveBlocksPerMultiprocessor(&per_cu, (const void*)mega, NT, DYN_LDS);
    if (per_cu < 1) per_cu = 1;
    if (per_cu > 1) per_cu = 1;
    grid_blocks = cus * per_cu;
    if (ws_size < WS_NEED + 256) fprintf(stderr, "kernel_launch: workspace too small: %zu < %zu\n", ws_size, (size_t)WS_NEED);
  }
  hipMemsetAsync((unsigned char*)d_ws + OFF_BAR, 0, 256, stream);
  Params p{};
  for (int i = 0; i < 38; ++i) p.in[i] = (const float*)d_in[i];
  p.out = (float*)d_out;
  p.ws = (unsigned char*)d_ws;
  void* args[] = {&p};
  hipError_t e = hipLaunchCooperativeKernel((const void*)mega, dim3(grid_blocks), dim3(NT), args, DYN_LDS, stream);
  if (e != hipSuccess) fprintf(stderr, "cooperative launch failed: %s (grid %d)\n", hipGetErrorString(e), grid_blocks);
}
```

```cpp
#include <hip/hip_runtime.h>
#include <hip/hip_bf16.h>
#include <hip/hip_cooperative_groups.h>
#include <cstdio>
namespace cg = cooperative_groups;

typedef unsigned short bf16_t;
using bf16x8 = __attribute__((ext_vector_type(8))) short;
using f32x4 = __attribute__((ext_vector_type(4))) float;

#ifndef PH
#define PH 0xFFFFFFu
#endif
#ifndef DBL
#define DBL 0u
#endif
#define NREP(n) ((int)((PH >> (n)) & 1u) * (1 + (int)((DBL >> (n)) & 1u)))
#define NT 512
#define DYN_LDS 81920
#define T_TOT 33792
#define T_P 32768
#define LOG2_THETA 18.931568569324174f

#define O_Y 0
#define O_SWAK_P 34603008
#define O_SWAV_P 34734080
#define O_SSMRE_P 34865152
#define O_SSMIM_P 34881536
#define O_POOL_P 34897920
#define O_CKV_P 34959360
#define O_KPE_P 43347968
#define O_SWAK_S 44396544
#define O_SWAV_S 44920832
#define O_SSMRE_S 45445120
#define O_SSMIM_S 45510656
#define O_POOL_S 45576192
#define O_CKV_S 45821952
#define O_KPE_S 46084096

constexpr size_t OFF_PROJ = 0;
constexpr size_t OFF_TAB = OFF_PROJ + 88670208ull;
constexpr size_t OFF_MIX = OFF_TAB + 67108864ull;
constexpr size_t OFF_QBUF = OFF_MIX + 69206016ull;
constexpr size_t OFF_QMLA = OFF_QBUF + 69206016ull;
constexpr size_t OFF_Z = OFF_QMLA + 51904512ull;
constexpr size_t OFF_M = OFF_Z + 34603008ull;
constexpr size_t OFF_C = OFF_M + 34603008ull;
constexpr size_t OFF_KP = OFF_C + 17301504ull;
constexpr size_t OFF_VT0 = OFF_KP + 2162688ull;
constexpr size_t OFF_KALL = OFF_VT0 + 8388608ull;
constexpr size_t OFF_VTALL = OFF_KALL + 1327104ull;
constexpr size_t OFF_KPS = OFF_VTALL + 1572864ull;
constexpr size_t OFF_WT = OFF_KPS + 4325376ull;
constexpr size_t WS_NEED = OFF_WT + 16187392ull;
constexpr size_t OFF_XB = WS_NEED + 1024;
constexpr size_t OFF_KUPS = OFF_PROJ;
constexpr size_t OFF_VTS = OFF_PROJ + 69206016ull;
constexpr size_t WT_IN_E = 0;
constexpr size_t WT_OUT_E = WT_IN_E + 1310720;
constexpr size_t WT_GLU = WT_OUT_E + 1048576;
constexpr size_t WT_IN_O = WT_GLU + 262144;
constexpr size_t WT_OUT_O = WT_IN_O + 1343488;
constexpr size_t WT_POOL = WT_OUT_O + 1048576;
constexpr size_t WT_UQ = WT_POOL + 65536;
constexpr size_t WT_UK = WT_UQ + 393216;
constexpr size_t WT_UV = WT_UK + 131072;
constexpr size_t WT_PQ = WT_UV + 131072;
constexpr size_t WT_KEYS = WT_PQ + 2097152;

struct Params {
  const float* in[38];
  float* out;
  unsigned char* ws;
};

typedef __bf16 bf16x2_t __attribute__((ext_vector_type(2)));
typedef float float2_t __attribute__((ext_vector_type(2)));
__device__ __forceinline__ unsigned pack2(float a, float b) {
  float2_t f = {a, b};
  bf16x2_t h = __builtin_convertvector(f, bf16x2_t);
  return __builtin_bit_cast(unsigned, h);
}
__device__ __forceinline__ unsigned short f2bf(float f) { return (unsigned short)(pack2(f, 0.f) & 0xffffu); }
__device__ __forceinline__ float bf2f(unsigned short b) { return __uint_as_float(((unsigned)b) << 16); }
__device__ __forceinline__ float lo2f(unsigned u) { return __uint_as_float(u << 16); }
__device__ __forceinline__ float hi2f(unsigned u) { return __uint_as_float(u & 0xffff0000u); }
__device__ __forceinline__ void unpack8(uint4 v, float* x) {
  x[0] = lo2f(v.x); x[1] = hi2f(v.x); x[2] = lo2f(v.y); x[3] = hi2f(v.y);
  x[4] = lo2f(v.z); x[5] = hi2f(v.z); x[6] = lo2f(v.w); x[7] = hi2f(v.w);
}
__device__ __forceinline__ uint4 pack8(const float* x) {
  uint4 v; v.x = pack2(x[0], x[1]); v.y = pack2(x[2], x[3]); v.z = pack2(x[4], x[5]); v.w = pack2(x[6], x[7]); return v;
}
template <int CTRL> __device__ __forceinline__ float dpp_f(float v) {
  return __int_as_float(__builtin_amdgcn_update_dpp(0, __float_as_int(v), CTRL, 0xf, 0xf, true));
}
__device__ __forceinline__ float row16_max(float v) {
  v = fmaxf(v, dpp_f<0xB1>(v)); v = fmaxf(v, dpp_f<0x4E>(v)); v = fmaxf(v, dpp_f<0x141>(v)); v = fmaxf(v, dpp_f<0x140>(v)); return v;
}
__device__ __forceinline__ float row16_sum(float v) {
  v += dpp_f<0xB1>(v); v += dpp_f<0x4E>(v); v += dpp_f<0x141>(v); v += dpp_f<0x140>(v); return v;
}
__device__ __forceinline__ float wave_sum(float v) {
  v = row16_sum(v);
  const float a = __int_as_float(__builtin_amdgcn_readlane(__float_as_int(v), 0));
  const float b = __int_as_float(__builtin_amdgcn_readlane(__float_as_int(v), 16));
  const float c = __int_as_float(__builtin_amdgcn_readlane(__float_as_int(v), 32));
  const float d = __int_as_float(__builtin_amdgcn_readlane(__float_as_int(v), 48));
  return (a + b) + (c + d);
}
__device__ __forceinline__ void sincos_rev(float ang, float& s, float& c) {
  float rev = ang * 0.15915494309189535f;
  rev = rev - floorf(rev);
  s = __builtin_amdgcn_sinf(rev);
  c = __builtin_amdgcn_cosf(rev);
}
__device__ __forceinline__ float gelu_tanh(float x) {
  float y = 0.7978845608028654f * (x + 0.044715f * x * x * x);
  float t = 1.f - 2.f / (1.f + __expf(2.f * y));
  return 0.5f * x * (1.f + t);
}
__device__ __forceinline__ float gelu_erf(float x) { return 0.5f * x * (1.f + erff(x * 0.7071067811865476f)); }
__device__ __forceinline__ int logical_bid() {
  const int G = (int)gridDim.x, b = (int)blockIdx.x;
  return ((G & 7) == 0) ? ((b & 7) * (G >> 3) + (b >> 3)) : b;
}
__device__ __forceinline__ int rot_start(int vbase) {
  int G = (int)gridDim.x;
  int s = (logical_bid() - vbase) % G;
  if (s < 0) s += G;
  return s;
}

__device__ __forceinline__ void transpose_convert(int tid, unsigned char* smem, const float* __restrict__ src, bf16_t* __restrict__ dst, int K, int N, int& vbase, const float* __restrict__ kgain = nullptr) {
  float* tl = (float*)smem;
  const int tk = K / 64, tn = (N + 63) / 64;
  const int ntiles = tk * tn;
  for (int tile = rot_start(vbase); tile < ntiles; tile += gridDim.x) {
    const int k0 = (tile / tn) * 64, n0 = (tile % tn) * 64;
    __syncthreads();
#pragma unroll
    for (int i = 0; i < 2; ++i) {
      int r = (tid >> 4) + 32 * i, c4 = (tid & 15) * 4;
      float4 v = make_float4(0.f, 0.f, 0.f, 0.f);
      if (n0 + c4 < N) v = *(const float4*)(src + (size_t)(k0 + r) * N + n0 + c4);
      const float gk = kgain ? kgain[k0 + r] : 1.f;
      tl[r * 65 + c4 + 0] = v.x * gk; tl[r * 65 + c4 + 1] = v.y * gk; tl[r * 65 + c4 + 2] = v.z * gk; tl[r * 65 + c4 + 3] = v.w * gk;
    }
    __syncthreads();
    int n = tid >> 3, k8 = (tid & 7) * 8;
    if (n0 + n < N) {
      float x[8];
#pragma unroll
      for (int j = 0; j < 8; ++j) x[j] = tl[(k8 + j) * 65 + n];
      *(uint4*)(dst + (size_t)(n0 + n) * K + k0 + k8) = pack8(x);
    }
  }
  vbase += ntiles;
}

__device__ __forceinline__ void convert_plain(int tid, const float* __restrict__ src, bf16_t* __restrict__ dst, size_t n) {
  size_t i = ((size_t)blockIdx.x * NT + tid) * 8;
  const size_t stride = (size_t)gridDim.x * NT * 8;
  for (; i < n; i += stride) {
    float4 a = *(const float4*)(src + i), b = *(const float4*)(src + i + 4);
    uint4 v; v.x = pack2(a.x, a.y); v.y = pack2(a.z, a.w); v.z = pack2(b.x, b.y); v.w = pack2(b.z, b.w);
    *(uint4*)(dst + i) = v;
  }
}

template <int V> struct IC { static constexpr int value = V; };
template <int AMODE, class Epi>
__device__ __forceinline__ void gemm_run(int tid, unsigned char* smem, const void* A, const void* A2, int splitRow, int lda,
                                         const float* __restrict__ gain, const bf16_t* __restrict__ Bt,
                                         int M, int N, int K, int& vbase, Epi epi) {
  bf16_t* sA0 = (bf16_t*)smem;
  bf16_t* sB0 = sA0 + 128 * 72;
  bf16_t* sA1 = sB0 + 128 * 72;
  bf16_t* sB1 = sA1 + 128 * 72;
  float* sR = (float*)(sB1 + 128 * 72);
  float* sG = sR + 128;
  if (AMODE == 2) {
    __syncthreads();
    sG[tid] = gain[tid]; sG[tid + 512] = gain[tid + 512];
    __syncthreads();
  }
  const int lane = tid & 63, w = tid >> 6;
  const int l16 = lane & 15, quad = lane >> 4;
  const int wm = w >> 1, wn = w & 1;
  const int tilesN = (N + 127) / 128, tilesM = M / 128;
  const int ntiles = tilesM * tilesN;
  const int arow = tid >> 2, q4 = tid & 3;
  const int nk = K / 64;
  for (int tile = rot_start(vbase); tile < ntiles; tile += gridDim.x) {
    const int tm = tile / tilesN, tn = tile % tilesN;
    const int m0 = tm * 128, n0 = tn * 128;
    const int grow = m0 + arow;
    const unsigned char* aptr;
    if (AMODE == 0 || AMODE == 3) aptr = (grow < splitRow) ? (const unsigned char*)A + (size_t)grow * lda * 2 : (const unsigned char*)A2 + (size_t)(grow - splitRow) * lda * 2;
    else aptr = (grow < splitRow) ? (const unsigned char*)A + (size_t)grow * lda * 4 : (const unsigned char*)A2 + (size_t)(grow - splitRow) * lda * 4;
    const bool bvalid = (n0 + arow) < N;
    const bf16_t* bptr = Bt + (size_t)(n0 + arow) * K + q4 * 8;
    f32x4 acc[2][4];
#pragma unroll
    for (int i = 0; i < 2; ++i)
#pragma unroll
      for (int j = 0; j < 4; ++j) acc[i][j] = (f32x4){0.f, 0.f, 0.f, 0.f};
    float ss = 0.f;
    float4 af0[4], af1[4], af2[4], af3[4];
    uint4 ab0_0, ab0_1, ab1_0, ab1_1, ab2_0, ab2_1, ab3_0, ab3_1;
    uint4 bb0_0, bb0_1, bb1_0, bb1_1, bb2_0, bb2_1, bb3_0, bb3_1;
#define GLOAD(AF, AB, BB, KT) { \
      const int k0_ = (KT) * 64; \
      if (AMODE == 0 || AMODE == 3) { AB##_0 = *(const uint4*)(aptr + (size_t)(k0_ + q4 * 8) * 2); AB##_1 = *(const uint4*)(aptr + (size_t)(k0_ + 32 + q4 * 8) * 2); } \
      else { \
        _Pragma("unroll") for (int i = 0; i < 4; ++i) AF[i] = *(const float4*)(aptr + (size_t)(k0_ + 16 * i + q4 * 4) * 4); \
      } \
      if (bvalid) { BB##_0 = *(const uint4*)(bptr + k0_); BB##_1 = *(const uint4*)(bptr + k0_ + 32); } \
      else { BB##_0 = make_uint4(0, 0, 0, 0); BB##_1 = BB##_0; } }
#define LSTORE(AF, AB, BB, KT, sA, sB) { \
      if (AMODE == 0 || AMODE == 3) { \
        *(uint4*)(sA + arow * 72 + q4 * 8) = AB##_0; \
        *(uint4*)(sA + arow * 72 + 32 + q4 * 8) = AB##_1; \
        if (AMODE == 3) { \
          ss = __builtin_amdgcn_fdot2_f32_bf16(__builtin_bit_cast(bf16x2_t, AB##_0.x), __builtin_bit_cast(bf16x2_t, AB##_0.x), ss, false); \
          ss = __builtin_amdgcn_fdot2_f32_bf16(__builtin_bit_cast(bf16x2_t, AB##_0.y), __builtin_bit_cast(bf16x2_t, AB##_0.y), ss, false); \
          ss = __builtin_amdgcn_fdot2_f32_bf16(__builtin_bit_cast(bf16x2_t, AB##_0.z), __builtin_bit_cast(bf16x2_t, AB##_0.z), ss, false); \
          ss = __builtin_amdgcn_fdot2_f32_bf16(__builtin_bit_cast(bf16x2_t, AB##_0.w), __builtin_bit_cast(bf16x2_t, AB##_0.w), ss, false); \
          ss = __builtin_amdgcn_fdot2_f32_bf16(__builtin_bit_cast(bf16x2_t, AB##_1.x), __builtin_bit_cast(bf16x2_t, AB##_1.x), ss, false); \
          ss = __builtin_amdgcn_fdot2_f32_bf16(__builtin_bit_cast(bf16x2_t, AB##_1.y), __builtin_bit_cast(bf16x2_t, AB##_1.y), ss, false); \
          ss = __builtin_amdgcn_fdot2_f32_bf16(__builtin_bit_cast(bf16x2_t, AB##_1.z), __builtin_bit_cast(bf16x2_t, AB##_1.z), ss, false); \
          ss = __builtin_amdgcn_fdot2_f32_bf16(__builtin_bit_cast(bf16x2_t, AB##_1.w), __builtin_bit_cast(bf16x2_t, AB##_1.w), ss, false); \
        } \
      } else { \
        if (AMODE == 2) { \
          const float* gp = sG + (KT) * 64 + q4 * 4; \
          _Pragma("unroll") for (int i = 0; i < 4; ++i) { \
            float4 g = *(const float4*)(gp + 16 * i); \
            ss += AF[i].x * AF[i].x + AF[i].y * AF[i].y + AF[i].z * AF[i].z + AF[i].w * AF[i].w; \
            AF[i].x *= g.x; AF[i].y *= g.y; AF[i].z *= g.z; AF[i].w *= g.w; \
          } \
        } \
        *(uint2*)(sA + arow * 72 + q4 * 4) = make_uint2(pack2(AF[0].x, AF[0].y), pack2(AF[0].z, AF[0].w)); \
        *(uint2*)(sA + arow * 72 + 16 + q4 * 4) = make_uint2(pack2(AF[1].x, AF[1].y), pack2(AF[1].z, AF[1].w)); \
        *(uint2*)(sA + arow * 72 + 32 + q4 * 4) = make_uint2(pack2(AF[2].x, AF[2].y), pack2(AF[2].z, AF[2].w)); \
        *(uint2*)(sA + arow * 72 + 48 + q4 * 4) = make_uint2(pack2(AF[3].x, AF[3].y), pack2(AF[3].z, AF[3].w)); \
      } \
      *(uint4*)(sB + arow * 72 + q4 * 8) = BB##_0; \
      *(uint4*)(sB + arow * 72 + 32 + q4 * 8) = BB##_1; }
#define GCOMPUTE(sA, sB) { \
      _Pragma("unroll") for (int ks = 0; ks < 2; ++ks) { \
        bf16x8 a[2], b[4]; \
        _Pragma("unroll") for (int i = 0; i < 2; ++i) a[i] = *(const bf16x8*)(sA + (wm * 32 + i * 16 + l16) * 72 + ks * 32 + quad * 8); \
        _Pragma("unroll") for (int j = 0; j < 4; ++j) b[j] = *(const bf16x8*)(sB + (wn * 64 + j * 16 + l16) * 72 + ks * 32 + quad * 8); \
        _Pragma("unroll") for (int i = 0; i < 2; ++i) \
          _Pragma("unroll") for (int j = 0; j < 4; ++j) acc[i][j] = __builtin_amdgcn_mfma_f32_16x16x32_bf16(a[i], b[j], acc[i][j], 0, 0, 0); \
      } }
    __syncthreads();
    GLOAD(af0, ab0, bb0, 0);
    GLOAD(af1, ab1, bb1, 1);
    if (2 < nk) GLOAD(af2, ab2, bb2, 2);
    if (3 < nk) GLOAD(af3, ab3, bb3, 3);
    LSTORE(af0, ab0, bb0, 0, sA0, sB0);
    if (4 < nk) GLOAD(af0, ab0, bb0, 4);
    for (int kt = 0; kt < nk; kt += 4) {
      __syncthreads();
      LSTORE(af1, ab1, bb1, kt + 1, sA1, sB1);
      if (kt + 5 < nk) GLOAD(af1, ab1, bb1, kt + 5);
      GCOMPUTE(sA0, sB0);
      __syncthreads();
      if (kt + 2 < nk) { LSTORE(af2, ab2, bb2, kt + 2, sA0, sB0); if (kt + 6 < nk) GLOAD(af2, ab2, bb2, kt + 6); }
      GCOMPUTE(sA1, sB1);
      if (kt + 2 >= nk) break;
      __syncthreads();
      LSTORE(af3, ab3, bb3, kt + 3, sA1, sB1);
      if (kt + 7 < nk) GLOAD(af3, ab3, bb3, kt + 7);
      GCOMPUTE(sA0, sB0);
      __syncthreads();
      if (kt + 4 < nk) { LSTORE(af0, ab0, bb0, kt + 4, sA0, sB0); if (kt + 8 < nk) GLOAD(af0, ab0, bb0, kt + 8); }
      GCOMPUTE(sA1, sB1);
    }
    if (AMODE == 2 || AMODE == 3) {
      ss += __shfl_xor(ss, 1);
      ss += __shfl_xor(ss, 2);
      if ((tid & 3) == 0) sR[arow] = rsqrtf(ss / (float)K + 1e-6f);
      __syncthreads();
    }
    if (Epi::CHUNK) {
      float* sC = (float*)smem;
      __syncthreads();
#pragma unroll
      for (int i = 0; i < 2; ++i)
#pragma unroll
        for (int r = 0; r < 4; ++r) {
          const int rl = wm * 32 + i * 16 + quad * 4 + r;
          const float rs = (AMODE == 2 || AMODE == 3) ? sR[rl] : 1.f;
#pragma unroll
          for (int j = 0; j < 4; ++j) sC[rl * 132 + wn * 64 + j * 16 + l16] = acc[i][j][r] * rs;
        }
      __syncthreads();
      if (Epi::CHUNK == 1) {
#pragma unroll
        for (int it = 0; it < 4; ++it) {
          const int chunk = tid + it * 512;
          const int row = chunk >> 4, c8 = (chunk & 15) * 8;
          if (n0 + c8 < N) {
            const float4 v0 = *(const float4*)(sC + row * 132 + c8), v1 = *(const float4*)(sC + row * 132 + c8 + 4);
            const float v[8] = {v0.x, v0.y, v0.z, v0.w, v1.x, v1.y, v1.z, v1.w};
            epi.chunk(m0 + row, n0 + c8, v);
          }
        }
      } else {
#pragma unroll
        for (int it = 0; it < 4; ++it) {
          const int chunk = tid + it * 512;
          const int col = chunk & 127, r8 = (chunk >> 7) * 8;
          if (n0 + col < N) {
            float v[8];
#pragma unroll
            for (int i = 0; i < 8; ++i) v[i] = sC[(r8 + i) * 132 + col];
            epi.chunk(m0 + r8, n0 + col, v);
          }
        }
      }
    } else {
#pragma unroll
    for (int i = 0; i < 2; ++i)
#pragma unroll
      for (int r = 0; r < 4; ++r) {
        const int rl = wm * 32 + i * 16 + quad * 4 + r;
        const float rs = (AMODE == 2 || AMODE == 3) ? sR[rl] : 1.f;
#pragma unroll
        for (int j = 0; j < 4; ++j) {
          const int col = n0 + wn * 64 + j * 16 + l16;
          if (col < N) epi(m0 + rl, col, acc[i][j][r] * rs);
        }
      }
    }
  }
  vbase += ntiles;
}

struct AttnDesc {
  const bf16_t* q; int ldq; int active; int kt_lo, kt_hi; bf16_t* out; int ldo; float m0, l0; int pos0;
  const bf16_t* k; int ldk; const bf16_t* kx; const bf16_t* vt; int ldv; int vts; int nkeys; int bt_lo, bt_hi; float scale;
};

template <int DQK>
__device__ __forceinline__ void attn_item(int tid, unsigned char* smem, const AttnDesc& d) {
  constexpr int LDK = DQK + 8;
  bf16_t* sK = (bf16_t*)smem;
  bf16_t* sVt = sK + 64 * 104;
  bf16_t* sP = sVt + 64 * 72;
  const int lane = tid & 63, w = tid >> 6;
  const int l16 = lane & 15, quad = lane >> 4;
  bf16_t* sPw = sP + w * 16 * 72;
  bf16x8 qf[DQK / 32];
  if (d.active) {
#pragma unroll
    for (int ks = 0; ks < DQK / 32; ++ks) {
      const bf16_t* qp = d.q + (size_t)l16 * d.ldq + ks * 32 + quad * 8;
      uint4 v = *(const uint4*)qp;
      if (DQK == 96 && ks == 2) {
        const int pq = (quad < 2) ? 16 : -16;
        uint4 pv = *(const uint4*)(qp + pq);
        float x[8], y[8];
        unpack8(v, x); unpack8(pv, y);
        const float pos = (float)(d.pos0 + l16);
#pragma unroll
        for (int j = 0; j < 8; ++j) {
          const int f = (quad & 1) * 8 + j;
          float inv = exp2f(-(float)f * (LOG2_THETA / 16.f));
          float sn, cs; sincos_rev(pos * inv, sn, cs);
          x[j] = (quad < 2) ? (x[j] * cs - y[j] * sn) : (x[j] * cs + y[j] * sn);
        }
        v = pack8(x);
      }
      qf[ks] = *(bf16x8*)&v;
    }
  }
  f32x4 o[4];
#pragma unroll
  for (int i = 0; i < 4; ++i) o[i] = (f32x4){0.f, 0.f, 0.f, 0.f};
  float m[4], l[4];
#pragma unroll
  for (int r = 0; r < 4; ++r) { m[r] = d.m0; l[r] = d.l0; }

  const int key = tid >> 3, seg = tid & 7;
  const int key2 = (tid >> 2) & 63, seg2 = tid & 3;
  uint4 kv_r = make_uint4(0, 0, 0, 0), vv_r = kv_r, xv_r = kv_r;
  if (d.bt_lo < d.bt_hi) {
    kv_r = *(const uint4*)(d.k + (size_t)(d.bt_lo * 64 + key) * d.ldk + seg * 8);
    vv_r = *(const uint4*)(d.vt + (size_t)d.bt_lo * d.vts + (size_t)key * d.ldv + seg * 8);
    if (DQK == 96 && tid < 256) xv_r = *(const uint4*)(d.kx + (size_t)(d.bt_lo * 64 + key2) * 32 + seg2 * 8);
  }
  for (int kt = d.bt_lo; kt < d.bt_hi; ++kt) {
    __syncthreads();
    *(uint4*)(sK + key * LDK + seg * 8) = kv_r;
    *(uint4*)(sVt + key * 72 + seg * 8) = vv_r;
    if (DQK == 96 && tid < 256) *(uint4*)(sK + key2 * LDK + 64 + seg2 * 8) = xv_r;
    __syncthreads();
    if (kt + 1 < d.bt_hi) {
      kv_r = *(const uint4*)(d.k + (size_t)((kt + 1) * 64 + key) * d.ldk + seg * 8);
      vv_r = *(const uint4*)(d.vt + (size_t)(kt + 1) * d.vts + (size_t)key * d.ldv + seg * 8);
      if (DQK == 96 && tid < 256) xv_r = *(const uint4*)(d.kx + (size_t)((kt + 1) * 64 + key2) * 32 + seg2 * 8);
    }
    if (d.active && kt >= d.kt_lo && kt < d.kt_hi) {
      f32x4 s[4];
#pragma unroll
      for (int i = 0; i < 4; ++i) s[i] = (f32x4){0.f, 0.f, 0.f, 0.f};
#pragma unroll
      for (int ks = 0; ks < DQK / 32; ++ks)
#pragma unroll
        for (int nt = 0; nt < 4; ++nt) {
          bf16x8 b = *(const bf16x8*)(sK + (nt * 16 + l16) * LDK + ks * 32 + quad * 8);
          s[nt] = __builtin_amdgcn_mfma_f32_16x16x32_bf16(qf[ks], b, s[nt], 0, 0, 0);
        }
#pragma unroll
      for (int nt = 0; nt < 4; ++nt) {
        const bool valid = (kt * 64 + nt * 16 + l16) < d.nkeys;
#pragma unroll
        for (int r = 0; r < 4; ++r) s[nt][r] = valid ? s[nt][r] * d.scale : -1e30f;
      }
#pragma unroll
      for (int r = 0; r < 4; ++r) {
        float mx = fmaxf(fmaxf(s[0][r], s[1][r]), fmaxf(s[2][r], s[3][r]));
        mx = row16_max(mx);
        const float mnew = fmaxf(m[r], mx);
        const float alpha = __expf(m[r] - mnew);
        float p0 = __expf(s[0][r] - mnew), p1 = __expf(s[1][r] - mnew), p2 = __expf(s[2][r] - mnew), p3 = __expf(s[3][r] - mnew);
        float rs = p0 + p1 + p2 + p3;
        rs = row16_sum(rs);
        l[r] = l[r] * alpha + rs;
        m[r] = mnew;
#pragma unroll
        for (int dt = 0; dt < 4; ++dt) o[dt][r] *= alpha;
        bf16_t* pr = sPw + (quad * 4 + r) * 72 + l16;
        pr[0] = f2bf(p0); pr[16] = f2bf(p1); pr[32] = f2bf(p2); pr[48] = f2bf(p3);
      }
      asm volatile("s_waitcnt lgkmcnt(0)" ::: "memory");
#pragma unroll
      for (int ks = 0; ks < 2; ++ks) {
        bf16x8 a = *(const bf16x8*)(sPw + l16 * 72 + ks * 32 + quad * 8);
#pragma unroll
        for (int dt = 0; dt < 4; ++dt) {
          bf16x8 b = *(const bf16x8*)(sVt + (dt * 16 + l16) * 72 + ks * 32 + quad * 8);
          o[dt] = __builtin_amdgcn_mfma_f32_16x16x32_bf16(a, b, o[dt], 0, 0, 0);
        }
      }
      asm volatile("s_waitcnt lgkmcnt(0)" ::: "memory");
    }
  }
  if (d.active) {
#pragma unroll
    for (int r = 0; r < 4; ++r) {
      const float il = 1.f / l[r];
#pragma unroll
      for (int dt = 0; dt < 4; ++dt) d.out[(size_t)(quad * 4 + r) * d.ldo + dt * 16 + l16] = f2bf(o[dt][r] * il);
    }
  }
}

template <int MODE>
__device__ __forceinline__ void s5_item(int tid, float* sUw, const Params& p, int item) {
  const int lane = tid & 63;
  const bf16_t* proj = (const bf16_t*)(p.ws + OFF_PROJ);
  int b, chunk, g, tok0; bool isS;
  if (item < 32768) { isS = false; g = item & 31; chunk = (item >> 5) & 127; b = item >> 12; tok0 = b * 4096 + chunk * 32; }
  else { isS = true; int it = item - 32768; g = it & 31; b = it >> 5; chunk = 0; tok0 = T_P + b * 32; }
  const int n = lane;
  const int gn = g * 64 + n;
  const float lr = fminf(p.in[15][gn], -1e-4f), li = p.in[16][gn];
  const float dt = __expf(p.in[17][g]);
  const float mag = __expf(lr * dt);
  float sn, cs; sincos_rev(li * dt, sn, cs);
  const float abr = mag * cs, abi = mag * sn;
  const float den = lr * lr + li * li;
  const float nr = abr - 1.f, ni = abi;
  const float fre = (nr * lr + ni * li) / den, fim = (ni * lr - nr * li) / den;
  float2_t bb2[16];
  {
    const float4* br4 = (const float4*)(p.in[18] + (size_t)gn * 16);
    const float4* bi4 = (const float4*)(p.in[19] + (size_t)gn * 16);
#pragma unroll
    for (int i = 0; i < 4; ++i) {
      float4 r4 = br4[i], i4 = bi4[i];
      bb2[4 * i + 0] = (float2_t){fre * r4.x - fim * i4.x, fre * i4.x + fim * r4.x};
      bb2[4 * i + 1] = (float2_t){fre * r4.y - fim * i4.y, fre * i4.y + fim * r4.y};
      bb2[4 * i + 2] = (float2_t){fre * r4.z - fim * i4.z, fre * i4.z + fim * r4.z};
      bb2[4 * i + 3] = (float2_t){fre * r4.w - fim * i4.w, fre * i4.w + fim * r4.w};
    }
  }
  {
    const int t = lane >> 1, c8 = (lane & 1) * 8;
    uint4 uv = *(const uint4*)(proj + (size_t)(tok0 + t) * 1280 + 768 + g * 16 + c8);
    float x[8]; unpack8(uv, x);
    *(float4*)(sUw + t * 16 + c8) = make_float4(x[0], x[1], x[2], x[3]);
    *(float4*)(sUw + t * 16 + c8 + 4) = make_float4(x[4], x[5], x[6], x[7]);
  }
  asm volatile("s_waitcnt lgkmcnt(0)" ::: "memory");
  float hr = 0.f, hi = 0.f;
  if (MODE == 0) {
#pragma unroll 4
    for (int t = 0; t < 32; ++t) {
      float uu[16];
#pragma unroll
      for (int i = 0; i < 4; ++i) { float4 v = *(const float4*)(sUw + t * 16 + 4 * i); uu[4 * i] = v.x; uu[4 * i + 1] = v.y; uu[4 * i + 2] = v.z; uu[4 * i + 3] = v.w; }
      float2_t bu2 = {0.f, 0.f};
#pragma unroll
      for (int c = 0; c < 16; ++c) bu2 += bb2[c] * (float2_t){uu[c], uu[c]};
      const float nhr = abr * hr - abi * hi + bu2.x, nhi = abr * hi + abi * hr + bu2.y;
      hr = nhr; hi = nhi;
    }
    float* s1re = (float*)(p.ws + OFF_QMLA);
    float* s1im = s1re + 2097152;
    const size_t idx = ((size_t)(b * 128 + chunk) * 32 + g) * 64 + n;
    s1re[idx] = hr; s1im[idx] = hi;
    asm volatile("s_waitcnt lgkmcnt(0)" ::: "memory");
    return;
  } else {
    float2_t cr2[8], ci2[8];
#pragma unroll
    for (int c = 0; c < 8; ++c) {
      cr2[c] = (float2_t){p.in[20][(size_t)(g * 16 + 2 * c) * 64 + n], p.in[20][(size_t)(g * 16 + 2 * c + 1) * 64 + n]};
      ci2[c] = (float2_t){p.in[21][(size_t)(g * 16 + 2 * c) * 64 + n], p.in[21][(size_t)(g * 16 + 2 * c + 1) * 64 + n]};
    }
    if (isS) { hr = p.in[4][(size_t)(b * 32 + g) * 64 + n]; hi = p.in[5][(size_t)(b * 32 + g) * 64 + n]; }
    else {
      const float* hinre = (const float*)(p.ws + OFF_QMLA) + 2 * 2097152;
      const float* hinim = hinre + 2097152;
      const size_t idx = ((size_t)(b * 128 + chunk) * 32 + g) * 64 + n;
      hr = hinre[idx]; hi = hinim[idx];
    }
    const int b0 = lane & 1, b1 = (lane >> 1) & 1, b2 = (lane >> 2) & 1, b3 = (lane >> 3) & 1;
    const int cc = b0 * 8 + b1 * 4 + b2 * 2 + b3;
    const int quad = lane >> 4;
    const float dsk = p.in[22][g * 16 + cc];
    bf16_t* zbuf = (bf16_t*)(p.ws + OFF_Z);
    float zkeep = 0.f;
#pragma unroll 2
    for (int t = 0; t < 32; ++t) {
      float uu[16];
#pragma unroll
      for (int i = 0; i < 4; ++i) { float4 v = *(const float4*)(sUw + t * 16 + 4 * i); uu[4 * i] = v.x; uu[4 * i + 1] = v.y; uu[4 * i + 2] = v.z; uu[4 * i + 3] = v.w; }
      float2_t bu2 = {0.f, 0.f};
#pragma unroll
      for (int c = 0; c < 16; ++c) bu2 += bb2[c] * (float2_t){uu[c], uu[c]};
      const float nhr = abr * hr - abi * hi + bu2.x, nhi = abr * hi + abi * hr + bu2.y;
      hr = nhr; hi = nhi;
      float v16[16];
#pragma unroll
      for (int c = 0; c < 8; ++c) {
        const float2_t vv = cr2[c] * (float2_t){hr, hr} - ci2[c] * (float2_t){hi, hi};
        v16[2 * c] = vv.x; v16[2 * c + 1] = vv.y;
      }
      float v8[8], v4[4], v2[2], v1;
#pragma unroll
      for (int i = 0; i < 8; ++i) { float keep = b0 ? v16[8 + i] : v16[i]; float send = b0 ? v16[i] : v16[8 + i]; v8[i] = keep + __shfl_xor(send, 1); }
#pragma unroll
      for (int i = 0; i < 4; ++i) { float keep = b1 ? v8[4 + i] : v8[i]; float send = b1 ? v8[i] : v8[4 + i]; v4[i] = keep + __shfl_xor(send, 2); }
#pragma unroll
      for (int i = 0; i < 2; ++i) { float keep = b2 ? v4[2 + i] : v4[i]; float send = b2 ? v4[i] : v4[2 + i]; v2[i] = keep + __shfl_xor(send, 4); }
      { float keep = b3 ? v2[1] : v2[0]; float send = b3 ? v2[0] : v2[1]; v1 = keep + __shfl_xor(send, 8); }
      v1 += __shfl_xor(v1, 16);
      v1 += __shfl_xor(v1, 32);
      const float y = v1 + dsk * sUw[t * 16 + cc];
      const float z = gelu_tanh(y);
      if (quad == (t & 3)) zkeep = z;
      if ((t & 3) == 3) zbuf[(size_t)(tok0 + t - 3 + quad) * 512 + g * 16 + cc] = f2bf(zkeep);
    }
    if (isS) {
      p.out[O_SSMRE_S + (size_t)(b * 32 + g) * 64 + n] = hr;
      p.out[O_SSMIM_S + (size_t)(b * 32 + g) * 64 + n] = hi;
    }
    asm volatile("s_waitcnt lgkmcnt(0)" ::: "memory");
  }
}

#define TAB_V_OFF 16777216ull
#define TAB_SU_OFF 33554432ull
#define TAB_SV_OFF (33554432ull + 65536ull)
__device__ __forceinline__ void quant_rows(const float* __restrict__ src, unsigned char* __restrict__ dst, float* __restrict__ scales, int gw, int nw, int tid) {
  const int lane = tid & 63;
  for (int row = gw; row < 16384; row += nw) {
    const float* r = src + (size_t)row * 1024 + lane * 16;
    float x[16];
#pragma unroll
    for (int i = 0; i < 4; ++i) { float4 v = *(const float4*)(r + 4 * i); x[4 * i] = v.x; x[4 * i + 1] = v.y; x[4 * i + 2] = v.z; x[4 * i + 3] = v.w; }
    float am = 0.f;
#pragma unroll
    for (int i = 0; i < 16; ++i) am = fmaxf(am, fabsf(x[i]));
#pragma unroll
    for (int o = 32; o; o >>= 1) am = fmaxf(am, __shfl_xor(am, o));
    const float inv = (am > 0.f) ? 127.f / am : 0.f;
    unsigned q[4];
#pragma unroll
    for (int i = 0; i < 4; ++i) {
      unsigned b0 = (unsigned)((int)rintf(x[4 * i] * inv)) & 255u, b1 = (unsigned)((int)rintf(x[4 * i + 1] * inv)) & 255u;
      unsigned b2 = (unsigned)((int)rintf(x[4 * i + 2] * inv)) & 255u, b3 = (unsigned)((int)rintf(x[4 * i + 3] * inv)) & 255u;
      q[i] = b0 | (b1 << 8) | (b2 << 16) | (b3 << 24);
    }
    *(uint4*)(dst + (size_t)(lane >> 3) * 2097152 + (size_t)row * 128 + (lane & 7) * 16) = make_uint4(q[0], q[1], q[2], q[3]);
    if (lane == 0) scales[row] = am * (1.f / 127.f);
  }
}

__device__ __forceinline__ float ub0(unsigned u) { return (float)(u & 0xffu); }
__device__ __forceinline__ float ub1(unsigned u) { return (float)((u >> 8) & 0xffu); }
__device__ __forceinline__ float ub2(unsigned u) { return (float)((u >> 16) & 0xffu); }
__device__ __forceinline__ float ub3(unsigned u) { return (float)(u >> 24); }
__device__ __forceinline__ float dot16(const float* xn, uint4 u) {
  float d = 0.f;
  d += xn[0] * ub0(u.x); d += xn[1] * ub1(u.x); d += xn[2] * ub2(u.x); d += xn[3] * ub3(u.x);
  d += xn[4] * ub0(u.y); d += xn[5] * ub1(u.y); d += xn[6] * ub2(u.y); d += xn[7] * ub3(u.y);
  d += xn[8] * ub0(u.z); d += xn[9] * ub1(u.z); d += xn[10] * ub2(u.z); d += xn[11] * ub3(u.z);
  d += xn[12] * ub0(u.w); d += xn[13] * ub1(u.w); d += xn[14] * ub2(u.w); d += xn[15] * ub3(u.w);
  return d;
}
__device__ __forceinline__ void axpy16(float* acc, float a, uint4 u) {
  acc[0] += a * ub0(u.x); acc[1] += a * ub1(u.x); acc[2] += a * ub2(u.x); acc[3] += a * ub3(u.x);
  acc[4] += a * ub0(u.y); acc[5] += a * ub1(u.y); acc[6] += a * ub2(u.y); acc[7] += a * ub3(u.y);
  acc[8] += a * ub0(u.z); acc[9] += a * ub1(u.z); acc[10] += a * ub2(u.z); acc[11] += a * ub3(u.z);
  acc[12] += a * ub0(u.w); acc[13] += a * ub1(u.w); acc[14] += a * ub2(u.w); acc[15] += a * ub3(u.w);
}

template <bool FINAL, bool DRY>
__device__ __forceinline__ void peer_token(int tid, const Params& p, int layer, int tok) {
  const int lane = tid & 63;
  float* xres = p.out + O_Y;
  const float* gain = p.in[10] + layer * 1024;
  const unsigned char* U = p.ws + OFF_TAB;
  const unsigned char* V = U + TAB_V_OFF;
  const int* ebuf = (const int*)(p.ws + OFF_M);
  const float* gbuf = (const float*)(p.ws + OFF_M + 17301504ull);
  const float* sus = (const float*)(p.ws + OFF_TAB + TAB_SU_OFF);
  const float* svs = (const float*)(p.ws + OFF_TAB + TAB_SV_OFF);
  float* xr = xres + (size_t)tok * 1024 + lane * 16;
  float x[16], xn[16], acc[16];
  float ss = 0.f, sx = 0.f;
#pragma unroll
  for (int i = 0; i < 4; ++i) {
    float4 v = *(const float4*)(xr + 4 * i);
    float4 g = *(const float4*)(gain + lane * 16 + 4 * i);
    x[4 * i] = v.x; x[4 * i + 1] = v.y; x[4 * i + 2] = v.z; x[4 * i + 3] = v.w;
    xn[4 * i] = v.x * g.x; xn[4 * i + 1] = v.y * g.y; xn[4 * i + 2] = v.z * g.z; xn[4 * i + 3] = v.w * g.w;
    ss += v.x * v.x + v.y * v.y + v.z * v.z + v.w * v.w;
    sx += xn[4 * i] + xn[4 * i + 1] + xn[4 * i + 2] + xn[4 * i + 3];
  }
  ss = wave_sum(ss);
  sx = wave_sum(sx);
  const float rstd = rsqrtf(ss * (1.f / 1024.f) + 1e-6f);
#pragma unroll
  for (int i = 0; i < 16; ++i) acc[i] = 0.f;
  float sumA = 0.f;
  const int b0 = lane & 1, b1 = (lane >> 1) & 1, b2 = (lane >> 2) & 1;
  const int pe = b0 * 4 + b1 * 2 + b2;
  const size_t pbase = (size_t)tok * 128 + pe;
#pragma unroll 1
  for (int kb = 0; kb < 16; ++kb) {
    const int myeid = ebuf[pbase + kb * 8];
    const float myg = gbuf[pbase + kb * 8] * svs[myeid];
    const float mysu = sus[myeid];
    uint4 uu[8], vv[8];
#pragma unroll
    for (int j = 0; j < 8; ++j) {
      const int src = ((j & 1) << 2) | (j & 2) | ((j >> 2) & 1);
      const int eid = __builtin_amdgcn_readlane(myeid, src);
      uu[j] = *(const uint4*)(U + (size_t)eid * 1024 + lane * 16);
      vv[j] = *(const uint4*)(V + (size_t)eid * 1024 + lane * 16);
    }
    float d[8];
#pragma unroll
    for (int j = 0; j < 8; ++j) d[j] = dot16(xn, uu[j]);
    float w4[4], w2[2], w1;
#pragma unroll
    for (int i = 0; i < 4; ++i) { float keep = b0 ? d[4 + i] : d[i]; float send = b0 ? d[i] : d[4 + i]; w4[i] = keep + __shfl_xor(send, 1); }
#pragma unroll
    for (int i = 0; i < 2; ++i) { float keep = b1 ? w4[2 + i] : w4[i]; float send = b1 ? w4[i] : w4[2 + i]; w2[i] = keep + __shfl_xor(send, 2); }
    { float keep = b2 ? w2[1] : w2[0]; float send = b2 ? w2[0] : w2[1]; w1 = keep + __shfl_xor(send, 4); }
    w1 += __shfl_xor(w1, 8); w1 += __shfl_xor(w1, 16); w1 += __shfl_xor(w1, 32);
    const float dot = rstd * mysu * (w1 - 128.f * sx);
    const float a = gelu_erf(dot) * myg;
#pragma unroll
    for (int j = 0; j < 8; ++j) {
      const int src = ((j & 1) << 2) | (j & 2) | ((j >> 2) & 1);
      const float A = __int_as_float(__builtin_amdgcn_readlane(__float_as_int(a), src));
      sumA += A;
      axpy16(acc, A, vv[j]);
    }
  }
  float y[16];
#pragma unroll
  for (int i = 0; i < 16; ++i) y[i] = x[i] + acc[i] - 128.f * sumA;
  if (FINAL) {
    float s2 = 0.f;
#pragma unroll
    for (int i = 0; i < 16; ++i) s2 += y[i] * y[i];
    s2 = wave_sum(s2);
    const float r2 = rsqrtf(s2 * (1.f / 1024.f) + 1e-6f);
    const float* gf = p.in[11] + lane * 16;
#pragma unroll
    for (int i = 0; i < 4; ++i) {
      float4 g = *(const float4*)(gf + 4 * i);
      y[4 * i] *= r2 * g.x; y[4 * i + 1] *= r2 * g.y; y[4 * i + 2] *= r2 * g.z; y[4 * i + 3] *= r2 * g.w;
    }
  }
  if (DRY && ss != -1.f) return;
#pragma unroll
  for (int i = 0; i < 4; ++i) *(float4*)(xr + 4 * i) = make_float4(y[4 * i], y[4 * i + 1], y[4 * i + 2], y[4 * i + 3]);
}

#define OFF_PD OFF_MIX
#define OFF_PSS OFF_KP
#define OFF_PSX (OFF_KP + 1081344ull)
template <int CTRL> __device__ __forceinline__ int dpp_i(int v) { return __builtin_amdgcn_update_dpp(0, v, CTRL, 0xf, 0xf, true); }
__device__ __forceinline__ unsigned packq4(float a, float b, float c, float d, float inv) {
  const unsigned q0 = (unsigned)((int)rintf(a * inv)) & 255u, q1 = (unsigned)((int)rintf(b * inv)) & 255u;
  const unsigned q2 = (unsigned)((int)rintf(c * inv)) & 255u, q3 = (unsigned)((int)rintf(d * inv));
  return q0 | (q1 << 8) | (q2 << 16) | (q3 << 24);
}
__device__ __forceinline__ void peer9a_token(int tid, const Params& p, int layer, int tok, int j) {
  const int lane = tid & 63, g8 = lane >> 3, sub = lane & 7;
  const float* xr = p.out + O_Y + (size_t)tok * 1024 + j * 128 + sub * 16;
  const float* gn = p.in[10] + layer * 1024 + j * 128 + sub * 16;
  const unsigned char* U = p.ws + OFF_TAB + (size_t)j * 2097152 + sub * 16;
  const int* eb = (const int*)(p.ws + OFF_M) + (size_t)tok * 128 + g8;
  float* pd = (float*)(p.ws + OFF_PD) + ((size_t)tok * 8 + j) * 128;
  int eid[16];
#pragma unroll
  for (int k = 0; k < 16; ++k) eid[k] = eb[k * 8];
  float xs[16];
  float ss = 0.f, am = 0.f;
#pragma unroll
  for (int i = 0; i < 4; ++i) {
    float4 v = *(const float4*)(xr + 4 * i);
    float4 g = *(const float4*)(gn + 4 * i);
    xs[4 * i] = v.x * g.x; xs[4 * i + 1] = v.y * g.y; xs[4 * i + 2] = v.z * g.z; xs[4 * i + 3] = v.w * g.w;
    ss += v.x * v.x + v.y * v.y + v.z * v.z + v.w * v.w;
    am = fmaxf(fmaxf(am, fmaxf(fabsf(xs[4 * i]), fabsf(xs[4 * i + 1]))), fmaxf(fabsf(xs[4 * i + 2]), fabsf(xs[4 * i + 3])));
  }
  uint4 rows[16];
#pragma unroll
  for (int k = 0; k < 16; ++k) rows[k] = *(const uint4*)(U + (size_t)eid[k] * 128);
  am = fmaxf(am, dpp_f<0xB1>(am)); am = fmaxf(am, dpp_f<0x4E>(am)); am = fmaxf(am, dpp_f<0x141>(am));
  const float inv = (am > 0.f) ? 127.f / am : 0.f;
  const float xscale = am * (1.f / 127.f);
  int xq[4];
#pragma unroll
  for (int d = 0; d < 4; ++d) xq[d] = (int)packq4(xs[4 * d], xs[4 * d + 1], xs[4 * d + 2], xs[4 * d + 3], inv);
  int keep0 = 0, keep1 = 0;
#pragma unroll
  for (int k = 0; k < 16; ++k) {
    int D = __builtin_amdgcn_sdot4((int)rows[k].x, xq[0], 0, false);
    D = __builtin_amdgcn_sdot4((int)rows[k].y, xq[1], D, false);
    D = __builtin_amdgcn_sdot4((int)rows[k].z, xq[2], D, false);
    D = __builtin_amdgcn_sdot4((int)rows[k].w, xq[3], D, false);
    D += dpp_i<0xB1>(D); D += dpp_i<0x4E>(D); D += dpp_i<0x141>(D);
    if (k < 8) keep0 = (sub == k) ? D : keep0; else keep1 = (sub == k - 8) ? D : keep1;
  }
  pd[sub * 8 + g8] = (float)keep0 * xscale;
  pd[64 + sub * 8 + g8] = (float)keep1 * xscale;
  ss += dpp_f<0xB1>(ss); ss += dpp_f<0x4E>(ss); ss += dpp_f<0x141>(ss);
  if (lane == 0) ((float*)(p.ws + OFF_PSS))[(size_t)tok * 8 + j] = ss;
}

__device__ __forceinline__ void peer9m_token(int tid, unsigned char* smem, const Params& p, int tok) {
  const int lane = tid & 63, w = __builtin_amdgcn_readfirstlane(tid >> 6);
  unsigned char* sAq = smem + w * 128;
  const float* pd = (const float*)(p.ws + OFF_PD) + (size_t)tok * 1024;
  float* pss = (float*)(p.ws + OFF_PSS) + (size_t)tok * 8;
  const int* ebuf = (const int*)(p.ws + OFF_M) + (size_t)tok * 128;
  float* gbuf = (float*)(p.ws + OFF_M + 17301504ull) + (size_t)tok * 128;
  const float* sus = (const float*)(p.ws + OFF_TAB + TAB_SU_OFF);
  const float* svs = (const float*)(p.ws + OFF_TAB + TAB_SV_OFF);
  float ss = 0.f, d0 = 0.f, d1 = 0.f;
#pragma unroll
  for (int j = 0; j < 8; ++j) { ss += pss[j]; d0 += pd[j * 128 + lane]; d1 += pd[j * 128 + 64 + lane]; }
  const int e0 = ebuf[lane], e1 = ebuf[64 + lane];
  const float rstd = rsqrtf(ss * (1.f / 1024.f) + 1e-6f);
  const float a0 = gelu_erf(rstd * sus[e0] * d0) * gbuf[lane] * svs[e0];
  const float a1 = gelu_erf(rstd * sus[e1] * d1) * gbuf[64 + lane] * svs[e1];
  float am = row16_max(fmaxf(fabsf(a0), fabsf(a1)));
  {
    const float m0 = __int_as_float(__builtin_amdgcn_readlane(__float_as_int(am), 0)), m1 = __int_as_float(__builtin_amdgcn_readlane(__float_as_int(am), 16));
    const float m2 = __int_as_float(__builtin_amdgcn_readlane(__float_as_int(am), 32)), m3 = __int_as_float(__builtin_amdgcn_readlane(__float_as_int(am), 48));
    am = fmaxf(fmaxf(m0, m1), fmaxf(m2, m3));
  }
  const float inv = (am > 0.f) ? 127.f / am : 0.f;
  const int addr0 = (lane & 7) * 16 + (lane >> 3);
  sAq[addr0] = (unsigned char)((int)rintf(a0 * inv) & 255);
  sAq[addr0 + 8] = (unsigned char)((int)rintf(a1 * inv) & 255);
  asm volatile("s_waitcnt lgkmcnt(0)" ::: "memory");
  unsigned pk = 0u;
  if (lane < 32) pk = ((const unsigned*)sAq)[lane];
  asm volatile("s_waitcnt vmcnt(0) lgkmcnt(0)" ::: "memory");
  if (lane < 32) ((unsigned*)gbuf)[lane] = pk;
  if (lane == 0) pss[0] = am * (1.f / 127.f);
  asm volatile("s_waitcnt lgkmcnt(0)" ::: "memory");
}

__device__ __forceinline__ void peer9b_token(int tid, const Params& p, int tok, int j) {
  const int lane = tid & 63, g8 = lane >> 3, sub = lane & 7;
  float* xr = p.out + O_Y + (size_t)tok * 1024 + j * 128 + sub * 16;
  const unsigned char* V = p.ws + OFF_TAB + TAB_V_OFF + (size_t)j * 2097152 + sub * 16;
  const int* eb = (const int*)(p.ws + OFF_M) + (size_t)tok * 128 + g8;
  const uint4 apk = *(const uint4*)((const unsigned*)(p.ws + OFF_M + 17301504ull) + (size_t)tok * 128 + g8 * 4);
  const float scaleA = ((const float*)(p.ws + OFF_PSS))[(size_t)tok * 8];
  int eid[16];
#pragma unroll
  for (int k = 0; k < 16; ++k) eid[k] = eb[k * 8];
  uint4 rows[16];
#pragma unroll
  for (int k = 0; k < 16; ++k) rows[k] = *(const uint4*)(V + (size_t)eid[k] * 128);
  int acci[16];
#pragma unroll
  for (int i = 0; i < 16; ++i) acci[i] = 0;
#define P9B_DW(DWF, DW, AP, KQ) { \
    const unsigned r0 = rows[(KQ) * 4 + 0].DWF, r1 = rows[(KQ) * 4 + 1].DWF, r2 = rows[(KQ) * 4 + 2].DWF, r3 = rows[(KQ) * 4 + 3].DWF; \
    const unsigned t0 = __builtin_amdgcn_perm(r1, r0, 0x05010400u), t1 = __builtin_amdgcn_perm(r1, r0, 0x07030602u); \
    const unsigned t2 = __builtin_amdgcn_perm(r3, r2, 0x05010400u), t3 = __builtin_amdgcn_perm(r3, r2, 0x07030602u); \
    acci[(DW) * 4 + 0] = __builtin_amdgcn_sdot4((int)__builtin_amdgcn_perm(t2, t0, 0x05040100u), (int)(AP), acci[(DW) * 4 + 0], false); \
    acci[(DW) * 4 + 1] = __builtin_amdgcn_sdot4((int)__builtin_amdgcn_perm(t2, t0, 0x07060302u), (int)(AP), acci[(DW) * 4 + 1], false); \
    acci[(DW) * 4 + 2] = __builtin_amdgcn_sdot4((int)__builtin_amdgcn_perm(t3, t1, 0x05040100u), (int)(AP), acci[(DW) * 4 + 2], false); \
    acci[(DW) * 4 + 3] = __builtin_amdgcn_sdot4((int)__builtin_amdgcn_perm(t3, t1, 0x07060302u), (int)(AP), acci[(DW) * 4 + 3], false); }
#define P9B_KQ(AP, KQ) { P9B_DW(x, 0, AP, KQ) P9B_DW(y, 1, AP, KQ) P9B_DW(z, 2, AP, KQ) P9B_DW(w, 3, AP, KQ) }
  P9B_KQ(apk.x, 0) P9B_KQ(apk.y, 1) P9B_KQ(apk.z, 2) P9B_KQ(apk.w, 3)
  float acc[16];
#pragma unroll
  for (int i = 0; i < 16; ++i) acc[i] = (float)acci[i] * scaleA;
  const int b3 = (lane >> 3) & 1, b4 = (lane >> 4) & 1, b5 = (lane >> 5) & 1;
  float v8[8], v4[4], v2[2];
#pragma unroll
  for (int i = 0; i < 8; ++i) { float keep = b3 ? acc[8 + i] : acc[i]; float send = b3 ? acc[i] : acc[8 + i]; v8[i] = keep + dpp_f<0x128>(send); }
#pragma unroll
  for (int i = 0; i < 4; ++i) { float keep = b4 ? v8[4 + i] : v8[i]; float send = b4 ? v8[i] : v8[4 + i]; v4[i] = keep + __shfl_xor(send, 16); }
#pragma unroll
  for (int i = 0; i < 2; ++i) { float keep = b5 ? v4[2 + i] : v4[i]; float send = b5 ? v4[i] : v4[2 + i]; v2[i] = keep + __shfl_xor(send, 32); }
  const int c = b3 * 8 + b4 * 4 + b5 * 2;
  float2 xv = *(const float2*)(xr + c);
  xv.x += v2[0];
  xv.y += v2[1];
  *(float2*)(xr + c) = xv;
  *(unsigned*)((bf16_t*)(p.ws + OFF_XB) + (size_t)tok * 1024 + j * 128 + sub * 16 + c) = pack2(xv.x, xv.y);
}

__device__ __forceinline__ void final_norm_token(int tid, const Params& p, int tok) {
  const int lane = tid & 63;
  float* xr = p.out + O_Y + (size_t)tok * 1024 + lane * 16;
  const float* gf = p.in[11] + lane * 16;
  float y[16]; float s2 = 0.f;
#pragma unroll
  for (int i = 0; i < 4; ++i) { float4 v = *(const float4*)(xr + 4 * i); y[4 * i] = v.x; y[4 * i + 1] = v.y; y[4 * i + 2] = v.z; y[4 * i + 3] = v.w; s2 += v.x * v.x + v.y * v.y + v.z * v.z + v.w * v.w; }
  s2 = wave_sum(s2);
  const float r2 = rsqrtf(s2 * (1.f / 1024.f) + 1e-6f);
#pragma unroll
  for (int i = 0; i < 4; ++i) {
    float4 g = *(const float4*)(gf + 4 * i);
    *(float4*)(xr + 4 * i) = make_float4(y[4 * i] * r2 * g.x, y[4 * i + 1] * r2 * g.y, y[4 * i + 2] * r2 * g.z, y[4 * i + 3] * r2 * g.w);
  }
}

__device__ __forceinline__ unsigned f2ukey(float v) { unsigned u = __float_as_uint(v); return (u & 0x80000000u) ? ~u : (u | 0x80000000u); }
__device__ __forceinline__ float ukey2f(unsigned k) { unsigned u = (k & 0x80000000u) ? (k & 0x7fffffffu) : ~k; return __uint_as_float(u); }
__device__ __forceinline__ int popc64(unsigned long long m) { return __builtin_popcountll(m); }
__device__ __forceinline__ int mbcnt64(unsigned long long m) { return (int)__builtin_amdgcn_mbcnt_hi((unsigned)(m >> 32), __builtin_amdgcn_mbcnt_lo((unsigned)m, 0u)); }

struct TopkFrags { bf16x8 a[2][2]; bf16x8 b[2][2]; };
__device__ __forceinline__ void topk_load(TopkFrags& f, int tid, const Params& p, int layer, int item) {
  const int lane = tid & 63, w = __builtin_amdgcn_readfirstlane(tid >> 6);
  const int l16 = lane & 15, quad = lane >> 4;
  const int h = item & 7, tok0 = (item >> 3) * 32;
  const int pp = w >> 2;
  const bf16_t* qb = (const bf16_t*)(p.ws + OFF_QBUF);
  const bf16_t* keys = (const bf16_t*)(p.ws + OFF_WT) + WT_KEYS + (size_t)((layer * 8 + h) * 2 + pp) * 8192;
#pragma unroll
  for (int ks = 0; ks < 2; ++ks) {
#pragma unroll
    for (int mt = 0; mt < 2; ++mt) f.a[ks][mt] = *(const bf16x8*)(qb + (size_t)(tok0 + mt * 16 + l16) * 1024 + h * 128 + pp * 64 + ks * 32 + quad * 8);
#pragma unroll
    for (int j = 0; j < 2; ++j) {
      const int nt = (w & 3) * 2 + j;
      f.b[ks][j] = *(const bf16x8*)(keys + (nt * 16 + l16) * 64 + ks * 32 + quad * 8);
    }
  }
}

__device__ __forceinline__ void peer_topk_item(int tid, unsigned char* smem, const Params& p, const TopkFrags& f, int item) {
  unsigned* sS = (unsigned*)smem;
  const int lane = tid & 63, w = __builtin_amdgcn_readfirstlane(tid >> 6);
  const int l16 = lane & 15, quad = lane >> 4;
  const int h = item & 7, tile = item >> 3;
  const int tok0 = tile * 32;
  unsigned* wtop = (unsigned*)(smem + 32768) + w * 256;
  float* wexp = (float*)(wtop + 128);
  __syncthreads();
  {
    const int pp = w >> 2;
    f32x4 acc[2][2];
#pragma unroll
    for (int i = 0; i < 2; ++i)
#pragma unroll
      for (int j = 0; j < 2; ++j) acc[i][j] = (f32x4){0.f, 0.f, 0.f, 0.f};
#pragma unroll
    for (int ks = 0; ks < 2; ++ks)
#pragma unroll
      for (int mt = 0; mt < 2; ++mt)
#pragma unroll
        for (int j = 0; j < 2; ++j) acc[mt][j] = __builtin_amdgcn_mfma_f32_16x16x32_bf16(f.a[ks][mt], f.b[ks][j], acc[mt][j], 0, 0, 0);
#pragma unroll
    for (int mt = 0; mt < 2; ++mt)
#pragma unroll
      for (int j = 0; j < 2; ++j) {
        const int nt = (w & 3) * 2 + j;
#pragma unroll
        for (int r = 0; r < 4; ++r) {
          const int key = nt * 16 + l16;
          sS[((mt * 16 + quad * 4 + r) * 2 + pp) * 128 + key] = (f2ukey(acc[mt][j][r]) & ~127u) | (unsigned)(127 - key);
        }
      }
  }
  __syncthreads();
  int* ebuf = (int*)(p.ws + OFF_M);
  float* gbuf = (float*)(p.ws + OFF_M + 17301504ull);
  unsigned k0[8], k1[8], T[8];
#pragma unroll
  for (int c = 0; c < 8; ++c) {
    const unsigned* row = sS + ((w * 4 + (c >> 1)) * 2 + (c & 1)) * 128;
    k0[c] = row[lane]; k1[c] = row[64 + lane]; T[c] = 0u;
  }
#pragma unroll 1
  for (int bit = 31; bit >= 7; --bit) {
    const unsigned bm = 1u << bit;
#pragma unroll
    for (int c = 0; c < 8; ++c) {
      const unsigned cand = T[c] | bm;
      const int cnt = popc64(__builtin_amdgcn_ballot_w64(k0[c] >= cand)) + popc64(__builtin_amdgcn_ballot_w64(k1[c] >= cand));
      T[c] = (cnt >= 16) ? cand : T[c];
    }
  }
  {
    bool need = false;
#pragma unroll
    for (int c = 0; c < 8; ++c) {
      const int cnt = popc64(__builtin_amdgcn_ballot_w64(k0[c] >= T[c])) + popc64(__builtin_amdgcn_ballot_w64(k1[c] >= T[c]));
      need = need || (cnt > 16);
    }
    if (need) {
#pragma unroll 1
      for (int bit = 6; bit >= 0; --bit) {
        const unsigned bm = 1u << bit;
#pragma unroll
        for (int c = 0; c < 8; ++c) {
          const unsigned cand = T[c] | bm;
          const int cnt = popc64(__builtin_amdgcn_ballot_w64(k0[c] >= cand)) + popc64(__builtin_amdgcn_ballot_w64(k1[c] >= cand));
          T[c] = (cnt >= 16) ? cand : T[c];
        }
      }
    }
  }
#pragma unroll
  for (int c = 0; c < 8; ++c) {
    const unsigned long long m0 = __builtin_amdgcn_ballot_w64(k0[c] >= T[c]);
    const unsigned long long m1 = __builtin_amdgcn_ballot_w64(k1[c] >= T[c]);
    const int s0 = mbcnt64(m0), s1 = popc64(m0) + mbcnt64(m1);
    if (k0[c] >= T[c]) wtop[c * 16 + s0] = k0[c];
    if (k1[c] >= T[c]) wtop[c * 16 + s1] = k1[c];
  }
  asm volatile("s_waitcnt lgkmcnt(0)" ::: "memory");
#define ROR_CNT(S) { const unsigned o_ = (unsigned)__builtin_amdgcn_update_dpp(0, (int)key_, 0x120 + (S), 0xf, 0xf, true); rk_ += (o_ > key_) ? 1 : 0; }
#pragma unroll
  for (int pass = 0; pass < 2; ++pass) {
    const int L = pass * 4 + (lane >> 4);
    const unsigned key_ = wtop[L * 16 + (lane & 15)];
    int rk_ = 0;
    ROR_CNT(1) ROR_CNT(2) ROR_CNT(3) ROR_CNT(4) ROR_CNT(5) ROR_CNT(6) ROR_CNT(7) ROR_CNT(8)
    ROR_CNT(9) ROR_CNT(10) ROR_CNT(11) ROR_CNT(12) ROR_CNT(13) ROR_CNT(14) ROR_CNT(15)
    wtop[L * 16 + rk_] = key_;
  }
  asm volatile("s_waitcnt lgkmcnt(0)" ::: "memory");
  int ci = (lane >= 16) + (lane >= 24) + (lane >= 29) + (lane >= 33) + (lane >= 36) + (lane >= 38) + (lane >= 40) + (lane >= 42);
#pragma unroll
  for (int t = 43; t < 50; ++t) ci += (lane >= t);
  int cstart = 0;
  cstart = (ci >= 1) ? 16 : cstart; cstart = (ci >= 2) ? 24 : cstart; cstart = (ci >= 3) ? 29 : cstart; cstart = (ci >= 4) ? 33 : cstart;
  cstart = (ci >= 5) ? 36 : cstart; cstart = (ci >= 6) ? 38 : cstart; cstart = (ci >= 7) ? 40 : cstart; cstart = (ci >= 8) ? 42 : cstart;
  cstart = (ci >= 9) ? (34 + ci) : cstart;
  const int cj = lane - cstart;
  const bool cvalid = lane < 50;
  unsigned kav[4], kbv[4], ck[4], T2[4]; float cs[4];
#pragma unroll
  for (int t = 0; t < 4; ++t) {
    kav[t] = 0u; kbv[t] = 0u; cs[t] = 0.f; ck[t] = 0u; T2[t] = 0u;
    if (cvalid) {
      kav[t] = wtop[(t * 2) * 16 + ci]; kbv[t] = wtop[(t * 2 + 1) * 16 + cj];
      cs[t] = ukey2f(kav[t]) + ukey2f(kbv[t]);
      ck[t] = ((f2ukey(cs[t]) & ~63u) | (unsigned)(63 - lane)) | 0u;
      ck[t] = (ck[t] == 0u) ? 1u : ck[t];
    }
  }
#pragma unroll 1
  for (int bit = 31; bit >= 6; --bit) {
    const unsigned bm = 1u << bit;
#pragma unroll
    for (int t = 0; t < 4; ++t) {
      const unsigned cand = T2[t] | bm;
      const int cnt = popc64(__builtin_amdgcn_ballot_w64(ck[t] >= cand));
      T2[t] = (cnt >= 16) ? cand : T2[t];
    }
  }
  {
    bool need = false;
#pragma unroll
    for (int t = 0; t < 4; ++t) need = need || (popc64(__builtin_amdgcn_ballot_w64(ck[t] >= T2[t])) > 16);
    if (need) {
#pragma unroll 1
      for (int bit = 5; bit >= 0; --bit) {
        const unsigned bm = 1u << bit;
#pragma unroll
        for (int t = 0; t < 4; ++t) {
          const unsigned cand = T2[t] | bm;
          const int cnt = popc64(__builtin_amdgcn_ballot_w64(ck[t] >= cand));
          T2[t] = (cnt >= 16) ? cand : T2[t];
        }
      }
    }
  }
  int* weid = (int*)(wexp + 64);
#pragma unroll
  for (int t = 0; t < 4; ++t) {
    const float cT = ukey2f(T2[t]);
    const bool win = ck[t] >= T2[t];
    const int sl = mbcnt64(__builtin_amdgcn_ballot_w64(win));
    if (win) {
      wexp[t * 16 + sl] = __expf(fminf(cs[t] - cT, 60.f));
      weid[t * 16 + sl] = (127 - (int)(kav[t] & 127u)) * 128 + (127 - (int)(kbv[t] & 127u));
    }
  }
  asm volatile("s_waitcnt lgkmcnt(0)" ::: "memory");
  {
    const int t = lane >> 4, sl = lane & 15;
    float es = 0.f;
#pragma unroll
    for (int q = 0; q < 4; ++q) { const float4 ee = *(const float4*)(wexp + t * 16 + q * 4); es += ee.x + ee.y + ee.z + ee.w; }
    const float e = wexp[t * 16 + sl];
    const int id = weid[t * 16 + sl];
    const size_t o = (size_t)(tok0 + w * 4 + t) * 128 + h * 16 + sl;
    ebuf[o] = id;
    gbuf[o] = e / es;
  }
  asm volatile("s_waitcnt lgkmcnt(0)" ::: "memory");
}

struct EpiStoreBf16 { bf16_t* dst; int ld; static constexpr int CHUNK = 1;
  __device__ void operator()(int r, int c, float v) const { dst[(size_t)r * ld + c] = f2bf(v); }
  __device__ void chunk(int r, int c, const float* v) const { *(uint4*)(dst + (size_t)r * ld + c) = pack8(v); } };
struct EpiGlu { const bf16_t* z; const float* bias; bf16_t* mix; static constexpr int CHUNK = 1;
  __device__ void operator()(int r, int c, float v) const {
    float zz = bf2f(z[(size_t)r * 512 + c]); float s = v + bias[c]; mix[(size_t)r * 1024 + 512 + c] = f2bf(zz / (1.f + __expf(-s))); }
  __device__ void chunk(int r, int c, const float* v) const {
    float zz[8]; unpack8(*(const uint4*)(z + (size_t)r * 512 + c), zz);
    const float4 b0 = *(const float4*)(bias + c), b1 = *(const float4*)(bias + c + 4);
    const float bb[8] = {b0.x, b0.y, b0.z, b0.w, b1.x, b1.y, b1.z, b1.w};
    float o[8];
#pragma unroll
    for (int i = 0; i < 8; ++i) o[i] = zz[i] / (1.f + __expf(-(v[i] + bb[i])));
    *(uint4*)(mix + (size_t)r * 1024 + 512 + c) = pack8(o); } };
struct EpiRes0 { const float* xp; const float* xs; float* xres; bf16_t* xb; static constexpr int CHUNK = 1;
  __device__ void operator()(int r, int c, float v) const {
    float x = (r < T_P) ? xp[(size_t)r * 1024 + c] : xs[(size_t)(r - T_P) * 1024 + c]; xres[(size_t)r * 1024 + c] = x + v; }
  __device__ void chunk(int r, int c, const float* v) const {
    const float* src = (r < T_P) ? xp + (size_t)r * 1024 + c : xs + (size_t)(r - T_P) * 1024 + c;
    const float4 a = *(const float4*)src, b = *(const float4*)(src + 4);
    float* d = xres + (size_t)r * 1024 + c;
    const float o[8] = {a.x + v[0], a.y + v[1], a.z + v[2], a.w + v[3], b.x + v[4], b.y + v[5], b.z + v[6], b.w + v[7]};
    *(float4*)d = make_float4(o[0], o[1], o[2], o[3]);
    *(float4*)(d + 4) = make_float4(o[4], o[5], o[6], o[7]);
    *(uint4*)(xb + (size_t)r * 1024 + c) = pack8(o); } };
struct EpiRes1 { float* xres; bf16_t* xb; static constexpr int CHUNK = 1;
  __device__ void operator()(int r, int c, float v) const { xres[(size_t)r * 1024 + c] += v; }
  __device__ void chunk(int r, int c, const float* v) const {
    float* d = xres + (size_t)r * 1024 + c;
    const float4 a = *(const float4*)d, b = *(const float4*)(d + 4);
    const float o[8] = {a.x + v[0], a.y + v[1], a.z + v[2], a.w + v[3], b.x + v[4], b.y + v[5], b.z + v[6], b.w + v[7]};
    *(float4*)d = make_float4(o[0], o[1], o[2], o[3]);
    *(float4*)(d + 4) = make_float4(o[4], o[5], o[6], o[7]);
    *(uint4*)(xb + (size_t)r * 1024 + c) = pack8(o); } };
struct EpiPool { bf16_t* mix; const float* scale; int g; static constexpr int CHUNK = 0;
  __device__ void operator()(int r, int c, float v) const { mix[(size_t)r * 1024 + g * 128 + c] = f2bf(v * scale[g * 128 + c]); }
  __device__ void chunk(int, int, const float*) const {} };
struct EpiKup { bf16_t* dst; int rowsPerB; int keyOff; int bStride; static constexpr int CHUNK = 1;
  __device__ void operator()(int r, int c, float v) const {
    int b = r / rowsPerB, key = r % rowsPerB + keyOff; dst[((size_t)(b * 8 + (c >> 6)) * bStride + key) * 64 + (c & 63)] = f2bf(v); }
  __device__ void chunk(int r, int c, const float* v) const {
    int b = r / rowsPerB, key = r % rowsPerB + keyOff; *(uint4*)(dst + ((size_t)(b * 8 + (c >> 6)) * bStride + key) * 64 + (c & 63)) = pack8(v); } };
struct EpiVt { bf16_t* dst; int rowsPerB; int keyOff; int ldv; static constexpr int CHUNK = 2;
  __device__ void operator()(int r, int c, float v) const {
    int b = r / rowsPerB, key = r % rowsPerB + keyOff;
    dst[((size_t)(b * 8 + (c >> 6)) * (ldv >> 6) + (key >> 6)) * 4096 + (c & 63) * 64 + (key & 63)] = f2bf(v); }
  __device__ void chunk(int r, int c, const float* v) const {
    int b = r / rowsPerB, key = r % rowsPerB + keyOff;
    *(uint4*)(dst + ((size_t)(b * 8 + (c >> 6)) * (ldv >> 6) + (key >> 6)) * 4096 + (c & 63) * 64 + (key & 63)) = pack8(v); } };


typedef const Params __attribute__((address_space(4))) KParams;

constexpr size_t OFF_BAR = WS_NEED;
__device__ __forceinline__ void grid_barrier(unsigned* ctr, unsigned target) {
  asm volatile("s_waitcnt vmcnt(0)" ::: "memory");
  __syncthreads();
  if (threadIdx.x == 0) {
    __builtin_amdgcn_fence(__ATOMIC_RELEASE, "agent");
    asm volatile("s_waitcnt vmcnt(0)" ::: "memory");
    __hip_atomic_fetch_add(ctr, 1u, __ATOMIC_RELAXED, __HIP_MEMORY_SCOPE_AGENT);
    unsigned spins = 0;
    while (__hip_atomic_load(ctr, __ATOMIC_RELAXED, __HIP_MEMORY_SCOPE_AGENT) < target) {
      __builtin_amdgcn_s_sleep(1);
      if (++spins > (1u << 27)) break;
    }
    __builtin_amdgcn_fence(__ATOMIC_ACQUIRE, "agent");
    asm volatile("s_waitcnt vmcnt(0)" ::: "memory");
  }
  __syncthreads();
}
#define GRID_BAR() { unsigned* ctr_ = (unsigned*)(((KParams*)__builtin_amdgcn_kernarg_segment_ptr())->ws + OFF_BAR); bar_k += 1; grid_barrier(ctr_, (unsigned)bar_k * gridDim.x); }
#define PHASE_BEGIN \
  Params p; \
  { KParams* kp_ = (KParams*)__builtin_amdgcn_kernarg_segment_ptr(); asm volatile("" : "+s"(kp_)); \
    _Pragma("unroll") for (int i_ = 0; i_ < 38; ++i_) p.in[i_] = kp_->in[i_]; \
    p.out = kp_->out; p.ws = kp_->ws; } \
  int tid = threadIdx.x; asm volatile("" : "+v"(tid)); \
  const int lane = tid & 63, w = __builtin_amdgcn_readfirstlane(tid >> 6); \
  const int gw = blockIdx.x * 8 + w, nw = gridDim.x * 8; \
  const size_t gtid = (size_t)blockIdx.x * NT + tid, gthreads = (size_t)gridDim.x * NT; \
  bf16_t* wt = (bf16_t*)(p.ws + OFF_WT); \
  bf16_t* proj = (bf16_t*)(p.ws + OFF_PROJ); \
  bf16_t* mix = (bf16_t*)(p.ws + OFF_MIX); \
  bf16_t* qbuf = (bf16_t*)(p.ws + OFF_QBUF); \
  bf16_t* zbuf = (bf16_t*)(p.ws + OFF_Z); \
  float* xres = p.out + O_Y; \
  (void)lane; (void)gw; (void)nw; (void)gtid; (void)gthreads; (void)wt; (void)proj; (void)mix; (void)qbuf; (void)zbuf; (void)xres;

template <int LAYER>
__device__ __forceinline__ void peer_phases(int& bar_k, unsigned char* smem) {
  const int layer = LAYER;
    for (int rep_ = 0; rep_ < NREP(7); ++rep_)
    {
    PHASE_BEGIN
      int vb = 0;
      gemm_run<3>(tid, smem, (const bf16_t*)(p.ws + OFF_XB), (const bf16_t*)(p.ws + OFF_XB), T_TOT, 1024, nullptr, wt + WT_PQ + (size_t)layer * 1048576, T_TOT, 1024, 1024, vb, EpiStoreBf16{qbuf, 1024});
    }
    GRID_BAR();
    for (int rep_ = 0; rep_ < NREP(8); ++rep_) {
    PHASE_BEGIN
    {
      TopkFrags fr;
      int item = blockIdx.x;
      if (item < 1056 * 8) topk_load(fr, tid, p, layer, item);
      for (; item < 1056 * 8; item += gridDim.x) {
        TopkFrags cur = fr;
        const int nxt = item + gridDim.x;
        if (nxt < 1056 * 8) topk_load(fr, tid, p, layer, nxt);
        peer_topk_item(tid, smem, p, cur, item);
      }
    }
    }
    GRID_BAR();
    for (int rep_ = 0; rep_ < NREP(9); ++rep_) {
    PHASE_BEGIN
      int j = blockIdx.x & 7, lb = blockIdx.x >> 3, nb = ((int)gridDim.x - j + 7) >> 3;
      {
        unsigned* cnt_ = (unsigned*)(p.ws + OFF_BAR) + 16;
        bool ok_ = true;
#pragma unroll
        for (int x_ = 0; x_ < 16; ++x_) {
          const unsigned c_ = __hip_atomic_load(&cnt_[x_], __ATOMIC_RELAXED, __HIP_MEMORY_SCOPE_AGENT);
          ok_ = ok_ && ((x_ < 8) ? (c_ > 0u) : (c_ == 0u));
        }
        if (ok_) {
          j = ((const int*)(smem + (DYN_LDS - 16)))[0]; lb = ((const int*)(smem + (DYN_LDS - 16)))[1];
          nb = (int)__hip_atomic_load(&cnt_[j], __ATOMIC_RELAXED, __HIP_MEMORY_SCOPE_AGENT);
        }
      }
      for (int tok = lb * 8 + w; tok < T_TOT; tok += nb * 8) peer9a_token(tid, p, layer, tok, j);
    }
    GRID_BAR();
    for (int rep_ = 0; rep_ < NREP(9); ++rep_) {
    PHASE_BEGIN
      for (int tok = gw; tok < T_TOT; tok += nw) peer9m_token(tid, smem, p, tok);
    }
    GRID_BAR();
    for (int rep_ = 0; rep_ < NREP(9); ++rep_) {
    PHASE_BEGIN
      int j = blockIdx.x & 7, lb = blockIdx.x >> 3, nb = ((int)gridDim.x - j + 7) >> 3;
      {
        unsigned* cnt_ = (unsigned*)(p.ws + OFF_BAR) + 16;
        bool ok_ = true;
#pragma unroll
        for (int x_ = 0; x_ < 16; ++x_) {
          const unsigned c_ = __hip_atomic_load(&cnt_[x_], __ATOMIC_RELAXED, __HIP_MEMORY_SCOPE_AGENT);
          ok_ = ok_ && ((x_ < 8) ? (c_ > 0u) : (c_ == 0u));
        }
        if (ok_) {
          j = ((const int*)(smem + (DYN_LDS - 16)))[0]; lb = ((const int*)(smem + (DYN_LDS - 16)))[1];
          nb = (int)__hip_atomic_load(&cnt_[j], __ATOMIC_RELAXED, __HIP_MEMORY_SCOPE_AGENT);
        }
      }
      for (int tok = lb * 8 + w; tok < T_TOT; tok += nb * 8) peer9b_token(tid, p, tok, j);
    }
    if (layer == 1) {
      GRID_BAR();
      for (int rep_ = 0; rep_ < NREP(9); ++rep_) {
      PHASE_BEGIN
        for (int tok = gw; tok < T_TOT; tok += nw) final_norm_token(tid, p, tok);
      }
    }
}

__global__ void __launch_bounds__(NT) mega(Params kparams_) {
  cg::grid_group grid = cg::this_grid();
  int bar_k = 0;
  extern __shared__ __attribute__((aligned(16))) unsigned char smem[];
  if (threadIdx.x == 0) {
    unsigned* cnt_ = (unsigned*)(((KParams*)__builtin_amdgcn_kernarg_segment_ptr())->ws + OFF_BAR) + 16;
    const unsigned xcc_ = (unsigned)__builtin_amdgcn_s_getreg((3 << 11) | 20) & 0xFu;
    const unsigned rank_ = __hip_atomic_fetch_add(&cnt_[xcc_], 1u, __ATOMIC_RELAXED, __HIP_MEMORY_SCOPE_AGENT);
    ((int*)(smem + (DYN_LDS - 16)))[0] = (int)xcc_;
    ((int*)(smem + (DYN_LDS - 16)))[1] = (int)rank_;
  }

  for (int rep_ = 0; rep_ < NREP(0); ++rep_)
  {
    PHASE_BEGIN
    int vb = 0;
    transpose_convert(tid, smem, p.in[12], wt + WT_IN_E, 1024, 1280, vb, p.in[9]);
    transpose_convert(tid, smem, p.in[13], wt + WT_OUT_E, 1024, 1024, vb);
    transpose_convert(tid, smem, p.in[23], wt + WT_GLU, 512, 512, vb);
    transpose_convert(tid, smem, p.in[25], wt + WT_IN_O, 1024, 1312, vb, p.in[9] + 1024);
    transpose_convert(tid, smem, p.in[26], wt + WT_OUT_O, 1024, 1024, vb);
    for (int g = 0; g < 4; ++g) transpose_convert(tid, smem, p.in[27] + g * 16384, wt + WT_POOL + g * 16384, 128, 128, vb);
    transpose_convert(tid, smem, p.in[31], wt + WT_UQ, 512, 768, vb);
    transpose_convert(tid, smem, p.in[32], wt + WT_UK, 256, 512, vb);
    transpose_convert(tid, smem, p.in[33], wt + WT_UV, 256, 512, vb);
    transpose_convert(tid, smem, p.in[34], wt + WT_PQ, 1024, 1024, vb, p.in[10]);
    transpose_convert(tid, smem, p.in[34] + 1048576, wt + WT_PQ + 1048576, 1024, 1024, vb, p.in[10] + 1024);
    convert_plain(tid, p.in[0], (bf16_t*)(p.ws + OFF_XB), 33554432);
    convert_plain(tid, p.in[1], (bf16_t*)(p.ws + OFF_XB) + 33554432, 1048576);
    convert_plain(tid, p.in[35], wt + WT_KEYS, 262144);
    quant_rows(p.in[36], p.ws + OFF_TAB, (float*)(p.ws + OFF_TAB + TAB_SU_OFF), gw, nw, tid);
    quant_rows(p.in[37], p.ws + OFF_TAB + TAB_V_OFF, (float*)(p.ws + OFF_TAB + TAB_SV_OFF), gw, nw, tid);
  }
  grid.sync();

  for (int rep_ = 0; rep_ < NREP(1); ++rep_)
  {
    PHASE_BEGIN
    int vb = 0;
    gemm_run<3>(tid, smem, (const bf16_t*)(p.ws + OFF_XB), (const bf16_t*)(p.ws + OFF_XB), T_TOT, 1024, nullptr, wt + WT_IN_E, T_TOT, 1280, 1024, vb, EpiStoreBf16{proj, 1280});
  }
  GRID_BAR();

  for (int rep_ = 0; rep_ < NREP(2); ++rep_)
  {
    PHASE_BEGIN
    bf16_t* vt0 = (bf16_t*)(p.ws + OFF_VT0);
    bf16_t* kall = (bf16_t*)(p.ws + OFF_KALL);
    bf16_t* vtall = (bf16_t*)(p.ws + OFF_VTALL);
    for (int tok = gw; tok < T_TOT; tok += nw) {
      const bool isS = tok >= T_P;
      int b, t, pos;
      if (!isS) { b = tok >> 12; t = tok & 4095; pos = t; } else { int s = tok - T_P; b = s >> 5; t = s & 31; pos = 2048 + t; }
      bf16_t* row = proj + (size_t)tok * 1280;
      const int lm = lane & 7;
      float sn[8], cs[8];
#pragma unroll
      for (int j = 0; j < 8; ++j) { float inv = exp2f(-(float)j * (LOG2_THETA / 8.f)); sincos_rev((float)pos * inv, sn[j], cs[j]); }
      {
        uint4 qv = *(const uint4*)(row + lane * 8);
        float x[8]; unpack8(qv, x);
#pragma unroll
        for (int j = 0; j < 8; ++j) {
          float other = __shfl_xor(x[j], 1);
          if (lm == 0) x[j] = x[j] * cs[j] - other * sn[j];
          else if (lm == 1) x[j] = x[j] * cs[j] + other * sn[j];
        }
        *(uint4*)(row + lane * 8) = pack8(x);
      }
      {
        uint4 kv = make_uint4(0, 0, 0, 0);
        if (lane < 32) kv = *(const uint4*)(row + 512 + lane * 8);
        float x[8]; unpack8(kv, x);
#pragma unroll
        for (int j = 0; j < 8; ++j) {
          float other = __shfl_xor(x[j], 1);
          if (lane < 16) {
            if (lm == 0) x[j] = x[j] * cs[j] - other * sn[j];
            else if (lm == 1) x[j] = x[j] * cs[j] + other * sn[j];
          }
        }
        if (lane < 32) {
          const uint4 pk = pack8(x);
          const int e0 = (lane & 15) * 8;
          if (!isS) {
            if (lane < 16) *(uint4*)(row + 512 + lane * 8) = pk;
            else {
              const int kvh = e0 >> 6, d0 = e0 & 63;
#pragma unroll
              for (int j = 0; j < 8; ++j) vt0[((size_t)(b * 2 + kvh) * 64 + d0 + j) * 4096 + t] = f2bf(x[j]);
            }
            if (t >= 3968) {
              float* dst = p.out + ((lane < 16) ? O_SWAK_P : O_SWAV_P) + ((size_t)(b * 128 + (t - 3968)) * 128 + e0);
              *(float4*)dst = make_float4(x[0], x[1], x[2], x[3]);
              *(float4*)(dst + 4) = make_float4(x[4], x[5], x[6], x[7]);
            }
          } else {
            float* dst = p.out + ((lane < 16) ? O_SWAK_S : O_SWAV_S) + ((size_t)(b * 128 + 96 + t) * 128 + e0);
            *(float4*)dst = make_float4(x[0], x[1], x[2], x[3]);
            *(float4*)(dst + 4) = make_float4(x[4], x[5], x[6], x[7]);
            if (lane < 16) *(uint4*)(kall + (size_t)(b * 160 + 128 + t) * 128 + e0) = pk;
            else {
              const int kvh = e0 >> 6, d0 = e0 & 63;
#pragma unroll
              for (int j = 0; j < 8; ++j) vtall[((size_t)(b * 2 + kvh) * 64 + d0 + j) * 192 + 128 + t] = f2bf(x[j]);
            }
          }
        }
      }
    }
    for (size_t idx = gtid; idx < (size_t)32 * 96 * 128; idx += gthreads) {
      const int e = (int)(idx & 127); const int wd = (int)((idx >> 7) % 96); const int b = (int)(idx / (96 * 128));
      const size_t src = ((size_t)(b * 128 + 32 + wd)) * 128 + e, dst = ((size_t)(b * 128 + wd)) * 128 + e;
      p.out[O_SWAK_S + dst] = p.in[2][src];
      p.out[O_SWAV_S + dst] = p.in[3][src];
    }
    for (size_t idx = gtid; idx < (size_t)32 * 128 * 128; idx += gthreads) {
      const int e = (int)(idx & 127); const int key = (int)((idx >> 7) & 127); const int b = (int)(idx >> 14);
      kall[(size_t)(b * 160 + key) * 128 + e] = f2bf(p.in[2][idx]);
      vtall[((size_t)(b * 2 + (e >> 6)) * 64 + (e & 63)) * 192 + key] = f2bf(p.in[3][idx]);
    }
    for (size_t idx = gtid; idx < (size_t)32 * 2 * 64 * 32; idx += gthreads) {
      const int kk = (int)(idx & 31); const size_t rr = idx >> 5;
      vtall[rr * 192 + 160 + kk] = 0;
    }
    float* sUw = (float*)smem + w * 512;
    for (int item = gw; item < 32768; item += nw) s5_item<0>(tid, sUw, p, item);
  }
  GRID_BAR();

  for (int rep_ = 0; rep_ < NREP(3); ++rep_)
  {
    PHASE_BEGIN
    if (gtid < 16384) {
      const int n = (int)(gtid & 63), g = (int)((gtid >> 6) & 31), b = (int)(gtid >> 11);
      const int gn = g * 64 + n;
      const float lr = fminf(p.in[15][gn], -1e-4f), li = p.in[16][gn];
      const float dt = __expf(p.in[17][g]);
      const float mag = __expf(lr * dt);
      float sn, cs; sincos_rev(li * dt, sn, cs);
      float ar = mag * cs, ai = mag * sn;
#pragma unroll
      for (int i = 0; i < 5; ++i) { float nr = ar * ar - ai * ai, ni = 2.f * ar * ai; ar = nr; ai = ni; }
      const float* s1re = (const float*)(p.ws + OFF_QMLA);
      const float* s1im = s1re + 2097152;
      float* hinre = (float*)(p.ws + OFF_QMLA) + 2 * 2097152;
      float* hinim = hinre + 2097152;
      float hr = 0.f, hi = 0.f;
#pragma unroll 8
      for (int c = 0; c < 128; ++c) {
        const size_t idx = ((size_t)(b * 128 + c) * 32 + g) * 64 + n;
        hinre[idx] = hr; hinim[idx] = hi;
        const float sr = s1re[idx], si = s1im[idx];
        const float nhr = ar * hr - ai * hi + sr, nhi = ar * hi + ai * hr + si;
        hr = nhr; hi = nhi;
      }
      p.out[O_SSMRE_P + (size_t)(b * 32 + g) * 64 + n] = hr;
      p.out[O_SSMIM_P + (size_t)(b * 32 + g) * 64 + n] = hi;
    }
    const bf16_t* vt0 = (const bf16_t*)(p.ws + OFF_VT0);
    const bf16_t* kall = (const bf16_t*)(p.ws + OFF_KALL);
    const bf16_t* vtall = (const bf16_t*)(p.ws + OFF_VTALL);
    const float* sink = p.in[14];
    for (int item = blockIdx.x; item < 2048 + 256; item += gridDim.x) {
      AttnDesc d;
      d.scale = 0.125f; d.kx = nullptr; d.pos0 = 0;
      if (item < 2048) {
        const int h = item & 7, pr = (item >> 3) & 31, b = item >> 8;
        const int kvh = h >> 2;
        const int chunk = pr * 2 + (w >> 2);
        const int tok = b * 4096 + chunk * 64 + (w & 3) * 16;
        d.q = proj + (size_t)tok * 1280 + h * 64; d.ldq = 1280; d.active = 1;
        d.kt_lo = max(0, chunk - 2); d.kt_hi = chunk + 1;
        d.out = mix + (size_t)tok * 1024 + h * 64; d.ldo = 1024;
        d.m0 = sink[h]; d.l0 = 1.f;
        d.k = proj + (size_t)(b * 4096) * 1280 + 512 + kvh * 64; d.ldk = 1280;
        d.vt = vt0 + (size_t)(b * 2 + kvh) * 64 * 4096; d.ldv = 4096; d.vts = 64; d.nkeys = 4096;
        d.bt_lo = max(0, pr * 2 - 2); d.bt_hi = pr * 2 + 2;
      } else {
        const int it = item - 2048;
        const int h = it & 7, b = it >> 3;
        const int kvh = h >> 2;
        const int tok = T_P + b * 32 + (w & 1) * 16;
        d.q = proj + (size_t)tok * 1280 + h * 64; d.ldq = 1280; d.active = (w < 2);
        d.kt_lo = 0; d.kt_hi = 3;
        d.out = mix + (size_t)tok * 1024 + h * 64; d.ldo = 1024;
        d.m0 = sink[h]; d.l0 = 1.f;
        d.k = kall + (size_t)(b * 160) * 128 + kvh * 64; d.ldk = 128;
        d.vt = vtall + (size_t)(b * 2 + kvh) * 64 * 192; d.ldv = 192; d.vts = 64; d.nkeys = 160;
        d.bt_lo = 0; d.bt_hi = 3;
      }
      attn_item<64>(tid, smem, d);
    }
  }
  GRID_BAR();

  for (int rep_ = 0; rep_ < NREP(4); ++rep_)
  {
    PHASE_BEGIN
    float* sUw = (float*)smem + w * 512;
    for (int item = gw; item < 33792; item += nw) s5_item<1>(tid, sUw, p, item);
  }
  GRID_BAR();

  for (int rep_ = 0; rep_ < NREP(5); ++rep_)
  {
    PHASE_BEGIN
    int vb = 0;
    gemm_run<0>(tid, smem, zbuf, zbuf, T_TOT, 512, nullptr, wt + WT_GLU, T_TOT, 512, 512, vb, EpiGlu{zbuf, p.in[24], mix});
  }
  GRID_BAR();

  for (int rep_ = 0; rep_ < NREP(6); ++rep_)
  {
    PHASE_BEGIN
    int vb = 0;
    gemm_run<0>(tid, smem, mix, mix, T_TOT, 1024, nullptr, wt + WT_OUT_E, T_TOT, 1024, 1024, vb, EpiRes0{p.in[0], p.in[1], xres, (bf16_t*)(p.ws + OFF_XB)});
  }
  GRID_BAR();

  peer_phases<0>(bar_k, smem);
  GRID_BAR();
      for (int rep_ = 0; rep_ < NREP(10); ++rep_)
      {
    PHASE_BEGIN
        int vb = 0;
        gemm_run<3>(tid, smem, (const bf16_t*)(p.ws + OFF_XB), (const bf16_t*)(p.ws + OFF_XB), T_TOT, 1024, nullptr, wt + WT_IN_O, T_TOT, 1312, 1024, vb, EpiStoreBf16{proj, 1312});
      }
      GRID_BAR();
      for (int rep_ = 0; rep_ < NREP(11); ++rep_)
      {
    PHASE_BEGIN
        bf16_t* cqn = zbuf;
        bf16_t* mbuf = (bf16_t*)(p.ws + OFF_M);
        bf16_t* cbuf = (bf16_t*)(p.ws + OFF_C);
        bf16_t* kpbuf = (bf16_t*)(p.ws + OFF_KP);
        bf16_t* kps = (bf16_t*)(p.ws + OFF_KPS);
        for (int tok = gw; tok < T_TOT; tok += nw) {
          const bool isS = tok >= T_P;
          int b, t, pos;
          if (!isS) { b = tok >> 12; t = tok & 4095; pos = t; } else { int s = tok - T_P; b = s >> 5; t = s & 31; pos = 2048 + t; }
          const bf16_t* row = proj + (size_t)tok * 1312;
          {
            uint4 v = *(const uint4*)(row + lane * 8);
            float x[8]; unpack8(v, x);
            float ss = 0.f;
#pragma unroll
            for (int j = 0; j < 8; ++j) ss += x[j] * x[j];
            ss = wave_sum(ss);
            const float rs = rsqrtf(ss * (1.f / 512.f) + 1e-6f);
            const float4 g0 = *(const float4*)(p.in[29] + lane * 8), g1 = *(const float4*)(p.in[29] + lane * 8 + 4);
            x[0] *= rs * g0.x; x[1] *= rs * g0.y; x[2] *= rs * g0.z; x[3] *= rs * g0.w;
            x[4] *= rs * g1.x; x[5] *= rs * g1.y; x[6] *= rs * g1.z; x[7] *= rs * g1.w;
            *(uint4*)(cqn + (size_t)tok * 512 + lane * 8) = pack8(x);
          }
          {
            uint2 v = *(const uint2*)(row + 512 + lane * 4);
            float x0 = lo2f(v.x), x1 = hi2f(v.x), x2 = lo2f(v.y), x3 = hi2f(v.y);
            float ss = wave_sum(x0 * x0 + x1 * x1 + x2 * x2 + x3 * x3);
            const float rs = rsqrtf(ss * (1.f / 256.f) + 1e-6f);
            const float4 g = *(const float4*)(p.in[30] + lane * 4);
            x0 *= rs * g.x; x1 *= rs * g.y; x2 *= rs * g.z; x3 *= rs * g.w;
            uint2 o; o.x = pack2(x0, x1); o.y = pack2(x2, x3);
            *(uint2*)(cbuf + (size_t)tok * 256 + lane * 4) = o;
            float* dst = isS ? (p.out + O_CKV_S + (size_t)(tok - T_P) * 256 + lane * 4) : (p.out + O_CKV_P + (size_t)tok * 256 + lane * 4);
            *(float4*)dst = make_float4(x0, x1, x2, x3);
          }
          {
            float xv = 0.f;
            if (lane < 32) xv = bf2f(row[768 + lane]);
            const float other = __shfl_xor(xv, 16);
            const int f = lane & 15;
            const float inv = exp2f(-(float)f * (LOG2_THETA / 16.f));
            float sn, cs; sincos_rev((float)pos * inv, sn, cs);
            const float r = (lane < 16) ? (xv * cs - other * sn) : (xv * cs + other * sn);
            if (lane < 32) {
              kpbuf[(size_t)tok * 32 + lane] = f2bf(r);
              if (isS) { p.out[O_KPE_S + (size_t)(tok - T_P) * 32 + lane] = r; kps[((size_t)b * 2112 + 2048 + t) * 32 + lane] = f2bf(r); }
              else p.out[O_KPE_P + (size_t)tok * 32 + lane] = r;
            }
          }
          {
            const int gi = lane >> 4; const int wlen = 2 << gi;
            float tot[8], cur[8];
#pragma unroll
            for (int j = 0; j < 8; ++j) tot[j] = 0.f;
            uint4 v = *(const uint4*)(row + 800 + lane * 8);
            unpack8(v, cur);
#pragma unroll
            for (int j = 0; j < 8; ++j) tot[j] = cur[j];
            for (int jb = 1; jb < 16; ++jb) {
              if (jb < wlen) {
                const int tt = t - jb;
                if (tt >= 0) {
                  uint4 pv = *(const uint4*)(row - (size_t)jb * 1312 + 800 + lane * 8);
                  float y[8]; unpack8(pv, y);
#pragma unroll
                  for (int j = 0; j < 8; ++j) tot[j] += y[j];
                } else if (isS) {
                  const float* sp = p.in[6] + ((size_t)b * 15 + (15 + tt)) * 512 + lane * 8;
                  float4 a = *(const float4*)sp, bq = *(const float4*)(sp + 4);
                  tot[0] += a.x; tot[1] += a.y; tot[2] += a.z; tot[3] += a.w; tot[4] += bq.x; tot[5] += bq.y; tot[6] += bq.z; tot[7] += bq.w;
                }
              }
            }
            const float cnt = (float)min(pos + 1, wlen);
            float mm[8];
#pragma unroll
            for (int j = 0; j < 8; ++j) mm[j] = tot[j] / cnt - cur[j];
            *(uint4*)(mbuf + (size_t)tok * 512 + lane * 8) = pack8(mm);
            const int tlen = isS ? 32 : 4096;
            if (t >= tlen - 15) {
              const int i = t - (tlen - 15);
              float* dst = isS ? (p.out + O_POOL_S + ((size_t)b * 15 + i) * 512 + lane * 8) : (p.out + O_POOL_P + ((size_t)b * 15 + i) * 512 + lane * 8);
              *(float4*)dst = make_float4(cur[0], cur[1], cur[2], cur[3]);
              *(float4*)(dst + 4) = make_float4(cur[4], cur[5], cur[6], cur[7]);
            }
          }
        }
        for (size_t idx = gtid; idx < (size_t)32 * 2048 * 32; idx += gthreads) {
          const int e = (int)(idx & 31); const int key = (int)((idx >> 5) & 2047); const int b = (int)(idx >> 16);
          kps[((size_t)b * 2112 + key) * 32 + e] = f2bf(p.in[8][idx]);
        }
      }
      GRID_BAR();
      for (int rep_ = 0; rep_ < NREP(12); ++rep_)
      {
    PHASE_BEGIN
        bf16_t* cqn = zbuf;
        bf16_t* mbuf = (bf16_t*)(p.ws + OFF_M);
        bf16_t* cbuf = (bf16_t*)(p.ws + OFF_C);
        bf16_t* qmla = (bf16_t*)(p.ws + OFF_QMLA);
        bf16_t* kupp = qbuf;
        bf16_t* vtp = qbuf + 16777216;
        bf16_t* kups = (bf16_t*)(p.ws + OFF_KUPS);
        bf16_t* vts = (bf16_t*)(p.ws + OFF_VTS);
        for (size_t idx = gtid; idx < (size_t)32 * 8 * 64 * 32; idx += gthreads) {
          const int kk = (int)(idx & 31); const size_t rr = idx >> 5;
          vts[((rr >> 6) * 33 + 32) * 4096 + (rr & 63) * 64 + 32 + kk] = 0;
        }
        int vb = 0;
        gemm_run<1>(tid, smem, p.in[7], p.in[7], 65536, 256, nullptr, wt + WT_UK, 65536, 512, 256, vb, EpiKup{kups, 2048, 0, 2112});
        gemm_run<1>(tid, smem, p.in[7], p.in[7], 65536, 256, nullptr, wt + WT_UV, 65536, 512, 256, vb, EpiVt{vts, 2048, 0, 2112});
        gemm_run<0>(tid, smem, cqn, cqn, T_TOT, 512, nullptr, wt + WT_UQ, T_TOT, 768, 512, vb, EpiStoreBf16{qmla, 768});
        gemm_run<0>(tid, smem, cbuf, cbuf, T_P, 256, nullptr, wt + WT_UK, T_P, 512, 256, vb, EpiKup{kupp, 4096, 0, 4096});
        gemm_run<0>(tid, smem, cbuf, cbuf, T_P, 256, nullptr, wt + WT_UV, T_P, 512, 256, vb, EpiVt{vtp, 4096, 0, 4096});
        gemm_run<0>(tid, smem, cbuf + (size_t)T_P * 256, cbuf, 1024, 256, nullptr, wt + WT_UK, 1024, 512, 256, vb, EpiKup{kups, 32, 2048, 2112});
        gemm_run<0>(tid, smem, cbuf + (size_t)T_P * 256, cbuf, 1024, 256, nullptr, wt + WT_UV, 1024, 512, 256, vb, EpiVt{vts, 32, 2048, 2112});
        for (int g = 0; g < 4; ++g)
          gemm_run<0>(tid, smem, mbuf + g * 128, mbuf, T_TOT, 512, nullptr, wt + WT_POOL + g * 16384, T_TOT, 128, 128, vb, EpiPool{mix, p.in[28], g});
      }
      GRID_BAR();
      for (int rep_ = 0; rep_ < NREP(13); ++rep_)
      {
    PHASE_BEGIN
        const bf16_t* qmla = (const bf16_t*)(p.ws + OFF_QMLA);
        const bf16_t* kupp = qbuf;
        const bf16_t* vtp = qbuf + 16777216;
        const bf16_t* kups = (const bf16_t*)(p.ws + OFF_KUPS);
        const bf16_t* vts = (const bf16_t*)(p.ws + OFF_VTS);
        const bf16_t* kpbuf = (const bf16_t*)(p.ws + OFF_KP);
        const bf16_t* kps = (const bf16_t*)(p.ws + OFF_KPS);
        const int G = gridDim.x;
        const bool xsched = (G == 256);
        const int nitems = 2048 + 256;
        const int xcd = blockIdx.x & 7, loc = blockIdx.x >> 3;
        for (int k = 0;; ++k) {
          int pit, sit = -1;
          if (xsched) {
            if (k >= 9) break;
            if (k == 0) { pit = -1; sit = blockIdx.x; }
            else {
              const int r = k - 1;
              const int grp = xcd + 8 * r;
              const int pr = (r & 1) ? (31 - loc) : loc;
              pit = ((31 - pr) << 6) | grp;
            }
          } else {
            const int posn = (k & 1) ? (G - 1 - (int)blockIdx.x) : (int)blockIdx.x;
            const int v = k * G + posn;
            if (k * G >= nitems) break;
            if (v >= nitems) continue;
            if (v < 1024) pit = v; else if (v < 1280) { pit = -1; sit = v - 1024; } else pit = v - 256;
          }
          AttnDesc d;
          d.scale = 0.10206207261596575f; d.m0 = -1e30f; d.l0 = 0.f;
          if (pit >= 0) {
            const int pr = 31 - (pit >> 6); const int h = pit & 7, b = (pit >> 3) & 7;
            const int chunk = pr * 2 + (w >> 2);
            const int tok = b * 4096 + chunk * 64 + (w & 3) * 16;
            d.q = qmla + (size_t)tok * 768 + h * 96; d.ldq = 768; d.active = 1; d.pos0 = chunk * 64 + (w & 3) * 16;
            d.kt_lo = 0; d.kt_hi = chunk + 1;
            d.out = mix + (size_t)tok * 1024 + 512 + h * 64; d.ldo = 1024;
            d.k = kupp + (size_t)(b * 8 + h) * 4096 * 64; d.ldk = 64;
            d.kx = kpbuf + (size_t)(b * 4096) * 32;
            d.vt = vtp + (size_t)(b * 8 + h) * 64 * 4096; d.ldv = 64; d.vts = 4096; d.nkeys = 4096;
            d.bt_lo = 0; d.bt_hi = pr * 2 + 2;
          } else {
            const int h = sit & 7, b = sit >> 3;
            const int tok = T_P + b * 32 + (w & 1) * 16;
            d.q = qmla + (size_t)tok * 768 + h * 96; d.ldq = 768; d.active = (w < 2); d.pos0 = 2048 + (w & 1) * 16;
            d.kt_lo = 0; d.kt_hi = 33;
            d.out = mix + (size_t)tok * 1024 + 512 + h * 64; d.ldo = 1024;
            d.k = kups + (size_t)(b * 8 + h) * 2112 * 64; d.ldk = 64;
            d.kx = kps + (size_t)(b * 2112) * 32;
            d.vt = vts + (size_t)(b * 8 + h) * 64 * 2112; d.ldv = 64; d.vts = 4096; d.nkeys = 2080;
            d.bt_lo = 0; d.bt_hi = 33;
          }
          attn_item<96>(tid, smem, d);
        }
      }
      GRID_BAR();
      for (int rep_ = 0; rep_ < NREP(14); ++rep_)
      {
    PHASE_BEGIN
        quant_rows(p.in[36] + 16777216, p.ws + OFF_TAB, (float*)(p.ws + OFF_TAB + TAB_SU_OFF), gw, nw, tid);
        quant_rows(p.in[37] + 16777216, p.ws + OFF_TAB + TAB_V_OFF, (float*)(p.ws + OFF_TAB + TAB_SV_OFF), gw, nw, tid);
        int vb = 0;
        gemm_run<0>(tid, smem, mix, mix, T_TOT, 1024, nullptr, wt + WT_OUT_O, T_TOT, 1024, 1024, vb, EpiRes1{xres, (bf16_t*)(p.ws + OFF_XB)});
      }
      GRID_BAR();
  peer_phases<1>(bar_k, smem);
}

extern "C" void kernel_launch(void* const* d_in, const int* in_sizes, int n_in, void* d_out, int out_size, void* d_ws, size_t ws_size, hipStream_t stream) {
  static int grid_blocks = 0;
  if (grid_blocks == 0) {
    int dev = 0, cus = 0, per_cu = 0;
    hipGetDevice(&dev);
    hipDeviceGetAttribute(&cus, hipDeviceAttributeMultiprocessorCount, dev);
    hipFuncSetAttribute((const void*)mega, hipFuncAttributeMaxDynamicSharedMemorySize, DYN_LDS);
    hipOccupancyMaxActiveBlocksPerMultiprocessor(&per_cu, (const void*)mega, NT, DYN_LDS);
    if (per_cu < 1) per_cu = 1;
    if (per_cu > 1) per_cu = 1;
    grid_blocks = cus * per_cu;
    if (ws_size < WS_NEED + 1024 + 69206016ull) fprintf(stderr, "kernel_launch: workspace too small: %zu < %zu\n", ws_size, (size_t)WS_NEED);
  }
  hipMemsetAsync((unsigned char*)d_ws + OFF_BAR, 0, 256, stream);
  Params p{};
  for (int i = 0; i < 38; ++i) p.in[i] = (const float*)d_in[i];
  p.out = (float*)d_out;
  p.ws = (unsigned char*)d_ws;
  void* args[] = {&p};
  hipError_t e = hipLaunchCooperativeKernel((const void*)mega, dim3(grid_blocks), dim3(NT), args, DYN_LDS, stream);
  if (e != hipSuccess) fprintf(stderr, "cooperative launch failed: %s (grid %d)\n", hipGetErrorString(e), grid_blocks);
}
```

```cpp
#include <hip/hip_runtime.h>
#include <hip/hip_bf16.h>
#include <hip/hip_cooperative_groups.h>
#include <cstdio>
namespace cg = cooperative_groups;

typedef unsigned short bf16_t;
using bf16x8 = __attribute__((ext_vector_type(8))) short;
using f32x4 = __attribute__((ext_vector_type(4))) float;

#ifndef PH
#define PH 0xFFFFFFu
#endif
#ifndef DBL
#define DBL 0u
#endif
#define NREP(n) ((int)((PH >> (n)) & 1u) * (1 + (int)((DBL >> (n)) & 1u)))
#define NT 512
#define DYN_LDS 81920
#define T_TOT 33792
#define T_P 32768
#define LOG2_THETA 18.931568569324174f

#define O_Y 0
#define O_SWAK_P 34603008
#define O_SWAV_P 34734080
#define O_SSMRE_P 34865152
#define O_SSMIM_P 34881536
#define O_POOL_P 34897920
#define O_CKV_P 34959360
#define O_KPE_P 43347968
#define O_SWAK_S 44396544
#define O_SWAV_S 44920832
#define O_SSMRE_S 45445120
#define O_SSMIM_S 45510656
#define O_POOL_S 45576192
#define O_CKV_S 45821952
#define O_KPE_S 46084096

constexpr size_t OFF_PROJ = 0;
constexpr size_t OFF_TAB = OFF_PROJ + 88670208ull;
constexpr size_t OFF_MIX = OFF_TAB + 67108864ull;
constexpr size_t OFF_QBUF = OFF_MIX + 69206016ull;
constexpr size_t OFF_QMLA = OFF_QBUF + 69206016ull;
constexpr size_t OFF_Z = OFF_QMLA + 51904512ull;
constexpr size_t OFF_M = OFF_Z + 34603008ull;
constexpr size_t OFF_C = OFF_M + 34603008ull;
constexpr size_t OFF_KP = OFF_C + 17301504ull;
constexpr size_t OFF_VT0 = OFF_KP + 2162688ull;
constexpr size_t OFF_KALL = OFF_VT0 + 8388608ull;
constexpr size_t OFF_VTALL = OFF_KALL + 1327104ull;
constexpr size_t OFF_KPS = OFF_VTALL + 1572864ull;
constexpr size_t OFF_WT = OFF_KPS + 4325376ull;
constexpr size_t WS_NEED = OFF_WT + 16187392ull;
constexpr size_t OFF_KUPS = OFF_PROJ;
constexpr size_t OFF_VTS = OFF_PROJ + 69206016ull;
constexpr size_t WT_IN_E = 0;
constexpr size_t WT_OUT_E = WT_IN_E + 1310720;
constexpr size_t WT_GLU = WT_OUT_E + 1048576;
constexpr size_t WT_IN_O = WT_GLU + 262144;
constexpr size_t WT_OUT_O = WT_IN_O + 1343488;
constexpr size_t WT_POOL = WT_OUT_O + 1048576;
constexpr size_t WT_UQ = WT_POOL + 65536;
constexpr size_t WT_UK = WT_UQ + 393216;
constexpr size_t WT_UV = WT_UK + 131072;
constexpr size_t WT_PQ = WT_UV + 131072;
constexpr size_t WT_KEYS = WT_PQ + 2097152;

struct Params {
  const float* in[38];
  float* out;
  unsigned char* ws;
};

typedef __bf16 bf16x2_t __attribute__((ext_vector_type(2)));
typedef float float2_t __attribute__((ext_vector_type(2)));
__device__ __forceinline__ unsigned pack2(float a, float b) {
  float2_t f = {a, b};
  bf16x2_t h = __builtin_convertvector(f, bf16x2_t);
  return __builtin_bit_cast(unsigned, h);
}
__device__ __forceinline__ unsigned short f2bf(float f) { return (unsigned short)(pack2(f, 0.f) & 0xffffu); }
__device__ __forceinline__ float bf2f(unsigned short b) { return __uint_as_float(((unsigned)b) << 16); }
__device__ __forceinline__ float lo2f(unsigned u) { return __uint_as_float(u << 16); }
__device__ __forceinline__ float hi2f(unsigned u) { return __uint_as_float(u & 0xffff0000u); }
__device__ __forceinline__ void unpack8(uint4 v, float* x) {
  x[0] = lo2f(v.x); x[1] = hi2f(v.x); x[2] = lo2f(v.y); x[3] = hi2f(v.y);
  x[4] = lo2f(v.z); x[5] = hi2f(v.z); x[6] = lo2f(v.w); x[7] = hi2f(v.w);
}
__device__ __forceinline__ uint4 pack8(const float* x) {
  uint4 v; v.x = pack2(x[0], x[1]); v.y = pack2(x[2], x[3]); v.z = pack2(x[4], x[5]); v.w = pack2(x[6], x[7]); return v;
}
template <int CTRL> __device__ __forceinline__ float dpp_f(float v) {
  return __int_as_float(__builtin_amdgcn_update_dpp(0, __float_as_int(v), CTRL, 0xf, 0xf, true));
}
__device__ __forceinline__ float row16_max(float v) {
  v = fmaxf(v, dpp_f<0xB1>(v)); v = fmaxf(v, dpp_f<0x4E>(v)); v = fmaxf(v, dpp_f<0x141>(v)); v = fmaxf(v, dpp_f<0x140>(v)); return v;
}
__device__ __forceinline__ float row16_sum(float v) {
  v += dpp_f<0xB1>(v); v += dpp_f<0x4E>(v); v += dpp_f<0x141>(v); v += dpp_f<0x140>(v); return v;
}
__device__ __forceinline__ float wave_sum(float v) {
  v = row16_sum(v);
  const float a = __int_as_float(__builtin_amdgcn_readlane(__float_as_int(v), 0));
  const float b = __int_as_float(__builtin_amdgcn_readlane(__float_as_int(v), 16));
  const float c = __int_as_float(__builtin_amdgcn_readlane(__float_as_int(v), 32));
  const float d = __int_as_float(__builtin_amdgcn_readlane(__float_as_int(v), 48));
  return (a + b) + (c + d);
}
__device__ __forceinline__ void sincos_rev(float ang, float& s, float& c) {
  float rev = ang * 0.15915494309189535f;
  rev = rev - floorf(rev);
  s = __builtin_amdgcn_sinf(rev);
  c = __builtin_amdgcn_cosf(rev);
}
__device__ __forceinline__ float gelu_tanh(float x) {
  float y = 0.7978845608028654f * (x + 0.044715f * x * x * x);
  float t = 1.f - 2.f / (1.f + __expf(2.f * y));
  return 0.5f * x * (1.f + t);
}
__device__ __forceinline__ float gelu_erf(float x) { return 0.5f * x * (1.f + erff(x * 0.7071067811865476f)); }
__device__ __forceinline__ int logical_bid() {
  const int G = (int)gridDim.x, b = (int)blockIdx.x;
  return ((G & 7) == 0) ? ((b & 7) * (G >> 3) + (b >> 3)) : b;
}
__device__ __forceinline__ int rot_start(int vbase) {
  int G = (int)gridDim.x;
  int s = (logical_bid() - vbase) % G;
  if (s < 0) s += G;
  return s;
}

__device__ __forceinline__ void transpose_convert(int tid, unsigned char* smem, const float* __restrict__ src, bf16_t* __restrict__ dst, int K, int N, int& vbase) {
  float* tl = (float*)smem;
  const int tk = K / 64, tn = (N + 63) / 64;
  const int ntiles = tk * tn;
  for (int tile = rot_start(vbase); tile < ntiles; tile += gridDim.x) {
    const int k0 = (tile / tn) * 64, n0 = (tile % tn) * 64;
    __syncthreads();
#pragma unroll
    for (int i = 0; i < 2; ++i) {
      int r = (tid >> 4) + 32 * i, c4 = (tid & 15) * 4;
      float4 v = make_float4(0.f, 0.f, 0.f, 0.f);
      if (n0 + c4 < N) v = *(const float4*)(src + (size_t)(k0 + r) * N + n0 + c4);
      tl[r * 65 + c4 + 0] = v.x; tl[r * 65 + c4 + 1] = v.y; tl[r * 65 + c4 + 2] = v.z; tl[r * 65 + c4 + 3] = v.w;
    }
    __syncthreads();
    int n = tid >> 3, k8 = (tid & 7) * 8;
    if (n0 + n < N) {
      float x[8];
#pragma unroll
      for (int j = 0; j < 8; ++j) x[j] = tl[(k8 + j) * 65 + n];
      *(uint4*)(dst + (size_t)(n0 + n) * K + k0 + k8) = pack8(x);
    }
  }
  vbase += ntiles;
}

__device__ __forceinline__ void convert_plain(int tid, const float* __restrict__ src, bf16_t* __restrict__ dst, size_t n) {
  size_t i = ((size_t)blockIdx.x * NT + tid) * 8;
  const size_t stride = (size_t)gridDim.x * NT * 8;
  for (; i < n; i += stride) {
    float4 a = *(const float4*)(src + i), b = *(const float4*)(src + i + 4);
    uint4 v; v.x = pack2(a.x, a.y); v.y = pack2(a.z, a.w); v.z = pack2(b.x, b.y); v.w = pack2(b.z, b.w);
    *(uint4*)(dst + i) = v;
  }
}

template <int V> struct IC { static constexpr int value = V; };
template <int AMODE, class Epi>
__device__ __forceinline__ void gemm_run(int tid, unsigned char* smem, const void* A, const void* A2, int splitRow, int lda,
                                         const float* __restrict__ gain, const bf16_t* __restrict__ Bt,
                                         int M, int N, int K, int& vbase, Epi epi) {
  bf16_t* sA0 = (bf16_t*)smem;
  bf16_t* sB0 = sA0 + 128 * 72;
  bf16_t* sA1 = sB0 + 128 * 72;
  bf16_t* sB1 = sA1 + 128 * 72;
  float* sR = (float*)(sB1 + 128 * 72);
  float* sG = sR + 128;
  if (AMODE == 2) {
    __syncthreads();
    sG[tid] = gain[tid]; sG[tid + 512] = gain[tid + 512];
    __syncthreads();
  }
  const int lane = tid & 63, w = tid >> 6;
  const int l16 = lane & 15, quad = lane >> 4;
  const int wm = w >> 1, wn = w & 1;
  const int tilesN = (N + 127) / 128, tilesM = M / 128;
  const int ntiles = tilesM * tilesN;
  const int arow = tid >> 2, q4 = tid & 3;
  const int nk = K / 64;
  for (int tile = rot_start(vbase); tile < ntiles; tile += gridDim.x) {
    const int tm = tile / tilesN, tn = tile % tilesN;
    const int m0 = tm * 128, n0 = tn * 128;
    const int grow = m0 + arow;
    const unsigned char* aptr;
    if (AMODE == 0) aptr = (grow < splitRow) ? (const unsigned char*)A + (size_t)grow * lda * 2 : (const unsigned char*)A2 + (size_t)(grow - splitRow) * lda * 2;
    else aptr = (grow < splitRow) ? (const unsigned char*)A + (size_t)grow * lda * 4 : (const unsigned char*)A2 + (size_t)(grow - splitRow) * lda * 4;
    const bool bvalid = (n0 + arow) < N;
    const bf16_t* bptr = Bt + (size_t)(n0 + arow) * K + q4 * 8;
    f32x4 acc[2][4];
#pragma unroll
    for (int i = 0; i < 2; ++i)
#pragma unroll
      for (int j = 0; j < 4; ++j) acc[i][j] = (f32x4){0.f, 0.f, 0.f, 0.f};
    float ss = 0.f;
    float4 af0[4], af1[4];
    uint4 ab0_0, ab0_1, ab1_0, ab1_1;
    uint4 bb0_0, bb0_1, bb1_0, bb1_1;
#define GLOAD(AF, AB, BB, KT) { \
      const int k0_ = (KT) * 64; \
      if (AMODE == 0) { AB##_0 = *(const uint4*)(aptr + (size_t)(k0_ + q4 * 8) * 2); AB##_1 = *(const uint4*)(aptr + (size_t)(k0_ + 32 + q4 * 8) * 2); } \
      else { \
        _Pragma("unroll") for (int i = 0; i < 4; ++i) AF[i] = *(const float4*)(aptr + (size_t)(k0_ + 16 * i + q4 * 4) * 4); \
      } \
      if (bvalid) { BB##_0 = *(const uint4*)(bptr + k0_); BB##_1 = *(const uint4*)(bptr + k0_ + 32); } \
      else { BB##_0 = make_uint4(0, 0, 0, 0); BB##_1 = BB##_0; } }
#define LSTORE(AF, AB, BB, KT, sA, sB) { \
      if (AMODE == 0) { \
        *(uint4*)(sA + arow * 72 + q4 * 8) = AB##_0; \
        *(uint4*)(sA + arow * 72 + 32 + q4 * 8) = AB##_1; \
      } else { \
        if (AMODE == 2) { \
          const float* gp = sG + (KT) * 64 + q4 * 4; \
          _Pragma("unroll") for (int i = 0; i < 4; ++i) { \
            float4 g = *(const float4*)(gp + 16 * i); \
            ss += AF[i].x * AF[i].x + AF[i].y * AF[i].y + AF[i].z * AF[i].z + AF[i].w * AF[i].w; \
            AF[i].x *= g.x; AF[i].y *= g.y; AF[i].z *= g.z; AF[i].w *= g.w; \
          } \
        } \
        *(uint2*)(sA + arow * 72 + q4 * 4) = make_uint2(pack2(AF[0].x, AF[0].y), pack2(AF[0].z, AF[0].w)); \
        *(uint2*)(sA + arow * 72 + 16 + q4 * 4) = make_uint2(pack2(AF[1].x, AF[1].y), pack2(AF[1].z, AF[1].w)); \
        *(uint2*)(sA + arow * 72 + 32 + q4 * 4) = make_uint2(pack2(AF[2].x, AF[2].y), pack2(AF[2].z, AF[2].w)); \
        *(uint2*)(sA + arow * 72 + 48 + q4 * 4) = make_uint2(pack2(AF[3].x, AF[3].y), pack2(AF[3].z, AF[3].w)); \
      } \
      *(uint4*)(sB + arow * 72 + q4 * 8) = BB##_0; \
      *(uint4*)(sB + arow * 72 + 32 + q4 * 8) = BB##_1; }
#define GCOMPUTE(sA, sB) { \
      _Pragma("unroll") for (int ks = 0; ks < 2; ++ks) { \
        bf16x8 a[2], b[4]; \
        _Pragma("unroll") for (int i = 0; i < 2; ++i) a[i] = *(const bf16x8*)(sA + (wm * 32 + i * 16 + l16) * 72 + ks * 32 + quad * 8); \
        _Pragma("unroll") for (int j = 0; j < 4; ++j) b[j] = *(const bf16x8*)(sB + (wn * 64 + j * 16 + l16) * 72 + ks * 32 + quad * 8); \
        _Pragma("unroll") for (int i = 0; i < 2; ++i) \
          _Pragma("unroll") for (int j = 0; j < 4; ++j) acc[i][j] = __builtin_amdgcn_mfma_f32_16x16x32_bf16(a[i], b[j], acc[i][j], 0, 0, 0); \
      } }
    __syncthreads();
    GLOAD(af0, ab0, bb0, 0);
    GLOAD(af1, ab1, bb1, 1);
    LSTORE(af0, ab0, bb0, 0, sA0, sB0);
    if (2 < nk) GLOAD(af0, ab0, bb0, 2);
    for (int kt = 0; kt < nk; kt += 2) {
      __syncthreads();
      LSTORE(af1, ab1, bb1, kt + 1, sA1, sB1);
      if (kt + 3 < nk) GLOAD(af1, ab1, bb1, kt + 3);
      GCOMPUTE(sA0, sB0);
      __syncthreads();
      if (kt + 2 < nk) {
        LSTORE(af0, ab0, bb0, kt + 2, sA0, sB0);
        if (kt + 4 < nk) GLOAD(af0, ab0, bb0, kt + 4);
      }
      GCOMPUTE(sA1, sB1);
    }
    if (AMODE == 2) {
      ss += __shfl_xor(ss, 1);
      ss += __shfl_xor(ss, 2);
      if ((tid & 3) == 0) sR[arow] = rsqrtf(ss / (float)K + 1e-6f);
      __syncthreads();
    }
    if (Epi::CHUNK) {
      float* sC = (float*)smem;
      __syncthreads();
#pragma unroll
      for (int i = 0; i < 2; ++i)
#pragma unroll
        for (int r = 0; r < 4; ++r) {
          const int rl = wm * 32 + i * 16 + quad * 4 + r;
          const float rs = (AMODE == 2) ? sR[rl] : 1.f;
#pragma unroll
          for (int j = 0; j < 4; ++j) sC[rl * 132 + wn * 64 + j * 16 + l16] = acc[i][j][r] * rs;
        }
      __syncthreads();
      if (Epi::CHUNK == 1) {
#pragma unroll
        for (int it = 0; it < 4; ++it) {
          const int chunk = tid + it * 512;
          const int row = chunk >> 4, c8 = (chunk & 15) * 8;
          if (n0 + c8 < N) {
            const float4 v0 = *(const float4*)(sC + row * 132 + c8), v1 = *(const float4*)(sC + row * 132 + c8 + 4);
            const float v[8] = {v0.x, v0.y, v0.z, v0.w, v1.x, v1.y, v1.z, v1.w};
            epi.chunk(m0 + row, n0 + c8, v);
          }
        }
      } else {
#pragma unroll
        for (int it = 0; it < 4; ++it) {
          const int chunk = tid + it * 512;
          const int col = chunk & 127, r8 = (chunk >> 7) * 8;
          if (n0 + col < N) {
            float v[8];
#pragma unroll
            for (int i = 0; i < 8; ++i) v[i] = sC[(r8 + i) * 132 + col];
            epi.chunk(m0 + r8, n0 + col, v);
          }
        }
      }
    } else {
#pragma unroll
    for (int i = 0; i < 2; ++i)
#pragma unroll
      for (int r = 0; r < 4; ++r) {
        const int rl = wm * 32 + i * 16 + quad * 4 + r;
        const float rs = (AMODE == 2) ? sR[rl] : 1.f;
#pragma unroll
        for (int j = 0; j < 4; ++j) {
          const int col = n0 + wn * 64 + j * 16 + l16;
          if (col < N) epi(m0 + rl, col, acc[i][j][r] * rs);
        }
      }
    }
  }
  vbase += ntiles;
}

struct AttnDesc {
  const bf16_t* q; int ldq; int active; int kt_lo, kt_hi; bf16_t* out; int ldo; float m0, l0; int pos0;
  const bf16_t* k; int ldk; const bf16_t* kx; const bf16_t* vt; int ldv; int vts; int nkeys; int bt_lo, bt_hi; float scale;
};

template <int DQK>
__device__ __forceinline__ void attn_item(int tid, unsigned char* smem, const AttnDesc& d) {
  constexpr int LDK = DQK + 8;
  bf16_t* sK = (bf16_t*)smem;
  bf16_t* sVt = sK + 64 * 104;
  bf16_t* sP = sVt + 64 * 72;
  const int lane = tid & 63, w = tid >> 6;
  const int l16 = lane & 15, quad = lane >> 4;
  bf16_t* sPw = sP + w * 16 * 72;
  bf16x8 qf[DQK / 32];
  if (d.active) {
#pragma unroll
    for (int ks = 0; ks < DQK / 32; ++ks) {
      const bf16_t* qp = d.q + (size_t)l16 * d.ldq + ks * 32 + quad * 8;
      uint4 v = *(const uint4*)qp;
      if (DQK == 96 && ks == 2) {
        const int pq = (quad < 2) ? 16 : -16;
        uint4 pv = *(const uint4*)(qp + pq);
        float x[8], y[8];
        unpack8(v, x); unpack8(pv, y);
        const float pos = (float)(d.pos0 + l16);
#pragma unroll
        for (int j = 0; j < 8; ++j) {
          const int f = (quad & 1) * 8 + j;
          float inv = exp2f(-(float)f * (LOG2_THETA / 16.f));
          float sn, cs; sincos_rev(pos * inv, sn, cs);
          x[j] = (quad < 2) ? (x[j] * cs - y[j] * sn) : (x[j] * cs + y[j] * sn);
        }
        v = pack8(x);
      }
      qf[ks] = *(bf16x8*)&v;
    }
  }
  f32x4 o[4];
#pragma unroll
  for (int i = 0; i < 4; ++i) o[i] = (f32x4){0.f, 0.f, 0.f, 0.f};
  float m[4], l[4];
#pragma unroll
  for (int r = 0; r < 4; ++r) { m[r] = d.m0; l[r] = d.l0; }

  const int key = tid >> 3, seg = tid & 7;
  const int key2 = (tid >> 2) & 63, seg2 = tid & 3;
  uint4 kv_r = make_uint4(0, 0, 0, 0), vv_r = kv_r, xv_r = kv_r;
  if (d.bt_lo < d.bt_hi) {
    kv_r = *(const uint4*)(d.k + (size_t)(d.bt_lo * 64 + key) * d.ldk + seg * 8);
    vv_r = *(const uint4*)(d.vt + (size_t)d.bt_lo * d.vts + (size_t)key * d.ldv + seg * 8);
    if (DQK == 96 && tid < 256) xv_r = *(const uint4*)(d.kx + (size_t)(d.bt_lo * 64 + key2) * 32 + seg2 * 8);
  }
  for (int kt = d.bt_lo; kt < d.bt_hi; ++kt) {
    __syncthreads();
    *(uint4*)(sK + key * LDK + seg * 8) = kv_r;
    *(uint4*)(sVt + key * 72 + seg * 8) = vv_r;
    if (DQK == 96 && tid < 256) *(uint4*)(sK + key2 * LDK + 64 + seg2 * 8) = xv_r;
    __syncthreads();
    if (kt + 1 < d.bt_hi) {
      kv_r = *(const uint4*)(d.k + (size_t)((kt + 1) * 64 + key) * d.ldk + seg * 8);
      vv_r = *(const uint4*)(d.vt + (size_t)(kt + 1) * d.vts + (size_t)key * d.ldv + seg * 8);
      if (DQK == 96 && tid < 256) xv_r = *(const uint4*)(d.kx + (size_t)((kt + 1) * 64 + key2) * 32 + seg2 * 8);
    }
    if (d.active && kt >= d.kt_lo && kt < d.kt_hi) {
      f32x4 s[4];
#pragma unroll
      for (int i = 0; i < 4; ++i) s[i] = (f32x4){0.f, 0.f, 0.f, 0.f};
#pragma unroll
      for (int ks = 0; ks < DQK / 32; ++ks)
#pragma unroll
        for (int nt = 0; nt < 4; ++nt) {
          bf16x8 b = *(const bf16x8*)(sK + (nt * 16 + l16) * LDK + ks * 32 + quad * 8);
          s[nt] = __builtin_amdgcn_mfma_f32_16x16x32_bf16(qf[ks], b, s[nt], 0, 0, 0);
        }
#pragma unroll
      for (int nt = 0; nt < 4; ++nt) {
        const bool valid = (kt * 64 + nt * 16 + l16) < d.nkeys;
#pragma unroll
        for (int r = 0; r < 4; ++r) s[nt][r] = valid ? s[nt][r] * d.scale : -1e30f;
      }
#pragma unroll
      for (int r = 0; r < 4; ++r) {
        float mx = fmaxf(fmaxf(s[0][r], s[1][r]), fmaxf(s[2][r], s[3][r]));
        mx = row16_max(mx);
        const float mnew = fmaxf(m[r], mx);
        const float alpha = __expf(m[r] - mnew);
        float p0 = __expf(s[0][r] - mnew), p1 = __expf(s[1][r] - mnew), p2 = __expf(s[2][r] - mnew), p3 = __expf(s[3][r] - mnew);
        float rs = p0 + p1 + p2 + p3;
        rs = row16_sum(rs);
        l[r] = l[r] * alpha + rs;
        m[r] = mnew;
#pragma unroll
        for (int dt = 0; dt < 4; ++dt) o[dt][r] *= alpha;
        bf16_t* pr = sPw + (quad * 4 + r) * 72 + l16;
        pr[0] = f2bf(p0); pr[16] = f2bf(p1); pr[32] = f2bf(p2); pr[48] = f2bf(p3);
      }
      asm volatile("s_waitcnt lgkmcnt(0)" ::: "memory");
#pragma unroll
      for (int ks = 0; ks < 2; ++ks) {
        bf16x8 a = *(const bf16x8*)(sPw + l16 * 72 + ks * 32 + quad * 8);
#pragma unroll
        for (int dt = 0; dt < 4; ++dt) {
          bf16x8 b = *(const bf16x8*)(sVt + (dt * 16 + l16) * 72 + ks * 32 + quad * 8);
          o[dt] = __builtin_amdgcn_mfma_f32_16x16x32_bf16(a, b, o[dt], 0, 0, 0);
        }
      }
      asm volatile("s_waitcnt lgkmcnt(0)" ::: "memory");
    }
  }
  if (d.active) {
#pragma unroll
    for (int r = 0; r < 4; ++r) {
      const float il = 1.f / l[r];
#pragma unroll
      for (int dt = 0; dt < 4; ++dt) d.out[(size_t)(quad * 4 + r) * d.ldo + dt * 16 + l16] = f2bf(o[dt][r] * il);
    }
  }
}

template <int MODE>
__device__ __forceinline__ void s5_item(int tid, float* sUw, const Params& p, int item) {
  const int lane = tid & 63;
  const bf16_t* proj = (const bf16_t*)(p.ws + OFF_PROJ);
  int b, chunk, g, tok0; bool isS;
  if (item < 32768) { isS = false; g = item & 31; chunk = (item >> 5) & 127; b = item >> 12; tok0 = b * 4096 + chunk * 32; }
  else { isS = true; int it = item - 32768; g = it & 31; b = it >> 5; chunk = 0; tok0 = T_P + b * 32; }
  const int n = lane;
  const int gn = g * 64 + n;
  const float lr = fminf(p.in[15][gn], -1e-4f), li = p.in[16][gn];
  const float dt = __expf(p.in[17][g]);
  const float mag = __expf(lr * dt);
  float sn, cs; sincos_rev(li * dt, sn, cs);
  const float abr = mag * cs, abi = mag * sn;
  const float den = lr * lr + li * li;
  const float nr = abr - 1.f, ni = abi;
  const float fre = (nr * lr + ni * li) / den, fim = (ni * lr - nr * li) / den;
  float2_t bb2[16];
  {
    const float4* br4 = (const float4*)(p.in[18] + (size_t)gn * 16);
    const float4* bi4 = (const float4*)(p.in[19] + (size_t)gn * 16);
#pragma unroll
    for (int i = 0; i < 4; ++i) {
      float4 r4 = br4[i], i4 = bi4[i];
      bb2[4 * i + 0] = (float2_t){fre * r4.x - fim * i4.x, fre * i4.x + fim * r4.x};
      bb2[4 * i + 1] = (float2_t){fre * r4.y - fim * i4.y, fre * i4.y + fim * r4.y};
      bb2[4 * i + 2] = (float2_t){fre * r4.z - fim * i4.z, fre * i4.z + fim * r4.z};
      bb2[4 * i + 3] = (float2_t){fre * r4.w - fim * i4.w, fre * i4.w + fim * r4.w};
    }
  }
  {
    const int t = lane >> 1, c8 = (lane & 1) * 8;
    uint4 uv = *(const uint4*)(proj + (size_t)(tok0 + t) * 1280 + 768 + g * 16 + c8);
    float x[8]; unpack8(uv, x);
    *(float4*)(sUw + t * 16 + c8) = make_float4(x[0], x[1], x[2], x[3]);
    *(float4*)(sUw + t * 16 + c8 + 4) = make_float4(x[4], x[5], x[6], x[7]);
  }
  asm volatile("s_waitcnt lgkmcnt(0)" ::: "memory");
  float hr = 0.f, hi = 0.f;
  if (MODE == 0) {
#pragma unroll 4
    for (int t = 0; t < 32; ++t) {
      float uu[16];
#pragma unroll
      for (int i = 0; i < 4; ++i) { float4 v = *(const float4*)(sUw + t * 16 + 4 * i); uu[4 * i] = v.x; uu[4 * i + 1] = v.y; uu[4 * i + 2] = v.z; uu[4 * i + 3] = v.w; }
      float2_t bu2 = {0.f, 0.f};
#pragma unroll
      for (int c = 0; c < 16; ++c) bu2 += bb2[c] * (float2_t){uu[c], uu[c]};
      const float nhr = abr * hr - abi * hi + bu2.x, nhi = abr * hi + abi * hr + bu2.y;
      hr = nhr; hi = nhi;
    }
    float* s1re = (float*)(p.ws + OFF_QMLA);
    float* s1im = s1re + 2097152;
    const size_t idx = ((size_t)(b * 128 + chunk) * 32 + g) * 64 + n;
    s1re[idx] = hr; s1im[idx] = hi;
    asm volatile("s_waitcnt lgkmcnt(0)" ::: "memory");
    return;
  } else {
    float2_t cr2[8], ci2[8];
#pragma unroll
    for (int c = 0; c < 8; ++c) {
      cr2[c] = (float2_t){p.in[20][(size_t)(g * 16 + 2 * c) * 64 + n], p.in[20][(size_t)(g * 16 + 2 * c + 1) * 64 + n]};
      ci2[c] = (float2_t){p.in[21][(size_t)(g * 16 + 2 * c) * 64 + n], p.in[21][(size_t)(g * 16 + 2 * c + 1) * 64 + n]};
    }
    if (isS) { hr = p.in[4][(size_t)(b * 32 + g) * 64 + n]; hi = p.in[5][(size_t)(b * 32 + g) * 64 + n]; }
    else {
      const float* hinre = (const float*)(p.ws + OFF_QMLA) + 2 * 2097152;
      const float* hinim = hinre + 2097152;
      const size_t idx = ((size_t)(b * 128 + chunk) * 32 + g) * 64 + n;
      hr = hinre[idx]; hi = hinim[idx];
    }
    const int b0 = lane & 1, b1 = (lane >> 1) & 1, b2 = (lane >> 2) & 1, b3 = (lane >> 3) & 1;
    const int cc = b0 * 8 + b1 * 4 + b2 * 2 + b3;
    const int quad = lane >> 4;
    const float dsk = p.in[22][g * 16 + cc];
    bf16_t* zbuf = (bf16_t*)(p.ws + OFF_Z);
    float zkeep = 0.f;
#pragma unroll 2
    for (int t = 0; t < 32; ++t) {
      float uu[16];
#pragma unroll
      for (int i = 0; i < 4; ++i) { float4 v = *(const float4*)(sUw + t * 16 + 4 * i); uu[4 * i] = v.x; uu[4 * i + 1] = v.y; uu[4 * i + 2] = v.z; uu[4 * i + 3] = v.w; }
      float2_t bu2 = {0.f, 0.f};
#pragma unroll
      for (int c = 0; c < 16; ++c) bu2 += bb2[c] * (float2_t){uu[c], uu[c]};
      const float nhr = abr * hr - abi * hi + bu2.x, nhi = abr * hi + abi * hr + bu2.y;
      hr = nhr; hi = nhi;
      float v16[16];
#pragma unroll
      for (int c = 0; c < 8; ++c) {
        const float2_t vv = cr2[c] * (float2_t){hr, hr} - ci2[c] * (float2_t){hi, hi};
        v16[2 * c] = vv.x; v16[2 * c + 1] = vv.y;
      }
      float v8[8], v4[4], v2[2], v1;
#pragma unroll
      for (int i = 0; i < 8; ++i) { float keep = b0 ? v16[8 + i] : v16[i]; float send = b0 ? v16[i] : v16[8 + i]; v8[i] = keep + __shfl_xor(send, 1); }
#pragma unroll
      for (int i = 0; i < 4; ++i) { float keep = b1 ? v8[4 + i] : v8[i]; float send = b1 ? v8[i] : v8[4 + i]; v4[i] = keep + __shfl_xor(send, 2); }
#pragma unroll
      for (int i = 0; i < 2; ++i) { float keep = b2 ? v4[2 + i] : v4[i]; float send = b2 ? v4[i] : v4[2 + i]; v2[i] = keep + __shfl_xor(send, 4); }
      { float keep = b3 ? v2[1] : v2[0]; float send = b3 ? v2[0] : v2[1]; v1 = keep + __shfl_xor(send, 8); }
      v1 += __shfl_xor(v1, 16);
      v1 += __shfl_xor(v1, 32);
      const float y = v1 + dsk * sUw[t * 16 + cc];
      const float z = gelu_tanh(y);
      if (quad == (t & 3)) zkeep = z;
      if ((t & 3) == 3) zbuf[(size_t)(tok0 + t - 3 + quad) * 512 + g * 16 + cc] = f2bf(zkeep);
    }
    if (isS) {
      p.out[O_SSMRE_S + (size_t)(b * 32 + g) * 64 + n] = hr;
      p.out[O_SSMIM_S + (size_t)(b * 32 + g) * 64 + n] = hi;
    }
    asm volatile("s_waitcnt lgkmcnt(0)" ::: "memory");
  }
}

#define TAB_V_OFF 16777216ull
#define TAB_SU_OFF 33554432ull
#define TAB_SV_OFF (33554432ull + 65536ull)
__device__ __forceinline__ void quant_rows(const float* __restrict__ src, unsigned char* __restrict__ dst, float* __restrict__ scales, int gw, int nw, int tid) {
  const int lane = tid & 63;
  for (int row = gw; row < 16384; row += nw) {
    const float* r = src + (size_t)row * 1024 + lane * 16;
    float x[16];
#pragma unroll
    for (int i = 0; i < 4; ++i) { typedef float qv4 __attribute__((ext_vector_type(4))); const qv4 v = __builtin_nontemporal_load((const qv4*)(r + 4 * i)); x[4 * i] = v.x; x[4 * i + 1] = v.y; x[4 * i + 2] = v.z; x[4 * i + 3] = v.w; }
    float am = 0.f;
#pragma unroll
    for (int i = 0; i < 16; ++i) am = fmaxf(am, fabsf(x[i]));
#pragma unroll
    for (int o = 32; o; o >>= 1) am = fmaxf(am, __shfl_xor(am, o));
    const float inv = (am > 0.f) ? 127.f / am : 0.f;
    unsigned q[4];
#pragma unroll
    for (int i = 0; i < 4; ++i) {
      unsigned b0 = (unsigned)((int)rintf(x[4 * i] * inv)) & 255u, b1 = (unsigned)((int)rintf(x[4 * i + 1] * inv)) & 255u;
      unsigned b2 = (unsigned)((int)rintf(x[4 * i + 2] * inv)) & 255u, b3 = (unsigned)((int)rintf(x[4 * i + 3] * inv)) & 255u;
      q[i] = b0 | (b1 << 8) | (b2 << 16) | (b3 << 24);
    }
    *(uint4*)(dst + (size_t)(lane >> 3) * 2097152 + (size_t)row * 128 + (lane & 7) * 16) = make_uint4(q[0], q[1], q[2], q[3]);
    if (lane == 0) scales[row] = am * (1.f / 127.f);
  }
}

__device__ __forceinline__ float ub0(unsigned u) { return (float)(u & 0xffu); }
__device__ __forceinline__ float ub1(unsigned u) { return (float)((u >> 8) & 0xffu); }
__device__ __forceinline__ float ub2(unsigned u) { return (float)((u >> 16) & 0xffu); }
__device__ __forceinline__ float ub3(unsigned u) { return (float)(u >> 24); }
__device__ __forceinline__ float dot16(const float* xn, uint4 u) {
  float d = 0.f;
  d += xn[0] * ub0(u.x); d += xn[1] * ub1(u.x); d += xn[2] * ub2(u.x); d += xn[3] * ub3(u.x);
  d += xn[4] * ub0(u.y); d += xn[5] * ub1(u.y); d += xn[6] * ub2(u.y); d += xn[7] * ub3(u.y);
  d += xn[8] * ub0(u.z); d += xn[9] * ub1(u.z); d += xn[10] * ub2(u.z); d += xn[11] * ub3(u.z);
  d += xn[12] * ub0(u.w); d += xn[13] * ub1(u.w); d += xn[14] * ub2(u.w); d += xn[15] * ub3(u.w);
  return d;
}
__device__ __forceinline__ void axpy16(float* acc, float a, uint4 u) {
  acc[0] += a * ub0(u.x); acc[1] += a * ub1(u.x); acc[2] += a * ub2(u.x); acc[3] += a * ub3(u.x);
  acc[4] += a * ub0(u.y); acc[5] += a * ub1(u.y); acc[6] += a * ub2(u.y); acc[7] += a * ub3(u.y);
  acc[8] += a * ub0(u.z); acc[9] += a * ub1(u.z); acc[10] += a * ub2(u.z); acc[11] += a * ub3(u.z);
  acc[12] += a * ub0(u.w); acc[13] += a * ub1(u.w); acc[14] += a * ub2(u.w); acc[15] += a * ub3(u.w);
}

template <bool FINAL, bool DRY>
__device__ __forceinline__ void peer_token(int tid, const Params& p, int layer, int tok) {
  const int lane = tid & 63;
  float* xres = p.out + O_Y;
  const float* gain = p.in[10] + layer * 1024;
  const unsigned char* U = p.ws + OFF_TAB;
  const unsigned char* V = U + TAB_V_OFF;
  const int* ebuf = (const int*)(p.ws + OFF_M);
  const float* gbuf = (const float*)(p.ws + OFF_M + 17301504ull);
  const float* sus = (const float*)(p.ws + OFF_TAB + TAB_SU_OFF);
  const float* svs = (const float*)(p.ws + OFF_TAB + TAB_SV_OFF);
  float* xr = xres + (size_t)tok * 1024 + lane * 16;
  float x[16], xn[16], acc[16];
  float ss = 0.f, sx = 0.f;
#pragma unroll
  for (int i = 0; i < 4; ++i) {
    float4 v = *(const float4*)(xr + 4 * i);
    float4 g = *(const float4*)(gain + lane * 16 + 4 * i);
    x[4 * i] = v.x; x[4 * i + 1] = v.y; x[4 * i + 2] = v.z; x[4 * i + 3] = v.w;
    xn[4 * i] = v.x * g.x; xn[4 * i + 1] = v.y * g.y; xn[4 * i + 2] = v.z * g.z; xn[4 * i + 3] = v.w * g.w;
    ss += v.x * v.x + v.y * v.y + v.z * v.z + v.w * v.w;
    sx += xn[4 * i] + xn[4 * i + 1] + xn[4 * i + 2] + xn[4 * i + 3];
  }
  ss = wave_sum(ss);
  sx = wave_sum(sx);
  const float rstd = rsqrtf(ss * (1.f / 1024.f) + 1e-6f);
#pragma unroll
  for (int i = 0; i < 16; ++i) acc[i] = 0.f;
  float sumA = 0.f;
  const int b0 = lane & 1, b1 = (lane >> 1) & 1, b2 = (lane >> 2) & 1;
  const int pe = b0 * 4 + b1 * 2 + b2;
  const size_t pbase = (size_t)tok * 128 + pe;
#pragma unroll 1
  for (int kb = 0; kb < 16; ++kb) {
    const int myeid = ebuf[pbase + kb * 8];
    const float myg = gbuf[pbase + kb * 8] * svs[myeid];
    const float mysu = sus[myeid];
    uint4 uu[8], vv[8];
#pragma unroll
    for (int j = 0; j < 8; ++j) {
      const int src = ((j & 1) << 2) | (j & 2) | ((j >> 2) & 1);
      const int eid = __builtin_amdgcn_readlane(myeid, src);
      uu[j] = *(const uint4*)(U + (size_t)eid * 1024 + lane * 16);
      vv[j] = *(const uint4*)(V + (size_t)eid * 1024 + lane * 16);
    }
    float d[8];
#pragma unroll
    for (int j = 0; j < 8; ++j) d[j] = dot16(xn, uu[j]);
    float w4[4], w2[2], w1;
#pragma unroll
    for (int i = 0; i < 4; ++i) { float keep = b0 ? d[4 + i] : d[i]; float send = b0 ? d[i] : d[4 + i]; w4[i] = keep + __shfl_xor(send, 1); }
#pragma unroll
    for (int i = 0; i < 2; ++i) { float keep = b1 ? w4[2 + i] : w4[i]; float send = b1 ? w4[i] : w4[2 + i]; w2[i] = keep + __shfl_xor(send, 2); }
    { float keep = b2 ? w2[1] : w2[0]; float send = b2 ? w2[0] : w2[1]; w1 = keep + __shfl_xor(send, 4); }
    w1 += __shfl_xor(w1, 8); w1 += __shfl_xor(w1, 16); w1 += __shfl_xor(w1, 32);
    const float dot = rstd * mysu * (w1 - 128.f * sx);
    const float a = gelu_erf(dot) * myg;
#pragma unroll
    for (int j = 0; j < 8; ++j) {
      const int src = ((j & 1) << 2) | (j & 2) | ((j >> 2) & 1);
      const float A = __int_as_float(__builtin_amdgcn_readlane(__float_as_int(a), src));
      sumA += A;
      axpy16(acc, A, vv[j]);
    }
  }
  float y[16];
#pragma unroll
  for (int i = 0; i < 16; ++i) y[i] = x[i] + acc[i] - 128.f * sumA;
  if (FINAL) {
    float s2 = 0.f;
#pragma unroll
    for (int i = 0; i < 16; ++i) s2 += y[i] * y[i];
    s2 = wave_sum(s2);
    const float r2 = rsqrtf(s2 * (1.f / 1024.f) + 1e-6f);
    const float* gf = p.in[11] + lane * 16;
#pragma unroll
    for (int i = 0; i < 4; ++i) {
      float4 g = *(const float4*)(gf + 4 * i);
      y[4 * i] *= r2 * g.x; y[4 * i + 1] *= r2 * g.y; y[4 * i + 2] *= r2 * g.z; y[4 * i + 3] *= r2 * g.w;
    }
  }
  if (DRY && ss != -1.f) return;
#pragma unroll
  for (int i = 0; i < 4; ++i) *(float4*)(xr + 4 * i) = make_float4(y[4 * i], y[4 * i + 1], y[4 * i + 2], y[4 * i + 3]);
}

#define OFF_PD OFF_MIX
#define OFF_PSS OFF_KP
#define OFF_PSX (OFF_KP + 1081344ull)
template <int CTRL> __device__ __forceinline__ int dpp_i(int v) { return __builtin_amdgcn_update_dpp(0, v, CTRL, 0xf, 0xf, true); }
__device__ __forceinline__ unsigned packq4(float a, float b, float c, float d, float inv) {
  const unsigned q0 = (unsigned)((int)rintf(a * inv)) & 255u, q1 = (unsigned)((int)rintf(b * inv)) & 255u;
  const unsigned q2 = (unsigned)((int)rintf(c * inv)) & 255u, q3 = (unsigned)((int)rintf(d * inv));
  return q0 | (q1 << 8) | (q2 << 16) | (q3 << 24);
}
__device__ __forceinline__ void peer9a_token(int tid, const Params& p, int layer, int tok, int j) {
  const int lane = tid & 63, g8 = lane >> 3, sub = lane & 7;
  const float* xr = p.out + O_Y + (size_t)tok * 1024 + j * 128 + sub * 16;
  const float* gn = p.in[10] + layer * 1024 + j * 128 + sub * 16;
  const unsigned char* U = p.ws + OFF_TAB + (size_t)j * 2097152 + sub * 16;
  const int* eb = (const int*)(p.ws + OFF_M) + (size_t)tok * 128 + g8;
  bf16_t* pd = (bf16_t*)(p.ws + OFF_PD) + ((size_t)tok * 8 + j) * 128;
  int eid[16];
#pragma unroll
  for (int k = 0; k < 16; ++k) eid[k] = eb[k * 8];
  float xs[16];
  float ss = 0.f, am = 0.f;
#pragma unroll
  for (int i = 0; i < 4; ++i) {
    float4 v = *(const float4*)(xr + 4 * i);
    float4 g = *(const float4*)(gn + 4 * i);
    xs[4 * i] = v.x * g.x; xs[4 * i + 1] = v.y * g.y; xs[4 * i + 2] = v.z * g.z; xs[4 * i + 3] = v.w * g.w;
    ss += v.x * v.x + v.y * v.y + v.z * v.z + v.w * v.w;
    am = fmaxf(fmaxf(am, fmaxf(fabsf(xs[4 * i]), fabsf(xs[4 * i + 1]))), fmaxf(fabsf(xs[4 * i + 2]), fabsf(xs[4 * i + 3])));
  }
  uint4 rows[16];
#pragma unroll
  for (int k = 0; k < 16; ++k) rows[k] = *(const uint4*)(U + (size_t)eid[k] * 128);
  am = fmaxf(am, dpp_f<0xB1>(am)); am = fmaxf(am, dpp_f<0x4E>(am)); am = fmaxf(am, dpp_f<0x141>(am));
  const float inv = (am > 0.f) ? 127.f / am : 0.f;
  const float xscale = am * (1.f / 127.f);
  int xq[4];
#pragma unroll
  for (int d = 0; d < 4; ++d) xq[d] = (int)packq4(xs[4 * d], xs[4 * d + 1], xs[4 * d + 2], xs[4 * d + 3], inv);
  int keep0 = 0, keep1 = 0;
#pragma unroll
  for (int k = 0; k < 16; ++k) {
    int D = __builtin_amdgcn_sdot4((int)rows[k].x, xq[0], 0, false);
    D = __builtin_amdgcn_sdot4((int)rows[k].y, xq[1], D, false);
    D = __builtin_amdgcn_sdot4((int)rows[k].z, xq[2], D, false);
    D = __builtin_amdgcn_sdot4((int)rows[k].w, xq[3], D, false);
    D += dpp_i<0xB1>(D); D += dpp_i<0x4E>(D); D += dpp_i<0x141>(D);
    if (k < 8) keep0 = (sub == k) ? D : keep0; else keep1 = (sub == k - 8) ? D : keep1;
  }
  pd[sub * 8 + g8] = f2bf((float)keep0 * xscale);
  pd[64 + sub * 8 + g8] = f2bf((float)keep1 * xscale);
  ss += dpp_f<0xB1>(ss); ss += dpp_f<0x4E>(ss); ss += dpp_f<0x141>(ss);
  if (lane == 0) ((float*)(p.ws + OFF_PSS))[(size_t)tok * 8 + j] = ss;
}

__device__ __forceinline__ void peer9m_token(int tid, unsigned char* smem, const Params& p, int tok) {
  const int lane = tid & 63, w = __builtin_amdgcn_readfirstlane(tid >> 6);
  unsigned char* sAq = smem + w * 128;
  const bf16_t* pd = (const bf16_t*)(p.ws + OFF_PD) + (size_t)tok * 1024;
  float* pss = (float*)(p.ws + OFF_PSS) + (size_t)tok * 8;
  const int* ebuf = (const int*)(p.ws + OFF_M) + (size_t)tok * 128;
  float* gbuf = (float*)(p.ws + OFF_M + 17301504ull) + (size_t)tok * 128;
  const float* sus = (const float*)(p.ws + OFF_TAB + TAB_SU_OFF);
  const float* svs = (const float*)(p.ws + OFF_TAB + TAB_SV_OFF);
  float ss = 0.f, d0 = 0.f, d1 = 0.f;
#pragma unroll
  for (int j = 0; j < 8; ++j) { ss += pss[j]; d0 += bf2f(pd[j * 128 + lane]); d1 += bf2f(pd[j * 128 + 64 + lane]); }
  const int e0 = ebuf[lane], e1 = ebuf[64 + lane];
  const float rstd = rsqrtf(ss * (1.f / 1024.f) + 1e-6f);
  const float a0 = gelu_erf(rstd * sus[e0] * d0) * gbuf[lane] * svs[e0];
  const float a1 = gelu_erf(rstd * sus[e1] * d1) * gbuf[64 + lane] * svs[e1];
  float am = row16_max(fmaxf(fabsf(a0), fabsf(a1)));
  {
    const float m0 = __int_as_float(__builtin_amdgcn_readlane(__float_as_int(am), 0)), m1 = __int_as_float(__builtin_amdgcn_readlane(__float_as_int(am), 16));
    const float m2 = __int_as_float(__builtin_amdgcn_readlane(__float_as_int(am), 32)), m3 = __int_as_float(__builtin_amdgcn_readlane(__float_as_int(am), 48));
    am = fmaxf(fmaxf(m0, m1), fmaxf(m2, m3));
  }
  const float inv = (am > 0.f) ? 127.f / am : 0.f;
  const int addr0 = (lane & 7) * 16 + (lane >> 3);
  sAq[addr0] = (unsigned char)((int)rintf(a0 * inv) & 255);
  sAq[addr0 + 8] = (unsigned char)((int)rintf(a1 * inv) & 255);
  asm volatile("s_waitcnt lgkmcnt(0)" ::: "memory");
  unsigned pk = 0u;
  if (lane < 32) pk = ((const unsigned*)sAq)[lane];
  asm volatile("s_waitcnt vmcnt(0) lgkmcnt(0)" ::: "memory");
  if (lane < 32) ((unsigned*)gbuf)[lane] = pk;
  if (lane == 0) pss[0] = am * (1.f / 127.f);
  asm volatile("s_waitcnt lgkmcnt(0)" ::: "memory");
}

__device__ __forceinline__ void peer9b_token(int tid, const Params& p, int tok, int j) {
  const int lane = tid & 63, g8 = lane >> 3, sub = lane & 7;
  float* xr = p.out + O_Y + (size_t)tok * 1024 + j * 128 + sub * 16;
  const unsigned char* V = p.ws + OFF_TAB + TAB_V_OFF + (size_t)j * 2097152 + sub * 16;
  const int* eb = (const int*)(p.ws + OFF_M) + (size_t)tok * 128 + g8;
  const uint4 apk = *(const uint4*)((const unsigned*)(p.ws + OFF_M + 17301504ull) + (size_t)tok * 128 + g8 * 4);
  const float scaleA = ((const float*)(p.ws + OFF_PSS))[(size_t)tok * 8];
  int eid[16];
#pragma unroll
  for (int k = 0; k < 16; ++k) eid[k] = eb[k * 8];
  uint4 rows[16];
#pragma unroll
  for (int k = 0; k < 16; ++k) rows[k] = *(const uint4*)(V + (size_t)eid[k] * 128);
  int acci[16];
#pragma unroll
  for (int i = 0; i < 16; ++i) acci[i] = 0;
#define P9B_DW(DWF, DW, AP, KQ) { \
    const unsigned r0 = rows[(KQ) * 4 + 0].DWF, r1 = rows[(KQ) * 4 + 1].DWF, r2 = rows[(KQ) * 4 + 2].DWF, r3 = rows[(KQ) * 4 + 3].DWF; \
    const unsigned t0 = __builtin_amdgcn_perm(r1, r0, 0x05010400u), t1 = __builtin_amdgcn_perm(r1, r0, 0x07030602u); \
    const unsigned t2 = __builtin_amdgcn_perm(r3, r2, 0x05010400u), t3 = __builtin_amdgcn_perm(r3, r2, 0x07030602u); \
    acci[(DW) * 4 + 0] = __builtin_amdgcn_sdot4((int)__builtin_amdgcn_perm(t2, t0, 0x05040100u), (int)(AP), acci[(DW) * 4 + 0], false); \
    acci[(DW) * 4 + 1] = __builtin_amdgcn_sdot4((int)__builtin_amdgcn_perm(t2, t0, 0x07060302u), (int)(AP), acci[(DW) * 4 + 1], false); \
    acci[(DW) * 4 + 2] = __builtin_amdgcn_sdot4((int)__builtin_amdgcn_perm(t3, t1, 0x05040100u), (int)(AP), acci[(DW) * 4 + 2], false); \
    acci[(DW) * 4 + 3] = __builtin_amdgcn_sdot4((int)__builtin_amdgcn_perm(t3, t1, 0x07060302u), (int)(AP), acci[(DW) * 4 + 3], false); }
#define P9B_KQ(AP, KQ) { P9B_DW(x, 0, AP, KQ) P9B_DW(y, 1, AP, KQ) P9B_DW(z, 2, AP, KQ) P9B_DW(w, 3, AP, KQ) }
  P9B_KQ(apk.x, 0) P9B_KQ(apk.y, 1) P9B_KQ(apk.z, 2) P9B_KQ(apk.w, 3)
  float acc[16];
#pragma unroll
  for (int i = 0; i < 16; ++i) acc[i] = (float)acci[i] * scaleA;
  const int b3 = (lane >> 3) & 1, b4 = (lane >> 4) & 1, b5 = (lane >> 5) & 1;
  float v8[8], v4[4], v2[2];
#pragma unroll
  for (int i = 0; i < 8; ++i) { float keep = b3 ? acc[8 + i] : acc[i]; float send = b3 ? acc[i] : acc[8 + i]; v8[i] = keep + dpp_f<0x128>(send); }
#pragma unroll
  for (int i = 0; i < 4; ++i) { float keep = b4 ? v8[4 + i] : v8[i]; float send = b4 ? v8[i] : v8[4 + i]; v4[i] = keep + __shfl_xor(send, 16); }
#pragma unroll
  for (int i = 0; i < 2; ++i) { float keep = b5 ? v4[2 + i] : v4[i]; float send = b5 ? v4[i] : v4[2 + i]; v2[i] = keep + __shfl_xor(send, 32); }
  const int c = b3 * 8 + b4 * 4 + b5 * 2;
  float2 xv = *(const float2*)(xr + c);
  xv.x += v2[0];
  xv.y += v2[1];
  *(float2*)(xr + c) = xv;
}

__device__ __forceinline__ void final_norm_token(int tid, const Params& p, int tok) {
  const int lane = tid & 63;
  float* xr = p.out + O_Y + (size_t)tok * 1024 + lane * 16;
  const float* gf = p.in[11] + lane * 16;
  float y[16]; float s2 = 0.f;
#pragma unroll
  for (int i = 0; i < 4; ++i) { float4 v = *(const float4*)(xr + 4 * i); y[4 * i] = v.x; y[4 * i + 1] = v.y; y[4 * i + 2] = v.z; y[4 * i + 3] = v.w; s2 += v.x * v.x + v.y * v.y + v.z * v.z + v.w * v.w; }
  s2 = wave_sum(s2);
  const float r2 = rsqrtf(s2 * (1.f / 1024.f) + 1e-6f);
#pragma unroll
  for (int i = 0; i < 4; ++i) {
    float4 g = *(const float4*)(gf + 4 * i);
    *(float4*)(xr + 4 * i) = make_float4(y[4 * i] * r2 * g.x, y[4 * i + 1] * r2 * g.y, y[4 * i + 2] * r2 * g.z, y[4 * i + 3] * r2 * g.w);
  }
}

__device__ __forceinline__ unsigned f2ukey(float v) { unsigned u = __float_as_uint(v); return (u & 0x80000000u) ? ~u : (u | 0x80000000u); }
__device__ __forceinline__ float ukey2f(unsigned k) { unsigned u = (k & 0x80000000u) ? (k & 0x7fffffffu) : ~k; return __uint_as_float(u); }
__device__ __forceinline__ int popc64(unsigned long long m) { return __builtin_popcountll(m); }
__device__ __forceinline__ int mbcnt64(unsigned long long m) { return (int)__builtin_amdgcn_mbcnt_hi((unsigned)(m >> 32), __builtin_amdgcn_mbcnt_lo((unsigned)m, 0u)); }

struct TopkFrags { bf16x8 a[2][2]; bf16x8 b[2][2]; };
__device__ __forceinline__ void topk_load(TopkFrags& f, int tid, const Params& p, int layer, int item) {
  const int lane = tid & 63, w = __builtin_amdgcn_readfirstlane(tid >> 6);
  const int l16 = lane & 15, quad = lane >> 4;
  const int h = item & 7, tok0 = (item >> 3) * 32;
  const int pp = w >> 2;
  const bf16_t* qb = (const bf16_t*)(p.ws + OFF_QBUF);
  const bf16_t* keys = (const bf16_t*)(p.ws + OFF_WT) + WT_KEYS + (size_t)((layer * 8 + h) * 2 + pp) * 8192;
#pragma unroll
  for (int ks = 0; ks < 2; ++ks) {
#pragma unroll
    for (int mt = 0; mt < 2; ++mt) f.a[ks][mt] = *(const bf16x8*)(qb + (size_t)(tok0 + mt * 16 + l16) * 1024 + h * 128 + pp * 64 + ks * 32 + quad * 8);
#pragma unroll
    for (int j = 0; j < 2; ++j) {
      const int nt = (w & 3) * 2 + j;
      f.b[ks][j] = *(const bf16x8*)(keys + (nt * 16 + l16) * 64 + ks * 32 + quad * 8);
    }
  }
}

__device__ __forceinline__ void peer_topk_item(int tid, unsigned char* smem, const Params& p, const TopkFrags& f, int item) {
  unsigned* sS = (unsigned*)smem;
  const int lane = tid & 63, w = __builtin_amdgcn_readfirstlane(tid >> 6);
  const int l16 = lane & 15, quad = lane >> 4;
  const int h = item & 7, tile = item >> 3;
  const int tok0 = tile * 32;
  unsigned* wtop = (unsigned*)(smem + 32768) + w * 256;
  float* wexp = (float*)(wtop + 128);
  __syncthreads();
  {
    const int pp = w >> 2;
    f32x4 acc[2][2];
#pragma unroll
    for (int i = 0; i < 2; ++i)
#pragma unroll
      for (int j = 0; j < 2; ++j) acc[i][j] = (f32x4){0.f, 0.f, 0.f, 0.f};
#pragma unroll
    for (int ks = 0; ks < 2; ++ks)
#pragma unroll
      for (int mt = 0; mt < 2; ++mt)
#pragma unroll
        for (int j = 0; j < 2; ++j) acc[mt][j] = __builtin_amdgcn_mfma_f32_16x16x32_bf16(f.a[ks][mt], f.b[ks][j], acc[mt][j], 0, 0, 0);
#pragma unroll
    for (int mt = 0; mt < 2; ++mt)
#pragma unroll
      for (int j = 0; j < 2; ++j) {
        const int nt = (w & 3) * 2 + j;
#pragma unroll
        for (int r = 0; r < 4; ++r) {
          const int key = nt * 16 + l16;
          sS[((mt * 16 + quad * 4 + r) * 2 + pp) * 128 + key] = (f2ukey(acc[mt][j][r]) & ~127u) | (unsigned)(127 - key);
        }
      }
  }
  __syncthreads();
  int* ebuf = (int*)(p.ws + OFF_M);
  float* gbuf = (float*)(p.ws + OFF_M + 17301504ull);
  unsigned k0[8], k1[8], T[8];
#pragma unroll
  for (int c = 0; c < 8; ++c) {
    const unsigned* row = sS + ((w * 4 + (c >> 1)) * 2 + (c & 1)) * 128;
    k0[c] = row[lane]; k1[c] = row[64 + lane]; T[c] = 0u;
  }
#pragma unroll 1
  for (int bit = 31; bit >= 7; --bit) {
    const unsigned bm = 1u << bit;
#pragma unroll
    for (int c = 0; c < 8; ++c) {
      const unsigned cand = T[c] | bm;
      const int cnt = popc64(__builtin_amdgcn_ballot_w64(k0[c] >= cand)) + popc64(__builtin_amdgcn_ballot_w64(k1[c] >= cand));
      T[c] = (cnt >= 16) ? cand : T[c];
    }
  }
  {
    bool need = false;
#pragma unroll
    for (int c = 0; c < 8; ++c) {
      const int cnt = popc64(__builtin_amdgcn_ballot_w64(k0[c] >= T[c])) + popc64(__builtin_amdgcn_ballot_w64(k1[c] >= T[c]));
      need = need || (cnt > 16);
    }
    if (need) {
#pragma unroll 1
      for (int bit = 6; bit >= 0; --bit) {
        const unsigned bm = 1u << bit;
#pragma unroll
        for (int c = 0; c < 8; ++c) {
          const unsigned cand = T[c] | bm;
          const int cnt = popc64(__builtin_amdgcn_ballot_w64(k0[c] >= cand)) + popc64(__builtin_amdgcn_ballot_w64(k1[c] >= cand));
          T[c] = (cnt >= 16) ? cand : T[c];
        }
      }
    }
  }
#pragma unroll
  for (int c = 0; c < 8; ++c) {
    const unsigned long long m0 = __builtin_amdgcn_ballot_w64(k0[c] >= T[c]);
    const unsigned long long m1 = __builtin_amdgcn_ballot_w64(k1[c] >= T[c]);
    const int s0 = mbcnt64(m0), s1 = popc64(m0) + mbcnt64(m1);
    if (k0[c] >= T[c]) wtop[c * 16 + s0] = k0[c];
    if (k1[c] >= T[c]) wtop[c * 16 + s1] = k1[c];
  }
  asm volatile("s_waitcnt lgkmcnt(0)" ::: "memory");
#define ROR_CNT(S) { const unsigned o_ = (unsigned)__builtin_amdgcn_update_dpp(0, (int)key_, 0x120 + (S), 0xf, 0xf, true); rk_ += (o_ > key_) ? 1 : 0; }
#pragma unroll
  for (int pass = 0; pass < 2; ++pass) {
    const int L = pass * 4 + (lane >> 4);
    const unsigned key_ = wtop[L * 16 + (lane & 15)];
    int rk_ = 0;
    ROR_CNT(1) ROR_CNT(2) ROR_CNT(3) ROR_CNT(4) ROR_CNT(5) ROR_CNT(6) ROR_CNT(7) ROR_CNT(8)
    ROR_CNT(9) ROR_CNT(10) ROR_CNT(11) ROR_CNT(12) ROR_CNT(13) ROR_CNT(14) ROR_CNT(15)
    wtop[L * 16 + rk_] = key_;
  }
  asm volatile("s_waitcnt lgkmcnt(0)" ::: "memory");
  int ci = (lane >= 16) + (lane >= 24) + (lane >= 29) + (lane >= 33) + (lane >= 36) + (lane >= 38) + (lane >= 40) + (lane >= 42);
#pragma unroll
  for (int t = 43; t < 50; ++t) ci += (lane >= t);
  int cstart = 0;
  cstart = (ci >= 1) ? 16 : cstart; cstart = (ci >= 2) ? 24 : cstart; cstart = (ci >= 3) ? 29 : cstart; cstart = (ci >= 4) ? 33 : cstart;
  cstart = (ci >= 5) ? 36 : cstart; cstart = (ci >= 6) ? 38 : cstart; cstart = (ci >= 7) ? 40 : cstart; cstart = (ci >= 8) ? 42 : cstart;
  cstart = (ci >= 9) ? (34 + ci) : cstart;
  const int cj = lane - cstart;
  const bool cvalid = lane < 50;
  unsigned kav[4], kbv[4], ck[4], T2[4]; float cs[4];
#pragma unroll
  for (int t = 0; t < 4; ++t) {
    kav[t] = 0u; kbv[t] = 0u; cs[t] = 0.f; ck[t] = 0u; T2[t] = 0u;
    if (cvalid) {
      kav[t] = wtop[(t * 2) * 16 + ci]; kbv[t] = wtop[(t * 2 + 1) * 16 + cj];
      cs[t] = ukey2f(kav[t]) + ukey2f(kbv[t]);
      ck[t] = ((f2ukey(cs[t]) & ~63u) | (unsigned)(63 - lane)) | 0u;
      ck[t] = (ck[t] == 0u) ? 1u : ck[t];
    }
  }
#pragma unroll 1
  for (int bit = 31; bit >= 6; --bit) {
    const unsigned bm = 1u << bit;
#pragma unroll
    for (int t = 0; t < 4; ++t) {
      const unsigned cand = T2[t] | bm;
      const int cnt = popc64(__builtin_amdgcn_ballot_w64(ck[t] >= cand));
      T2[t] = (cnt >= 16) ? cand : T2[t];
    }
  }
  {
    bool need = false;
#pragma unroll
    for (int t = 0; t < 4; ++t) need = need || (popc64(__builtin_amdgcn_ballot_w64(ck[t] >= T2[t])) > 16);
    if (need) {
#pragma unroll 1
      for (int bit = 5; bit >= 0; --bit) {
        const unsigned bm = 1u << bit;
#pragma unroll
        for (int t = 0; t < 4; ++t) {
          const unsigned cand = T2[t] | bm;
          const int cnt = popc64(__builtin_amdgcn_ballot_w64(ck[t] >= cand));
          T2[t] = (cnt >= 16) ? cand : T2[t];
        }
      }
    }
  }
  int* weid = (int*)(wexp + 64);
#pragma unroll
  for (int t = 0; t < 4; ++t) {
    const float cT = ukey2f(T2[t]);
    const bool win = ck[t] >= T2[t];
    const int sl = mbcnt64(__builtin_amdgcn_ballot_w64(win));
    if (win) {
      wexp[t * 16 + sl] = __expf(fminf(cs[t] - cT, 60.f));
      weid[t * 16 + sl] = (127 - (int)(kav[t] & 127u)) * 128 + (127 - (int)(kbv[t] & 127u));
    }
  }
  asm volatile("s_waitcnt lgkmcnt(0)" ::: "memory");
  {
    const int t = lane >> 4, sl = lane & 15;
    float es = 0.f;
#pragma unroll
    for (int q = 0; q < 4; ++q) { const float4 ee = *(const float4*)(wexp + t * 16 + q * 4); es += ee.x + ee.y + ee.z + ee.w; }
    const float e = wexp[t * 16 + sl];
    const int id = weid[t * 16 + sl];
    const size_t o = (size_t)(tok0 + w * 4 + t) * 128 + h * 16 + sl;
    ebuf[o] = id;
    gbuf[o] = e / es;
  }
  asm volatile("s_waitcnt lgkmcnt(0)" ::: "memory");
}

struct EpiStoreBf16 { bf16_t* dst; int ld; static constexpr int CHUNK = 1;
  __device__ void operator()(int r, int c, float v) const { dst[(size_t)r * ld + c] = f2bf(v); }
  __device__ void chunk(int r, int c, const float* v) const { *(uint4*)(dst + (size_t)r * ld + c) = pack8(v); } };
struct EpiGlu { const bf16_t* z; const float* bias; bf16_t* mix; static constexpr int CHUNK = 1;
  __device__ void operator()(int r, int c, float v) const {
    float zz = bf2f(z[(size_t)r * 512 + c]); float s = v + bias[c]; mix[(size_t)r * 1024 + 512 + c] = f2bf(zz / (1.f + __expf(-s))); }
  __device__ void chunk(int r, int c, const float* v) const {
    float zz[8]; unpack8(*(const uint4*)(z + (size_t)r * 512 + c), zz);
    const float4 b0 = *(const float4*)(bias + c), b1 = *(const float4*)(bias + c + 4);
    const float bb[8] = {b0.x, b0.y, b0.z, b0.w, b1.x, b1.y, b1.z, b1.w};
    float o[8];
#pragma unroll
    for (int i = 0; i < 8; ++i) o[i] = zz[i] / (1.f + __expf(-(v[i] + bb[i])));
    *(uint4*)(mix + (size_t)r * 1024 + 512 + c) = pack8(o); } };
struct EpiRes0 { const float* xp; const float* xs; float* xres; static constexpr int CHUNK = 1;
  __device__ void operator()(int r, int c, float v) const {
    float x = (r < T_P) ? xp[(size_t)r * 1024 + c] : xs[(size_t)(r - T_P) * 1024 + c]; xres[(size_t)r * 1024 + c] = x + v; }
  __device__ void chunk(int r, int c, const float* v) const {
    const float* src = (r < T_P) ? xp + (size_t)r * 1024 + c : xs + (size_t)(r - T_P) * 1024 + c;
    const float4 a = *(const float4*)src, b = *(const float4*)(src + 4);
    float* d = xres + (size_t)r * 1024 + c;
    *(float4*)d = make_float4(a.x + v[0], a.y + v[1], a.z + v[2], a.w + v[3]);
    *(float4*)(d + 4) = make_float4(b.x + v[4], b.y + v[5], b.z + v[6], b.w + v[7]); } };
struct EpiRes1 { float* xres; static constexpr int CHUNK = 1;
  __device__ void operator()(int r, int c, float v) const { xres[(size_t)r * 1024 + c] += v; }
  __device__ void chunk(int r, int c, const float* v) const {
    float* d = xres + (size_t)r * 1024 + c;
    const float4 a = *(const float4*)d, b = *(const float4*)(d + 4);
    *(float4*)d = make_float4(a.x + v[0], a.y + v[1], a.z + v[2], a.w + v[3]);
    *(float4*)(d + 4) = make_float4(b.x + v[4], b.y + v[5], b.z + v[6], b.w + v[7]); } };
struct EpiPool { bf16_t* mix; const float* scale; int g; static constexpr int CHUNK = 0;
  __device__ void operator()(int r, int c, float v) const { mix[(size_t)r * 1024 + g * 128 + c] = f2bf(v * scale[g * 128 + c]); }
  __device__ void chunk(int, int, const float*) const {} };
struct EpiKup { bf16_t* dst; int rowsPerB; int keyOff; int bStride; static constexpr int CHUNK = 1;
  __device__ void operator()(int r, int c, float v) const {
    int b = r / rowsPerB, key = r % rowsPerB + keyOff; dst[((size_t)(b * 8 + (c >> 6)) * bStride + key) * 64 + (c & 63)] = f2bf(v); }
  __device__ void chunk(int r, int c, const float* v) const {
    int b = r / rowsPerB, key = r % rowsPerB + keyOff; *(uint4*)(dst + ((size_t)(b * 8 + (c >> 6)) * bStride + key) * 64 + (c & 63)) = pack8(v); } };
struct EpiVt { bf16_t* dst; int rowsPerB; int keyOff; int ldv; static constexpr int CHUNK = 2;
  __device__ void operator()(int r, int c, float v) const {
    int b = r / rowsPerB, key = r % rowsPerB + keyOff;
    dst[((size_t)(b * 8 + (c >> 6)) * (ldv >> 6) + (key >> 6)) * 4096 + (c & 63) * 64 + (key & 63)] = f2bf(v); }
  __device__ void chunk(int r, int c, const float* v) const {
    int b = r / rowsPerB, key = r % rowsPerB + keyOff;
    *(uint4*)(dst + ((size_t)(b * 8 + (c >> 6)) * (ldv >> 6) + (key >> 6)) * 4096 + (c & 63) * 64 + (key & 63)) = pack8(v); } };


typedef const Params __attribute__((address_space(4))) KParams;

constexpr size_t OFF_BAR = WS_NEED;
__device__ __forceinline__ void grid_barrier(unsigned* ctr, unsigned target) {
  asm volatile("s_waitcnt vmcnt(0)" ::: "memory");
  __syncthreads();
  if (threadIdx.x == 0) {
    __builtin_amdgcn_fence(__ATOMIC_RELEASE, "agent");
    asm volatile("s_waitcnt vmcnt(0)" ::: "memory");
    __hip_atomic_fetch_add(ctr, 1u, __ATOMIC_RELAXED, __HIP_MEMORY_SCOPE_AGENT);
    unsigned spins = 0;
    while (__hip_atomic_load(ctr, __ATOMIC_RELAXED, __HIP_MEMORY_SCOPE_AGENT) < target) {
      __builtin_amdgcn_s_sleep(1);
      if (++spins > (1u << 27)) break;
    }
    __builtin_amdgcn_fence(__ATOMIC_ACQUIRE, "agent");
    asm volatile("s_waitcnt vmcnt(0)" ::: "memory");
  }
  __syncthreads();
}
#define GRID_BAR() { unsigned* ctr_ = (unsigned*)(((KParams*)__builtin_amdgcn_kernarg_segment_ptr())->ws + OFF_BAR); bar_k += 1; grid_barrier(ctr_, (unsigned)bar_k * gridDim.x); }
#define PHASE_BEGIN \
  Params p; \
  { KParams* kp_ = (KParams*)__builtin_amdgcn_kernarg_segment_ptr(); asm volatile("" : "+s"(kp_)); \
    _Pragma("unroll") for (int i_ = 0; i_ < 38; ++i_) p.in[i_] = kp_->in[i_]; \
    p.out = kp_->out; p.ws = kp_->ws; } \
  int tid = threadIdx.x; asm volatile("" : "+v"(tid)); \
  const int lane = tid & 63, w = __builtin_amdgcn_readfirstlane(tid >> 6); \
  const int gw = blockIdx.x * 8 + w, nw = gridDim.x * 8; \
  const size_t gtid = (size_t)blockIdx.x * NT + tid, gthreads = (size_t)gridDim.x * NT; \
  bf16_t* wt = (bf16_t*)(p.ws + OFF_WT); \
  bf16_t* proj = (bf16_t*)(p.ws + OFF_PROJ); \
  bf16_t* mix = (bf16_t*)(p.ws + OFF_MIX); \
  bf16_t* qbuf = (bf16_t*)(p.ws + OFF_QBUF); \
  bf16_t* zbuf = (bf16_t*)(p.ws + OFF_Z); \
  float* xres = p.out + O_Y; \
  (void)lane; (void)gw; (void)nw; (void)gtid; (void)gthreads; (void)wt; (void)proj; (void)mix; (void)qbuf; (void)zbuf; (void)xres;

template <int LAYER>
__device__ __forceinline__ void peer_phases(int& bar_k, unsigned char* smem) {
  const int layer = LAYER;
    for (int rep_ = 0; rep_ < NREP(7); ++rep_)
    {
    PHASE_BEGIN
      int vb = 0;
      gemm_run<2>(tid, smem, xres, xres, T_TOT, 1024, p.in[10] + layer * 1024, wt + WT_PQ + (size_t)layer * 1048576, T_TOT, 1024, 1024, vb, EpiStoreBf16{qbuf, 1024});
    }
    GRID_BAR();
    for (int rep_ = 0; rep_ < NREP(8); ++rep_) {
    PHASE_BEGIN
    {
      TopkFrags fr;
      int item = blockIdx.x;
      if (item < 1056 * 8) topk_load(fr, tid, p, layer, item);
      for (; item < 1056 * 8; item += gridDim.x) {
        TopkFrags cur = fr;
        const int nxt = item + gridDim.x;
        if (nxt < 1056 * 8) topk_load(fr, tid, p, layer, nxt);
        peer_topk_item(tid, smem, p, cur, item);
      }
    }
    }
    GRID_BAR();
    for (int rep_ = 0; rep_ < NREP(9); ++rep_) {
    PHASE_BEGIN
      int j = blockIdx.x & 7, lb = blockIdx.x >> 3, nb = ((int)gridDim.x - j + 7) >> 3;
      {
        unsigned* cnt_ = (unsigned*)(p.ws + OFF_BAR) + 16;
        bool ok_ = true;
#pragma unroll
        for (int x_ = 0; x_ < 16; ++x_) {
          const unsigned c_ = __hip_atomic_load(&cnt_[x_], __ATOMIC_RELAXED, __HIP_MEMORY_SCOPE_AGENT);
          ok_ = ok_ && ((x_ < 8) ? (c_ > 0u) : (c_ == 0u));
        }
        if (ok_) {
          j = ((const int*)(smem + (DYN_LDS - 16)))[0]; lb = ((const int*)(smem + (DYN_LDS - 16)))[1];
          nb = (int)__hip_atomic_load(&cnt_[j], __ATOMIC_RELAXED, __HIP_MEMORY_SCOPE_AGENT);
        }
      }
      for (int tok = lb * 8 + w; tok < T_TOT; tok += nb * 8) peer9a_token(tid, p, layer, tok, j);
    }
    GRID_BAR();
    for (int rep_ = 0; rep_ < NREP(9); ++rep_) {
    PHASE_BEGIN
      for (int tok = gw; tok < T_TOT; tok += nw) peer9m_token(tid, smem, p, tok);
    }
    GRID_BAR();
    for (int rep_ = 0; rep_ < NREP(9); ++rep_) {
    PHASE_BEGIN
      int j = blockIdx.x & 7, lb = blockIdx.x >> 3, nb = ((int)gridDim.x - j + 7) >> 3;
      {
        unsigned* cnt_ = (unsigned*)(p.ws + OFF_BAR) + 16;
        bool ok_ = true;
#pragma unroll
        for (int x_ = 0; x_ < 16; ++x_) {
          const unsigned c_ = __hip_atomic_load(&cnt_[x_], __ATOMIC_RELAXED, __HIP_MEMORY_SCOPE_AGENT);
          ok_ = ok_ && ((x_ < 8) ? (c_ > 0u) : (c_ == 0u));
        }
        if (ok_) {
          j = ((const int*)(smem + (DYN_LDS - 16)))[0]; lb = ((const int*)(smem + (DYN_LDS - 16)))[1];
          nb = (int)__hip_atomic_load(&cnt_[j], __ATOMIC_RELAXED, __HIP_MEMORY_SCOPE_AGENT);
        }
      }
      for (int tok = lb * 8 + w; tok < T_TOT; tok += nb * 8) peer9b_token(tid, p, tok, j);
    }
    if (layer == 1) {
      GRID_BAR();
      for (int rep_ = 0; rep_ < NREP(9); ++rep_) {
      PHASE_BEGIN
        for (int tok = gw; tok < T_TOT; tok += nw) final_norm_token(tid, p, tok);
      }
    }
}

__global__ void __launch_bounds__(NT) mega(Params kparams_) {
  cg::grid_group grid = cg::this_grid();
  int bar_k = 0;
  extern __shared__ __attribute__((aligned(16))) unsigned char smem[];
  if (threadIdx.x == 0) {
    unsigned* cnt_ = (unsigned*)(((KParams*)__builtin_amdgcn_kernarg_segment_ptr())->ws + OFF_BAR) + 16;
    const unsigned xcc_ = (unsigned)__builtin_amdgcn_s_getreg((3 << 11) | 20) & 0xFu;
    const unsigned rank_ = __hip_atomic_fetch_add(&cnt_[xcc_], 1u, __ATOMIC_RELAXED, __HIP_MEMORY_SCOPE_AGENT);
    ((int*)(smem + (DYN_LDS - 16)))[0] = (int)xcc_;
    ((int*)(smem + (DYN_LDS - 16)))[1] = (int)rank_;
  }

  for (int rep_ = 0; rep_ < NREP(0); ++rep_)
  {
    PHASE_BEGIN
    int vb = 0;
    transpose_convert(tid, smem, p.in[12], wt + WT_IN_E, 1024, 1280, vb);
    transpose_convert(tid, smem, p.in[13], wt + WT_OUT_E, 1024, 1024, vb);
    transpose_convert(tid, smem, p.in[23], wt + WT_GLU, 512, 512, vb);
    transpose_convert(tid, smem, p.in[25], wt + WT_IN_O, 1024, 1312, vb);
    transpose_convert(tid, smem, p.in[26], wt + WT_OUT_O, 1024, 1024, vb);
    for (int g = 0; g < 4; ++g) transpose_convert(tid, smem, p.in[27] + g * 16384, wt + WT_POOL + g * 16384, 128, 128, vb);
    transpose_convert(tid, smem, p.in[31], wt + WT_UQ, 512, 768, vb);
    transpose_convert(tid, smem, p.in[32], wt + WT_UK, 256, 512, vb);
    transpose_convert(tid, smem, p.in[33], wt + WT_UV, 256, 512, vb);
    transpose_convert(tid, smem, p.in[34], wt + WT_PQ, 1024, 1024, vb);
    transpose_convert(tid, smem, p.in[34] + 1048576, wt + WT_PQ + 1048576, 1024, 1024, vb);
    convert_plain(tid, p.in[35], wt + WT_KEYS, 262144);
    quant_rows(p.in[36], p.ws + OFF_TAB, (float*)(p.ws + OFF_TAB + TAB_SU_OFF), gw, nw, tid);
    quant_rows(p.in[37], p.ws + OFF_TAB + TAB_V_OFF, (float*)(p.ws + OFF_TAB + TAB_SV_OFF), gw, nw, tid);
  }
  grid.sync();

  for (int rep_ = 0; rep_ < NREP(1); ++rep_)
  {
    PHASE_BEGIN
    int vb = 0;
    gemm_run<2>(tid, smem, p.in[0], p.in[1], T_P, 1024, p.in[9], wt + WT_IN_E, T_TOT, 1280, 1024, vb, EpiStoreBf16{proj, 1280});
  }
  GRID_BAR();

  for (int rep_ = 0; rep_ < NREP(2); ++rep_)
  {
    PHASE_BEGIN
    bf16_t* vt0 = (bf16_t*)(p.ws + OFF_VT0);
    bf16_t* kall = (bf16_t*)(p.ws + OFF_KALL);
    bf16_t* vtall = (bf16_t*)(p.ws + OFF_VTALL);
    for (int tok = gw; tok < T_TOT; tok += nw) {
      const bool isS = tok >= T_P;
      int b, t, pos;
      if (!isS) { b = tok >> 12; t = tok & 4095; pos = t; } else { int s = tok - T_P; b = s >> 5; t = s & 31; pos = 2048 + t; }
      bf16_t* row = proj + (size_t)tok * 1280;
      const int lm = lane & 7;
      float sn[8], cs[8];
#pragma unroll
      for (int j = 0; j < 8; ++j) { float inv = exp2f(-(float)j * (LOG2_THETA / 8.f)); sincos_rev((float)pos * inv, sn[j], cs[j]); }
      {
        uint4 qv = *(const uint4*)(row + lane * 8);
        float x[8]; unpack8(qv, x);
#pragma unroll
        for (int j = 0; j < 8; ++j) {
          float other = __shfl_xor(x[j], 1);
          if (lm == 0) x[j] = x[j] * cs[j] - other * sn[j];
          else if (lm == 1) x[j] = x[j] * cs[j] + other * sn[j];
        }
        *(uint4*)(row + lane * 8) = pack8(x);
      }
      {
        uint4 kv = make_uint4(0, 0, 0, 0);
        if (lane < 32) kv = *(const uint4*)(row + 512 + lane * 8);
        float x[8]; unpack8(kv, x);
#pragma unroll
        for (int j = 0; j < 8; ++j) {
          float other = __shfl_xor(x[j], 1);
          if (lane < 16) {
            if (lm == 0) x[j] = x[j] * cs[j] - other * sn[j];
            else if (lm == 1) x[j] = x[j] * cs[j] + other * sn[j];
          }
        }
        if (lane < 32) {
          const uint4 pk = pack8(x);
          const int e0 = (lane & 15) * 8;
          if (!isS) {
            if (lane < 16) *(uint4*)(row + 512 + lane * 8) = pk;
            else {
              const int kvh = e0 >> 6, d0 = e0 & 63;
#pragma unroll
              for (int j = 0; j < 8; ++j) vt0[((size_t)(b * 2 + kvh) * 64 + d0 + j) * 4096 + t] = f2bf(x[j]);
            }
            if (t >= 3968) {
              float* dst = p.out + ((lane < 16) ? O_SWAK_P : O_SWAV_P) + ((size_t)(b * 128 + (t - 3968)) * 128 + e0);
              *(float4*)dst = make_float4(x[0], x[1], x[2], x[3]);
              *(float4*)(dst + 4) = make_float4(x[4], x[5], x[6], x[7]);
            }
          } else {
            float* dst = p.out + ((lane < 16) ? O_SWAK_S : O_SWAV_S) + ((size_t)(b * 128 + 96 + t) * 128 + e0);
            *(float4*)dst = make_float4(x[0], x[1], x[2], x[3]);
            *(float4*)(dst + 4) = make_float4(x[4], x[5], x[6], x[7]);
            if (lane < 16) *(uint4*)(kall + (size_t)(b * 160 + 128 + t) * 128 + e0) = pk;
            else {
              const int kvh = e0 >> 6, d0 = e0 & 63;
#pragma unroll
              for (int j = 0; j < 8; ++j) vtall[((size_t)(b * 2 + kvh) * 64 + d0 + j) * 192 + 128 + t] = f2bf(x[j]);
            }
          }
        }
      }
    }
    for (size_t idx = gtid; idx < (size_t)32 * 96 * 128; idx += gthreads) {
      const int e = (int)(idx & 127); const int wd = (int)((idx >> 7) % 96); const int b = (int)(idx / (96 * 128));
      const size_t src = ((size_t)(b * 128 + 32 + wd)) * 128 + e, dst = ((size_t)(b * 128 + wd)) * 128 + e;
      p.out[O_SWAK_S + dst] = p.in[2][src];
      p.out[O_SWAV_S + dst] = p.in[3][src];
    }
    for (size_t idx = gtid; idx < (size_t)32 * 128 * 128; idx += gthreads) {
      const int e = (int)(idx & 127); const int key = (int)((idx >> 7) & 127); const int b = (int)(idx >> 14);
      kall[(size_t)(b * 160 + key) * 128 + e] = f2bf(p.in[2][idx]);
      vtall[((size_t)(b * 2 + (e >> 6)) * 64 + (e & 63)) * 192 + key] = f2bf(p.in[3][idx]);
    }
    for (size_t idx = gtid; idx < (size_t)32 * 2 * 64 * 32; idx += gthreads) {
      const int kk = (int)(idx & 31); const size_t rr = idx >> 5;
      vtall[rr * 192 + 160 + kk] = 0;
    }
    float* sUw = (float*)smem + w * 512;
    for (int item = gw; item < 32768; item += nw) s5_item<0>(tid, sUw, p, item);
  }
  GRID_BAR();

  for (int rep_ = 0; rep_ < NREP(3); ++rep_)
  {
    PHASE_BEGIN
    if (gtid < 16384) {
      const int n = (int)(gtid & 63), g = (int)((gtid >> 6) & 31), b = (int)(gtid >> 11);
      const int gn = g * 64 + n;
      const float lr = fminf(p.in[15][gn], -1e-4f), li = p.in[16][gn];
      const float dt = __expf(p.in[17][g]);
      const float mag = __expf(lr * dt);
      float sn, cs; sincos_rev(li * dt, sn, cs);
      float ar = mag * cs, ai = mag * sn;
#pragma unroll
      for (int i = 0; i < 5; ++i) { float nr = ar * ar - ai * ai, ni = 2.f * ar * ai; ar = nr; ai = ni; }
      const float* s1re = (const float*)(p.ws + OFF_QMLA);
      const float* s1im = s1re + 2097152;
      float* hinre = (float*)(p.ws + OFF_QMLA) + 2 * 2097152;
      float* hinim = hinre + 2097152;
      float hr = 0.f, hi = 0.f;
#pragma unroll 8
      for (int c = 0; c < 128; ++c) {
        const size_t idx = ((size_t)(b * 128 + c) * 32 + g) * 64 + n;
        hinre[idx] = hr; hinim[idx] = hi;
        const float sr = s1re[idx], si = s1im[idx];
        const float nhr = ar * hr - ai * hi + sr, nhi = ar * hi + ai * hr + si;
        hr = nhr; hi = nhi;
      }
      p.out[O_SSMRE_P + (size_t)(b * 32 + g) * 64 + n] = hr;
      p.out[O_SSMIM_P + (size_t)(b * 32 + g) * 64 + n] = hi;
    }
    const bf16_t* vt0 = (const bf16_t*)(p.ws + OFF_VT0);
    const bf16_t* kall = (const bf16_t*)(p.ws + OFF_KALL);
    const bf16_t* vtall = (const bf16_t*)(p.ws + OFF_VTALL);
    const float* sink = p.in[14];
    for (int item = blockIdx.x; item < 2048 + 256; item += gridDim.x) {
      AttnDesc d;
      d.scale = 0.125f; d.kx = nullptr; d.pos0 = 0;
      if (item < 2048) {
        const int h = item & 7, pr = (item >> 3) & 31, b = item >> 8;
        const int kvh = h >> 2;
        const int chunk = pr * 2 + (w >> 2);
        const int tok = b * 4096 + chunk * 64 + (w & 3) * 16;
        d.q = proj + (size_t)tok * 1280 + h * 64; d.ldq = 1280; d.active = 1;
        d.kt_lo = max(0, chunk - 2); d.kt_hi = chunk + 1;
        d.out = mix + (size_t)tok * 1024 + h * 64; d.ldo = 1024;
        d.m0 = sink[h]; d.l0 = 1.f;
        d.k = proj + (size_t)(b * 4096) * 1280 + 512 + kvh * 64; d.ldk = 1280;
        d.vt = vt0 + (size_t)(b * 2 + kvh) * 64 * 4096; d.ldv = 4096; d.vts = 64; d.nkeys = 4096;
        d.bt_lo = max(0, pr * 2 - 2); d.bt_hi = pr * 2 + 2;
      } else {
        const int it = item - 2048;
        const int h = it & 7, b = it >> 3;
        const int kvh = h >> 2;
        const int tok = T_P + b * 32 + (w & 1) * 16;
        d.q = proj + (size_t)tok * 1280 + h * 64; d.ldq = 1280; d.active = (w < 2);
        d.kt_lo = 0; d.kt_hi = 3;
        d.out = mix + (size_t)tok * 1024 + h * 64; d.ldo = 1024;
        d.m0 = sink[h]; d.l0 = 1.f;
        d.k = kall + (size_t)(b * 160) * 128 + kvh * 64; d.ldk = 128;
        d.vt = vtall + (size_t)(b * 2 + kvh) * 64 * 192; d.ldv = 192; d.vts = 64; d.nkeys = 160;
        d.bt_lo = 0; d.bt_hi = 3;
      }
      attn_item<64>(tid, smem, d);
    }
  }
  GRID_BAR();

  for (int rep_ = 0; rep_ < NREP(4); ++rep_)
  {
    PHASE_BEGIN
    float* sUw = (float*)smem + w * 512;
    for (int item = gw; item < 33792; item += nw) s5_item<1>(tid, sUw, p, item);
  }
  GRID_BAR();

  for (int rep_ = 0; rep_ < NREP(5); ++rep_)
  {
    PHASE_BEGIN
    int vb = 0;
    gemm_run<0>(tid, smem, zbuf, zbuf, T_TOT, 512, nullptr, wt + WT_GLU, T_TOT, 512, 512, vb, EpiGlu{zbuf, p.in[24], mix});
  }
  GRID_BAR();

  for (int rep_ = 0; rep_ < NREP(6); ++rep_)
  {
    PHASE_BEGIN
    int vb = 0;
    gemm_run<0>(tid, smem, mix, mix, T_TOT, 1024, nullptr, wt + WT_OUT_E, T_TOT, 1024, 1024, vb, EpiRes0{p.in[0], p.in[1], xres});
  }
  GRID_BAR();

  peer_phases<0>(bar_k, smem);
  GRID_BAR();
      for (int rep_ = 0; rep_ < NREP(10); ++rep_)
      {
    PHASE_BEGIN
        int vb = 0;
        gemm_run<2>(tid, smem, xres, xres, T_TOT, 1024, p.in[9] + 1024, wt + WT_IN_O, T_TOT, 1312, 1024, vb, EpiStoreBf16{proj, 1312});
      }
      GRID_BAR();
      for (int rep_ = 0; rep_ < NREP(11); ++rep_)
      {
    PHASE_BEGIN
        bf16_t* cqn = zbuf;
        bf16_t* mbuf = (bf16_t*)(p.ws + OFF_M);
        bf16_t* cbuf = (bf16_t*)(p.ws + OFF_C);
        bf16_t* kpbuf = (bf16_t*)(p.ws + OFF_KP);
        bf16_t* kps = (bf16_t*)(p.ws + OFF_KPS);
        for (int tok = gw; tok < T_TOT; tok += nw) {
          const bool isS = tok >= T_P;
          int b, t, pos;
          if (!isS) { b = tok >> 12; t = tok & 4095; pos = t; } else { int s = tok - T_P; b = s >> 5; t = s & 31; pos = 2048 + t; }
          const bf16_t* row = proj + (size_t)tok * 1312;
          {
            uint4 v = *(const uint4*)(row + lane * 8);
            float x[8]; unpack8(v, x);
            float ss = 0.f;
#pragma unroll
            for (int j = 0; j < 8; ++j) ss += x[j] * x[j];
            ss = wave_sum(ss);
            const float rs = rsqrtf(ss * (1.f / 512.f) + 1e-6f);
            const float4 g0 = *(const float4*)(p.in[29] + lane * 8), g1 = *(const float4*)(p.in[29] + lane * 8 + 4);
            x[0] *= rs * g0.x; x[1] *= rs * g0.y; x[2] *= rs * g0.z; x[3] *= rs * g0.w;
            x[4] *= rs * g1.x; x[5] *= rs * g1.y; x[6] *= rs * g1.z; x[7] *= rs * g1.w;
            *(uint4*)(cqn + (size_t)tok * 512 + lane * 8) = pack8(x);
          }
          {
            uint2 v = *(const uint2*)(row + 512 + lane * 4);
            float x0 = lo2f(v.x), x1 = hi2f(v.x), x2 = lo2f(v.y), x3 = hi2f(v.y);
            float ss = wave_sum(x0 * x0 + x1 * x1 + x2 * x2 + x3 * x3);
            const float rs = rsqrtf(ss * (1.f / 256.f) + 1e-6f);
            const float4 g = *(const float4*)(p.in[30] + lane * 4);
            x0 *= rs * g.x; x1 *= rs * g.y; x2 *= rs * g.z; x3 *= rs * g.w;
            uint2 o; o.x = pack2(x0, x1); o.y = pack2(x2, x3);
            *(uint2*)(cbuf + (size_t)tok * 256 + lane * 4) = o;
            float* dst = isS ? (p.out + O_CKV_S + (size_t)(tok - T_P) * 256 + lane * 4) : (p.out + O_CKV_P + (size_t)tok * 256 + lane * 4);
            *(float4*)dst = make_float4(x0, x1, x2, x3);
          }
          {
            float xv = 0.f;
            if (lane < 32) xv = bf2f(row[768 + lane]);
            const float other = __shfl_xor(xv, 16);
            const int f = lane & 15;
            const float inv = exp2f(-(float)f * (LOG2_THETA / 16.f));
            float sn, cs; sincos_rev((float)pos * inv, sn, cs);
            const float r = (lane < 16) ? (xv * cs - other * sn) : (xv * cs + other * sn);
            if (lane < 32) {
              kpbuf[(size_t)tok * 32 + lane] = f2bf(r);
              if (isS) { p.out[O_KPE_S + (size_t)(tok - T_P) * 32 + lane] = r; kps[((size_t)b * 2112 + 2048 + t) * 32 + lane] = f2bf(r); }
              else p.out[O_KPE_P + (size_t)tok * 32 + lane] = r;
            }
          }
          {
            const int gi = lane >> 4; const int wlen = 2 << gi;
            float tot[8], cur[8];
#pragma unroll
            for (int j = 0; j < 8; ++j) tot[j] = 0.f;
            uint4 v = *(const uint4*)(row + 800 + lane * 8);
            unpack8(v, cur);
#pragma unroll
            for (int j = 0; j < 8; ++j) tot[j] = cur[j];
            for (int jb = 1; jb < 16; ++jb) {
              if (jb < wlen) {
                const int tt = t - jb;
                if (tt >= 0) {
                  uint4 pv = *(const uint4*)(row - (size_t)jb * 1312 + 800 + lane * 8);
                  float y[8]; unpack8(pv, y);
#pragma unroll
                  for (int j = 0; j < 8; ++j) tot[j] += y[j];
                } else if (isS) {
                  const float* sp = p.in[6] + ((size_t)b * 15 + (15 + tt)) * 512 + lane * 8;
                  float4 a = *(const float4*)sp, bq = *(const float4*)(sp + 4);
                  tot[0] += a.x; tot[1] += a.y; tot[2] += a.z; tot[3] += a.w; tot[4] += bq.x; tot[5] += bq.y; tot[6] += bq.z; tot[7] += bq.w;
                }
              }
            }
            const float cnt = (float)min(pos + 1, wlen);
            float mm[8];
#pragma unroll
            for (int j = 0; j < 8; ++j) mm[j] = tot[j] / cnt - cur[j];
            *(uint4*)(mbuf + (size_t)tok * 512 + lane * 8) = pack8(mm);
            const int tlen = isS ? 32 : 4096;
            if (t >= tlen - 15) {
              const int i = t - (tlen - 15);
              float* dst = isS ? (p.out + O_POOL_S + ((size_t)b * 15 + i) * 512 + lane * 8) : (p.out + O_POOL_P + ((size_t)b * 15 + i) * 512 + lane * 8);
              *(float4*)dst = make_float4(cur[0], cur[1], cur[2], cur[3]);
              *(float4*)(dst + 4) = make_float4(cur[4], cur[5], cur[6], cur[7]);
            }
          }
        }
        for (size_t idx = gtid; idx < (size_t)32 * 2048 * 32; idx += gthreads) {
          const int e = (int)(idx & 31); const int key = (int)((idx >> 5) & 2047); const int b = (int)(idx >> 16);
          kps[((size_t)b * 2112 + key) * 32 + e] = f2bf(p.in[8][idx]);
        }
      }
      GRID_BAR();
      for (int rep_ = 0; rep_ < NREP(12); ++rep_)
      {
    PHASE_BEGIN
        bf16_t* cqn = zbuf;
        bf16_t* mbuf = (bf16_t*)(p.ws + OFF_M);
        bf16_t* cbuf = (bf16_t*)(p.ws + OFF_C);
        bf16_t* qmla = (bf16_t*)(p.ws + OFF_QMLA);
        bf16_t* kupp = qbuf;
        bf16_t* vtp = qbuf + 16777216;
        bf16_t* kups = (bf16_t*)(p.ws + OFF_KUPS);
        bf16_t* vts = (bf16_t*)(p.ws + OFF_VTS);
        for (size_t idx = gtid; idx < (size_t)32 * 8 * 64 * 32; idx += gthreads) {
          const int kk = (int)(idx & 31); const size_t rr = idx >> 5;
          vts[((rr >> 6) * 33 + 32) * 4096 + (rr & 63) * 64 + 32 + kk] = 0;
        }
        int vb = 0;
        gemm_run<1>(tid, smem, p.in[7], p.in[7], 65536, 256, nullptr, wt + WT_UK, 65536, 512, 256, vb, EpiKup{kups, 2048, 0, 2112});
        gemm_run<1>(tid, smem, p.in[7], p.in[7], 65536, 256, nullptr, wt + WT_UV, 65536, 512, 256, vb, EpiVt{vts, 2048, 0, 2112});
        gemm_run<0>(tid, smem, cqn, cqn, T_TOT, 512, nullptr, wt + WT_UQ, T_TOT, 768, 512, vb, EpiStoreBf16{qmla, 768});
        gemm_run<0>(tid, smem, cbuf, cbuf, T_P, 256, nullptr, wt + WT_UK, T_P, 512, 256, vb, EpiKup{kupp, 4096, 0, 4096});
        gemm_run<0>(tid, smem, cbuf, cbuf, T_P, 256, nullptr, wt + WT_UV, T_P, 512, 256, vb, EpiVt{vtp, 4096, 0, 4096});
        gemm_run<0>(tid, smem, cbuf + (size_t)T_P * 256, cbuf, 1024, 256, nullptr, wt + WT_UK, 1024, 512, 256, vb, EpiKup{kups, 32, 2048, 2112});
        gemm_run<0>(tid, smem, cbuf + (size_t)T_P * 256, cbuf, 1024, 256, nullptr, wt + WT_UV, 1024, 512, 256, vb, EpiVt{vts, 32, 2048, 2112});
        for (int g = 0; g < 4; ++g)
          gemm_run<0>(tid, smem, mbuf + g * 128, mbuf, T_TOT, 512, nullptr, wt + WT_POOL + g * 16384, T_TOT, 128, 128, vb, EpiPool{mix, p.in[28], g});
      }
      GRID_BAR();
      for (int rep_ = 0; rep_ < NREP(13); ++rep_)
      {
    PHASE_BEGIN
        const bf16_t* qmla = (const bf16_t*)(p.ws + OFF_QMLA);
        const bf16_t* kupp = qbuf;
        const bf16_t* vtp = qbuf + 16777216;
        const bf16_t* kups = (const bf16_t*)(p.ws + OFF_KUPS);
        const bf16_t* vts = (const bf16_t*)(p.ws + OFF_VTS);
        const bf16_t* kpbuf = (const bf16_t*)(p.ws + OFF_KP);
        const bf16_t* kps = (const bf16_t*)(p.ws + OFF_KPS);
        const int G = gridDim.x;
        const bool xsched = (G == 256);
        const int nitems = 2048 + 256;
        const int xcd = blockIdx.x & 7, loc = blockIdx.x >> 3;
        for (int k = 0;; ++k) {
          int pit, sit = -1;
          if (xsched) {
            if (k >= 9) break;
            if (k == 0) { pit = -1; sit = blockIdx.x; }
            else {
              const int r = k - 1;
              const int grp = xcd + 8 * r;
              const int pr = (r & 1) ? (31 - loc) : loc;
              pit = ((31 - pr) << 6) | grp;
            }
          } else {
            const int posn = (k & 1) ? (G - 1 - (int)blockIdx.x) : (int)blockIdx.x;
            const int v = k * G + posn;
            if (k * G >= nitems) break;
            if (v >= nitems) continue;
            if (v < 1024) pit = v; else if (v < 1280) { pit = -1; sit = v - 1024; } else pit = v - 256;
          }
          AttnDesc d;
          d.scale = 0.10206207261596575f; d.m0 = -1e30f; d.l0 = 0.f;
          if (pit >= 0) {
            const int pr = 31 - (pit >> 6); const int h = pit & 7, b = (pit >> 3) & 7;
            const int chunk = pr * 2 + (w >> 2);
            const int tok = b * 4096 + chunk * 64 + (w & 3) * 16;
            d.q = qmla + (size_t)tok * 768 + h * 96; d.ldq = 768; d.active = 1; d.pos0 = chunk * 64 + (w & 3) * 16;
            d.kt_lo = 0; d.kt_hi = chunk + 1;
            d.out = mix + (size_t)tok * 1024 + 512 + h * 64; d.ldo = 1024;
            d.k = kupp + (size_t)(b * 8 + h) * 4096 * 64; d.ldk = 64;
            d.kx = kpbuf + (size_t)(b * 4096) * 32;
            d.vt = vtp + (size_t)(b * 8 + h) * 64 * 4096; d.ldv = 64; d.vts = 4096; d.nkeys = 4096;
            d.bt_lo = 0; d.bt_hi = pr * 2 + 2;
          } else {
            const int h = sit & 7, b = sit >> 3;
            const int tok = T_P + b * 32 + (w & 1) * 16;
            d.q = qmla + (size_t)tok * 768 + h * 96; d.ldq = 768; d.active = (w < 2); d.pos0 = 2048 + (w & 1) * 16;
            d.kt_lo = 0; d.kt_hi = 33;
            d.out = mix + (size_t)tok * 1024 + 512 + h * 64; d.ldo = 1024;
            d.k = kups + (size_t)(b * 8 + h) * 2112 * 64; d.ldk = 64;
            d.kx = kps + (size_t)(b * 2112) * 32;
            d.vt = vts + (size_t)(b * 8 + h) * 64 * 2112; d.ldv = 64; d.vts = 4096; d.nkeys = 2080;
            d.bt_lo = 0; d.bt_hi = 33;
          }
          attn_item<96>(tid, smem, d);
        }
      }
      GRID_BAR();
      for (int rep_ = 0; rep_ < NREP(14); ++rep_)
      {
    PHASE_BEGIN
        quant_rows(p.in[36] + 16777216, p.ws + OFF_TAB, (float*)(p.ws + OFF_TAB + TAB_SU_OFF), gw, nw, tid);
        quant_rows(p.in[37] + 16777216, p.ws + OFF_TAB + TAB_V_OFF, (float*)(p.ws + OFF_TAB + TAB_SV_OFF), gw, nw, tid);
        int vb = 0;
        gemm_run<0>(tid, smem, mix, mix, T_TOT, 1024, nullptr, wt + WT_OUT_O, T_TOT, 1024, 1024, vb, EpiRes1{xres});
      }
      GRID_BAR();
  peer_phases<1>(bar_k, smem);
}

extern "C" void kernel_launch(void* const* d_in, const int* in_sizes, int n_in, void* d_out, int out_size, void* d_ws, size_t ws_size, hipStream_t stream) {
  static int grid_blocks = 0;
  if (grid_blocks == 0) {
    int dev = 0, cus = 0, per_cu = 0;
    hipGetDevice(&dev);
    hipDeviceGetAttribute(&cus, hipDeviceAttributeMultiprocessorCount, dev);
    hipFuncSetAttribute((const void*)mega, hipFuncAttributeMaxDynamicSharedMemorySize, DYN_LDS);
    hipOccupancyMaxActiveBlocksPerMultiprocessor(&per_cu, (const void*)mega, NT, DYN_LDS);
    if (per_cu < 1) per_cu = 1;
    if (per_cu > 1) per_cu = 1;
    grid_blocks = cus * per_cu;
    if (ws_size < WS_NEED + 256) fprintf(stderr, "kernel_launch: workspace too small: %zu < %zu\n", ws_size, (size_t)WS_NEED);
  }
  hipMemsetAsync((unsigned char*)d_ws + OFF_BAR, 0, 256, stream);
  Params p{};
  for (int i = 0; i < 38; ++i) p.in[i] = (const float*)d_in[i];
  p.out = (float*)d_out;
  p.ws = (unsigned char*)d_ws;
  void* args[] = {&p};
  hipError_t e = hipLaunchCooperativeKernel((const void*)mega, dim3(grid_blocks), dim3(NT), args, DYN_LDS, stream);
  if (e != hipSuccess) fprintf(stderr, "cooperative launch failed: %s (grid %d)\n", hipGetErrorString(e), grid_blocks);
}
```

```cpp
#include <hip/hip_runtime.h>
#include <hip/hip_bf16.h>
#include <hip/hip_cooperative_groups.h>
#include <cstdio>
namespace cg = cooperative_groups;

typedef unsigned short bf16_t;
using bf16x8 = __attribute__((ext_vector_type(8))) short;
using f32x4 = __attribute__((ext_vector_type(4))) float;

#ifndef PH
#define PH 0xFFFFFFu
#endif
#ifndef DBL
#define DBL 0u
#endif
#define NREP(n) ((int)((PH >> (n)) & 1u) * (1 + (int)((DBL >> (n)) & 1u)))
#define NT 512
#define DYN_LDS 81920
#define T_TOT 33792
#define T_P 32768
#define LOG2_THETA 18.931568569324174f

#define O_Y 0
#define O_SWAK_P 34603008
#define O_SWAV_P 34734080
#define O_SSMRE_P 34865152
#define O_SSMIM_P 34881536
#define O_POOL_P 34897920
#define O_CKV_P 34959360
#define O_KPE_P 43347968
#define O_SWAK_S 44396544
#define O_SWAV_S 44920832
#define O_SSMRE_S 45445120
#define O_SSMIM_S 45510656
#define O_POOL_S 45576192
#define O_CKV_S 45821952
#define O_KPE_S 46084096

constexpr size_t OFF_PROJ = 0;
constexpr size_t OFF_TAB = OFF_PROJ + 88670208ull;
constexpr size_t OFF_MIX = OFF_TAB + 67108864ull;
constexpr size_t OFF_QBUF = OFF_MIX + 69206016ull;
constexpr size_t OFF_QMLA = OFF_QBUF + 69206016ull;
constexpr size_t OFF_Z = OFF_QMLA + 51904512ull;
constexpr size_t OFF_M = OFF_Z + 34603008ull;
constexpr size_t OFF_C = OFF_M + 34603008ull;
constexpr size_t OFF_KP = OFF_C + 17301504ull;
constexpr size_t OFF_VT0 = OFF_KP + 2162688ull;
constexpr size_t OFF_KALL = OFF_VT0 + 8388608ull;
constexpr size_t OFF_VTALL = OFF_KALL + 1327104ull;
constexpr size_t OFF_KPS = OFF_VTALL + 1572864ull;
constexpr size_t OFF_WT = OFF_KPS + 4325376ull;
constexpr size_t WS_NEED = OFF_WT + 16187392ull;
constexpr size_t OFF_KUPS = OFF_PROJ;
constexpr size_t OFF_VTS = OFF_PROJ + 69206016ull;
constexpr size_t WT_IN_E = 0;
constexpr size_t WT_OUT_E = WT_IN_E + 1310720;
constexpr size_t WT_GLU = WT_OUT_E + 1048576;
constexpr size_t WT_IN_O = WT_GLU + 262144;
constexpr size_t WT_OUT_O = WT_IN_O + 1343488;
constexpr size_t WT_POOL = WT_OUT_O + 1048576;
constexpr size_t WT_UQ = WT_POOL + 65536;
constexpr size_t WT_UK = WT_UQ + 393216;
constexpr size_t WT_UV = WT_UK + 131072;
constexpr size_t WT_PQ = WT_UV + 131072;
constexpr size_t WT_KEYS = WT_PQ + 2097152;

struct Params {
  const float* in[38];
  float* out;
  unsigned char* ws;
};

typedef __bf16 bf16x2_t __attribute__((ext_vector_type(2)));
typedef float float2_t __attribute__((ext_vector_type(2)));
__device__ __forceinline__ unsigned pack2(float a, float b) {
  float2_t f = {a, b};
  bf16x2_t h = __builtin_convertvector(f, bf16x2_t);
  return __builtin_bit_cast(unsigned, h);
}
__device__ __forceinline__ unsigned short f2bf(float f) { return (unsigned short)(pack2(f, 0.f) & 0xffffu); }
__device__ __forceinline__ float bf2f(unsigned short b) { return __uint_as_float(((unsigned)b) << 16); }
__device__ __forceinline__ float lo2f(unsigned u) { return __uint_as_float(u << 16); }
__device__ __forceinline__ float hi2f(unsigned u) { return __uint_as_float(u & 0xffff0000u); }
__device__ __forceinline__ void unpack8(uint4 v, float* x) {
  x[0] = lo2f(v.x); x[1] = hi2f(v.x); x[2] = lo2f(v.y); x[3] = hi2f(v.y);
  x[4] = lo2f(v.z); x[5] = hi2f(v.z); x[6] = lo2f(v.w); x[7] = hi2f(v.w);
}
__device__ __forceinline__ uint4 pack8(const float* x) {
  uint4 v; v.x = pack2(x[0], x[1]); v.y = pack2(x[2], x[3]); v.z = pack2(x[4], x[5]); v.w = pack2(x[6], x[7]); return v;
}
template <int CTRL> __device__ __forceinline__ float dpp_f(float v) {
  return __int_as_float(__builtin_amdgcn_update_dpp(0, __float_as_int(v), CTRL, 0xf, 0xf, true));
}
__device__ __forceinline__ float row16_max(float v) {
  v = fmaxf(v, dpp_f<0xB1>(v)); v = fmaxf(v, dpp_f<0x4E>(v)); v = fmaxf(v, dpp_f<0x141>(v)); v = fmaxf(v, dpp_f<0x140>(v)); return v;
}
__device__ __forceinline__ float row16_sum(float v) {
  v += dpp_f<0xB1>(v); v += dpp_f<0x4E>(v); v += dpp_f<0x141>(v); v += dpp_f<0x140>(v); return v;
}
__device__ __forceinline__ float wave_sum(float v) {
  v = row16_sum(v);
  const float a = __int_as_float(__builtin_amdgcn_readlane(__float_as_int(v), 0));
  const float b = __int_as_float(__builtin_amdgcn_readlane(__float_as_int(v), 16));
  const float c = __int_as_float(__builtin_amdgcn_readlane(__float_as_int(v), 32));
  const float d = __int_as_float(__builtin_amdgcn_readlane(__float_as_int(v), 48));
  return (a + b) + (c + d);
}
__device__ __forceinline__ void sincos_rev(float ang, float& s, float& c) {
  float rev = ang * 0.15915494309189535f;
  rev = rev - floorf(rev);
  s = __builtin_amdgcn_sinf(rev);
  c = __builtin_amdgcn_cosf(rev);
}
__device__ __forceinline__ float gelu_tanh(float x) {
  float y = 0.7978845608028654f * (x + 0.044715f * x * x * x);
  float t = 1.f - 2.f / (1.f + __expf(2.f * y));
  return 0.5f * x * (1.f + t);
}
__device__ __forceinline__ float gelu_erf(float x) { return 0.5f * x * (1.f + erff(x * 0.7071067811865476f)); }
__device__ __forceinline__ int logical_bid() {
  const int G = (int)gridDim.x, b = (int)blockIdx.x;
  return ((G & 7) == 0) ? ((b & 7) * (G >> 3) + (b >> 3)) : b;
}
__device__ __forceinline__ int rot_start(int vbase) {
  int G = (int)gridDim.x;
  int s = (logical_bid() - vbase) % G;
  if (s < 0) s += G;
  return s;
}

__device__ __forceinline__ void transpose_convert(int tid, unsigned char* smem, const float* __restrict__ src, bf16_t* __restrict__ dst, int K, int N, int& vbase) {
  float* tl = (float*)smem;
  const int tk = K / 64, tn = (N + 63) / 64;
  const int ntiles = tk * tn;
  for (int tile = rot_start(vbase); tile < ntiles; tile += gridDim.x) {
    const int k0 = (tile / tn) * 64, n0 = (tile % tn) * 64;
    __syncthreads();
#pragma unroll
    for (int i = 0; i < 2; ++i) {
      int r = (tid >> 4) + 32 * i, c4 = (tid & 15) * 4;
      float4 v = make_float4(0.f, 0.f, 0.f, 0.f);
      if (n0 + c4 < N) v = *(const float4*)(src + (size_t)(k0 + r) * N + n0 + c4);
      tl[r * 65 + c4 + 0] = v.x; tl[r * 65 + c4 + 1] = v.y; tl[r * 65 + c4 + 2] = v.z; tl[r * 65 + c4 + 3] = v.w;
    }
    __syncthreads();
    int n = tid >> 3, k8 = (tid & 7) * 8;
    if (n0 + n < N) {
      float x[8];
#pragma unroll
      for (int j = 0; j < 8; ++j) x[j] = tl[(k8 + j) * 65 + n];
      *(uint4*)(dst + (size_t)(n0 + n) * K + k0 + k8) = pack8(x);
    }
  }
  vbase += ntiles;
}

__device__ __forceinline__ void convert_plain(int tid, const float* __restrict__ src, bf16_t* __restrict__ dst, size_t n) {
  size_t i = ((size_t)blockIdx.x * NT + tid) * 8;
  const size_t stride = (size_t)gridDim.x * NT * 8;
  for (; i < n; i += stride) {
    float4 a = *(const float4*)(src + i), b = *(const float4*)(src + i + 4);
    uint4 v; v.x = pack2(a.x, a.y); v.y = pack2(a.z, a.w); v.z = pack2(b.x, b.y); v.w = pack2(b.z, b.w);
    *(uint4*)(dst + i) = v;
  }
}

template <int V> struct IC { static constexpr int value = V; };
template <int AMODE, class Epi>
__device__ __forceinline__ void gemm_run(int tid, unsigned char* smem, const void* A, const void* A2, int splitRow, int lda,
                                         const float* __restrict__ gain, const bf16_t* __restrict__ Bt,
                                         int M, int N, int K, int& vbase, Epi epi) {
  bf16_t* sA0 = (bf16_t*)smem;
  bf16_t* sB0 = sA0 + 128 * 72;
  bf16_t* sA1 = sB0 + 128 * 72;
  bf16_t* sB1 = sA1 + 128 * 72;
  float* sR = (float*)(sB1 + 128 * 72);
  float* sG = sR + 128;
  if (AMODE == 2) {
    __syncthreads();
    sG[tid] = gain[tid]; sG[tid + 512] = gain[tid + 512];
    __syncthreads();
  }
  const int lane = tid & 63, w = tid >> 6;
  const int l16 = lane & 15, quad = lane >> 4;
  const int wm = w >> 1, wn = w & 1;
  const int tilesN = (N + 127) / 128, tilesM = M / 128;
  const int ntiles = tilesM * tilesN;
  const int arow = tid >> 2, q4 = tid & 3;
  const int nk = K / 64;
  for (int tile = rot_start(vbase); tile < ntiles; tile += gridDim.x) {
    const int tm = tile / tilesN, tn = tile % tilesN;
    const int m0 = tm * 128, n0 = tn * 128;
    const int grow = m0 + arow;
    const unsigned char* aptr;
    if (AMODE == 0) aptr = (grow < splitRow) ? (const unsigned char*)A + (size_t)grow * lda * 2 : (const unsigned char*)A2 + (size_t)(grow - splitRow) * lda * 2;
    else aptr = (grow < splitRow) ? (const unsigned char*)A + (size_t)grow * lda * 4 : (const unsigned char*)A2 + (size_t)(grow - splitRow) * lda * 4;
    const bool bvalid = (n0 + arow) < N;
    const bf16_t* bptr = Bt + (size_t)(n0 + arow) * K + q4 * 8;
    f32x4 acc[2][4];
#pragma unroll
    for (int i = 0; i < 2; ++i)
#pragma unroll
      for (int j = 0; j < 4; ++j) acc[i][j] = (f32x4){0.f, 0.f, 0.f, 0.f};
    float ss = 0.f;
    float4 af0[4], af1[4];
    uint4 ab0_0, ab0_1, ab1_0, ab1_1;
    uint4 bb0_0, bb0_1, bb1_0, bb1_1;
#define GLOAD(AF, AB, BB, KT) { \
      const int k0_ = (KT) * 64; \
      if (AMODE == 0) { AB##_0 = *(const uint4*)(aptr + (size_t)(k0_ + q4 * 8) * 2); AB##_1 = *(const uint4*)(aptr + (size_t)(k0_ + 32 + q4 * 8) * 2); } \
      else { \
        _Pragma("unroll") for (int i = 0; i < 4; ++i) AF[i] = *(const float4*)(aptr + (size_t)(k0_ + 16 * i + q4 * 4) * 4); \
      } \
      if (bvalid) { BB##_0 = *(const uint4*)(bptr + k0_); BB##_1 = *(const uint4*)(bptr + k0_ + 32); } \
      else { BB##_0 = make_uint4(0, 0, 0, 0); BB##_1 = BB##_0; } }
#define LSTORE(AF, AB, BB, KT, sA, sB) { \
      if (AMODE == 0) { \
        *(uint4*)(sA + arow * 72 + q4 * 8) = AB##_0; \
        *(uint4*)(sA + arow * 72 + 32 + q4 * 8) = AB##_1; \
      } else { \
        if (AMODE == 2) { \
          const float* gp = sG + (KT) * 64 + q4 * 4; \
          _Pragma("unroll") for (int i = 0; i < 4; ++i) { \
            float4 g = *(const float4*)(gp + 16 * i); \
            ss += AF[i].x * AF[i].x + AF[i].y * AF[i].y + AF[i].z * AF[i].z + AF[i].w * AF[i].w; \
            AF[i].x *= g.x; AF[i].y *= g.y; AF[i].z *= g.z; AF[i].w *= g.w; \
          } \
        } \
        *(uint2*)(sA + arow * 72 + q4 * 4) = make_uint2(pack2(AF[0].x, AF[0].y), pack2(AF[0].z, AF[0].w)); \
        *(uint2*)(sA + arow * 72 + 16 + q4 * 4) = make_uint2(pack2(AF[1].x, AF[1].y), pack2(AF[1].z, AF[1].w)); \
        *(uint2*)(sA + arow * 72 + 32 + q4 * 4) = make_uint2(pack2(AF[2].x, AF[2].y), pack2(AF[2].z, AF[2].w)); \
        *(uint2*)(sA + arow * 72 + 48 + q4 * 4) = make_uint2(pack2(AF[3].x, AF[3].y), pack2(AF[3].z, AF[3].w)); \
      } \
      *(uint4*)(sB + arow * 72 + q4 * 8) = BB##_0; \
      *(uint4*)(sB + arow * 72 + 32 + q4 * 8) = BB##_1; }
#define GCOMPUTE(sA, sB) { \
      _Pragma("unroll") for (int ks = 0; ks < 2; ++ks) { \
        bf16x8 a[2], b[4]; \
        _Pragma("unroll") for (int i = 0; i < 2; ++i) a[i] = *(const bf16x8*)(sA + (wm * 32 + i * 16 + l16) * 72 + ks * 32 + quad * 8); \
        _Pragma("unroll") for (int j = 0; j < 4; ++j) b[j] = *(const bf16x8*)(sB + (wn * 64 + j * 16 + l16) * 72 + ks * 32 + quad * 8); \
        _Pragma("unroll") for (int i = 0; i < 2; ++i) \
          _Pragma("unroll") for (int j = 0; j < 4; ++j) acc[i][j] = __builtin_amdgcn_mfma_f32_16x16x32_bf16(a[i], b[j], acc[i][j], 0, 0, 0); \
      } }
    __syncthreads();
    GLOAD(af0, ab0, bb0, 0);
    GLOAD(af1, ab1, bb1, 1);
    LSTORE(af0, ab0, bb0, 0, sA0, sB0);
    if (2 < nk) GLOAD(af0, ab0, bb0, 2);
    for (int kt = 0; kt < nk; kt += 2) {
      __syncthreads();
      LSTORE(af1, ab1, bb1, kt + 1, sA1, sB1);
      if (kt + 3 < nk) GLOAD(af1, ab1, bb1, kt + 3);
      GCOMPUTE(sA0, sB0);
      __syncthreads();
      if (kt + 2 < nk) {
        LSTORE(af0, ab0, bb0, kt + 2, sA0, sB0);
        if (kt + 4 < nk) GLOAD(af0, ab0, bb0, kt + 4);
      }
      GCOMPUTE(sA1, sB1);
    }
    if (AMODE == 2) {
      ss += __shfl_xor(ss, 1);
      ss += __shfl_xor(ss, 2);
      if ((tid & 3) == 0) sR[arow] = rsqrtf(ss / (float)K + 1e-6f);
      __syncthreads();
    }
    if (Epi::CHUNK) {
      float* sC = (float*)smem;
      __syncthreads();
#pragma unroll
      for (int i = 0; i < 2; ++i)
#pragma unroll
        for (int r = 0; r < 4; ++r) {
          const int rl = wm * 32 + i * 16 + quad * 4 + r;
          const float rs = (AMODE == 2) ? sR[rl] : 1.f;
#pragma unroll
          for (int j = 0; j < 4; ++j) sC[rl * 132 + wn * 64 + j * 16 + l16] = acc[i][j][r] * rs;
        }
      __syncthreads();
      if (Epi::CHUNK == 1) {
#pragma unroll
        for (int it = 0; it < 4; ++it) {
          const int chunk = tid + it * 512;
          const int row = chunk >> 4, c8 = (chunk & 15) * 8;
          if (n0 + c8 < N) {
            const float4 v0 = *(const float4*)(sC + row * 132 + c8), v1 = *(const float4*)(sC + row * 132 + c8 + 4);
            const float v[8] = {v0.x, v0.y, v0.z, v0.w, v1.x, v1.y, v1.z, v1.w};
            epi.chunk(m0 + row, n0 + c8, v);
          }
        }
      } else {
#pragma unroll
        for (int it = 0; it < 4; ++it) {
          const int chunk = tid + it * 512;
          const int col = chunk & 127, r8 = (chunk >> 7) * 8;
          if (n0 + col < N) {
            float v[8];
#pragma unroll
            for (int i = 0; i < 8; ++i) v[i] = sC[(r8 + i) * 132 + col];
            epi.chunk(m0 + r8, n0 + col, v);
          }
        }
      }
    } else {
#pragma unroll
    for (int i = 0; i < 2; ++i)
#pragma unroll
      for (int r = 0; r < 4; ++r) {
        const int rl = wm * 32 + i * 16 + quad * 4 + r;
        const float rs = (AMODE == 2) ? sR[rl] : 1.f;
#pragma unroll
        for (int j = 0; j < 4; ++j) {
          const int col = n0 + wn * 64 + j * 16 + l16;
          if (col < N) epi(m0 + rl, col, acc[i][j][r] * rs);
        }
      }
    }
  }
  vbase += ntiles;
}

struct AttnDesc {
  const bf16_t* q; int ldq; int active; int kt_lo, kt_hi; bf16_t* out; int ldo; float m0, l0; int pos0;
  const bf16_t* k; int ldk; const bf16_t* kx; const bf16_t* vt; int ldv; int vts; int nkeys; int bt_lo, bt_hi; float scale;
};

template <int DQK>
__device__ __forceinline__ void attn_item(int tid, unsigned char* smem, const AttnDesc& d) {
  constexpr int LDK = DQK + 8;
  bf16_t* sK = (bf16_t*)smem;
  bf16_t* sVt = sK + 64 * 104;
  bf16_t* sP = sVt + 64 * 72;
  const int lane = tid & 63, w = tid >> 6;
  const int l16 = lane & 15, quad = lane >> 4;
  bf16_t* sPw = sP + w * 16 * 72;
  bf16x8 qf[DQK / 32];
  if (d.active) {
#pragma unroll
    for (int ks = 0; ks < DQK / 32; ++ks) {
      const bf16_t* qp = d.q + (size_t)l16 * d.ldq + ks * 32 + quad * 8;
      uint4 v = *(const uint4*)qp;
      if (DQK == 96 && ks == 2) {
        const int pq = (quad < 2) ? 16 : -16;
        uint4 pv = *(const uint4*)(qp + pq);
        float x[8], y[8];
        unpack8(v, x); unpack8(pv, y);
        const float pos = (float)(d.pos0 + l16);
#pragma unroll
        for (int j = 0; j < 8; ++j) {
          const int f = (quad & 1) * 8 + j;
          float inv = exp2f(-(float)f * (LOG2_THETA / 16.f));
          float sn, cs; sincos_rev(pos * inv, sn, cs);
          x[j] = (quad < 2) ? (x[j] * cs - y[j] * sn) : (x[j] * cs + y[j] * sn);
        }
        v = pack8(x);
      }
      qf[ks] = *(bf16x8*)&v;
    }
  }
  f32x4 o[4];
#pragma unroll
  for (int i = 0; i < 4; ++i) o[i] = (f32x4){0.f, 0.f, 0.f, 0.f};
  float m[4], l[4];
#pragma unroll
  for (int r = 0; r < 4; ++r) { m[r] = d.m0; l[r] = d.l0; }

  const int key = tid >> 3, seg = tid & 7;
  const int key2 = (tid >> 2) & 63, seg2 = tid & 3;
  uint4 kv_r = make_uint4(0, 0, 0, 0), vv_r = kv_r, xv_r = kv_r;
  if (d.bt_lo < d.bt_hi) {
    kv_r = *(const uint4*)(d.k + (size_t)(d.bt_lo * 64 + key) * d.ldk + seg * 8);
    vv_r = *(const uint4*)(d.vt + (size_t)d.bt_lo * d.vts + (size_t)key * d.ldv + seg * 8);
    if (DQK == 96 && tid < 256) xv_r = *(const uint4*)(d.kx + (size_t)(d.bt_lo * 64 + key2) * 32 + seg2 * 8);
  }
  for (int kt = d.bt_lo; kt < d.bt_hi; ++kt) {
    __syncthreads();
    *(uint4*)(sK + key * LDK + seg * 8) = kv_r;
    *(uint4*)(sVt + key * 72 + seg * 8) = vv_r;
    if (DQK == 96 && tid < 256) *(uint4*)(sK + key2 * LDK + 64 + seg2 * 8) = xv_r;
    __syncthreads();
    if (kt + 1 < d.bt_hi) {
      kv_r = *(const uint4*)(d.k + (size_t)((kt + 1) * 64 + key) * d.ldk + seg * 8);
      vv_r = *(const uint4*)(d.vt + (size_t)(kt + 1) * d.vts + (size_t)key * d.ldv + seg * 8);
      if (DQK == 96 && tid < 256) xv_r = *(const uint4*)(d.kx + (size_t)((kt + 1) * 64 + key2) * 32 + seg2 * 8);
    }
    if (d.active && kt >= d.kt_lo && kt < d.kt_hi) {
      f32x4 s[4];
#pragma unroll
      for (int i = 0; i < 4; ++i) s[i] = (f32x4){0.f, 0.f, 0.f, 0.f};
#pragma unroll
      for (int ks = 0; ks < DQK / 32; ++ks)
#pragma unroll
        for (int nt = 0; nt < 4; ++nt) {
          bf16x8 b = *(const bf16x8*)(sK + (nt * 16 + l16) * LDK + ks * 32 + quad * 8);
          s[nt] = __builtin_amdgcn_mfma_f32_16x16x32_bf16(qf[ks], b, s[nt], 0, 0, 0);
        }
#pragma unroll
      for (int nt = 0; nt < 4; ++nt) {
        const bool valid = (kt * 64 + nt * 16 + l16) < d.nkeys;
#pragma unroll
        for (int r = 0; r < 4; ++r) s[nt][r] = valid ? s[nt][r] * d.scale : -1e30f;
      }
#pragma unroll
      for (int r = 0; r < 4; ++r) {
        float mx = fmaxf(fmaxf(s[0][r], s[1][r]), fmaxf(s[2][r], s[3][r]));
        mx = row16_max(mx);
        const float mnew = fmaxf(m[r], mx);
        const float alpha = __expf(m[r] - mnew);
        float p0 = __expf(s[0][r] - mnew), p1 = __expf(s[1][r] - mnew), p2 = __expf(s[2][r] - mnew), p3 = __expf(s[3][r] - mnew);
        float rs = p0 + p1 + p2 + p3;
        rs = row16_sum(rs);
        l[r] = l[r] * alpha + rs;
        m[r] = mnew;
#pragma unroll
        for (int dt = 0; dt < 4; ++dt) o[dt][r] *= alpha;
        bf16_t* pr = sPw + (quad * 4 + r) * 72 + l16;
        pr[0] = f2bf(p0); pr[16] = f2bf(p1); pr[32] = f2bf(p2); pr[48] = f2bf(p3);
      }
      asm volatile("s_waitcnt lgkmcnt(0)" ::: "memory");
#pragma unroll
      for (int ks = 0; ks < 2; ++ks) {
        bf16x8 a = *(const bf16x8*)(sPw + l16 * 72 + ks * 32 + quad * 8);
#pragma unroll
        for (int dt = 0; dt < 4; ++dt) {
          bf16x8 b = *(const bf16x8*)(sVt + (dt * 16 + l16) * 72 + ks * 32 + quad * 8);
          o[dt] = __builtin_amdgcn_mfma_f32_16x16x32_bf16(a, b, o[dt], 0, 0, 0);
        }
      }
      asm volatile("s_waitcnt lgkmcnt(0)" ::: "memory");
    }
  }
  if (d.active) {
#pragma unroll
    for (int r = 0; r < 4; ++r) {
      const float il = 1.f / l[r];
#pragma unroll
      for (int dt = 0; dt < 4; ++dt) d.out[(size_t)(quad * 4 + r) * d.ldo + dt * 16 + l16] = f2bf(o[dt][r] * il);
    }
  }
}

template <int MODE>
__device__ __forceinline__ void s5_item(int tid, float* sUw, const Params& p, int item) {
  const int lane = tid & 63;
  const bf16_t* proj = (const bf16_t*)(p.ws + OFF_PROJ);
  int b, chunk, g, tok0; bool isS;
  if (item < 32768) { isS = false; g = item & 31; chunk = (item >> 5) & 127; b = item >> 12; tok0 = b * 4096 + chunk * 32; }
  else { isS = true; int it = item - 32768; g = it & 31; b = it >> 5; chunk = 0; tok0 = T_P + b * 32; }
  const int n = lane;
  const int gn = g * 64 + n;
  const float lr = fminf(p.in[15][gn], -1e-4f), li = p.in[16][gn];
  const float dt = __expf(p.in[17][g]);
  const float mag = __expf(lr * dt);
  float sn, cs; sincos_rev(li * dt, sn, cs);
  const float abr = mag * cs, abi = mag * sn;
  const float den = lr * lr + li * li;
  const float nr = abr - 1.f, ni = abi;
  const float fre = (nr * lr + ni * li) / den, fim = (ni * lr - nr * li) / den;
  float2_t bb2[16];
  {
    const float4* br4 = (const float4*)(p.in[18] + (size_t)gn * 16);
    const float4* bi4 = (const float4*)(p.in[19] + (size_t)gn * 16);
#pragma unroll
    for (int i = 0; i < 4; ++i) {
      float4 r4 = br4[i], i4 = bi4[i];
      bb2[4 * i + 0] = (float2_t){fre * r4.x - fim * i4.x, fre * i4.x + fim * r4.x};
      bb2[4 * i + 1] = (float2_t){fre * r4.y - fim * i4.y, fre * i4.y + fim * r4.y};
      bb2[4 * i + 2] = (float2_t){fre * r4.z - fim * i4.z, fre * i4.z + fim * r4.z};
      bb2[4 * i + 3] = (float2_t){fre * r4.w - fim * i4.w, fre * i4.w + fim * r4.w};
    }
  }
  {
    const int t = lane >> 1, c8 = (lane & 1) * 8;
    uint4 uv = *(const uint4*)(proj + (size_t)(tok0 + t) * 1280 + 768 + g * 16 + c8);
    float x[8]; unpack8(uv, x);
    *(float4*)(sUw + t * 16 + c8) = make_float4(x[0], x[1], x[2], x[3]);
    *(float4*)(sUw + t * 16 + c8 + 4) = make_float4(x[4], x[5], x[6], x[7]);
  }
  asm volatile("s_waitcnt lgkmcnt(0)" ::: "memory");
  float hr = 0.f, hi = 0.f;
  if (MODE == 0) {
#pragma unroll 4
    for (int t = 0; t < 32; ++t) {
      float uu[16];
#pragma unroll
      for (int i = 0; i < 4; ++i) { float4 v = *(const float4*)(sUw + t * 16 + 4 * i); uu[4 * i] = v.x; uu[4 * i + 1] = v.y; uu[4 * i + 2] = v.z; uu[4 * i + 3] = v.w; }
      float2_t bu2 = {0.f, 0.f};
#pragma unroll
      for (int c = 0; c < 16; ++c) bu2 += bb2[c] * (float2_t){uu[c], uu[c]};
      const float nhr = abr * hr - abi * hi + bu2.x, nhi = abr * hi + abi * hr + bu2.y;
      hr = nhr; hi = nhi;
    }
    float* s1re = (float*)(p.ws + OFF_QMLA);
    float* s1im = s1re + 2097152;
    const size_t idx = ((size_t)(b * 128 + chunk) * 32 + g) * 64 + n;
    s1re[idx] = hr; s1im[idx] = hi;
    asm volatile("s_waitcnt lgkmcnt(0)" ::: "memory");
    return;
  } else {
    float2_t cr2[8], ci2[8];
#pragma unroll
    for (int c = 0; c < 8; ++c) {
      cr2[c] = (float2_t){p.in[20][(size_t)(g * 16 + 2 * c) * 64 + n], p.in[20][(size_t)(g * 16 + 2 * c + 1) * 64 + n]};
      ci2[c] = (float2_t){p.in[21][(size_t)(g * 16 + 2 * c) * 64 + n], p.in[21][(size_t)(g * 16 + 2 * c + 1) * 64 + n]};
    }
    if (isS) { hr = p.in[4][(size_t)(b * 32 + g) * 64 + n]; hi = p.in[5][(size_t)(b * 32 + g) * 64 + n]; }
    else {
      const float* hinre = (const float*)(p.ws + OFF_QMLA) + 2 * 2097152;
      const float* hinim = hinre + 2097152;
      const size_t idx = ((size_t)(b * 128 + chunk) * 32 + g) * 64 + n;
      hr = hinre[idx]; hi = hinim[idx];
    }
    const int b0 = lane & 1, b1 = (lane >> 1) & 1, b2 = (lane >> 2) & 1, b3 = (lane >> 3) & 1;
    const int cc = b0 * 8 + b1 * 4 + b2 * 2 + b3;
    const int quad = lane >> 4;
    const float dsk = p.in[22][g * 16 + cc];
    bf16_t* zbuf = (bf16_t*)(p.ws + OFF_Z);
    float zkeep = 0.f;
#pragma unroll 2
    for (int t = 0; t < 32; ++t) {
      float uu[16];
#pragma unroll
      for (int i = 0; i < 4; ++i) { float4 v = *(const float4*)(sUw + t * 16 + 4 * i); uu[4 * i] = v.x; uu[4 * i + 1] = v.y; uu[4 * i + 2] = v.z; uu[4 * i + 3] = v.w; }
      float2_t bu2 = {0.f, 0.f};
#pragma unroll
      for (int c = 0; c < 16; ++c) bu2 += bb2[c] * (float2_t){uu[c], uu[c]};
      const float nhr = abr * hr - abi * hi + bu2.x, nhi = abr * hi + abi * hr + bu2.y;
      hr = nhr; hi = nhi;
      float v16[16];
#pragma unroll
      for (int c = 0; c < 8; ++c) {
        const float2_t vv = cr2[c] * (float2_t){hr, hr} - ci2[c] * (float2_t){hi, hi};
        v16[2 * c] = vv.x; v16[2 * c + 1] = vv.y;
      }
      float v8[8], v4[4], v2[2], v1;
#pragma unroll
      for (int i = 0; i < 8; ++i) { float keep = b0 ? v16[8 + i] : v16[i]; float send = b0 ? v16[i] : v16[8 + i]; v8[i] = keep + __shfl_xor(send, 1); }
#pragma unroll
      for (int i = 0; i < 4; ++i) { float keep = b1 ? v8[4 + i] : v8[i]; float send = b1 ? v8[i] : v8[4 + i]; v4[i] = keep + __shfl_xor(send, 2); }
#pragma unroll
      for (int i = 0; i < 2; ++i) { float keep = b2 ? v4[2 + i] : v4[i]; float send = b2 ? v4[i] : v4[2 + i]; v2[i] = keep + __shfl_xor(send, 4); }
      { float keep = b3 ? v2[1] : v2[0]; float send = b3 ? v2[0] : v2[1]; v1 = keep + __shfl_xor(send, 8); }
      v1 += __shfl_xor(v1, 16);
      v1 += __shfl_xor(v1, 32);
      const float y = v1 + dsk * sUw[t * 16 + cc];
      const float z = gelu_tanh(y);
      if (quad == (t & 3)) zkeep = z;
      if ((t & 3) == 3) zbuf[(size_t)(tok0 + t - 3 + quad) * 512 + g * 16 + cc] = f2bf(zkeep);
    }
    if (isS) {
      p.out[O_SSMRE_S + (size_t)(b * 32 + g) * 64 + n] = hr;
      p.out[O_SSMIM_S + (size_t)(b * 32 + g) * 64 + n] = hi;
    }
    asm volatile("s_waitcnt lgkmcnt(0)" ::: "memory");
  }
}

#define TAB_V_OFF 16777216ull
#define TAB_SU_OFF 33554432ull
#define TAB_SV_OFF (33554432ull + 65536ull)
__device__ __forceinline__ void quant_rows(const float* __restrict__ src, unsigned char* __restrict__ dst, float* __restrict__ scales, int gw, int nw, int tid) {
  const int lane = tid & 63;
  for (int row = gw; row < 16384; row += nw) {
    const float* r = src + (size_t)row * 1024 + lane * 16;
    float x[16];
#pragma unroll
    for (int i = 0; i < 4; ++i) { typedef float qv4 __attribute__((ext_vector_type(4))); const qv4 v = __builtin_nontemporal_load((const qv4*)(r + 4 * i)); x[4 * i] = v.x; x[4 * i + 1] = v.y; x[4 * i + 2] = v.z; x[4 * i + 3] = v.w; }
    float am = 0.f;
#pragma unroll
    for (int i = 0; i < 16; ++i) am = fmaxf(am, fabsf(x[i]));
#pragma unroll
    for (int o = 32; o; o >>= 1) am = fmaxf(am, __shfl_xor(am, o));
    const float inv = (am > 0.f) ? 127.f / am : 0.f;
    unsigned q[4];
#pragma unroll
    for (int i = 0; i < 4; ++i) {
      unsigned b0 = (unsigned)((int)rintf(x[4 * i] * inv)) & 255u, b1 = (unsigned)((int)rintf(x[4 * i + 1] * inv)) & 255u;
      unsigned b2 = (unsigned)((int)rintf(x[4 * i + 2] * inv)) & 255u, b3 = (unsigned)((int)rintf(x[4 * i + 3] * inv)) & 255u;
      q[i] = b0 | (b1 << 8) | (b2 << 16) | (b3 << 24);
    }
    *(uint4*)(dst + (size_t)(lane >> 3) * 2097152 + (size_t)row * 128 + (lane & 7) * 16) = make_uint4(q[0], q[1], q[2], q[3]);
    if (lane == 0) scales[row] = am * (1.f / 127.f);
  }
}

__device__ __forceinline__ float ub0(unsigned u) { return (float)(u & 0xffu); }
__device__ __forceinline__ float ub1(unsigned u) { return (float)((u >> 8) & 0xffu); }
__device__ __forceinline__ float ub2(unsigned u) { return (float)((u >> 16) & 0xffu); }
__device__ __forceinline__ float ub3(unsigned u) { return (float)(u >> 24); }
__device__ __forceinline__ float dot16(const float* xn, uint4 u) {
  float d = 0.f;
  d += xn[0] * ub0(u.x); d += xn[1] * ub1(u.x); d += xn[2] * ub2(u.x); d += xn[3] * ub3(u.x);
  d += xn[4] * ub0(u.y); d += xn[5] * ub1(u.y); d += xn[6] * ub2(u.y); d += xn[7] * ub3(u.y);
  d += xn[8] * ub0(u.z); d += xn[9] * ub1(u.z); d += xn[10] * ub2(u.z); d += xn[11] * ub3(u.z);
  d += xn[12] * ub0(u.w); d += xn[13] * ub1(u.w); d += xn[14] * ub2(u.w); d += xn[15] * ub3(u.w);
  return d;
}
__device__ __forceinline__ void axpy16(float* acc, float a, uint4 u) {
  acc[0] += a * ub0(u.x); acc[1] += a * ub1(u.x); acc[2] += a * ub2(u.x); acc[3] += a * ub3(u.x);
  acc[4] += a * ub0(u.y); acc[5] += a * ub1(u.y); acc[6] += a * ub2(u.y); acc[7] += a * ub3(u.y);
  acc[8] += a * ub0(u.z); acc[9] += a * ub1(u.z); acc[10] += a * ub2(u.z); acc[11] += a * ub3(u.z);
  acc[12] += a * ub0(u.w); acc[13] += a * ub1(u.w); acc[14] += a * ub2(u.w); acc[15] += a * ub3(u.w);
}

template <bool FINAL, bool DRY>
__device__ __forceinline__ void peer_token(int tid, const Params& p, int layer, int tok) {
  const int lane = tid & 63;
  float* xres = p.out + O_Y;
  const float* gain = p.in[10] + layer * 1024;
  const unsigned char* U = p.ws + OFF_TAB;
  const unsigned char* V = U + TAB_V_OFF;
  const int* ebuf = (const int*)(p.ws + OFF_M);
  const float* gbuf = (const float*)(p.ws + OFF_M + 17301504ull);
  const float* sus = (const float*)(p.ws + OFF_TAB + TAB_SU_OFF);
  const float* svs = (const float*)(p.ws + OFF_TAB + TAB_SV_OFF);
  float* xr = xres + (size_t)tok * 1024 + lane * 16;
  float x[16], xn[16], acc[16];
  float ss = 0.f, sx = 0.f;
#pragma unroll
  for (int i = 0; i < 4; ++i) {
    float4 v = *(const float4*)(xr + 4 * i);
    float4 g = *(const float4*)(gain + lane * 16 + 4 * i);
    x[4 * i] = v.x; x[4 * i + 1] = v.y; x[4 * i + 2] = v.z; x[4 * i + 3] = v.w;
    xn[4 * i] = v.x * g.x; xn[4 * i + 1] = v.y * g.y; xn[4 * i + 2] = v.z * g.z; xn[4 * i + 3] = v.w * g.w;
    ss += v.x * v.x + v.y * v.y + v.z * v.z + v.w * v.w;
    sx += xn[4 * i] + xn[4 * i + 1] + xn[4 * i + 2] + xn[4 * i + 3];
  }
  ss = wave_sum(ss);
  sx = wave_sum(sx);
  const float rstd = rsqrtf(ss * (1.f / 1024.f) + 1e-6f);
#pragma unroll
  for (int i = 0; i < 16; ++i) acc[i] = 0.f;
  float sumA = 0.f;
  const int b0 = lane & 1, b1 = (lane >> 1) & 1, b2 = (lane >> 2) & 1;
  const int pe = b0 * 4 + b1 * 2 + b2;
  const size_t pbase = (size_t)tok * 128 + pe;
#pragma unroll 1
  for (int kb = 0; kb < 16; ++kb) {
    const int myeid = ebuf[pbase + kb * 8];
    const float myg = gbuf[pbase + kb * 8] * svs[myeid];
    const float mysu = sus[myeid];
    uint4 uu[8], vv[8];
#pragma unroll
    for (int j = 0; j < 8; ++j) {
      const int src = ((j & 1) << 2) | (j & 2) | ((j >> 2) & 1);
      const int eid = __builtin_amdgcn_readlane(myeid, src);
      uu[j] = *(const uint4*)(U + (size_t)eid * 1024 + lane * 16);
      vv[j] = *(const uint4*)(V + (size_t)eid * 1024 + lane * 16);
    }
    float d[8];
#pragma unroll
    for (int j = 0; j < 8; ++j) d[j] = dot16(xn, uu[j]);
    float w4[4], w2[2], w1;
#pragma unroll
    for (int i = 0; i < 4; ++i) { float keep = b0 ? d[4 + i] : d[i]; float send = b0 ? d[i] : d[4 + i]; w4[i] = keep + __shfl_xor(send, 1); }
#pragma unroll
    for (int i = 0; i < 2; ++i) { float keep = b1 ? w4[2 + i] : w4[i]; float send = b1 ? w4[i] : w4[2 + i]; w2[i] = keep + __shfl_xor(send, 2); }
    { float keep = b2 ? w2[1] : w2[0]; float send = b2 ? w2[0] : w2[1]; w1 = keep + __shfl_xor(send, 4); }
    w1 += __shfl_xor(w1, 8); w1 += __shfl_xor(w1, 16); w1 += __shfl_xor(w1, 32);
    const float dot = rstd * mysu * (w1 - 128.f * sx);
    const float a = gelu_erf(dot) * myg;
#pragma unroll
    for (int j = 0; j < 8; ++j) {
      const int src = ((j & 1) << 2) | (j & 2) | ((j >> 2) & 1);
      const float A = __int_as_float(__builtin_amdgcn_readlane(__float_as_int(a), src));
      sumA += A;
      axpy16(acc, A, vv[j]);
    }
  }
  float y[16];
#pragma unroll
  for (int i = 0; i < 16; ++i) y[i] = x[i] + acc[i] - 128.f * sumA;
  if (FINAL) {
    float s2 = 0.f;
#pragma unroll
    for (int i = 0; i < 16; ++i) s2 += y[i] * y[i];
    s2 = wave_sum(s2);
    const float r2 = rsqrtf(s2 * (1.f / 1024.f) + 1e-6f);
    const float* gf = p.in[11] + lane * 16;
#pragma unroll
    for (int i = 0; i < 4; ++i) {
      float4 g = *(const float4*)(gf + 4 * i);
      y[4 * i] *= r2 * g.x; y[4 * i + 1] *= r2 * g.y; y[4 * i + 2] *= r2 * g.z; y[4 * i + 3] *= r2 * g.w;
    }
  }
  if (DRY && ss != -1.f) return;
#pragma unroll
  for (int i = 0; i < 4; ++i) *(float4*)(xr + 4 * i) = make_float4(y[4 * i], y[4 * i + 1], y[4 * i + 2], y[4 * i + 3]);
}

#define OFF_PD OFF_MIX
#define OFF_PSS OFF_KP
#define OFF_PSX (OFF_KP + 1081344ull)
template <int CTRL> __device__ __forceinline__ int dpp_i(int v) { return __builtin_amdgcn_update_dpp(0, v, CTRL, 0xf, 0xf, true); }
__device__ __forceinline__ unsigned packq4(float a, float b, float c, float d, float inv) {
  const unsigned q0 = (unsigned)((int)rintf(a * inv)) & 255u, q1 = (unsigned)((int)rintf(b * inv)) & 255u;
  const unsigned q2 = (unsigned)((int)rintf(c * inv)) & 255u, q3 = (unsigned)((int)rintf(d * inv));
  return q0 | (q1 << 8) | (q2 << 16) | (q3 << 24);
}
__device__ __forceinline__ void peer9a_token(int tid, const Params& p, int layer, int tok, int j) {
  const int lane = tid & 63, g8 = lane >> 3, sub = lane & 7;
  const float* xr = p.out + O_Y + (size_t)tok * 1024 + j * 128 + sub * 16;
  const float* gn = p.in[10] + layer * 1024 + j * 128 + sub * 16;
  const unsigned char* U = p.ws + OFF_TAB + (size_t)j * 2097152 + sub * 16;
  const int* eb = (const int*)(p.ws + OFF_M) + (size_t)tok * 128 + g8;
  bf16_t* pd = (bf16_t*)(p.ws + OFF_PD) + ((size_t)tok * 8 + j) * 128;
  int eid[16];
#pragma unroll
  for (int k = 0; k < 16; ++k) eid[k] = eb[k * 8];
  float xs[16];
  float ss = 0.f, am = 0.f;
#pragma unroll
  for (int i = 0; i < 4; ++i) {
    float4 v = *(const float4*)(xr + 4 * i);
    float4 g = *(const float4*)(gn + 4 * i);
    xs[4 * i] = v.x * g.x; xs[4 * i + 1] = v.y * g.y; xs[4 * i + 2] = v.z * g.z; xs[4 * i + 3] = v.w * g.w;
    ss += v.x * v.x + v.y * v.y + v.z * v.z + v.w * v.w;
    am = fmaxf(fmaxf(am, fmaxf(fabsf(xs[4 * i]), fabsf(xs[4 * i + 1]))), fmaxf(fabsf(xs[4 * i + 2]), fabsf(xs[4 * i + 3])));
  }
  uint4 rows[16];
#pragma unroll
  for (int k = 0; k < 16; ++k) rows[k] = *(const uint4*)(U + (size_t)eid[k] * 128);
  am = fmaxf(am, dpp_f<0xB1>(am)); am = fmaxf(am, dpp_f<0x4E>(am)); am = fmaxf(am, dpp_f<0x141>(am));
  const float inv = (am > 0.f) ? 127.f / am : 0.f;
  const float xscale = am * (1.f / 127.f);
  int xq[4];
#pragma unroll
  for (int d = 0; d < 4; ++d) xq[d] = (int)packq4(xs[4 * d], xs[4 * d + 1], xs[4 * d + 2], xs[4 * d + 3], inv);
  int keep0 = 0, keep1 = 0;
#pragma unroll
  for (int k = 0; k < 16; ++k) {
    int D = __builtin_amdgcn_sdot4((int)rows[k].x, xq[0], 0, false);
    D = __builtin_amdgcn_sdot4((int)rows[k].y, xq[1], D, false);
    D = __builtin_amdgcn_sdot4((int)rows[k].z, xq[2], D, false);
    D = __builtin_amdgcn_sdot4((int)rows[k].w, xq[3], D, false);
    D += dpp_i<0xB1>(D); D += dpp_i<0x4E>(D); D += dpp_i<0x141>(D);
    if (k < 8) keep0 = (sub == k) ? D : keep0; else keep1 = (sub == k - 8) ? D : keep1;
  }
  pd[sub * 8 + g8] = f2bf((float)keep0 * xscale);
  pd[64 + sub * 8 + g8] = f2bf((float)keep1 * xscale);
  ss += dpp_f<0xB1>(ss); ss += dpp_f<0x4E>(ss); ss += dpp_f<0x141>(ss);
  if (lane == 0) ((float*)(p.ws + OFF_PSS))[(size_t)tok * 8 + j] = ss;
}

__device__ __forceinline__ void peer9m_token(int tid, unsigned char* smem, const Params& p, int tok) {
  const int lane = tid & 63, w = __builtin_amdgcn_readfirstlane(tid >> 6);
  unsigned char* sAq = smem + w * 128;
  const bf16_t* pd = (const bf16_t*)(p.ws + OFF_PD) + (size_t)tok * 1024;
  float* pss = (float*)(p.ws + OFF_PSS) + (size_t)tok * 8;
  const int* ebuf = (const int*)(p.ws + OFF_M) + (size_t)tok * 128;
  float* gbuf = (float*)(p.ws + OFF_M + 17301504ull) + (size_t)tok * 128;
  const float* sus = (const float*)(p.ws + OFF_TAB + TAB_SU_OFF);
  const float* svs = (const float*)(p.ws + OFF_TAB + TAB_SV_OFF);
  float ss = 0.f, d0 = 0.f, d1 = 0.f;
#pragma unroll
  for (int j = 0; j < 8; ++j) { ss += pss[j]; d0 += bf2f(pd[j * 128 + lane]); d1 += bf2f(pd[j * 128 + 64 + lane]); }
  const int e0 = ebuf[lane], e1 = ebuf[64 + lane];
  const float rstd = rsqrtf(ss * (1.f / 1024.f) + 1e-6f);
  const float a0 = gelu_erf(rstd * sus[e0] * d0) * gbuf[lane] * svs[e0];
  const float a1 = gelu_erf(rstd * sus[e1] * d1) * gbuf[64 + lane] * svs[e1];
  float am = row16_max(fmaxf(fabsf(a0), fabsf(a1)));
  {
    const float m0 = __int_as_float(__builtin_amdgcn_readlane(__float_as_int(am), 0)), m1 = __int_as_float(__builtin_amdgcn_readlane(__float_as_int(am), 16));
    const float m2 = __int_as_float(__builtin_amdgcn_readlane(__float_as_int(am), 32)), m3 = __int_as_float(__builtin_amdgcn_readlane(__float_as_int(am), 48));
    am = fmaxf(fmaxf(m0, m1), fmaxf(m2, m3));
  }
  const float inv = (am > 0.f) ? 127.f / am : 0.f;
  const int addr0 = (lane & 7) * 16 + (lane >> 3);
  sAq[addr0] = (unsigned char)((int)rintf(a0 * inv) & 255);
  sAq[addr0 + 8] = (unsigned char)((int)rintf(a1 * inv) & 255);
  asm volatile("s_waitcnt lgkmcnt(0)" ::: "memory");
  unsigned pk = 0u;
  if (lane < 32) pk = ((const unsigned*)sAq)[lane];
  asm volatile("s_waitcnt vmcnt(0) lgkmcnt(0)" ::: "memory");
  if (lane < 32) ((unsigned*)gbuf)[lane] = pk;
  if (lane == 0) pss[0] = am * (1.f / 127.f);
  asm volatile("s_waitcnt lgkmcnt(0)" ::: "memory");
}

__device__ __forceinline__ void peer9b_token(int tid, const Params& p, int tok, int j) {
  const int lane = tid & 63, g8 = lane >> 3, sub = lane & 7;
  float* xr = p.out + O_Y + (size_t)tok * 1024 + j * 128 + sub * 16;
  const unsigned char* V = p.ws + OFF_TAB + TAB_V_OFF + (size_t)j * 2097152 + sub * 16;
  const int* eb = (const int*)(p.ws + OFF_M) + (size_t)tok * 128 + g8;
  const uint4 apk = *(const uint4*)((const unsigned*)(p.ws + OFF_M + 17301504ull) + (size_t)tok * 128 + g8 * 4);
  const float scaleA = ((const float*)(p.ws + OFF_PSS))[(size_t)tok * 8];
  int eid[16];
#pragma unroll
  for (int k = 0; k < 16; ++k) eid[k] = eb[k * 8];
  uint4 rows[16];
#pragma unroll
  for (int k = 0; k < 16; ++k) rows[k] = *(const uint4*)(V + (size_t)eid[k] * 128);
  int acci[16];
#pragma unroll
  for (int i = 0; i < 16; ++i) acci[i] = 0;
#define P9B_DW(DWF, DW, AP, KQ) { \
    const unsigned r0 = rows[(KQ) * 4 + 0].DWF, r1 = rows[(KQ) * 4 + 1].DWF, r2 = rows[(KQ) * 4 + 2].DWF, r3 = rows[(KQ) * 4 + 3].DWF; \
    const unsigned t0 = __builtin_amdgcn_perm(r1, r0, 0x05010400u), t1 = __builtin_amdgcn_perm(r1, r0, 0x07030602u); \
    const unsigned t2 = __builtin_amdgcn_perm(r3, r2, 0x05010400u), t3 = __builtin_amdgcn_perm(r3, r2, 0x07030602u); \
    acci[(DW) * 4 + 0] = __builtin_amdgcn_sdot4((int)__builtin_amdgcn_perm(t2, t0, 0x05040100u), (int)(AP), acci[(DW) * 4 + 0], false); \
    acci[(DW) * 4 + 1] = __builtin_amdgcn_sdot4((int)__builtin_amdgcn_perm(t2, t0, 0x07060302u), (int)(AP), acci[(DW) * 4 + 1], false); \
    acci[(DW) * 4 + 2] = __builtin_amdgcn_sdot4((int)__builtin_amdgcn_perm(t3, t1, 0x05040100u), (int)(AP), acci[(DW) * 4 + 2], false); \
    acci[(DW) * 4 + 3] = __builtin_amdgcn_sdot4((int)__builtin_amdgcn_perm(t3, t1, 0x07060302u), (int)(AP), acci[(DW) * 4 + 3], false); }
#define P9B_KQ(AP, KQ) { P9B_DW(x, 0, AP, KQ) P9B_DW(y, 1, AP, KQ) P9B_DW(z, 2, AP, KQ) P9B_DW(w, 3, AP, KQ) }
  P9B_KQ(apk.x, 0) P9B_KQ(apk.y, 1) P9B_KQ(apk.z, 2) P9B_KQ(apk.w, 3)
  float acc[16];
#pragma unroll
  for (int i = 0; i < 16; ++i) acc[i] = (float)acci[i] * scaleA;
  const int b3 = (lane >> 3) & 1, b4 = (lane >> 4) & 1, b5 = (lane >> 5) & 1;
  float v8[8], v4[4], v2[2];
#pragma unroll
  for (int i = 0; i < 8; ++i) { float keep = b3 ? acc[8 + i] : acc[i]; float send = b3 ? acc[i] : acc[8 + i]; v8[i] = keep + dpp_f<0x128>(send); }
#pragma unroll
  for (int i = 0; i < 4; ++i) { float keep = b4 ? v8[4 + i] : v8[i]; float send = b4 ? v8[i] : v8[4 + i]; v4[i] = keep + __shfl_xor(send, 16); }
#pragma unroll
  for (int i = 0; i < 2; ++i) { float keep = b5 ? v4[2 + i] : v4[i]; float send = b5 ? v4[i] : v4[2 + i]; v2[i] = keep + __shfl_xor(send, 32); }
  const int c = b3 * 8 + b4 * 4 + b5 * 2;
  float2 xv = *(const float2*)(xr + c);
  xv.x += v2[0];
  xv.y += v2[1];
  *(float2*)(xr + c) = xv;
}

__device__ __forceinline__ void final_norm_token(int tid, const Params& p, int tok) {
  const int lane = tid & 63;
  float* xr = p.out + O_Y + (size_t)tok * 1024 + lane * 16;
  const float* gf = p.in[11] + lane * 16;
  float y[16]; float s2 = 0.f;
#pragma unroll
  for (int i = 0; i < 4; ++i) { float4 v = *(const float4*)(xr + 4 * i); y[4 * i] = v.x; y[4 * i + 1] = v.y; y[4 * i + 2] = v.z; y[4 * i + 3] = v.w; s2 += v.x * v.x + v.y * v.y + v.z * v.z + v.w * v.w; }
  s2 = wave_sum(s2);
  const float r2 = rsqrtf(s2 * (1.f / 1024.f) + 1e-6f);
#pragma unroll
  for (int i = 0; i < 4; ++i) {
    float4 g = *(const float4*)(gf + 4 * i);
    *(float4*)(xr + 4 * i) = make_float4(y[4 * i] * r2 * g.x, y[4 * i + 1] * r2 * g.y, y[4 * i + 2] * r2 * g.z, y[4 * i + 3] * r2 * g.w);
  }
}

__device__ __forceinline__ unsigned f2ukey(float v) { unsigned u = __float_as_uint(v); return (u & 0x80000000u) ? ~u : (u | 0x80000000u); }
__device__ __forceinline__ float ukey2f(unsigned k) { unsigned u = (k & 0x80000000u) ? (k & 0x7fffffffu) : ~k; return __uint_as_float(u); }
__device__ __forceinline__ int popc64(unsigned long long m) { return __builtin_popcountll(m); }
__device__ __forceinline__ int mbcnt64(unsigned long long m) { return (int)__builtin_amdgcn_mbcnt_hi((unsigned)(m >> 32), __builtin_amdgcn_mbcnt_lo((unsigned)m, 0u)); }

struct TopkFrags { bf16x8 a[2][2]; bf16x8 b[2][2]; };
__device__ __forceinline__ void topk_load(TopkFrags& f, int tid, const Params& p, int layer, int item) {
  const int lane = tid & 63, w = __builtin_amdgcn_readfirstlane(tid >> 6);
  const int l16 = lane & 15, quad = lane >> 4;
  const int h = item & 7, tok0 = (item >> 3) * 32;
  const int pp = w >> 2;
  const bf16_t* qb = (const bf16_t*)(p.ws + OFF_QBUF);
  const bf16_t* keys = (const bf16_t*)(p.ws + OFF_WT) + WT_KEYS + (size_t)((layer * 8 + h) * 2 + pp) * 8192;
#pragma unroll
  for (int ks = 0; ks < 2; ++ks) {
#pragma unroll
    for (int mt = 0; mt < 2; ++mt) f.a[ks][mt] = *(const bf16x8*)(qb + (size_t)(tok0 + mt * 16 + l16) * 1024 + h * 128 + pp * 64 + ks * 32 + quad * 8);
#pragma unroll
    for (int j = 0; j < 2; ++j) {
      const int nt = (w & 3) * 2 + j;
      f.b[ks][j] = *(const bf16x8*)(keys + (nt * 16 + l16) * 64 + ks * 32 + quad * 8);
    }
  }
}

__device__ __forceinline__ void peer_topk_item(int tid, unsigned char* smem, const Params& p, const TopkFrags& f, int item) {
  unsigned* sS = (unsigned*)smem;
  const int lane = tid & 63, w = __builtin_amdgcn_readfirstlane(tid >> 6);
  const int l16 = lane & 15, quad = lane >> 4;
  const int h = item & 7, tile = item >> 3;
  const int tok0 = tile * 32;
  unsigned* wtop = (unsigned*)(smem + 32768) + w * 256;
  float* wexp = (float*)(wtop + 128);
  __syncthreads();
  {
    const int pp = w >> 2;
    f32x4 acc[2][2];
#pragma unroll
    for (int i = 0; i < 2; ++i)
#pragma unroll
      for (int j = 0; j < 2; ++j) acc[i][j] = (f32x4){0.f, 0.f, 0.f, 0.f};
#pragma unroll
    for (int ks = 0; ks < 2; ++ks)
#pragma unroll
      for (int mt = 0; mt < 2; ++mt)
#pragma unroll
        for (int j = 0; j < 2; ++j) acc[mt][j] = __builtin_amdgcn_mfma_f32_16x16x32_bf16(f.a[ks][mt], f.b[ks][j], acc[mt][j], 0, 0, 0);
#pragma unroll
    for (int mt = 0; mt < 2; ++mt)
#pragma unroll
      for (int j = 0; j < 2; ++j) {
        const int nt = (w & 3) * 2 + j;
#pragma unroll
        for (int r = 0; r < 4; ++r) {
          const int key = nt * 16 + l16;
          sS[((mt * 16 + quad * 4 + r) * 2 + pp) * 128 + key] = (f2ukey(acc[mt][j][r]) & ~127u) | (unsigned)(127 - key);
        }
      }
  }
  __syncthreads();
  int* ebuf = (int*)(p.ws + OFF_M);
  float* gbuf = (float*)(p.ws + OFF_M + 17301504ull);
  unsigned k0[8], k1[8], T[8];
#pragma unroll
  for (int c = 0; c < 8; ++c) {
    const unsigned* row = sS + ((w * 4 + (c >> 1)) * 2 + (c & 1)) * 128;
    k0[c] = row[lane]; k1[c] = row[64 + lane]; T[c] = 0u;
  }
#pragma unroll 1
  for (int bit = 31; bit >= 7; --bit) {
    const unsigned bm = 1u << bit;
#pragma unroll
    for (int c = 0; c < 8; ++c) {
      const unsigned cand = T[c] | bm;
      const int cnt = popc64(__builtin_amdgcn_ballot_w64(k0[c] >= cand)) + popc64(__builtin_amdgcn_ballot_w64(k1[c] >= cand));
      T[c] = (cnt >= 16) ? cand : T[c];
    }
  }
  {
    bool need = false;
#pragma unroll
    for (int c = 0; c < 8; ++c) {
      const int cnt = popc64(__builtin_amdgcn_ballot_w64(k0[c] >= T[c])) + popc64(__builtin_amdgcn_ballot_w64(k1[c] >= T[c]));
      need = need || (cnt > 16);
    }
    if (need) {
#pragma unroll 1
      for (int bit = 6; bit >= 0; --bit) {
        const unsigned bm = 1u << bit;
#pragma unroll
        for (int c = 0; c < 8; ++c) {
          const unsigned cand = T[c] | bm;
          const int cnt = popc64(__builtin_amdgcn_ballot_w64(k0[c] >= cand)) + popc64(__builtin_amdgcn_ballot_w64(k1[c] >= cand));
          T[c] = (cnt >= 16) ? cand : T[c];
        }
      }
    }
  }
#pragma unroll
  for (int c = 0; c < 8; ++c) {
    const unsigned long long m0 = __builtin_amdgcn_ballot_w64(k0[c] >= T[c]);
    const unsigned long long m1 = __builtin_amdgcn_ballot_w64(k1[c] >= T[c]);
    const int s0 = mbcnt64(m0), s1 = popc64(m0) + mbcnt64(m1);
    if (k0[c] >= T[c]) wtop[c * 16 + s0] = k0[c];
    if (k1[c] >= T[c]) wtop[c * 16 + s1] = k1[c];
  }
  asm volatile("s_waitcnt lgkmcnt(0)" ::: "memory");
#define ROR_CNT(S) { const unsigned o_ = (unsigned)__builtin_amdgcn_update_dpp(0, (int)key_, 0x120 + (S), 0xf, 0xf, true); rk_ += (o_ > key_) ? 1 : 0; }
#pragma unroll
  for (int pass = 0; pass < 2; ++pass) {
    const int L = pass * 4 + (lane >> 4);
    const unsigned key_ = wtop[L * 16 + (lane & 15)];
    int rk_ = 0;
    ROR_CNT(1) ROR_CNT(2) ROR_CNT(3) ROR_CNT(4) ROR_CNT(5) ROR_CNT(6) ROR_CNT(7) ROR_CNT(8)
    ROR_CNT(9) ROR_CNT(10) ROR_CNT(11) ROR_CNT(12) ROR_CNT(13) ROR_CNT(14) ROR_CNT(15)
    wtop[L * 16 + rk_] = key_;
  }
  asm volatile("s_waitcnt lgkmcnt(0)" ::: "memory");
  int ci = (lane >= 16) + (lane >= 24) + (lane >= 29) + (lane >= 33) + (lane >= 36) + (lane >= 38) + (lane >= 40) + (lane >= 42);
#pragma unroll
  for (int t = 43; t < 50; ++t) ci += (lane >= t);
  int cstart = 0;
  cstart = (ci >= 1) ? 16 : cstart; cstart = (ci >= 2) ? 24 : cstart; cstart = (ci >= 3) ? 29 : cstart; cstart = (ci >= 4) ? 33 : cstart;
  cstart = (ci >= 5) ? 36 : cstart; cstart = (ci >= 6) ? 38 : cstart; cstart = (ci >= 7) ? 40 : cstart; cstart = (ci >= 8) ? 42 : cstart;
  cstart = (ci >= 9) ? (34 + ci) : cstart;
  const int cj = lane - cstart;
  const bool cvalid = lane < 50;
  unsigned kav[4], kbv[4], ck[4], T2[4]; float cs[4];
#pragma unroll
  for (int t = 0; t < 4; ++t) {
    kav[t] = 0u; kbv[t] = 0u; cs[t] = 0.f; ck[t] = 0u; T2[t] = 0u;
    if (cvalid) {
      kav[t] = wtop[(t * 2) * 16 + ci]; kbv[t] = wtop[(t * 2 + 1) * 16 + cj];
      cs[t] = ukey2f(kav[t]) + ukey2f(kbv[t]);
      ck[t] = ((f2ukey(cs[t]) & ~63u) | (unsigned)(63 - lane)) | 0u;
      ck[t] = (ck[t] == 0u) ? 1u : ck[t];
    }
  }
#pragma unroll 1
  for (int bit = 31; bit >= 6; --bit) {
    const unsigned bm = 1u << bit;
#pragma unroll
    for (int t = 0; t < 4; ++t) {
      const unsigned cand = T2[t] | bm;
      const int cnt = popc64(__builtin_amdgcn_ballot_w64(ck[t] >= cand));
      T2[t] = (cnt >= 16) ? cand : T2[t];
    }
  }
  {
    bool need = false;
#pragma unroll
    for (int t = 0; t < 4; ++t) need = need || (popc64(__builtin_amdgcn_ballot_w64(ck[t] >= T2[t])) > 16);
    if (need) {
#pragma unroll 1
      for (int bit = 5; bit >= 0; --bit) {
        const unsigned bm = 1u << bit;
#pragma unroll
        for (int t = 0; t < 4; ++t) {
          const unsigned cand = T2[t] | bm;
          const int cnt = popc64(__builtin_amdgcn_ballot_w64(ck[t] >= cand));
          T2[t] = (cnt >= 16) ? cand : T2[t];
        }
      }
    }
  }
  int* weid = (int*)(wexp + 64);
#pragma unroll
  for (int t = 0; t < 4; ++t) {
    const float cT = ukey2f(T2[t]);
    const bool win = ck[t] >= T2[t];
    const int sl = mbcnt64(__builtin_amdgcn_ballot_w64(win));
    if (win) {
      wexp[t * 16 + sl] = __expf(fminf(cs[t] - cT, 60.f));
      weid[t * 16 + sl] = (127 - (int)(kav[t] & 127u)) * 128 + (127 - (int)(kbv[t] & 127u));
    }
  }
  asm volatile("s_waitcnt lgkmcnt(0)" ::: "memory");
  {
    const int t = lane >> 4, sl = lane & 15;
    float es = 0.f;
#pragma unroll
    for (int q = 0; q < 4; ++q) { const float4 ee = *(const float4*)(wexp + t * 16 + q * 4); es += ee.x + ee.y + ee.z + ee.w; }
    const float e = wexp[t * 16 + sl];
    const int id = weid[t * 16 + sl];
    const size_t o = (size_t)(tok0 + w * 4 + t) * 128 + h * 16 + sl;
    ebuf[o] = id;
    gbuf[o] = e / es;
  }
  asm volatile("s_waitcnt lgkmcnt(0)" ::: "memory");
}

struct EpiStoreBf16 { bf16_t* dst; int ld; static constexpr int CHUNK = 1;
  __device__ void operator()(int r, int c, float v) const { dst[(size_t)r * ld + c] = f2bf(v); }
  __device__ void chunk(int r, int c, const float* v) const { *(uint4*)(dst + (size_t)r * ld + c) = pack8(v); } };
struct EpiGlu { const bf16_t* z; const float* bias; bf16_t* mix; static constexpr int CHUNK = 1;
  __device__ void operator()(int r, int c, float v) const {
    float zz = bf2f(z[(size_t)r * 512 + c]); float s = v + bias[c]; mix[(size_t)r * 1024 + 512 + c] = f2bf(zz / (1.f + __expf(-s))); }
  __device__ void chunk(int r, int c, const float* v) const {
    float zz[8]; unpack8(*(const uint4*)(z + (size_t)r * 512 + c), zz);
    const float4 b0 = *(const float4*)(bias + c), b1 = *(const float4*)(bias + c + 4);
    const float bb[8] = {b0.x, b0.y, b0.z, b0.w, b1.x, b1.y, b1.z, b1.w};
    float o[8];
#pragma unroll
    for (int i = 0; i < 8; ++i) o[i] = zz[i] / (1.f + __expf(-(v[i] + bb[i])));
    *(uint4*)(mix + (size_t)r * 1024 + 512 + c) = pack8(o); } };
struct EpiRes0 { const float* xp; const float* xs; float* xres; static constexpr int CHUNK = 1;
  __device__ void operator()(int r, int c, float v) const {
    float x = (r < T_P) ? xp[(size_t)r * 1024 + c] : xs[(size_t)(r - T_P) * 1024 + c]; xres[(size_t)r * 1024 + c] = x + v; }
  __device__ void chunk(int r, int c, const float* v) const {
    const float* src = (r < T_P) ? xp + (size_t)r * 1024 + c : xs + (size_t)(r - T_P) * 1024 + c;
    const float4 a = *(const float4*)src, b = *(const float4*)(src + 4);
    float* d = xres + (size_t)r * 1024 + c;
    *(float4*)d = make_float4(a.x + v[0], a.y + v[1], a.z + v[2], a.w + v[3]);
    *(float4*)(d + 4) = make_float4(b.x + v[4], b.y + v[5], b.z + v[6], b.w + v[7]); } };
struct EpiRes1 { float* xres; static constexpr int CHUNK = 1;
  __device__ void operator()(int r, int c, float v) const { xres[(size_t)r * 1024 + c] += v; }
  __device__ void chunk(int r, int c, const float* v) const {
    float* d = xres + (size_t)r * 1024 + c;
    const float4 a = *(const float4*)d, b = *(const float4*)(d + 4);
    *(float4*)d = make_float4(a.x + v[0], a.y + v[1], a.z + v[2], a.w + v[3]);
    *(float4*)(d + 4) = make_float4(b.x + v[4], b.y + v[5], b.z + v[6], b.w + v[7]); } };
struct EpiPool { bf16_t* mix; const float* scale; int g; static constexpr int CHUNK = 0;
  __device__ void operator()(int r, int c, float v) const { mix[(size_t)r * 1024 + g * 128 + c] = f2bf(v * scale[g * 128 + c]); }
  __device__ void chunk(int, int, const float*) const {} };
struct EpiKup { bf16_t* dst; int rowsPerB; int keyOff; int bStride; static constexpr int CHUNK = 1;
  __device__ void operator()(int r, int c, float v) const {
    int b = r / rowsPerB, key = r % rowsPerB + keyOff; dst[((size_t)(b * 8 + (c >> 6)) * bStride + key) * 64 + (c & 63)] = f2bf(v); }
  __device__ void chunk(int r, int c, const float* v) const {
    int b = r / rowsPerB, key = r % rowsPerB + keyOff; *(uint4*)(dst + ((size_t)(b * 8 + (c >> 6)) * bStride + key) * 64 + (c & 63)) = pack8(v); } };
struct EpiVt { bf16_t* dst; int rowsPerB; int keyOff; int ldv; static constexpr int CHUNK = 2;
  __device__ void operator()(int r, int c, float v) const {
    int b = r / rowsPerB, key = r % rowsPerB + keyOff;
    dst[((size_t)(b * 8 + (c >> 6)) * (ldv >> 6) + (key >> 6)) * 4096 + (c & 63) * 64 + (key & 63)] = f2bf(v); }
  __device__ void chunk(int r, int c, const float* v) const {
    int b = r / rowsPerB, key = r % rowsPerB + keyOff;
    *(uint4*)(dst + ((size_t)(b * 8 + (c >> 6)) * (ldv >> 6) + (key >> 6)) * 4096 + (c & 63) * 64 + (key & 63)) = pack8(v); } };


typedef const Params __attribute__((address_space(4))) KParams;

constexpr size_t OFF_BAR = WS_NEED;
__device__ __forceinline__ void grid_barrier(unsigned* ctr, unsigned target) {
  asm volatile("s_waitcnt vmcnt(0)" ::: "memory");
  __syncthreads();
  if (threadIdx.x == 0) {
    __builtin_amdgcn_fence(__ATOMIC_RELEASE, "agent");
    asm volatile("s_waitcnt vmcnt(0)" ::: "memory");
    __hip_atomic_fetch_add(ctr, 1u, __ATOMIC_RELAXED, __HIP_MEMORY_SCOPE_AGENT);
    unsigned spins = 0;
    while (__hip_atomic_load(ctr, __ATOMIC_RELAXED, __HIP_MEMORY_SCOPE_AGENT) < target) {
      __builtin_amdgcn_s_sleep(1);
      if (++spins > (1u << 27)) break;
    }
    __builtin_amdgcn_fence(__ATOMIC_ACQUIRE, "agent");
    asm volatile("s_waitcnt vmcnt(0)" ::: "memory");
  }
  __syncthreads();
}
#define GRID_BAR() { unsigned* ctr_ = (unsigned*)(((KParams*)__builtin_amdgcn_kernarg_segment_ptr())->ws + OFF_BAR); bar_k += 1; grid_barrier(ctr_, (unsigned)bar_k * gridDim.x); }
#define PHASE_BEGIN \
  Params p; \
  { KParams* kp_ = (KParams*)__builtin_amdgcn_kernarg_segment_ptr(); asm volatile("" : "+s"(kp_)); \
    _Pragma("unroll") for (int i_ = 0; i_ < 38; ++i_) p.in[i_] = kp_->in[i_]; \
    p.out = kp_->out; p.ws = kp_->ws; } \
  int tid = threadIdx.x; asm volatile("" : "+v"(tid)); \
  const int lane = tid & 63, w = __builtin_amdgcn_readfirstlane(tid >> 6); \
  const int gw = blockIdx.x * 8 + w, nw = gridDim.x * 8; \
  const size_t gtid = (size_t)blockIdx.x * NT + tid, gthreads = (size_t)gridDim.x * NT; \
  bf16_t* wt = (bf16_t*)(p.ws + OFF_WT); \
  bf16_t* proj = (bf16_t*)(p.ws + OFF_PROJ); \
  bf16_t* mix = (bf16_t*)(p.ws + OFF_MIX); \
  bf16_t* qbuf = (bf16_t*)(p.ws + OFF_QBUF); \
  bf16_t* zbuf = (bf16_t*)(p.ws + OFF_Z); \
  float* xres = p.out + O_Y; \
  (void)lane; (void)gw; (void)nw; (void)gtid; (void)gthreads; (void)wt; (void)proj; (void)mix; (void)qbuf; (void)zbuf; (void)xres;

template <int LAYER>
__device__ __forceinline__ void peer_phases(int& bar_k, unsigned char* smem) {
  const int layer = LAYER;
    for (int rep_ = 0; rep_ < NREP(7); ++rep_)
    {
    PHASE_BEGIN
      int vb = 0;
      gemm_run<2>(tid, smem, xres, xres, T_TOT, 1024, p.in[10] + layer * 1024, wt + WT_PQ + (size_t)layer * 1048576, T_TOT, 1024, 1024, vb, EpiStoreBf16{qbuf, 1024});
    }
    GRID_BAR();
    for (int rep_ = 0; rep_ < NREP(8); ++rep_) {
    PHASE_BEGIN
    {
      TopkFrags fr;
      int item = blockIdx.x;
      if (item < 1056 * 8) topk_load(fr, tid, p, layer, item);
      for (; item < 1056 * 8; item += gridDim.x) {
        TopkFrags cur = fr;
        const int nxt = item + gridDim.x;
        if (nxt < 1056 * 8) topk_load(fr, tid, p, layer, nxt);
        peer_topk_item(tid, smem, p, cur, item);
      }
    }
    }
    GRID_BAR();
    for (int rep_ = 0; rep_ < NREP(9); ++rep_) {
    PHASE_BEGIN
      int j = blockIdx.x & 7, lb = blockIdx.x >> 3, nb = ((int)gridDim.x - j + 7) >> 3;
      {
        unsigned* cnt_ = (unsigned*)(p.ws + OFF_BAR) + 16;
        bool ok_ = true;
#pragma unroll
        for (int x_ = 0; x_ < 16; ++x_) {
          const unsigned c_ = __hip_atomic_load(&cnt_[x_], __ATOMIC_RELAXED, __HIP_MEMORY_SCOPE_AGENT);
          ok_ = ok_ && ((x_ < 8) ? (c_ > 0u) : (c_ == 0u));
        }
        if (ok_) {
          j = ((const int*)(smem + (DYN_LDS - 16)))[0]; lb = ((const int*)(smem + (DYN_LDS - 16)))[1];
          nb = (int)__hip_atomic_load(&cnt_[j], __ATOMIC_RELAXED, __HIP_MEMORY_SCOPE_AGENT);
        }
      }
      for (int tok = lb * 8 + w; tok < T_TOT; tok += nb * 8) peer9a_token(tid, p, layer, tok, j);
    }
    GRID_BAR();
    for (int rep_ = 0; rep_ < NREP(9); ++rep_) {
    PHASE_BEGIN
      for (int tok = gw; tok < T_TOT; tok += nw) peer9m_token(tid, smem, p, tok);
    }
    GRID_BAR();
    for (int rep_ = 0; rep_ < NREP(9); ++rep_) {
    PHASE_BEGIN
      int j = blockIdx.x & 7, lb = blockIdx.x >> 3, nb = ((int)gridDim.x - j + 7) >> 3;
      {
        unsigned* cnt_ = (unsigned*)(p.ws + OFF_BAR) + 16;
        bool ok_ = true;
#pragma unroll
        for (int x_ = 0; x_ < 16; ++x_) {
          const unsigned c_ = __hip_atomic_load(&cnt_[x_], __ATOMIC_RELAXED, __HIP_MEMORY_SCOPE_AGENT);
          ok_ = ok_ && ((x_ < 8) ? (c_ > 0u) : (c_ == 0u));
        }
        if (ok_) {
          j = ((const int*)(smem + (DYN_LDS - 16)))[0]; lb = ((const int*)(smem + (DYN_LDS - 16)))[1];
          nb = (int)__hip_atomic_load(&cnt_[j], __ATOMIC_RELAXED, __HIP_MEMORY_SCOPE_AGENT);
        }
      }
      for (int tok = lb * 8 + w; tok < T_TOT; tok += nb * 8) peer9b_token(tid, p, tok, j);
    }
    if (layer == 1) {
      GRID_BAR();
      for (int rep_ = 0; rep_ < NREP(9); ++rep_) {
      PHASE_BEGIN
        for (int tok = gw; tok < T_TOT; tok += nw) final_norm_token(tid, p, tok);
      }
    }
}

__global__ void __launch_bounds__(NT) mega(Params kparams_) {
  cg::grid_group grid = cg::this_grid();
  int bar_k = 0;
  extern __shared__ __attribute__((aligned(16))) unsigned char smem[];
  if (threadIdx.x == 0) {
    unsigned* cnt_ = (unsigned*)(((KParams*)__builtin_amdgcn_kernarg_segment_ptr())->ws + OFF_BAR) + 16;
    const unsigned xcc_ = (unsigned)__builtin_amdgcn_s_getreg((3 << 11) | 20) & 0xFu;
    const unsigned rank_ = __hip_atomic_fetch_add(&cnt_[xcc_], 1u, __ATOMIC_RELAXED, __HIP_MEMORY_SCOPE_AGENT);
    ((int*)(smem + (DYN_LDS - 16)))[0] = (int)xcc_;
    ((int*)(smem + (DYN_LDS - 16)))[1] = (int)rank_;
  }

  for (int rep_ = 0; rep_ < NREP(0); ++rep_)
  {
    PHASE_BEGIN
    int vb = 0;
    transpose_convert(tid, smem, p.in[12], wt + WT_IN_E, 1024, 1280, vb);
    transpose_convert(tid, smem, p.in[13], wt + WT_OUT_E, 1024, 1024, vb);
    transpose_convert(tid, smem, p.in[23], wt + WT_GLU, 512, 512, vb);
    transpose_convert(tid, smem, p.in[25], wt + WT_IN_O, 1024, 1312, vb);
    transpose_convert(tid, smem, p.in[26], wt + WT_OUT_O, 1024, 1024, vb);
    for (int g = 0; g < 4; ++g) transpose_convert(tid, smem, p.in[27] + g * 16384, wt + WT_POOL + g * 16384, 128, 128, vb);
    transpose_convert(tid, smem, p.in[31], wt + WT_UQ, 512, 768, vb);
    transpose_convert(tid, smem, p.in[32], wt + WT_UK, 256, 512, vb);
    transpose_convert(tid, smem, p.in[33], wt + WT_UV, 256, 512, vb);
    transpose_convert(tid, smem, p.in[34], wt + WT_PQ, 1024, 1024, vb);
    transpose_convert(tid, smem, p.in[34] + 1048576, wt + WT_PQ + 1048576, 1024, 1024, vb);
    convert_plain(tid, p.in[35], wt + WT_KEYS, 262144);
    quant_rows(p.in[36], p.ws + OFF_TAB, (float*)(p.ws + OFF_TAB + TAB_SU_OFF), gw, nw, tid);
    quant_rows(p.in[37], p.ws + OFF_TAB + TAB_V_OFF, (float*)(p.ws + OFF_TAB + TAB_SV_OFF), gw, nw, tid);
  }
  grid.sync();

  for (int rep_ = 0; rep_ < NREP(1); ++rep_)
  {
    PHASE_BEGIN
    int vb = 0;
    gemm_run<2>(tid, smem, p.in[0], p.in[1], T_P, 1024, p.in[9], wt + WT_IN_E, T_TOT, 1280, 1024, vb, EpiStoreBf16{proj, 1280});
  }
  GRID_BAR();

  for (int rep_ = 0; rep_ < NREP(2); ++rep_)
  {
    PHASE_BEGIN
    bf16_t* vt0 = (bf16_t*)(p.ws + OFF_VT0);
    bf16_t* kall = (bf16_t*)(p.ws + OFF_KALL);
    bf16_t* vtall = (bf16_t*)(p.ws + OFF_VTALL);
    for (int tok = gw; tok < T_TOT; tok += nw) {
      const bool isS = tok >= T_P;
      int b, t, pos;
      if (!isS) { b = tok >> 12; t = tok & 4095; pos = t; } else { int s = tok - T_P; b = s >> 5; t = s & 31; pos = 2048 + t; }
      bf16_t* row = proj + (size_t)tok * 1280;
      const int lm = lane & 7;
      float sn[8], cs[8];
#pragma unroll
      for (int j = 0; j < 8; ++j) { float inv = exp2f(-(float)j * (LOG2_THETA / 8.f)); sincos_rev((float)pos * inv, sn[j], cs[j]); }
      {
        uint4 qv = *(const uint4*)(row + lane * 8);
        float x[8]; unpack8(qv, x);
#pragma unroll
        for (int j = 0; j < 8; ++j) {
          float other = __shfl_xor(x[j], 1);
          if (lm == 0) x[j] = x[j] * cs[j] - other * sn[j];
          else if (lm == 1) x[j] = x[j] * cs[j] + other * sn[j];
        }
        *(uint4*)(row + lane * 8) = pack8(x);
      }
      {
        uint4 kv = make_uint4(0, 0, 0, 0);
        if (lane < 32) kv = *(const uint4*)(row + 512 + lane * 8);
        float x[8]; unpack8(kv, x);
#pragma unroll
        for (int j = 0; j < 8; ++j) {
          float other = __shfl_xor(x[j], 1);
          if (lane < 16) {
            if (lm == 0) x[j] = x[j] * cs[j] - other * sn[j];
            else if (lm == 1) x[j] = x[j] * cs[j] + other * sn[j];
          }
        }
        if (lane < 32) {
          const uint4 pk = pack8(x);
          const int e0 = (lane & 15) * 8;
          if (!isS) {
            if (lane < 16) *(uint4*)(row + 512 + lane * 8) = pk;
            else {
              const int kvh = e0 >> 6, d0 = e0 & 63;
#pragma unroll
              for (int j = 0; j < 8; ++j) vt0[((size_t)(b * 2 + kvh) * 64 + d0 + j) * 4096 + t] = f2bf(x[j]);
            }
            if (t >= 3968) {
              float* dst = p.out + ((lane < 16) ? O_SWAK_P : O_SWAV_P) + ((size_t)(b * 128 + (t - 3968)) * 128 + e0);
              *(float4*)dst = make_float4(x[0], x[1], x[2], x[3]);
              *(float4*)(dst + 4) = make_float4(x[4], x[5], x[6], x[7]);
            }
          } else {
            float* dst = p.out + ((lane < 16) ? O_SWAK_S : O_SWAV_S) + ((size_t)(b * 128 + 96 + t) * 128 + e0);
            *(float4*)dst = make_float4(x[0], x[1], x[2], x[3]);
            *(float4*)(dst + 4) = make_float4(x[4], x[5], x[6], x[7]);
            if (lane < 16) *(uint4*)(kall + (size_t)(b * 160 + 128 + t) * 128 + e0) = pk;
            else {
              const int kvh = e0 >> 6, d0 = e0 & 63;
#pragma unroll
              for (int j = 0; j < 8; ++j) vtall[((size_t)(b * 2 + kvh) * 64 + d0 + j) * 192 + 128 + t] = f2bf(x[j]);
            }
          }
        }
      }
    }
    for (size_t idx = gtid; idx < (size_t)32 * 96 * 128; idx += gthreads) {
      const int e = (int)(idx & 127); const int wd = (int)((idx >> 7) % 96); const int b = (int)(idx / (96 * 128));
      const size_t src = ((size_t)(b * 128 + 32 + wd)) * 128 + e, dst = ((size_t)(b * 128 + wd)) * 128 + e;
      p.out[O_SWAK_S + dst] = p.in[2][src];
      p.out[O_SWAV_S + dst] = p.in[3][src];
    }
    for (size_t idx = gtid; idx < (size_t)32 * 128 * 128; idx += gthreads) {
      const int e = (int)(idx & 127); const int key = (int)((idx >> 7) & 127); const int b = (int)(idx >> 14);
      kall[(size_t)(b * 160 + key) * 128 + e] = f2bf(p.in[2][idx]);
      vtall[((size_t)(b * 2 + (e >> 6)) * 64 + (e & 63)) * 192 + key] = f2bf(p.in[3][idx]);
    }
    for (size_t idx = gtid; idx < (size_t)32 * 2 * 64 * 32; idx += gthreads) {
      const int kk = (int)(idx & 31); const size_t rr = idx >> 5;
      vtall[rr * 192 + 160 + kk] = 0;
    }
    float* sUw = (float*)smem + w * 512;
    for (int item = gw; item < 32768; item += nw) s5_item<0>(tid, sUw, p, item);
  }
  GRID_BAR();

  for (int rep_ = 0; rep_ < NREP(3); ++rep_)
  {
    PHASE_BEGIN
    if (gtid < 16384) {
      const int n = (int)(gtid & 63), g = (int)((gtid >> 6) & 31), b = (int)(gtid >> 11);
      const int gn = g * 64 + n;
      const float lr = fminf(p.in[15][gn], -1e-4f), li = p.in[16][gn];
      const float dt = __expf(p.in[17][g]);
      const float mag = __expf(lr * dt);
      float sn, cs; sincos_rev(li * dt, sn, cs);
      float ar = mag * cs, ai = mag * sn;
#pragma unroll
      for (int i = 0; i < 5; ++i) { float nr = ar * ar - ai * ai, ni = 2.f * ar * ai; ar = nr; ai = ni; }
      const float* s1re = (const float*)(p.ws + OFF_QMLA);
      const float* s1im = s1re + 2097152;
      float* hinre = (float*)(p.ws + OFF_QMLA) + 2 * 2097152;
      float* hinim = hinre + 2097152;
      float hr = 0.f, hi = 0.f;
#pragma unroll 8
      for (int c = 0; c < 128; ++c) {
        const size_t idx = ((size_t)(b * 128 + c) * 32 + g) * 64 + n;
        hinre[idx] = hr; hinim[idx] = hi;
        const float sr = s1re[idx], si = s1im[idx];
        const float nhr = ar * hr - ai * hi + sr, nhi = ar * hi + ai * hr + si;
        hr = nhr; hi = nhi;
      }
      p.out[O_SSMRE_P + (size_t)(b * 32 + g) * 64 + n] = hr;
      p.out[O_SSMIM_P + (size_t)(b * 32 + g) * 64 + n] = hi;
    }
    const bf16_t* vt0 = (const bf16_t*)(p.ws + OFF_VT0);
    const bf16_t* kall = (const bf16_t*)(p.ws + OFF_KALL);
    const bf16_t* vtall = (const bf16_t*)(p.ws + OFF_VTALL);
    const float* sink = p.in[14];
    for (int item = blockIdx.x; item < 2048 + 256; item += gridDim.x) {
      AttnDesc d;
      d.scale = 0.125f; d.kx = nullptr; d.pos0 = 0;
      if (item < 2048) {
        const int h = item & 7, pr = (item >> 3) & 31, b = item >> 8;
        const int kvh = h >> 2;
        const int chunk = pr * 2 + (w >> 2);
        const int tok = b * 4096 + chunk * 64 + (w & 3) * 16;
        d.q = proj + (size_t)tok * 1280 + h * 64; d.ldq = 1280; d.active = 1;
        d.kt_lo = max(0, chunk - 2); d.kt_hi = chunk + 1;
        d.out = mix + (size_t)tok * 1024 + h * 64; d.ldo = 1024;
        d.m0 = sink[h]; d.l0 = 1.f;
        d.k = proj + (size_t)(b * 4096) * 1280 + 512 + kvh * 64; d.ldk = 1280;
        d.vt = vt0 + (size_t)(b * 2 + kvh) * 64 * 4096; d.ldv = 4096; d.vts = 64; d.nkeys = 4096;
        d.bt_lo = max(0, pr * 2 - 2); d.bt_hi = pr * 2 + 2;
      } else {
        const int it = item - 2048;
        const int h = it & 7, b = it >> 3;
        const int kvh = h >> 2;
        const int tok = T_P + b * 32 + (w & 1) * 16;
        d.q = proj + (size_t)tok * 1280 + h * 64; d.ldq = 1280; d.active = (w < 2);
        d.kt_lo = 0; d.kt_hi = 3;
        d.out = mix + (size_t)tok * 1024 + h * 64; d.ldo = 1024;
        d.m0 = sink[h]; d.l0 = 1.f;
        d.k = kall + (size_t)(b * 160) * 128 + kvh * 64; d.ldk = 128;
        d.vt = vtall + (size_t)(b * 2 + kvh) * 64 * 192; d.ldv = 192; d.vts = 64; d.nkeys = 160;
        d.bt_lo = 0; d.bt_hi = 3;
      }
      attn_item<64>(tid, smem, d);
    }
  }
  GRID_BAR();

  for (int rep_ = 0; rep_ < NREP(4); ++rep_)
  {
    PHASE_BEGIN
    float* sUw = (float*)smem + w * 512;
    for (int item = gw; item < 33792; item += nw) s5_item<1>(tid, sUw, p, item);
  }
  GRID_BAR();

  for (int rep_ = 0; rep_ < NREP(5); ++rep_)
  {
    PHASE_BEGIN
    int vb = 0;
    gemm_run<0>(tid, smem, zbuf, zbuf, T_TOT, 512, nullptr, wt + WT_GLU, T_TOT, 512, 512, vb, EpiGlu{zbuf, p.in[24], mix});
  }
  GRID_BAR();

  for (int rep_ = 0; rep_ < NREP(6); ++rep_)
  {
    PHASE_BEGIN
    int vb = 0;
    gemm_run<0>(tid, smem, mix, mix, T_TOT, 1024, nullptr, wt + WT_OUT_E, T_TOT, 1024, 1024, vb, EpiRes0{p.in[0], p.in[1], xres});
  }
  GRID_BAR();

  peer_phases<0>(bar_k, smem);
  GRID_BAR();
      for (int rep_ = 0; rep_ < NREP(10); ++rep_)
      {
    PHASE_BEGIN
        int vb = 0;
        gemm_run<2>(tid, smem, xres, xres, T_TOT, 1024, p.in[9] + 1024, wt + WT_IN_O, T_TOT, 1312, 1024, vb, EpiStoreBf16{proj, 1312});
      }
      GRID_BAR();
      for (int rep_ = 0; rep_ < NREP(11); ++rep_)
      {
    PHASE_BEGIN
        bf16_t* cqn = zbuf;
        bf16_t* mbuf = (bf16_t*)(p.ws + OFF_M);
        bf16_t* cbuf = (bf16_t*)(p.ws + OFF_C);
        bf16_t* kpbuf = (bf16_t*)(p.ws + OFF_KP);
        bf16_t* kps = (bf16_t*)(p.ws + OFF_KPS);
        for (int tok = gw; tok < T_TOT; tok += nw) {
          const bool isS = tok >= T_P;
          int b, t, pos;
          if (!isS) { b = tok >> 12; t = tok & 4095; pos = t; } else { int s = tok - T_P; b = s >> 5; t = s & 31; pos = 2048 + t; }
          const bf16_t* row = proj + (size_t)tok * 1312;
          {
            uint4 v = *(const uint4*)(row + lane * 8);
            float x[8]; unpack8(v, x);
            float ss = 0.f;
#pragma unroll
            for (int j = 0; j < 8; ++j) ss += x[j] * x[j];
            ss = wave_sum(ss);
            const float rs = rsqrtf(ss * (1.f / 512.f) + 1e-6f);
            const float4 g0 = *(const float4*)(p.in[29] + lane * 8), g1 = *(const float4*)(p.in[29] + lane * 8 + 4);
            x[0] *= rs * g0.x; x[1] *= rs * g0.y; x[2] *= rs * g0.z; x[3] *= rs * g0.w;
            x[4] *= rs * g1.x; x[5] *= rs * g1.y; x[6] *= rs * g1.z; x[7] *= rs * g1.w;
            *(uint4*)(cqn + (size_t)tok * 512 + lane * 8) = pack8(x);
          }
          {
            uint2 v = *(const uint2*)(row + 512 + lane * 4);
            float x0 = lo2f(v.x), x1 = hi2f(v.x), x2 = lo2f(v.y), x3 = hi2f(v.y);
            float ss = wave_sum(x0 * x0 + x1 * x1 + x2 * x2 + x3 * x3);
            const float rs = rsqrtf(ss * (1.f / 256.f) + 1e-6f);
            const float4 g = *(const float4*)(p.in[30] + lane * 4);
            x0 *= rs * g.x; x1 *= rs * g.y; x2 *= rs * g.z; x3 *= rs * g.w;
            uint2 o; o.x = pack2(x0, x1); o.y = pack2(x2, x3);
            *(uint2*)(cbuf + (size_t)tok * 256 + lane * 4) = o;
            float* dst = isS ? (p.out + O_CKV_S + (size_t)(tok - T_P) * 256 + lane * 4) : (p.out + O_CKV_P + (size_t)tok * 256 + lane * 4);
            *(float4*)dst = make_float4(x0, x1, x2, x3);
          }
          {
            float xv = 0.f;
            if (lane < 32) xv = bf2f(row[768 + lane]);
            const float other = __shfl_xor(xv, 16);
            const int f = lane & 15;
            const float inv = exp2f(-(float)f * (LOG2_THETA / 16.f));
            float sn, cs; sincos_rev((float)pos * inv, sn, cs);
            const float r = (lane < 16) ? (xv * cs - other * sn) : (xv * cs + other * sn);
            if (lane < 32) {
              kpbuf[(size_t)tok * 32 + lane] = f2bf(r);
              if (isS) { p.out[O_KPE_S + (size_t)(tok - T_P) * 32 + lane] = r; kps[((size_t)b * 2112 + 2048 + t) * 32 + lane] = f2bf(r); }
              else p.out[O_KPE_P + (size_t)tok * 32 + lane] = r;
            }
          }
          {
            const int gi = lane >> 4; const int wlen = 2 << gi;
            float tot[8], cur[8];
#pragma unroll
            for (int j = 0; j < 8; ++j) tot[j] = 0.f;
            uint4 v = *(const uint4*)(row + 800 + lane * 8);
            unpack8(v, cur);
#pragma unroll
            for (int j = 0; j < 8; ++j) tot[j] = cur[j];
            uint4 pvv[15];
#pragma unroll
            for (int jb = 1; jb < 16; ++jb) {
              pvv[jb - 1] = make_uint4(0, 0, 0, 0);
              if (jb < wlen && t - jb >= 0) pvv[jb - 1] = *(const uint4*)(row - (size_t)jb * 1312 + 800 + lane * 8);
            }
#pragma unroll
            for (int jb = 1; jb < 16; ++jb) {
              float y[8]; unpack8(pvv[jb - 1], y);
#pragma unroll
              for (int j = 0; j < 8; ++j) tot[j] += y[j];
            }
            if (isS) {
              for (int jb = 1; jb < 16; ++jb) {
                const int tt = t - jb;
                if (jb < wlen && tt < 0) {
                  const float* sp = p.in[6] + ((size_t)b * 15 + (15 + tt)) * 512 + lane * 8;
                  float4 a = *(const float4*)sp, bq = *(const float4*)(sp + 4);
                  tot[0] += a.x; tot[1] += a.y; tot[2] += a.z; tot[3] += a.w; tot[4] += bq.x; tot[5] += bq.y; tot[6] += bq.z; tot[7] += bq.w;
                }
              }
            }
            const float cnt = (float)min(pos + 1, wlen);
            float mm[8];
#pragma unroll
            for (int j = 0; j < 8; ++j) mm[j] = tot[j] / cnt - cur[j];
            *(uint4*)(mbuf + (size_t)tok * 512 + lane * 8) = pack8(mm);
            const int tlen = isS ? 32 : 4096;
            if (t >= tlen - 15) {
              const int i = t - (tlen - 15);
              float* dst = isS ? (p.out + O_POOL_S + ((size_t)b * 15 + i) * 512 + lane * 8) : (p.out + O_POOL_P + ((size_t)b * 15 + i) * 512 + lane * 8);
              *(float4*)dst = make_float4(cur[0], cur[1], cur[2], cur[3]);
              *(float4*)(dst + 4) = make_float4(cur[4], cur[5], cur[6], cur[7]);
            }
          }
        }
        for (size_t idx = gtid; idx < (size_t)32 * 2048 * 32; idx += gthreads) {
          const int e = (int)(idx & 31); const int key = (int)((idx >> 5) & 2047); const int b = (int)(idx >> 16);
          kps[((size_t)b * 2112 + key) * 32 + e] = f2bf(p.in[8][idx]);
        }
      }
      GRID_BAR();
      for (int rep_ = 0; rep_ < NREP(12); ++rep_)
      {
    PHASE_BEGIN
        bf16_t* cqn = zbuf;
        bf16_t* mbuf = (bf16_t*)(p.ws + OFF_M);
        bf16_t* cbuf = (bf16_t*)(p.ws + OFF_C);
        bf16_t* qmla = (bf16_t*)(p.ws + OFF_QMLA);
        bf16_t* kupp = qbuf;
        bf16_t* vtp = qbuf + 16777216;
        bf16_t* kups = (bf16_t*)(p.ws + OFF_KUPS);
        bf16_t* vts = (bf16_t*)(p.ws + OFF_VTS);
        for (size_t idx = gtid; idx < (size_t)32 * 8 * 64 * 32; idx += gthreads) {
          const int kk = (int)(idx & 31); const size_t rr = idx >> 5;
          vts[((rr >> 6) * 33 + 32) * 4096 + (rr & 63) * 64 + 32 + kk] = 0;
        }
        int vb = 0;
        gemm_run<1>(tid, smem, p.in[7], p.in[7], 65536, 256, nullptr, wt + WT_UK, 65536, 512, 256, vb, EpiKup{kups, 2048, 0, 2112});
        gemm_run<1>(tid, smem, p.in[7], p.in[7], 65536, 256, nullptr, wt + WT_UV, 65536, 512, 256, vb, EpiVt{vts, 2048, 0, 2112});
        gemm_run<0>(tid, smem, cqn, cqn, T_TOT, 512, nullptr, wt + WT_UQ, T_TOT, 768, 512, vb, EpiStoreBf16{qmla, 768});
        gemm_run<0>(tid, smem, cbuf, cbuf, T_P, 256, nullptr, wt + WT_UK, T_P, 512, 256, vb, EpiKup{kupp, 4096, 0, 4096});
        gemm_run<0>(tid, smem, cbuf, cbuf, T_P, 256, nullptr, wt + WT_UV, T_P, 512, 256, vb, EpiVt{vtp, 4096, 0, 4096});
        gemm_run<0>(tid, smem, cbuf + (size_t)T_P * 256, cbuf, 1024, 256, nullptr, wt + WT_UK, 1024, 512, 256, vb, EpiKup{kups, 32, 2048, 2112});
        gemm_run<0>(tid, smem, cbuf + (size_t)T_P * 256, cbuf, 1024, 256, nullptr, wt + WT_UV, 1024, 512, 256, vb, EpiVt{vts, 32, 2048, 2112});
        for (int g = 0; g < 4; ++g)
          gemm_run<0>(tid, smem, mbuf + g * 128, mbuf, T_TOT, 512, nullptr, wt + WT_POOL + g * 16384, T_TOT, 128, 128, vb, EpiPool{mix, p.in[28], g});
      }
      GRID_BAR();
      for (int rep_ = 0; rep_ < NREP(13); ++rep_)
      {
    PHASE_BEGIN
        const bf16_t* qmla = (const bf16_t*)(p.ws + OFF_QMLA);
        const bf16_t* kupp = qbuf;
        const bf16_t* vtp = qbuf + 16777216;
        const bf16_t* kups = (const bf16_t*)(p.ws + OFF_KUPS);
        const bf16_t* vts = (const bf16_t*)(p.ws + OFF_VTS);
        const bf16_t* kpbuf = (const bf16_t*)(p.ws + OFF_KP);
        const bf16_t* kps = (const bf16_t*)(p.ws + OFF_KPS);
        const int G = gridDim.x;
        const bool xsched = (G == 256);
        const int nitems = 2048 + 256;
        const int xcd = blockIdx.x & 7, loc = blockIdx.x >> 3;
        for (int k = 0;; ++k) {
          int pit, sit = -1;
          if (xsched) {
            if (k >= 9) break;
            if (k == 0) { pit = -1; sit = blockIdx.x; }
            else {
              const int r = k - 1;
              const int grp = xcd + 8 * r;
              const int pr = (r & 1) ? (31 - loc) : loc;
              pit = ((31 - pr) << 6) | grp;
            }
          } else {
            const int posn = (k & 1) ? (G - 1 - (int)blockIdx.x) : (int)blockIdx.x;
            const int v = k * G + posn;
            if (k * G >= nitems) break;
            if (v >= nitems) continue;
            if (v < 1024) pit = v; else if (v < 1280) { pit = -1; sit = v - 1024; } else pit = v - 256;
          }
          AttnDesc d;
          d.scale = 0.10206207261596575f; d.m0 = -1e30f; d.l0 = 0.f;
          if (pit >= 0) {
            const int pr = 31 - (pit >> 6); const int h = pit & 7, b = (pit >> 3) & 7;
            const int chunk = pr * 2 + (w >> 2);
            const int tok = b * 4096 + chunk * 64 + (w & 3) * 16;
            d.q = qmla + (size_t)tok * 768 + h * 96; d.ldq = 768; d.active = 1; d.pos0 = chunk * 64 + (w & 3) * 16;
            d.kt_lo = 0; d.kt_hi = chunk + 1;
            d.out = mix + (size_t)tok * 1024 + 512 + h * 64; d.ldo = 1024;
            d.k = kupp + (size_t)(b * 8 + h) * 4096 * 64; d.ldk = 64;
            d.kx = kpbuf + (size_t)(b * 4096) * 32;
            d.vt = vtp + (size_t)(b * 8 + h) * 64 * 4096; d.ldv = 64; d.vts = 4096; d.nkeys = 4096;
            d.bt_lo = 0; d.bt_hi = pr * 2 + 2;
          } else {
            const int h = sit & 7, b = sit >> 3;
            const int tok = T_P + b * 32 + (w & 1) * 16;
            d.q = qmla + (size_t)tok * 768 + h * 96; d.ldq = 768; d.active = (w < 2); d.pos0 = 2048 + (w & 1) * 16;
            d.kt_lo = 0; d.kt_hi = 33;
            d.out = mix + (size_t)tok * 1024 + 512 + h * 64; d.ldo = 1024;
            d.k = kups + (size_t)(b * 8 + h) * 2112 * 64; d.ldk = 64;
            d.kx = kps + (size_t)(b * 2112) * 32;
            d.vt = vts + (size_t)(b * 8 + h) * 64 * 2112; d.ldv = 64; d.vts = 4096; d.nkeys = 2080;
            d.bt_lo = 0; d.bt_hi = 33;
          }
          attn_item<96>(tid, smem, d);
        }
      }
      GRID_BAR();
      for (int rep_ = 0; rep_ < NREP(14); ++rep_)
      {
    PHASE_BEGIN
        quant_rows(p.in[36] + 16777216, p.ws + OFF_TAB, (float*)(p.ws + OFF_TAB + TAB_SU_OFF), gw, nw, tid);
        quant_rows(p.in[37] + 16777216, p.ws + OFF_TAB + TAB_V_OFF, (float*)(p.ws + OFF_TAB + TAB_SV_OFF), gw, nw, tid);
        int vb = 0;
        gemm_run<0>(tid, smem, mix, mix, T_TOT, 1024, nullptr, wt + WT_OUT_O, T_TOT, 1024, 1024, vb, EpiRes1{xres});
      }
      GRID_BAR();
  peer_phases<1>(bar_k, smem);
}

extern "C" void kernel_launch(void* const* d_in, const int* in_sizes, int n_in, void* d_out, int out_size, void* d_ws, size_t ws_size, hipStream_t stream) {
  static int grid_blocks = 0;
  if (grid_blocks == 0) {
    int dev = 0, cus = 0, per_cu = 0;
    hipGetDevice(&dev);
    hipDeviceGetAttribute(&cus, hipDeviceAttributeMultiprocessorCount, dev);
    hipFuncSetAttribute((const void*)mega, hipFuncAttributeMaxDynamicSharedMemorySize, DYN_LDS);
    hipOccupancyMaxActiveBlocksPerMultiprocessor(&per_cu, (const void*)mega, NT, DYN_LDS);
    if (per_cu < 1) per_cu = 1;
    if (per_cu > 1) per_cu = 1;
    grid_blocks = cus * per_cu;
    if (ws_size < WS_NEED + 256) fprintf(stderr, "kernel_launch: workspace too small: %zu < %zu\n", ws_size, (size_t)WS_NEED);
  }
  hipMemsetAsync((unsigned char*)d_ws + OFF_BAR, 0, 256, stream);
  Params p{};
  for (int i = 0; i < 38; ++i) p.in[i] = (const float*)d_in[i];
  p.out = (float*)d_out;
  p.ws = (unsigned char*)d_ws;
  void* args[] = {&p};
  hipError_t e = hipLaunchCooperativeKernel((const void*)mega, dim3(grid_blocks), dim3(NT), args, DYN_LDS, stream);
  if (e != hipSuccess) fprintf(stderr, "cooperative launch failed: %s (grid %d)\n", hipGetErrorString(e), grid_blocks);
}
```
